# Optimizing an MI355X kernel written in HIP

```python
import math
import jax, jax.numpy as jnp
from jax import lax
import numpy as np

D_MODEL = 1024
BATCH = 8
SEQ = 4096
DEPTH = 4

CHUNK = 64
Q_BLOCK = 128
EPS = 1e-6

SSM_WIDTH = 256
SSM_GROUP = 16
N_SSM_GROUPS = SSM_WIDTH // SSM_GROUP
SSM_STATE = 64
DT_MIN = 1e-3
DT_MAX = 1e-1

MLA_HEADS = 6
MLA_Q_RANK = 256
MLA_KV_RANK = 128
MLA_NOPE = 64
MLA_ROPE = 32
MLA_V = 64
MLA_QK = MLA_NOPE + MLA_ROPE
MLA_WIDTH = MLA_HEADS * MLA_V
ROPE_BASE = 10000.0

FOX_HEADS = 6
FOX_HEAD_DIM = 64
FOX_WIDTH = FOX_HEADS * FOX_HEAD_DIM

D_MIX = SSM_WIDTH + MLA_WIDTH + FOX_WIDTH
IN_SPLITS = (
    SSM_WIDTH,
    SSM_WIDTH + MLA_Q_RANK,
    SSM_WIDTH + MLA_Q_RANK + MLA_KV_RANK,
    SSM_WIDTH + MLA_Q_RANK + MLA_KV_RANK + MLA_ROPE,
    SSM_WIDTH + MLA_Q_RANK + MLA_KV_RANK + MLA_ROPE + FOX_WIDTH,
    SSM_WIDTH + MLA_Q_RANK + MLA_KV_RANK + MLA_ROPE + 2 * FOX_WIDTH,
    SSM_WIDTH + MLA_Q_RANK + MLA_KV_RANK + MLA_ROPE + 3 * FOX_WIDTH,
)
IN_COLS = SSM_WIDTH + MLA_Q_RANK + MLA_KV_RANK + MLA_ROPE + 3 * FOX_WIDTH + FOX_HEADS

D_FF = 2816
N_EXPERTS = 8
TOP_K = 2
D_FF_EXPERT = 1408
N_DENSE = (DEPTH + 1) // 2
N_MOE = DEPTH // 2

kernel_name = "hybrid_s5_mla_fox_moe_encoder"


def rms_norm(x, g):
    xf = x.astype(jnp.float32)
    y = xf * lax.rsqrt(jnp.mean(xf * xf, axis=-1, keepdims=True) + EPS)
    return (y * g.astype(jnp.float32)).astype(x.dtype)


def modulate(h, shift, scale):
    return h * (1.0 + scale[:, None, :]) + shift[:, None, :]


def rope_tables(positions):
    half = MLA_ROPE // 2
    inv = ROPE_BASE ** (-jnp.arange(half, dtype=jnp.float32) / half)
    ang = positions.astype(jnp.float32)[..., None] * inv
    return jnp.cos(ang), jnp.sin(ang)


def apply_rope(x, cos, sin):
    half = x.shape[-1] // 2
    x1 = x[..., :half].astype(jnp.float32)
    x2 = x[..., half:].astype(jnp.float32)
    cs = cos[:, :, None, :]
    sn = sin[:, :, None, :]
    return jnp.concatenate([x1 * cs - x2 * sn, x1 * sn + x2 * cs], axis=-1).astype(x.dtype)


def chunk_causal(t_pos, s_pos):
    return (s_pos // CHUNK) <= (t_pos // CHUNK)


def frame_causal(t_pos, s_pos):
    return s_pos <= t_pos


def block_sweep(q, k, v, scale, mask_fn, log_decay=None):
    L = q.shape[2]
    outs = []
    for qb in range(L // Q_BLOCK):
        q0, q1 = qb * Q_BLOCK, (qb + 1) * Q_BLOCK
        s = jnp.einsum("bhqd,bhkd->bhqk", q[:, :, q0:q1], k[:, :, :q1]).astype(jnp.float32) * scale
        if log_decay is not None:
            s = s + log_decay[:, :, q0:q1, None] - log_decay[:, :, None, :q1]
        t_pos = jnp.arange(q0, q1)[:, None]
        s_pos = jnp.arange(q1)[None, :]
        s = jnp.where(mask_fn(t_pos, s_pos), s, -jnp.inf)
        p = jax.nn.softmax(s, axis=-1)
        outs.append(jnp.einsum("bhqk,bhkd->bhqd", p.astype(v.dtype), v[:, :, :q1]))
    return jnp.concatenate(outs, axis=2)


def s5_mixer(u, lam_re, lam_im, log_dt, b_re, b_im, c_re, c_im, d_skip, w_glu, b_glu):
    Bn, L, _ = u.shape
    f32 = jnp.float32
    uf = u.astype(f32)
    ug = uf.reshape(Bn, L, N_SSM_GROUPS, SSM_GROUP)
    lam = lax.complex(lam_re.astype(f32), lam_im.astype(f32))
    dt = jnp.exp(log_dt.astype(f32))[:, None]
    lam_bar = jnp.exp(lam * dt)
    b = lax.complex(b_re.astype(f32), b_im.astype(f32))
    b_bar = ((lam_bar - 1.0) / lam)[..., None] * b
    bu = jnp.einsum("gpc,blgc->blgp", b_bar, ug)
    a = jnp.broadcast_to(lam_bar, bu.shape)

    def combine(left, right):
        a_l, b_l = left
        a_r, b_r = right
        return a_r * a_l, a_r * b_l + b_r

    _, states = lax.associative_scan(combine, (a, bu), axis=1)
    cmat = lax.complex(c_re.astype(f32), c_im.astype(f32))
    y = jnp.real(jnp.einsum("gcp,blgp->blgc", cmat, states)).reshape(Bn, L, SSM_WIDTH)
    y = jax.nn.gelu(y + d_skip.astype(f32) * uf)
    out = y * jax.nn.sigmoid(y @ w_glu.astype(f32) + b_glu.astype(f32))
    return out.astype(u.dtype)


def hybrid_mixer(h, cos, sin, w_in, lam_re, lam_im, log_dt, b_re, b_im, c_re, c_im, d_skip,
                 w_glu, b_glu, q_norm, kv_norm, w_uq, w_ukv, mla_gq, mla_gk,
                 fox_bf, fox_gq, fox_gk, out_norm, w_out):
    Bn, L, _ = h.shape
    proj = h @ w_in
    u, cq, ckv, kr, fq, fk, fv, fg = jnp.split(proj, IN_SPLITS, axis=-1)

    o_ssm = s5_mixer(u, lam_re, lam_im, log_dt, b_re, b_im, c_re, c_im, d_skip, w_glu, b_glu)

    q = (rms_norm(cq, q_norm) @ w_uq).reshape(Bn, L, MLA_HEADS, MLA_QK)
    kv = (rms_norm(ckv, kv_norm) @ w_ukv).reshape(Bn, L, MLA_HEADS, MLA_NOPE + MLA_V)
    k_nope, v_mla = kv[..., :MLA_NOPE], kv[..., MLA_NOPE:]
    k_rope = jnp.broadcast_to(kr[:, :, None, :], (Bn, L, MLA_HEADS, MLA_ROPE))
    k = jnp.concatenate([k_nope, k_rope], axis=-1)
    q = rms_norm(q, mla_gq)
    k = rms_norm(k, mla_gk)
    q = jnp.concatenate([q[..., :MLA_NOPE], apply_rope(q[..., MLA_NOPE:], cos, sin)], axis=-1)
    k = jnp.concatenate([k[..., :MLA_NOPE], apply_rope(k[..., MLA_NOPE:], cos, sin)], axis=-1)
    o_mla = block_sweep(q.transpose(0, 2, 1, 3), k.transpose(0, 2, 1, 3), v_mla.transpose(0, 2, 1, 3),
                        1.0 / math.sqrt(MLA_QK), chunk_causal)
    o_mla = o_mla.transpose(0, 2, 1, 3).reshape(Bn, L, MLA_WIDTH)

    fqh = rms_norm(fq.reshape(Bn, L, FOX_HEADS, FOX_HEAD_DIM), fox_gq)
    fkh = rms_norm(fk.reshape(Bn, L, FOX_HEADS, FOX_HEAD_DIM), fox_gk)
    fvh = fv.reshape(Bn, L, FOX_HEADS, FOX_HEAD_DIM)
    log_f = jax.nn.log_sigmoid(fg.astype(jnp.float32) + fox_bf.astype(jnp.float32))
    cum_log_f = jnp.cumsum(log_f, axis=1).transpose(0, 2, 1)
    o_fox = block_sweep(fqh.transpose(0, 2, 1, 3), fkh.transpose(0, 2, 1, 3), fvh.transpose(0, 2, 1, 3),
                        1.0 / math.sqrt(FOX_HEAD_DIM), frame_causal, log_decay=cum_log_f)
    o_fox = o_fox.transpose(0, 2, 1, 3).reshape(Bn, L, FOX_WIDTH)

    e1 = SSM_WIDTH
    e2 = SSM_WIDTH + MLA_WIDTH
    merged = jnp.concatenate([
        rms_norm(o_ssm, out_norm[:e1]),
        rms_norm(o_mla.astype(h.dtype), out_norm[e1:e2]),
        rms_norm(o_fox.astype(h.dtype), out_norm[e2:]),
    ], axis=-1)
    return merged @ w_out


def swiglu(t, w_gate, w_up, w_down):
    return (jax.nn.silu(t @ w_gate) * (t @ w_up)) @ w_down


def moe_ffn(h, w_router, b_router, w_gate, w_up, w_down):
    Bn, L, D = h.shape
    t = h.reshape(Bn * L, D)
    logits = (t @ w_router).astype(jnp.float32) + b_router.astype(jnp.float32)
    top_v, top_i = lax.top_k(logits, TOP_K)
    p = jax.nn.softmax(top_v, axis=-1)
    combine = jnp.sum(jax.nn.one_hot(top_i, N_EXPERTS, dtype=jnp.float32) * p[..., None], axis=1)
    out = jnp.zeros_like(t)
    for e in range(N_EXPERTS):
        out = out + combine[:, e:e + 1].astype(t.dtype) * swiglu(t, w_gate[e], w_up[e], w_down[e])
    return out.reshape(Bn, L, D)


def setup_inputs(seed: int = 0) -> dict:
    key = jax.random.key(seed)
    keys = iter(jax.random.split(key, 48))
    f32 = jnp.float32

    def nrm(shape, std):
        return std * jax.random.normal(next(keys), shape, f32)

    def gain(shape):
        return 1.0 + nrm(shape, 0.02)

    x = jax.random.normal(next(keys), (BATCH, SEQ, D_MODEL), f32)
    c = jax.random.normal(next(keys), (BATCH, D_MODEL), f32)
    offset = jax.random.randint(next(keys), (BATCH,), 0, 64, jnp.int32) * CHUNK
    positions = (offset[:, None] + jnp.arange(SEQ, dtype=jnp.int32)[None, :]).astype(jnp.int32)

    G, P = N_SSM_GROUPS, SSM_STATE
    lam_im_base = jnp.pi * jnp.arange(P, dtype=f32)
    log_dt = jax.random.uniform(next(keys), (DEPTH, G), f32, math.log(DT_MIN), math.log(DT_MAX))

    return {
        "x": x,
        "c": c,
        "positions": positions,
        "norm_mix": gain((DEPTH, D_MODEL)),
        "norm_ffn": gain((DEPTH, D_MODEL)),
        "w_ada": nrm((DEPTH, D_MODEL, 6 * D_MODEL), 0.5 * D_MODEL ** -0.5),
        "b_ada": nrm((DEPTH, 6 * D_MODEL), 0.02),
        "w_in": nrm((DEPTH, D_MODEL, IN_COLS), D_MODEL ** -0.5),
        "ssm_lam_re": -0.5 + nrm((DEPTH, G, P), 0.01),
        "ssm_lam_im": lam_im_base + nrm((DEPTH, G, P), 0.01),
        "ssm_log_dt": log_dt,
        "ssm_b_re": nrm((DEPTH, G, P, SSM_GROUP), (2 * SSM_GROUP) ** -0.5),
        "ssm_b_im": nrm((DEPTH, G, P, SSM_GROUP), (2 * SSM_GROUP) ** -0.5),
        "ssm_c_re": nrm((DEPTH, G, SSM_GROUP, P), 0.5),
        "ssm_c_im": nrm((DEPTH, G, SSM_GROUP, P), 0.5),
        "ssm_d": nrm((DEPTH, SSM_WIDTH), 1.0),
        "ssm_w_glu": nrm((DEPTH, SSM_WIDTH, SSM_WIDTH), SSM_WIDTH ** -0.5),
        "ssm_b_glu": nrm((DEPTH, SSM_WIDTH), 0.02),
        "mla_q_norm": gain((DEPTH, MLA_Q_RANK)),
        "mla_kv_norm": gain((DEPTH, MLA_KV_RANK)),
        "mla_w_uq": nrm((DEPTH, MLA_Q_RANK, MLA_HEADS * MLA_QK), MLA_Q_RANK ** -0.5),
        "mla_w_ukv": nrm((DEPTH, MLA_KV_RANK, MLA_HEADS * (MLA_NOPE + MLA_V)), MLA_KV_RANK ** -0.5),
        "mla_qk_gq": gain((DEPTH, MLA_QK)),
        "mla_qk_gk": gain((DEPTH, MLA_QK)),
        "fox_b_f": 3.0 + nrm((DEPTH, FOX_HEADS), 0.5),
        "fox_qk_gq": gain((DEPTH, FOX_HEAD_DIM)),
        "fox_qk_gk": gain((DEPTH, FOX_HEAD_DIM)),
        "out_norm": gain((DEPTH, D_MIX)),
        "w_out": nrm((DEPTH, D_MIX, D_MODEL), D_MIX ** -0.5),
        "ffn_w_gate": nrm((N_DENSE, D_MODEL, D_FF), D_MODEL ** -0.5),
        "ffn_w_up": nrm((N_DENSE, D_MODEL, D_FF), D_MODEL ** -0.5),
        "ffn_w_down": nrm((N_DENSE, D_FF, D_MODEL), D_FF ** -0.5),
        "moe_w_router": nrm((N_MOE, D_MODEL, N_EXPERTS), D_MODEL ** -0.5),
        "moe_b_router": nrm((N_MOE, N_EXPERTS), 0.01),
        "moe_w_gate": nrm((N_MOE, N_EXPERTS, D_MODEL, D_FF_EXPERT), D_MODEL ** -0.5),
        "moe_w_up": nrm((N_MOE, N_EXPERTS, D_MODEL, D_FF_EXPERT), D_MODEL ** -0.5),
        "moe_w_down": nrm((N_MOE, N_EXPERTS, D_FF_EXPERT, D_MODEL), D_FF_EXPERT ** -0.5),
    }


def reference(x, c, positions, norm_mix, norm_ffn, w_ada, b_ada, w_in,
              ssm_lam_re, ssm_lam_im, ssm_log_dt, ssm_b_re, ssm_b_im, ssm_c_re, ssm_c_im,
              ssm_d, ssm_w_glu, ssm_b_glu,
              mla_q_norm, mla_kv_norm, mla_w_uq, mla_w_ukv, mla_qk_gq, mla_qk_gk,
              fox_b_f, fox_qk_gq, fox_qk_gk, out_norm, w_out,
              ffn_w_gate, ffn_w_up, ffn_w_down,
              moe_w_router, moe_b_router, moe_w_gate, moe_w_up, moe_w_down):
    cos, sin = rope_tables(positions)
    c_act = jax.nn.silu(c)
    for i in range(DEPTH):
        ada = c_act @ w_ada[i] + b_ada[i]
        sh1, sc1, g1, sh2, sc2, g2 = jnp.split(ada, 6, axis=-1)

        h = modulate(rms_norm(x, norm_mix[i]), sh1, sc1)
        mix = hybrid_mixer(h, cos, sin, w_in[i],
                           ssm_lam_re[i], ssm_lam_im[i], ssm_log_dt[i], ssm_b_re[i], ssm_b_im[i],
                           ssm_c_re[i], ssm_c_im[i], ssm_d[i], ssm_w_glu[i], ssm_b_glu[i],
                           mla_q_norm[i], mla_kv_norm[i], mla_w_uq[i], mla_w_ukv[i],
                           mla_qk_gq[i], mla_qk_gk[i],
                           fox_b_f[i], fox_qk_gq[i], fox_qk_gk[i], out_norm[i], w_out[i])
        x = x + g1[:, None, :] * mix

        h = modulate(rms_norm(x, norm_ffn[i]), sh2, sc2)
        j = i // 2
        if i % 2 == 0:
            ff = swiglu(h, ffn_w_gate[j], ffn_w_up[j], ffn_w_down[j])
        else:
            ff = moe_ffn(h, moe_w_router[j], moe_b_router[j], moe_w_gate[j], moe_w_up[j], moe_w_down[j])
        x = x + g2[:, None, :] * ff
    return x
```

```cpp
#include <hip/hip_runtime.h>
#include <stdint.h>
#include <math.h>

typedef unsigned short bf16_t;
typedef float f32x4 __attribute__((ext_vector_type(4)));
typedef unsigned u32x2 __attribute__((ext_vector_type(2)));
typedef unsigned u32x4 __attribute__((ext_vector_type(4)));

constexpr int NB = 8, SEQ = 4096, T = NB * SEQ, D = 1024, DEPTH = 4;
constexpr int INC = 1830, PJ = 2048;
constexpr int PC_U = 0, PC_CQ = 256, PC_CKV = 512, PC_KR = 640, PC_FQ = 768, PC_FK = 1152, PC_FV = 1536, PC_FG = 1920;
constexpr int DFF = 2816, NEXP = 8, DFE = 1408;
constexpr float EPS = 1e-6f;
constexpr float LOG2E = 1.4426950408889634f;
constexpr float C2_MLA = 0.10206207261596577f * LOG2E;
constexpr float C2_FOX = 0.125f * LOG2E;
constexpr int NSLOT = 2 * T + NEXP * 256;

constexpr size_t MiB = 1u << 20;
constexpr size_t WS_CTL = 0, CTL_BYTES = 1 * MiB;
constexpr size_t WS_ADA = 1 * MiB;
constexpr size_t WS_COS = 2 * MiB, WS_SIN = 4 * MiB;
constexpr size_t WS_RSTDQ = 6 * MiB, WS_RSTDKV = 6 * MiB + 128 * 1024;
constexpr size_t WS_FG = 7 * MiB;
constexpr size_t WS_CLOC = 8 * MiB;
constexpr size_t WS_CTOT = 8 * MiB + 896 * 1024;
constexpr size_t WS_CB2 = 9 * MiB;
constexpr size_t WS_TOKINFO = 10 * MiB;
constexpr size_t WS_PROB = 10 * MiB + 512 * 1024;
constexpr size_t WS_SLOTOF = 10 * MiB + 768 * 1024;
constexpr size_t WS_P2E = 11 * MiB;
constexpr size_t WS_YG = 20 * MiB;
constexpr size_t WS_OSSM = 36 * MiB;
constexpr size_t WS_HBUF = 168 * MiB;
constexpr size_t WS_BIG = 232 * MiB;
constexpr size_t WS_PROJ = WS_BIG;
constexpr size_t WS_QRAW = WS_BIG + 128 * MiB;
constexpr size_t WS_KVRAW = WS_BIG + 176 * MiB;
constexpr size_t WS_QMLA = WS_BIG + 224 * MiB;
constexpr size_t WS_KMLA = WS_BIG + 260 * MiB;
constexpr size_t WS_OBUF = WS_BIG + 296 * MiB;
constexpr size_t WS_ACT = WS_BIG;
constexpr size_t WS_HG = WS_BIG;
constexpr size_t WS_ACTM = WS_BIG + 132 * MiB;
constexpr size_t WS_END = WS_BIG + 344 * MiB;

constexpr int CW_CNT = 1024;

struct Params {
    const float* x; const float* c; const int* pos; const float* norm_mix; const float* norm_ffn; const float* w_ada; const float* b_ada; const float* w_in;
    const float* lam_re; const float* lam_im; const float* log_dt; const float* b_re; const float* b_im; const float* c_re; const float* c_im;
    const float* ssm_d; const float* w_glu; const float* b_glu;
    const float* q_norm; const float* kv_norm; const float* w_uq; const float* w_ukv; const float* mla_gq; const float* mla_gk;
    const float* fox_bf; const float* fox_gq; const float* fox_gk; const float* out_norm; const float* w_out;
    const float* ffn_wg; const float* ffn_wu; const float* ffn_wd;
    const float* moe_wr; const float* moe_br; const float* moe_wg; const float* moe_wu; const float* moe_wd;
    float* out; unsigned char* ws;
};

__device__ __forceinline__ float bf2f(bf16_t h) { return __uint_as_float(((unsigned)h) << 16); }
__device__ __forceinline__ bf16_t f2bf(float f) { unsigned u = __float_as_uint(f); return (bf16_t)((u + 0x7fffu + ((u >> 16) & 1u)) >> 16); }
__device__ __forceinline__ unsigned pk2(float lo, float hi) { return (unsigned)f2bf(lo) | ((unsigned)f2bf(hi) << 16); }
__device__ __forceinline__ float wsum(float v) {
#pragma unroll
    for (int o = 32; o > 0; o >>= 1) v += __shfl_xor(v, o);
    return v;
}
__device__ __forceinline__ float silu_f(float v) { return v / (1.f + __expf(-v)); }
__device__ __forceinline__ float sigmoid_f(float v) { return 1.f / (1.f + __expf(-v)); }
__device__ __forceinline__ float gelu_tanh(float x) { return 0.5f * x * (1.f + tanhf(0.7978845608028654f * (x + 0.044715f * x * x * x))); }
__device__ __forceinline__ float* adap(const Params& P, int layer, int b, int which) { return (float*)(P.ws + WS_ADA) + ((size_t)(layer * NB + b) * 6 + which) * D; }

template <class FA, class FT, class FB, class FS>
__device__ __forceinline__ void naive_gemm(int M, int N, int K, FA fa, FT ft, FB fb, FS fs, float* sm) {
    const int tid = threadIdx.x, ty = tid >> 5, tx = tid & 31;
    float (*As)[132] = (float (*)[132])sm;
    float (*Bs)[132] = (float (*)[132])(sm + 16 * 132);
    const int tm = (M + 127) / 128, tn = (N + 127) / 128;
    for (int tile = blockIdx.x; tile < tm * tn; tile += gridDim.x) {
        const int bm = (tile / tn) * 128, bn = (tile % tn) * 128;
        const int ctx = ft(bm);
        float acc[8][4];
#pragma unroll
        for (int i = 0; i < 8; ++i)
#pragma unroll
            for (int j = 0; j < 4; ++j) acc[i][j] = 0.f;
        for (int k0 = 0; k0 < K; k0 += 16) {
#pragma unroll
            for (int j = 0; j < 4; ++j) {
                const int e = tid + 512 * j, r = e >> 4, kk = e & 15;
                As[kk][r] = (bm + r < M) ? fa(bm + r, k0 + kk) : 0.f;
                const int k2 = e >> 7, cc = e & 127;
                Bs[k2][cc] = (bn + cc < N) ? fb(k0 + k2, bn + cc, ctx) : 0.f;
            }
            __syncthreads();
#pragma unroll
            for (int kk = 0; kk < 16; ++kk) {
                const f32x4 a0 = *(const f32x4*)&As[kk][ty * 8], a1 = *(const f32x4*)&As[kk][ty * 8 + 4], b = *(const f32x4*)&Bs[kk][tx * 4];
                const float a[8] = {a0[0], a0[1], a0[2], a0[3], a1[0], a1[1], a1[2], a1[3]};
#pragma unroll
                for (int i = 0; i < 8; ++i)
#pragma unroll
                    for (int j = 0; j < 4; ++j) acc[i][j] = fmaf(a[i], b[j], acc[i][j]);
            }
            __syncthreads();
        }
#pragma unroll
        for (int i = 0; i < 8; ++i) { const int row = bm + ty * 8 + i; if (row < M) fs(row, bn + tx * 4, acc[i]); }
    }
}

__global__ void __launch_bounds__(512) k_prologue(Params P) {
    __shared__ float cact[NB * D];
    for (int i = threadIdx.x; i < NB * D; i += 512) cact[i] = silu_f(P.c[i]);
    __syncthreads();
    float* ada = (float*)(P.ws + WS_ADA);
    const int gt = blockIdx.x * 512 + threadIdx.x, nt = gridDim.x * 512;
    for (int idx = gt; idx < DEPTH * 6 * D; idx += nt) {
        const int layer = idx / (6 * D), j = idx % (6 * D);
        const float* w = P.w_ada + (size_t)layer * D * 6 * D + j;
        float acc[NB];
#pragma unroll
        for (int b = 0; b < NB; ++b) acc[b] = 0.f;
        for (int k = 0; k < D; ++k) { const float wv = w[(size_t)k * 6 * D];
#pragma unroll
            for (int b = 0; b < NB; ++b) acc[b] = fmaf(cact[b * D + k], wv, acc[b]); }
        const float bb = P.b_ada[layer * 6 * D + j];
#pragma unroll
        for (int b = 0; b < NB; ++b) ada[(size_t)(layer * NB + b) * 6 * D + j] = acc[b] + bb;
    }
    float* cs = (float*)(P.ws + WS_COS); float* sn = (float*)(P.ws + WS_SIN);
    for (int idx = gt; idx < T * 16; idx += nt) {
        const int t = idx >> 4, j = idx & 15;
        const float inv = powf(10000.f, -(float)j / 16.f);
        const double ang = (double)P.pos[t] * pow(10000.0, -(double)j / 16.0); (void)inv;
        cs[idx] = (float)cos(ang); sn[idx] = (float)sin(ang);
    }
}

template <int MODE>
__global__ void __launch_bounds__(512) k_norm(Params P, int layer, const float* src, int copy) {
    const int wid = threadIdx.x >> 6, lane = threadIdx.x & 63;
    const float* gain = (MODE == 0 ? P.norm_mix : P.norm_ffn) + layer * D;
    bf16_t* hb = (bf16_t*)(P.ws + WS_HBUF);
    for (int row = blockIdx.x * 8 + wid; row < T; row += gridDim.x * 8) {
        const int b = row / SEQ;
        const float* sh = adap(P, layer, b, MODE == 0 ? 0 : 3); const float* sc = adap(P, layer, b, MODE == 0 ? 1 : 4);
        f32x4 v[4]; float ss = 0.f;
#pragma unroll
        for (int q = 0; q < 4; ++q) { v[q] = *(const f32x4*)(src + (size_t)row * D + q * 256 + lane * 4); ss += v[q][0] * v[q][0] + v[q][1] * v[q][1] + v[q][2] * v[q][2] + v[q][3] * v[q][3]; }
        if (MODE == 0 && copy) {
#pragma unroll
            for (int q = 0; q < 4; ++q) *(f32x4*)(P.out + (size_t)row * D + q * 256 + lane * 4) = v[q];
        }
        ss = wsum(ss);
        const float rstd = rsqrtf(ss * (1.f / D) + EPS);
        float lg[NEXP];
#pragma unroll
        for (int e = 0; e < NEXP; ++e) lg[e] = 0.f;
#pragma unroll
        for (int q = 0; q < 4; ++q) {
            const int col = q * 256 + lane * 4;
            const f32x4 g = *(const f32x4*)(gain + col), s1 = *(const f32x4*)(sc + col), s0 = *(const f32x4*)(sh + col);
            float h[4];
#pragma unroll
            for (int j = 0; j < 4; ++j) h[j] = v[q][j] * rstd * g[j] * (1.f + s1[j]) + s0[j];
            u32x2 o; o.x = pk2(h[0], h[1]); o.y = pk2(h[2], h[3]);
            *(u32x2*)(hb + (size_t)row * D + col) = o;
            if (MODE == 2) {
                const float* wr = P.moe_wr + (size_t)(layer / 2) * D * NEXP + (size_t)col * NEXP;
#pragma unroll
                for (int j = 0; j < 4; ++j) { const f32x4 w0 = *(const f32x4*)(wr + j * 8), w1 = *(const f32x4*)(wr + j * 8 + 4);
                    lg[0] += h[j] * w0[0]; lg[1] += h[j] * w0[1]; lg[2] += h[j] * w0[2]; lg[3] += h[j] * w0[3];
                    lg[4] += h[j] * w1[0]; lg[5] += h[j] * w1[1]; lg[6] += h[j] * w1[2]; lg[7] += h[j] * w1[3]; }
            }
        }
        if (MODE == 2) {
#pragma unroll
            for (int e = 0; e < NEXP; ++e) lg[e] = wsum(lg[e]) + P.moe_br[(layer / 2) * NEXP + e];
            if (lane == 0) {
                int i0 = 0; float v0 = lg[0];
#pragma unroll
                for (int e = 1; e < NEXP; ++e) if (lg[e] > v0) { v0 = lg[e]; i0 = e; }
                int i1 = -1; float v1 = -INFINITY;
#pragma unroll
                for (int e = 0; e < NEXP; ++e) if (e != i0 && lg[e] > v1) { v1 = lg[e]; i1 = e; }
                const float p0 = 1.f / (1.f + expf(v1 - v0)), p1 = 1.f - p0;
                unsigned* cnt = (unsigned*)(P.ws + WS_CTL) + CW_CNT + 16 * (layer / 2);
                const int pos0 = (int)atomicAdd(cnt + i0, 1u), pos1 = (int)atomicAdd(cnt + i1, 1u);
                int* ti = (int*)(P.ws + WS_TOKINFO) + (size_t)row * 4; ti[0] = i0; ti[1] = pos0; ti[2] = i1; ti[3] = pos1;
                float* pr = (float*)(P.ws + WS_PROB) + (size_t)row * 2; pr[0] = p0; pr[1] = p1;
            }
        }
    }
}

__device__ __forceinline__ int proj_orig_col(int col) { return col < 672 ? col : (col < 768 ? -1 : (col < 1926 ? col - 96 : -1)); }
__global__ void __launch_bounds__(512) k_inproj_naive(Params P, int layer) {
    __shared__ float sm[2 * 16 * 132];
    const bf16_t* hb = (const bf16_t*)(P.ws + WS_HBUF); const float* w = P.w_in + (size_t)layer * D * INC;
    bf16_t* proj = (bf16_t*)(P.ws + WS_PROJ); float* fg = (float*)(P.ws + WS_FG);
    naive_gemm(T, PJ, D,
        [&](int r, int k) { return bf2f(hb[(size_t)r * D + k]); },
        [&](int) { return 0; },
        [&](int k, int col, int) { const int oc = proj_orig_col(col); return oc < 0 ? 0.f : w[(size_t)k * INC + oc]; },
        [&](int r, int c0, const float (&v)[4]) {
            u32x2 o; o.x = pk2(v[0], v[1]); o.y = pk2(v[2], v[3]); *(u32x2*)(proj + (size_t)r * PJ + c0) = o;
            if (c0 >= PC_FG && c0 < PC_FG + 8) { *(f32x4*)(fg + (size_t)r * 8 + (c0 - PC_FG)) = (f32x4){v[0], v[1], v[2], v[3]}; }
        }, sm);
}

__global__ void __launch_bounds__(512) k_passC(Params P, int layer) {
    __shared__ float lfs[128][8];
    const int wid = threadIdx.x >> 6, lane = threadIdx.x & 63;
    bf16_t* proj = (bf16_t*)(P.ws + WS_PROJ); const float* fg = (const float*)(P.ws + WS_FG);
    float* rq = (float*)(P.ws + WS_RSTDQ); float* rkv = (float*)(P.ws + WS_RSTDKV);
    float* cloc = (float*)(P.ws + WS_CLOC); float* ctot = (float*)(P.ws + WS_CTOT);
    const float gq = P.fox_gq[layer * 64 + lane] * C2_FOX, gk = P.fox_gk[layer * 64 + lane];
    for (int chunk = blockIdx.x; chunk < T / 128; chunk += gridDim.x) {
        for (int i = 0; i < 16; ++i) {
            const int tl = wid * 16 + i, row = chunk * 128 + tl;
            bf16_t* pr = proj + (size_t)row * PJ;
            { const u32x2 w = *(const u32x2*)(pr + PC_CQ + lane * 4); const float a = bf2f(w.x & 0xffff), b = bf2f(w.x >> 16), c = bf2f(w.y & 0xffff), d = bf2f(w.y >> 16);
              const float ss = wsum(a * a + b * b + c * c + d * d); if (lane == 0) rq[row] = rsqrtf(ss * (1.f / 256.f) + EPS); }
            { const unsigned w = *(const unsigned*)(pr + PC_CKV + lane * 2); const float a = bf2f(w & 0xffff), b = bf2f(w >> 16);
              const float ss = wsum(a * a + b * b); if (lane == 0) rkv[row] = rsqrtf(ss * (1.f / 128.f) + EPS); }
#pragma unroll
            for (int h = 0; h < 6; ++h) {
                const float a = bf2f(pr[PC_FQ + h * 64 + lane]); const float ra = rsqrtf(wsum(a * a) * (1.f / 64.f) + EPS); pr[PC_FQ + h * 64 + lane] = f2bf(a * ra * gq);
                const float b = bf2f(pr[PC_FK + h * 64 + lane]); const float rb = rsqrtf(wsum(b * b) * (1.f / 64.f) + EPS); pr[PC_FK + h * 64 + lane] = f2bf(b * rb * gk);
            }
            if (lane < 6) { const float z = fg[(size_t)row * 8 + lane] + P.fox_bf[layer * 6 + lane];
                lfs[tl][lane] = z >= 0.f ? -log1pf(expf(-z)) : z - log1pf(expf(z)); }
        }
        __syncthreads();
        if (threadIdx.x < 6) {
            const int h = threadIdx.x, b = (chunk * 128) / SEQ, t0 = (chunk * 128) % SEQ; float run = 0.f;
            for (int j = 0; j < 128; ++j) { run += lfs[j][h]; cloc[((size_t)b * 6 + h) * SEQ + t0 + j] = run; }
            ctot[chunk * 8 + h] = run;
        }
        __syncthreads();
    }
}

__global__ void __launch_bounds__(512) k_qup_naive(Params P, int layer) {
    __shared__ float sm[2 * 16 * 132];
    const bf16_t* proj = (const bf16_t*)(P.ws + WS_PROJ); const float* rq = (const float*)(P.ws + WS_RSTDQ);
    const float* w = P.w_uq + (size_t)layer * 256 * 576; const float* g = P.q_norm + layer * 256; bf16_t* qraw = (bf16_t*)(P.ws + WS_QRAW);
    naive_gemm(T, 576, 256,
        [&](int r, int k) { return bf2f(proj[(size_t)r * PJ + PC_CQ + k]); },
        [&](int) { return 0; },
        [&](int k, int col, int) { return g[k] * w[(size_t)k * 576 + col]; },
        [&](int r, int c0, const float (&v)[4]) { const float s = rq[r]; u32x2 o; o.x = pk2(v[0] * s, v[1] * s); o.y = pk2(v[2] * s, v[3] * s); *(u32x2*)(qraw + (size_t)r * 768 + c0) = o; }, sm);
}
__global__ void __launch_bounds__(512) k_kvup_naive(Params P, int layer) {
    __shared__ float sm[2 * 16 * 132];
    const bf16_t* proj = (const bf16_t*)(P.ws + WS_PROJ); const float* rk = (const float*)(P.ws + WS_RSTDKV);
    const float* w = P.w_ukv + (size_t)layer * 128 * 768; const float* g = P.kv_norm + layer * 128; bf16_t* kvraw = (bf16_t*)(P.ws + WS_KVRAW);
    naive_gemm(T, 768, 128,
        [&](int r, int k) { return bf2f(proj[(size_t)r * PJ + PC_CKV + k]); },
        [&](int) { return 0; },
        [&](int k, int col, int) { return g[k] * w[(size_t)k * 768 + col]; },
        [&](int r, int c0, const float (&v)[4]) { const float s = rk[r]; u32x2 o; o.x = pk2(v[0] * s, v[1] * s); o.y = pk2(v[2] * s, v[3] * s); *(u32x2*)(kvraw + (size_t)r * 768 + c0) = o; }, sm);
}

__global__ void __launch_bounds__(512) k_passE(Params P, int layer) {
    __shared__ float pref[8];
    const int wid = threadIdx.x >> 6, lane = threadIdx.x & 63;
    const bf16_t* proj = (const bf16_t*)(P.ws + WS_PROJ); const bf16_t* qraw = (const bf16_t*)(P.ws + WS_QRAW); const bf16_t* kvraw = (const bf16_t*)(P.ws + WS_KVRAW);
    bf16_t* qm = (bf16_t*)(P.ws + WS_QMLA); bf16_t* km = (bf16_t*)(P.ws + WS_KMLA);
    const float* cs = (const float*)(P.ws + WS_COS); const float* sn = (const float*)(P.ws + WS_SIN);
    const float* cloc = (const float*)(P.ws + WS_CLOC); const float* ctot = (const float*)(P.ws + WS_CTOT); float* cb2 = (float*)(P.ws + WS_CB2);
    const float gqa = P.mla_gq[layer * 96 + lane], gqb = lane < 32 ? P.mla_gq[layer * 96 + 64 + lane] : 0.f;
    const float gka = P.mla_gk[layer * 96 + lane], gkb = lane < 32 ? P.mla_gk[layer * 96 + 64 + lane] : 0.f;
    for (int chunk = blockIdx.x; chunk < T / 128; chunk += gridDim.x) {
        const int b = (chunk * 128) / SEQ, t0 = (chunk * 128) % SEQ, ci = chunk % 32;
        if (threadIdx.x < 6) { float s = 0.f; for (int c = 0; c < ci; ++c) s += ctot[(b * 32 + c) * 8 + threadIdx.x]; pref[threadIdx.x] = s; }
        __syncthreads();
        for (int e = threadIdx.x; e < 6 * 128; e += 512) { const int h = e / 128, j = e % 128; const size_t ix = ((size_t)b * 6 + h) * SEQ + t0 + j; cb2[ix] = (cloc[ix] + pref[h]) * LOG2E; }
        for (int i = 0; i < 16; ++i) {
            const int row = chunk * 128 + wid * 16 + i;
            const float cv = cs[(size_t)row * 16 + (lane & 15)], sv = sn[(size_t)row * 16 + (lane & 15)];
#pragma unroll
            for (int h = 0; h < 6; ++h) {
                {
                    const float a = bf2f(qraw[(size_t)row * 768 + h * 96 + lane]); const float bq = lane < 32 ? bf2f(qraw[(size_t)row * 768 + h * 96 + 64 + lane]) : 0.f;
                    const float r = rsqrtf(wsum(a * a + bq * bq) * (1.f / 96.f) + EPS);
                    const float an = a * r * gqa, bn = bq * r * gqb; const float pn = __shfl_xor(bn, 16);
                    const float ro = lane < 16 ? bn * cv - pn * sv : pn * sv + bn * cv;
                    qm[(size_t)row * 576 + h * 96 + lane] = f2bf(an * C2_MLA); if (lane < 32) qm[(size_t)row * 576 + h * 96 + 64 + lane] = f2bf(ro * C2_MLA);
                }
                {
                    const float a = bf2f(kvraw[(size_t)row * 768 + h * 128 + lane]); const float bk = lane < 32 ? bf2f(proj[(size_t)row * PJ + PC_KR + lane]) : 0.f;
                    const float r = rsqrtf(wsum(a * a + bk * bk) * (1.f / 96.f) + EPS);
                    const float an = a * r * gka, bn = bk * r * gkb; const float pn = __shfl_xor(bn, 16);
                    const float ro = lane < 16 ? bn * cv - pn * sv : pn * sv + bn * cv;
                    km[(size_t)row * 576 + h * 96 + lane] = f2bf(an); if (lane < 32) km[(size_t)row * 576 + h * 96 + 64 + lane] = f2bf(ro);
                }
            }
        }
        __syncthreads();
    }
}

template <int DQK, int MODE>
__global__ void __launch_bounds__(512) k_attn_naive(const bf16_t* Q, int ldq, const bf16_t* K, int ldk, const bf16_t* V, int ldv, int vhs, bf16_t* O, int ldo, const float* cb2) {
    __shared__ float Ks[64][DQK]; __shared__ float Vs[64][64]; __shared__ float cbs[64];
    const int tid = threadIdx.x;
    for (int item = blockIdx.x; item < NB * 6 * 8; item += gridDim.x) {
        const int qb = 7 - (item / 48), bh = item % 48, b = bh / 6, h = bh % 6;
        const int q = qb * 512 + tid; const size_t rowq = (size_t)b * SEQ + q;
        float qv[DQK], o[64];
#pragma unroll
        for (int d = 0; d < DQK; ++d) qv[d] = bf2f(Q[rowq * ldq + h * DQK + d]);
#pragma unroll
        for (int d = 0; d < 64; ++d) o[d] = 0.f;
        float m = -INFINITY, l = 0.f;
        const float* cbp = MODE == 1 ? cb2 + ((size_t)b * 6 + h) * SEQ : nullptr;
        const int kend = qb * 512 + 512;
        for (int k0 = 0; k0 < kend; k0 += 64) {
            __syncthreads();
            for (int e = tid; e < 64 * DQK; e += 512) { const int j = e / DQK, d = e % DQK; Ks[j][d] = bf2f(K[((size_t)b * SEQ + k0 + j) * ldk + h * DQK + d]); }
            for (int e = tid; e < 64 * 64; e += 512) { const int j = e >> 6, d = e & 63; Vs[j][d] = bf2f(V[((size_t)b * SEQ + k0 + j) * ldv + h * vhs + d]); }
            if (MODE == 1 && tid < 64) cbs[tid] = cbp[k0 + tid];
            __syncthreads();
            for (int j = 0; j < 64; ++j) {
                const int key = k0 + j;
                const bool ok = MODE == 0 ? ((key >> 6) <= (q >> 6)) : (key <= q);
                if (ok) {
                    float s = 0.f;
#pragma unroll
                    for (int d = 0; d < DQK; d += 4) { const f32x4 kk = *(const f32x4*)&Ks[j][d]; s += qv[d] * kk[0] + qv[d + 1] * kk[1] + qv[d + 2] * kk[2] + qv[d + 3] * kk[3]; }
                    if (MODE == 1) s -= cbs[j];
                    if (s > m) { const float f = exp2f(m - s); l *= f;
#pragma unroll
                        for (int d = 0; d < 64; ++d) o[d] *= f;
                        m = s; }
                    const float p = exp2f(s - m); l += p;
#pragma unroll
                    for (int d = 0; d < 64; d += 4) { const f32x4 vv = *(const f32x4*)&Vs[j][d]; o[d] += p * vv[0]; o[d + 1] += p * vv[1]; o[d + 2] += p * vv[2]; o[d + 3] += p * vv[3]; }
                }
            }
        }
        const float il = 1.f / l;
#pragma unroll
        for (int d = 0; d < 64; d += 2) *(unsigned*)(O + rowq * ldo + h * 64 + d) = pk2(o[d] * il, o[d + 1] * il);
    }
}

__global__ void __launch_bounds__(512) k_ssm_naive(Params P, int layer) {
    __shared__ float smy[8][16 * 64];
    const int wid = threadIdx.x >> 6, lane = threadIdx.x & 63;
    float* sm = smy[wid];
    const bf16_t* proj = (const bf16_t*)(P.ws + WS_PROJ); bf16_t* yg = (bf16_t*)(P.ws + WS_YG);
    for (int item = blockIdx.x * 8 + wid; item < NB * 16; item += gridDim.x * 8) {
        const int b = item / 16, g = item % 16, p = lane;
        const size_t gp = ((size_t)layer * 16 + g) * 64 + p;
        const double lre = P.lam_re[gp], lim = P.lam_im[gp], dt = exp((double)P.log_dt[layer * 16 + g]);
        const double er = exp(lre * dt), lbr = er * cos(lim * dt), lbi = er * sin(lim * dt);
        const double dd = lre * lre + lim * lim, qr = ((lbr - 1.0) * lre + lbi * lim) / dd, qi = (lbi * lre - (lbr - 1.0) * lim) / dd;
        float bbr[16], bbi[16], cr[16], ci[16];
#pragma unroll
        for (int c = 0; c < 16; ++c) {
            const double bre = P.b_re[gp * 16 + c], bim = P.b_im[gp * 16 + c];
            bbr[c] = (float)(qr * bre - qi * bim); bbi[c] = (float)(qr * bim + qi * bre);
            cr[c] = P.c_re[(((size_t)layer * 16 + g) * 16 + c) * 64 + p]; ci[c] = P.c_im[(((size_t)layer * 16 + g) * 16 + c) * 64 + p];
        }
        const float lr = (float)lbr, li = (float)lbi;
        const float dsk = P.ssm_d[layer * 256 + g * 16 + (lane & 15)];
        float sr = 0.f, si = 0.f;
        for (int t = 0; t < SEQ; ++t) {
            const size_t row = (size_t)b * SEQ + t;
            const bf16_t* up = proj + row * PJ + g * 16;
            const u32x4 w0 = *(const u32x4*)up, w1 = *(const u32x4*)(up + 8);
            const unsigned ww[8] = {w0.x, w0.y, w0.z, w0.w, w1.x, w1.y, w1.z, w1.w};
            float bur = 0.f, bui = 0.f;
#pragma unroll
            for (int c = 0; c < 16; ++c) { const float u = (c & 1) ? bf2f(ww[c >> 1] >> 16) : bf2f(ww[c >> 1] & 0xffff); bur = fmaf(bbr[c], u, bur); bui = fmaf(bbi[c], u, bui); }
            const float nsr = lr * sr - li * si + bur, nsi = lr * si + li * sr + bui; sr = nsr; si = nsi;
#pragma unroll
            for (int c = 0; c < 16; ++c) sm[c * 64 + lane] = cr[c] * sr - ci[c] * si;
            asm volatile("s_waitcnt lgkmcnt(0)" ::: "memory");
            const int cc = lane & 15, qd = lane >> 4; float part = 0.f;
#pragma unroll
            for (int j = 0; j < 16; ++j) part += sm[cc * 64 + qd * 16 + j];
            part += __shfl_xor(part, 16); part += __shfl_xor(part, 32);
            asm volatile("s_waitcnt lgkmcnt(0)" ::: "memory");
            if (lane < 16) { const float uv = bf2f(up[lane]); yg[row * 256 + g * 16 + lane] = f2bf(gelu_tanh(part + dsk * uv)); }
        }
    }
}

__global__ void __launch_bounds__(512) k_glu_naive(Params P, int layer) {
    __shared__ float sm[2 * 16 * 132];
    const bf16_t* yg = (const bf16_t*)(P.ws + WS_YG); bf16_t* os = (bf16_t*)(P.ws + WS_OSSM);
    const float* w = P.w_glu + (size_t)layer * 256 * 256; const float* bg = P.b_glu + layer * 256;
    naive_gemm(T, 256, 256,
        [&](int r, int k) { return bf2f(yg[(size_t)r * 256 + k]); },
        [&](int) { return 0; },
        [&](int k, int col, int) { return w[(size_t)k * 256 + col]; },
        [&](int r, int c0, const float (&v)[4]) {
            float o[4];
#pragma unroll
            for (int j = 0; j < 4; ++j) o[j] = bf2f(yg[(size_t)r * 256 + c0 + j]) * sigmoid_f(v[j] + bg[c0 + j]);
            u32x2 w2; w2.x = pk2(o[0], o[1]); w2.y = pk2(o[2], o[3]); *(u32x2*)(os + (size_t)r * 256 + c0) = w2; }, sm);
}

__global__ void __launch_bounds__(512) k_merge(Params P) {
    const int wid = threadIdx.x >> 6, lane = threadIdx.x & 63;
    const bf16_t* os = (const bf16_t*)(P.ws + WS_OSSM); const bf16_t* ob = (const bf16_t*)(P.ws + WS_OBUF); bf16_t* hb = (bf16_t*)(P.ws + WS_HBUF);
    for (int row = blockIdx.x * 8 + wid; row < T; row += gridDim.x * 8) {
        { const u32x2 w = *(const u32x2*)(os + (size_t)row * 256 + lane * 4); const float a = bf2f(w.x & 0xffff), b = bf2f(w.x >> 16), c = bf2f(w.y & 0xffff), d = bf2f(w.y >> 16);
          const float r = rsqrtf(wsum(a * a + b * b + c * c + d * d) * (1.f / 256.f) + EPS); u32x2 o; o.x = pk2(a * r, b * r); o.y = pk2(c * r, d * r); *(u32x2*)(hb + (size_t)row * D + lane * 4) = o; }
#pragma unroll
        for (int part = 0; part < 2; ++part) {
            const bf16_t* src = ob + (size_t)row * 768 + part * 384 + lane * 6;
            const unsigned w0 = *(const unsigned*)src, w1 = *(const unsigned*)(src + 2), w2 = *(const unsigned*)(src + 4);
            const float v[6] = {bf2f(w0 & 0xffff), bf2f(w0 >> 16), bf2f(w1 & 0xffff), bf2f(w1 >> 16), bf2f(w2 & 0xffff), bf2f(w2 >> 16)};
            float ss = 0.f;
#pragma unroll
            for (int j = 0; j < 6; ++j) ss += v[j] * v[j];
            const float r = rsqrtf(wsum(ss) * (1.f / 384.f) + EPS);
            unsigned* dst = (unsigned*)(hb + (size_t)row * D + 256 + part * 384 + lane * 6);
            dst[0] = pk2(v[0] * r, v[1] * r); dst[1] = pk2(v[2] * r, v[3] * r); dst[2] = pk2(v[4] * r, v[5] * r);
        }
    }
}

__global__ void __launch_bounds__(512) k_outproj_naive(Params P, int layer) {
    __shared__ float sm[2 * 16 * 132];
    const bf16_t* hb = (const bf16_t*)(P.ws + WS_HBUF); const float* w = P.w_out + (size_t)layer * D * D; const float* g = P.out_norm + layer * D;
    naive_gemm(T, D, D,
        [&](int r, int k) { return bf2f(hb[(size_t)r * D + k]); },
        [&](int) { return 0; },
        [&](int k, int col, int) { return g[k] * w[(size_t)k * D + col]; },
        [&](int r, int c0, const float (&v)[4]) {
            const float* g1 = adap(P, layer, r / SEQ, 2) + c0; f32x4* xp = (f32x4*)(P.out + (size_t)r * D + c0); f32x4 xv = *xp;
#pragma unroll
            for (int j = 0; j < 4; ++j) xv[j] += g1[j] * v[j];
            *xp = xv; }, sm);
}

__global__ void __launch_bounds__(512) k_ffn1_naive(Params P, int layer) {
    __shared__ float sm[2 * 16 * 132];
    const bf16_t* hb = (const bf16_t*)(P.ws + WS_HBUF); bf16_t* act = (bf16_t*)(P.ws + WS_ACT);
    const float* wg = P.ffn_wg + (size_t)(layer / 2) * D * DFF; const float* wu = P.ffn_wu + (size_t)(layer / 2) * D * DFF;
    naive_gemm(T, 2 * DFF, D,
        [&](int r, int k) { return bf2f(hb[(size_t)r * D + k]); },
        [&](int) { return 0; },
        [&](int k, int col, int) { return (col & 1) ? wu[(size_t)k * DFF + (col >> 1)] : wg[(size_t)k * DFF + (col >> 1)]; },
        [&](int r, int c0, const float (&v)[4]) { *(unsigned*)(act + (size_t)r * DFF + (c0 >> 1)) = pk2(silu_f(v[0]) * v[1], silu_f(v[2]) * v[3]); }, sm);
}
__global__ void __launch_bounds__(512) k_ffn2_naive(Params P, int layer) {
    __shared__ float sm[2 * 16 * 132];
    const bf16_t* act = (const bf16_t*)(P.ws + WS_ACT); const float* w = P.ffn_wd + (size_t)(layer / 2) * DFF * D;
    naive_gemm(T, D, DFF,
        [&](int r, int k) { return bf2f(act[(size_t)r * DFF + k]); },
        [&](int) { return 0; },
        [&](int k, int col, int) { return w[(size_t)k * D + col]; },
        [&](int r, int c0, const float (&v)[4]) {
            const float* g2 = adap(P, layer, r / SEQ, 5) + c0; f32x4* xp = (f32x4*)(P.out + (size_t)r * D + c0); f32x4 xv = *xp;
#pragma unroll
            for (int j = 0; j < 4; ++j) xv[j] += g2[j] * v[j];
            *xp = xv; }, sm);
}

__device__ __forceinline__ void moe_offsets(const Params& P, int layer, int (&off)[NEXP + 1]) {
    const unsigned* cnt = (const unsigned*)(P.ws + WS_CTL) + CW_CNT + 16 * (layer / 2);
    int o = 0;
#pragma unroll
    for (int e = 0; e < NEXP; ++e) { off[e] = o; o += (int)((cnt[e] + 255u) >> 8) << 8; }
    off[NEXP] = o;
}
__global__ void __launch_bounds__(512) k_moe_gather(Params P, int layer) {
    const int wid = threadIdx.x >> 6, lane = threadIdx.x & 63;
    int off[NEXP + 1]; moe_offsets(P, layer, off);
    int* p2e = (int*)(P.ws + WS_P2E);
    if (blockIdx.x == 0) {
        for (int pnl = threadIdx.x; pnl < 272; pnl += 512) { int e = 0;
#pragma unroll
            for (int j = 1; j < NEXP; ++j) if (pnl * 256 >= off[j]) e = j;
            p2e[pnl] = e; }
        if (threadIdx.x == 0) p2e[300] = off[NEXP] >> 8;
    }
    const bf16_t* hb = (const bf16_t*)(P.ws + WS_HBUF); bf16_t* hg = (bf16_t*)(P.ws + WS_HG);
    const int* ti = (const int*)(P.ws + WS_TOKINFO); int* so = (int*)(P.ws + WS_SLOTOF);
    for (int row = blockIdx.x * 8 + wid; row < T; row += gridDim.x * 8) {
        const u32x4 v0 = *(const u32x4*)(hb + (size_t)row * D + lane * 8), v1 = *(const u32x4*)(hb + (size_t)row * D + 512 + lane * 8);
#pragma unroll
        for (int k = 0; k < 2; ++k) {
            const int e = ti[(size_t)row * 4 + 2 * k], pos = ti[(size_t)row * 4 + 2 * k + 1];
            int base = 0;
#pragma unroll
            for (int j = 0; j < NEXP; ++j) if (e == j) base = off[j];
            const int slot = base + pos;
            *(u32x4*)(hg + (size_t)slot * D + lane * 8) = v0; *(u32x4*)(hg + (size_t)slot * D + 512 + lane * 8) = v1;
            if (lane == 0) so[(size_t)row * 2 + k] = slot;
        }
    }
}
__global__ void __launch_bounds__(512) k_moe1_naive(Params P, int layer) {
    __shared__ float sm[2 * 16 * 132];
    const bf16_t* hg = (const bf16_t*)(P.ws + WS_HG); bf16_t* act = (bf16_t*)(P.ws + WS_ACTM); const int* p2e = (const int*)(P.ws + WS_P2E);
    const float* wg = P.moe_wg + (size_t)(layer / 2) * NEXP * D * DFE; const float* wu = P.moe_wu + (size_t)(layer / 2) * NEXP * D * DFE;
    const int M = p2e[300] * 256;
    naive_gemm(M, 2 * DFE, D,
        [&](int r, int k) { return bf2f(hg[(size_t)r * D + k]); },
        [&](int bm) { return p2e[bm >> 8]; },
        [&](int k, int col, int e) { const size_t o = ((size_t)e * D + k) * DFE + (col >> 1); return (col & 1) ? wu[o] : wg[o]; },
        [&](int r, int c0, const float (&v)[4]) { *(unsigned*)(act + (size_t)r * DFE + (c0 >> 1)) = pk2(silu_f(v[0]) * v[1], silu_f(v[2]) * v[3]); }, sm);
}
__global__ void __launch_bounds__(512) k_moe2_naive(Params P, int layer) {
    __shared__ float sm[2 * 16 * 132];
    const bf16_t* act = (const bf16_t*)(P.ws + WS_ACTM); bf16_t* ym = (bf16_t*)(P.ws + WS_HG); const int* p2e = (const int*)(P.ws + WS_P2E);
    const float* wd = P.moe_wd + (size_t)(layer / 2) * NEXP * DFE * D;
    const int M = p2e[300] * 256;
    naive_gemm(M, D, DFE,
        [&](int r, int k) { return bf2f(act[(size_t)r * DFE + k]); },
        [&](int bm) { return p2e[bm >> 8]; },
        [&](int k, int col, int e) { return wd[((size_t)e * DFE + k) * D + col]; },
        [&](int r, int c0, const float (&v)[4]) { u32x2 o; o.x = pk2(v[0], v[1]); o.y = pk2(v[2], v[3]); *(u32x2*)(ym + (size_t)r * D + c0) = o; }, sm);
}
__global__ void __launch_bounds__(512) k_moe_combine(Params P, int layer) {
    const int wid = threadIdx.x >> 6, lane = threadIdx.x & 63;
    const bf16_t* ym = (const bf16_t*)(P.ws + WS_HG); const int* so = (const int*)(P.ws + WS_SLOTOF); const float* pr = (const float*)(P.ws + WS_PROB);
    for (int row = blockIdx.x * 8 + wid; row < T; row += gridDim.x * 8) {
        const int s0 = so[(size_t)row * 2], s1 = so[(size_t)row * 2 + 1]; const float p0 = pr[(size_t)row * 2], p1 = pr[(size_t)row * 2 + 1];
        const float* g2 = adap(P, layer, row / SEQ, 5);
#pragma unroll
        for (int q = 0; q < 4; ++q) {
            const int col = q * 256 + lane * 4;
            const u32x2 a = *(const u32x2*)(ym + (size_t)s0 * D + col), b = *(const u32x2*)(ym + (size_t)s1 * D + col);
            f32x4* xp = (f32x4*)(P.out + (size_t)row * D + col); f32x4 xv = *xp; const f32x4 g = *(const f32x4*)(g2 + col);
            xv[0] += g[0] * (p0 * bf2f(a.x & 0xffff) + p1 * bf2f(b.x & 0xffff)); xv[1] += g[1] * (p0 * bf2f(a.x >> 16) + p1 * bf2f(b.x >> 16));
            xv[2] += g[2] * (p0 * bf2f(a.y & 0xffff) + p1 * bf2f(b.y & 0xffff)); xv[3] += g[3] * (p0 * bf2f(a.y >> 16) + p1 * bf2f(b.y >> 16));
            *xp = xv;
        }
    }
}

extern "C" void kernel_launch(void* const* d_in, const int* in_sizes, int n_in, void* d_out, int out_size, void* d_ws, size_t ws_size, hipStream_t stream) {
    if (ws_size < WS_END || n_in < 37) return;
    Params P{};
    P.x = (const float*)d_in[0]; P.c = (const float*)d_in[1]; P.pos = (const int*)d_in[2]; P.norm_mix = (const float*)d_in[3]; P.norm_ffn = (const float*)d_in[4];
    P.w_ada = (const float*)d_in[5]; P.b_ada = (const float*)d_in[6]; P.w_in = (const float*)d_in[7];
    P.lam_re = (const float*)d_in[8]; P.lam_im = (const float*)d_in[9]; P.log_dt = (const float*)d_in[10]; P.b_re = (const float*)d_in[11]; P.b_im = (const float*)d_in[12];
    P.c_re = (const float*)d_in[13]; P.c_im = (const float*)d_in[14]; P.ssm_d = (const float*)d_in[15]; P.w_glu = (const float*)d_in[16]; P.b_glu = (const float*)d_in[17];
    P.q_norm = (const float*)d_in[18]; P.kv_norm = (const float*)d_in[19]; P.w_uq = (const float*)d_in[20]; P.w_ukv = (const float*)d_in[21]; P.mla_gq = (const float*)d_in[22]; P.mla_gk = (const float*)d_in[23];
    P.fox_bf = (const float*)d_in[24]; P.fox_gq = (const float*)d_in[25]; P.fox_gk = (const float*)d_in[26]; P.out_norm = (const float*)d_in[27]; P.w_out = (const float*)d_in[28];
    P.ffn_wg = (const float*)d_in[29]; P.ffn_wu = (const float*)d_in[30]; P.ffn_wd = (const float*)d_in[31];
    P.moe_wr = (const float*)d_in[32]; P.moe_br = (const float*)d_in[33]; P.moe_wg = (const float*)d_in[34]; P.moe_wu = (const float*)d_in[35]; P.moe_wd = (const float*)d_in[36];
    P.out = (float*)d_out; P.ws = (unsigned char*)d_ws;
    hipMemsetAsync(d_ws, 0, CTL_BYTES, stream);
    const bf16_t* proj = (const bf16_t*)(P.ws + WS_PROJ);
    k_prologue<<<256, 512, 0, stream>>>(P);
    for (int layer = 0; layer < DEPTH; ++layer) {
        k_norm<0><<<1024, 512, 0, stream>>>(P, layer, layer == 0 ? P.x : P.out, layer == 0 ? 1 : 0);
        k_inproj_naive<<<1024, 512, 0, stream>>>(P, layer);
        k_passC<<<256, 512, 0, stream>>>(P, layer);
        k_qup_naive<<<1024, 512, 0, stream>>>(P, layer);
        k_kvup_naive<<<1024, 512, 0, stream>>>(P, layer);
        k_passE<<<256, 512, 0, stream>>>(P, layer);
        k_attn_naive<96, 0><<<384, 512, 0, stream>>>((const bf16_t*)(P.ws + WS_QMLA), 576, (const bf16_t*)(P.ws + WS_KMLA), 576, (const bf16_t*)(P.ws + WS_KVRAW) + 64, 768, 128, (bf16_t*)(P.ws + WS_OBUF), 768, nullptr);
        k_attn_naive<64, 1><<<384, 512, 0, stream>>>(proj + PC_FQ, PJ, proj + PC_FK, PJ, proj + PC_FV, PJ, 64, (bf16_t*)(P.ws + WS_OBUF) + 384, 768, (const float*)(P.ws + WS_CB2));
        k_ssm_naive<<<16, 512, 0, stream>>>(P, layer);
        k_glu_naive<<<512, 512, 0, stream>>>(P, layer);
        k_merge<<<1024, 512, 0, stream>>>(P);
        k_outproj_naive<<<1024, 512, 0, stream>>>(P, layer);
        if ((layer & 1) == 0) {
            k_norm<1><<<1024, 512, 0, stream>>>(P, layer, P.out, 0);
            k_ffn1_naive<<<2048, 512, 0, stream>>>(P, layer);
            k_ffn2_naive<<<1024, 512, 0, stream>>>(P, layer);
        } else {
            k_norm<2><<<1024, 512, 0, stream>>>(P, layer, P.out, 0);
            k_moe_gather<<<1024, 512, 0, stream>>>(P, layer);
            k_moe1_naive<<<2048, 512, 0, stream>>>(P, layer);
            k_moe2_naive<<<1024, 512, 0, stream>>>(P, layer);
            k_moe_combine<<<1024, 512, 0, stream>>>(P, layer);
        }
    }
}
```

```cpp
#include <hip/hip_runtime.h>
#include <stdint.h>
#include <math.h>

typedef unsigned short bf16_t;
typedef float f32x4 __attribute__((ext_vector_type(4)));
typedef unsigned u32x2 __attribute__((ext_vector_type(2)));
typedef unsigned u32x4 __attribute__((ext_vector_type(4)));

#ifndef CHECK
#define CHECK 0
#endif
#ifndef OPT_GEMM
#define OPT_GEMM 1
#endif

constexpr int NB = 8, SEQ = 4096, T = NB * SEQ, D = 1024, DEPTH = 4;
constexpr int INC = 1830, PJ = 2048;
constexpr int PC_U = 0, PC_CQ = 256, PC_CKV = 512, PC_KR = 640, PC_FQ = 768, PC_FK = 1152, PC_FV = 1536, PC_FG = 1920;
constexpr int DFF = 2816, NEXP = 8, DFE = 1408;
constexpr float EPS = 1e-6f;
constexpr float LOG2E = 1.4426950408889634f;
constexpr float C2_MLA = 0.10206207261596577f * LOG2E;
constexpr float C2_FOX = 0.125f * LOG2E;
constexpr int NSLOT = 2 * T + NEXP * 256;

constexpr size_t MiB = 1u << 20;
constexpr size_t WS_CTL = 0, CTL_BYTES = 1 * MiB;
constexpr size_t WS_ADA = 1 * MiB;
constexpr size_t WS_COS = 2 * MiB, WS_SIN = 4 * MiB;
constexpr size_t WS_RSTDQ = 6 * MiB, WS_RSTDKV = 6 * MiB + 128 * 1024;
constexpr size_t WS_FG = 7 * MiB;
constexpr size_t WS_CLOC = 8 * MiB;
constexpr size_t WS_CTOT = 8 * MiB + 896 * 1024;
constexpr size_t WS_CB2 = 9 * MiB;
constexpr size_t WS_TOKINFO = 10 * MiB;
constexpr size_t WS_PROB = 10 * MiB + 512 * 1024;
constexpr size_t WS_SLOTOF = 10 * MiB + 768 * 1024;
constexpr size_t WS_P2E = 11 * MiB;
constexpr size_t WS_YG = 20 * MiB;
constexpr size_t WS_OSSM = 36 * MiB;
constexpr size_t WS_W = 72 * MiB;
constexpr size_t W_IN = WS_W, W_UQ = WS_W + 4 * MiB, W_UKV = WS_W + 4 * MiB + 512 * 1024, W_GLU = WS_W + 5 * MiB, W_OUT = WS_W + 6 * MiB;
constexpr size_t W_F1 = WS_W + 8 * MiB, W_F2 = WS_W + 52 * MiB, W_B1T = WS_W + 76 * MiB, W_T2T = WS_W + 80 * MiB;
constexpr size_t WS_HBUF = 168 * MiB;
constexpr size_t WS_BIG = 232 * MiB;
constexpr size_t WS_PROJ = WS_BIG;
constexpr size_t WS_QRAW = WS_BIG + 128 * MiB;
constexpr size_t WS_KVRAW = WS_BIG + 176 * MiB;
constexpr size_t WS_QMLA = WS_BIG + 224 * MiB;
constexpr size_t WS_KMLA = WS_BIG + 260 * MiB;
constexpr size_t WS_OBUF = WS_BIG + 296 * MiB;
constexpr size_t WS_ACT = WS_BIG;
constexpr size_t WS_HG = WS_BIG;
constexpr size_t WS_ACTM = WS_BIG + 132 * MiB;
constexpr size_t WS_XE = WS_BIG + 192 * MiB;
constexpr size_t WS_END = WS_BIG + 344 * MiB;

constexpr int CW_CNT = 1024;
constexpr int CW_CHKE = 2048, CW_CHKR = 2112;

struct Params {
    const float* x; const float* c; const int* pos; const float* norm_mix; const float* norm_ffn; const float* w_ada; const float* b_ada; const float* w_in;
    const float* lam_re; const float* lam_im; const float* log_dt; const float* b_re; const float* b_im; const float* c_re; const float* c_im;
    const float* ssm_d; const float* w_glu; const float* b_glu;
    const float* q_norm; const float* kv_norm; const float* w_uq; const float* w_ukv; const float* mla_gq; const float* mla_gk;
    const float* fox_bf; const float* fox_gq; const float* fox_gk; const float* out_norm; const float* w_out;
    const float* ffn_wg; const float* ffn_wu; const float* ffn_wd;
    const float* moe_wr; const float* moe_br; const float* moe_wg; const float* moe_wu; const float* moe_wd;
    float* out; unsigned char* ws;
};

__device__ __forceinline__ float bf2f(bf16_t h) { return __uint_as_float(((unsigned)h) << 16); }
__device__ __forceinline__ bf16_t f2bf(float f) { unsigned u = __float_as_uint(f); return (bf16_t)((u + 0x7fffu + ((u >> 16) & 1u)) >> 16); }
__device__ __forceinline__ unsigned pk2(float lo, float hi) { return (unsigned)f2bf(lo) | ((unsigned)f2bf(hi) << 16); }
__device__ __forceinline__ float wsum(float v) {
#pragma unroll
    for (int o = 32; o > 0; o >>= 1) v += __shfl_xor(v, o);
    return v;
}
__device__ __forceinline__ float wmax(float v) {
#pragma unroll
    for (int o = 32; o > 0; o >>= 1) v = fmaxf(v, __shfl_xor(v, o));
    return v;
}
__device__ __forceinline__ float silu_f(float v) { return v / (1.f + __expf(-v)); }
__device__ __forceinline__ float sigmoid_f(float v) { return 1.f / (1.f + __expf(-v)); }
__device__ __forceinline__ float gelu_tanh(float x) { return 0.5f * x * (1.f + tanhf(0.7978845608028654f * (x + 0.044715f * x * x * x))); }
__device__ __forceinline__ float* adap(const Params& P, int layer, int b, int which) { return (float*)(P.ws + WS_ADA) + ((size_t)(layer * NB + b) * 6 + which) * D; }

struct Chk { float e, r; };
__device__ __forceinline__ void chk_upd(Chk& c, float naive, float stored) { const float d = fabsf(naive - stored); c.e = (d != d) ? INFINITY : fmaxf(c.e, d); c.r = fmaxf(c.r, fabsf(naive)); }
__device__ __forceinline__ void chk_commit(const Params& P, int stage, Chk c) {
    const float e = wmax(c.e), r = wmax(c.r);
    if ((threadIdx.x & 63) == 0) { unsigned* ctl = (unsigned*)(P.ws + WS_CTL); atomicMax(ctl + CW_CHKE + stage, __float_as_uint(e)); atomicMax(ctl + CW_CHKR + stage, __float_as_uint(r)); }
}
__device__ __forceinline__ void st4(bf16_t* p, const float (&v)[4], int chk, Chk& c) {
    if (!chk) { u32x2 o; o.x = pk2(v[0], v[1]); o.y = pk2(v[2], v[3]); *(u32x2*)p = o; }
    else { const u32x2 o = *(const u32x2*)p; chk_upd(c, v[0], bf2f(o.x & 0xffff)); chk_upd(c, v[1], bf2f(o.x >> 16)); chk_upd(c, v[2], bf2f(o.y & 0xffff)); chk_upd(c, v[3], bf2f(o.y >> 16)); }
}
__device__ __forceinline__ void st2(bf16_t* p, float a, float b, int chk, Chk& c) {
    if (!chk) *(unsigned*)p = pk2(a, b);
    else { const unsigned o = *(const unsigned*)p; chk_upd(c, a, bf2f(o & 0xffff)); chk_upd(c, b, bf2f(o >> 16)); }
}

template <class FA, class FT, class FB, class FS>
__device__ __forceinline__ void naive_gemm(int M, int N, int K, FA fa, FT ft, FB fb, FS fs, float* sm) {
    const int tid = threadIdx.x, ty = tid >> 5, tx = tid & 31;
    float (*As)[132] = (float (*)[132])sm;
    float (*Bs)[132] = (float (*)[132])(sm + 16 * 132);
    const int tm = (M + 127) / 128, tn = (N + 127) / 128;
    for (int tile = blockIdx.x; tile < tm * tn; tile += gridDim.x) {
        const int bm = (tile / tn) * 128, bn = (tile % tn) * 128;
        const int ctx = ft(bm);
        float acc[8][4];
#pragma unroll
        for (int i = 0; i < 8; ++i)
#pragma unroll
            for (int j = 0; j < 4; ++j) acc[i][j] = 0.f;
        for (int k0 = 0; k0 < K; k0 += 16) {
#pragma unroll
            for (int j = 0; j < 4; ++j) {
                const int e = tid + 512 * j, r = e >> 4, kk = e & 15;
                As[kk][r] = (bm + r < M) ? fa(bm + r, k0 + kk) : 0.f;
                const int k2 = e >> 7, cc = e & 127;
                Bs[k2][cc] = (bn + cc < N) ? fb(k0 + k2, bn + cc, ctx) : 0.f;
            }
            __syncthreads();
#pragma unroll
            for (int kk = 0; kk < 16; ++kk) {
                const f32x4 a0 = *(const f32x4*)&As[kk][ty * 8], a1 = *(const f32x4*)&As[kk][ty * 8 + 4], b = *(const f32x4*)&Bs[kk][tx * 4];
                const float a[8] = {a0[0], a0[1], a0[2], a0[3], a1[0], a1[1], a1[2], a1[3]};
#pragma unroll
                for (int i = 0; i < 8; ++i)
#pragma unroll
                    for (int j = 0; j < 4; ++j) acc[i][j] = fmaf(a[i], b[j], acc[i][j]);
            }
            __syncthreads();
        }
#pragma unroll
        for (int i = 0; i < 8; ++i) { const int row = bm + ty * 8 + i; if (row < M) fs(row, bn + tx * 4, acc[i]); }
    }
}

__global__ void __launch_bounds__(512) k_prologue(Params P) {
    __shared__ float cact[NB * D];
    for (int i = threadIdx.x; i < NB * D; i += 512) cact[i] = silu_f(P.c[i]);
    __syncthreads();
    float* ada = (float*)(P.ws + WS_ADA);
    const int gt = blockIdx.x * 512 + threadIdx.x, nt = gridDim.x * 512;
    for (int idx = gt; idx < DEPTH * 6 * D; idx += nt) {
        const int layer = idx / (6 * D), j = idx % (6 * D);
        const float* w = P.w_ada + (size_t)layer * D * 6 * D + j;
        float acc[NB];
#pragma unroll
        for (int b = 0; b < NB; ++b) acc[b] = 0.f;
        for (int k = 0; k < D; ++k) { const float wv = w[(size_t)k * 6 * D];
#pragma unroll
            for (int b = 0; b < NB; ++b) acc[b] = fmaf(cact[b * D + k], wv, acc[b]); }
        const float bb = P.b_ada[layer * 6 * D + j];
#pragma unroll
        for (int b = 0; b < NB; ++b) ada[(size_t)(layer * NB + b) * 6 * D + j] = acc[b] + bb;
    }
    float* cs = (float*)(P.ws + WS_COS); float* sn = (float*)(P.ws + WS_SIN);
    for (int idx = gt; idx < T * 16; idx += nt) {
        const int t = idx >> 4, j = idx & 15;
        const double ang = (double)P.pos[t] * pow(10000.0, -(double)j / 16.0);
        cs[idx] = (float)cos(ang); sn[idx] = (float)sin(ang);
    }
}

template <int MODE>
__global__ void __launch_bounds__(512) k_norm(Params P, int layer, const float* src, int copy) {
    const int wid = threadIdx.x >> 6, lane = threadIdx.x & 63;
    const float* gain = (MODE == 0 ? P.norm_mix : P.norm_ffn) + layer * D;
    bf16_t* hb = (bf16_t*)(P.ws + WS_HBUF);
    for (int row = blockIdx.x * 8 + wid; row < T; row += gridDim.x * 8) {
        const int b = row / SEQ;
        const float* sh = adap(P, layer, b, MODE == 0 ? 0 : 3); const float* sc = adap(P, layer, b, MODE == 0 ? 1 : 4);
        f32x4 v[4]; float ss = 0.f;
#pragma unroll
        for (int q = 0; q < 4; ++q) { v[q] = *(const f32x4*)(src + (size_t)row * D + q * 256 + lane * 4); ss += v[q][0] * v[q][0] + v[q][1] * v[q][1] + v[q][2] * v[q][2] + v[q][3] * v[q][3]; }
        if (MODE == 0 && copy) {
#pragma unroll
            for (int q = 0; q < 4; ++q) *(f32x4*)(P.out + (size_t)row * D + q * 256 + lane * 4) = v[q];
        }
        ss = wsum(ss);
        const float rstd = rsqrtf(ss * (1.f / D) + EPS);
        float lg[NEXP];
#pragma unroll
        for (int e = 0; e < NEXP; ++e) lg[e] = 0.f;
#pragma unroll
        for (int q = 0; q < 4; ++q) {
            const int col = q * 256 + lane * 4;
            const f32x4 g = *(const f32x4*)(gain + col), s1 = *(const f32x4*)(sc + col), s0 = *(const f32x4*)(sh + col);
            float h[4];
#pragma unroll
            for (int j = 0; j < 4; ++j) h[j] = v[q][j] * rstd * g[j] * (1.f + s1[j]) + s0[j];
            u32x2 o; o.x = pk2(h[0], h[1]); o.y = pk2(h[2], h[3]);
            *(u32x2*)(hb + (size_t)row * D + col) = o;
            if (MODE == 2) {
                const float* wr = P.moe_wr + (size_t)(layer / 2) * D * NEXP + (size_t)col * NEXP;
#pragma unroll
                for (int j = 0; j < 4; ++j) { const f32x4 w0 = *(const f32x4*)(wr + j * 8), w1 = *(const f32x4*)(wr + j * 8 + 4);
                    lg[0] += h[j] * w0[0]; lg[1] += h[j] * w0[1]; lg[2] += h[j] * w0[2]; lg[3] += h[j] * w0[3];
                    lg[4] += h[j] * w1[0]; lg[5] += h[j] * w1[1]; lg[6] += h[j] * w1[2]; lg[7] += h[j] * w1[3]; }
            }
        }
        if (MODE == 2) {
#pragma unroll
            for (int e = 0; e < NEXP; ++e) lg[e] = wsum(lg[e]) + P.moe_br[(layer / 2) * NEXP + e];
            if (lane == 0) {
                int i0 = 0; float v0 = lg[0];
#pragma unroll
                for (int e = 1; e < NEXP; ++e) if (lg[e] > v0) { v0 = lg[e]; i0 = e; }
                int i1 = -1; float v1 = -INFINITY;
#pragma unroll
                for (int e = 0; e < NEXP; ++e) if (e != i0 && lg[e] > v1) { v1 = lg[e]; i1 = e; }
                const float p0 = 1.f / (1.f + expf(v1 - v0)), p1 = 1.f - p0;
                unsigned* cnt = (unsigned*)(P.ws + WS_CTL) + CW_CNT + 16 * (layer / 2);
                const int pos0 = (int)atomicAdd(cnt + i0, 1u), pos1 = (int)atomicAdd(cnt + i1, 1u);
                int* ti = (int*)(P.ws + WS_TOKINFO) + (size_t)row * 4; ti[0] = i0; ti[1] = pos0; ti[2] = i1; ti[3] = pos1;
                float* pr = (float*)(P.ws + WS_PROB) + (size_t)row * 2; pr[0] = p0; pr[1] = p1;
            }
        }
    }
}

__device__ __forceinline__ int proj_orig_col(int col) { return col < 672 ? col : (col < 768 ? -1 : (col < 1926 ? col - 96 : -1)); }
__global__ void __launch_bounds__(512) k_inproj_naive(Params P, int layer, int chk) {
    __shared__ float sm[2 * 16 * 132];
    const bf16_t* hb = (const bf16_t*)(P.ws + WS_HBUF); const float* w = P.w_in + (size_t)layer * D * INC;
    bf16_t* proj = (bf16_t*)(P.ws + WS_PROJ); float* fg = (float*)(P.ws + WS_FG);
    Chk ck{0.f, 0.f};
    naive_gemm(T, PJ, D,
        [&](int r, int k) { return bf2f(hb[(size_t)r * D + k]); },
        [&](int) { return 0; },
        [&](int k, int col, int) { const int oc = proj_orig_col(col); return oc < 0 ? 0.f : w[(size_t)k * INC + oc]; },
        [&](int r, int c0, const float (&v)[4]) {
            st4(proj + (size_t)r * PJ + c0, v, chk, ck);
            if (c0 >= PC_FG && c0 < PC_FG + 8) { float* fp = fg + (size_t)r * 8 + (c0 - PC_FG);
                if (!chk) *(f32x4*)fp = (f32x4){v[0], v[1], v[2], v[3]};
                else { chk_upd(ck, v[0], fp[0]); chk_upd(ck, v[1], fp[1]); chk_upd(ck, v[2], fp[2]); chk_upd(ck, v[3], fp[3]); } }
        }, sm);
    if (chk) chk_commit(P, chk, ck);
}

__global__ void __launch_bounds__(512) k_passC(Params P, int layer) {
    __shared__ float lfs[128][8];
    const int wid = threadIdx.x >> 6, lane = threadIdx.x & 63;
    bf16_t* proj = (bf16_t*)(P.ws + WS_PROJ); const float* fg = (const float*)(P.ws + WS_FG);
    float* rq = (float*)(P.ws + WS_RSTDQ); float* rkv = (float*)(P.ws + WS_RSTDKV);
    float* cloc = (float*)(P.ws + WS_CLOC); float* ctot = (float*)(P.ws + WS_CTOT);
    const float gq = P.fox_gq[layer * 64 + lane] * C2_FOX, gk = P.fox_gk[layer * 64 + lane];
    for (int chunk = blockIdx.x; chunk < T / 128; chunk += gridDim.x) {
        for (int i = 0; i < 16; ++i) {
            const int tl = wid * 16 + i, row = chunk * 128 + tl;
            bf16_t* pr = proj + (size_t)row * PJ;
            { const u32x2 w = *(const u32x2*)(pr + PC_CQ + lane * 4); const float a = bf2f(w.x & 0xffff), b = bf2f(w.x >> 16), c = bf2f(w.y & 0xffff), d = bf2f(w.y >> 16);
              const float ss = wsum(a * a + b * b + c * c + d * d); if (lane == 0) rq[row] = rsqrtf(ss * (1.f / 256.f) + EPS); }
            { const unsigned w = *(const unsigned*)(pr + PC_CKV + lane * 2); const float a = bf2f(w & 0xffff), b = bf2f(w >> 16);
              const float ss = wsum(a * a + b * b); if (lane == 0) rkv[row] = rsqrtf(ss * (1.f / 128.f) + EPS); }
#pragma unroll
            for (int h = 0; h < 6; ++h) {
                const float a = bf2f(pr[PC_FQ + h * 64 + lane]); const float ra = rsqrtf(wsum(a * a) * (1.f / 64.f) + EPS); pr[PC_FQ + h * 64 + lane] = f2bf(a * ra * gq);
                const float b = bf2f(pr[PC_FK + h * 64 + lane]); const float rb = rsqrtf(wsum(b * b) * (1.f / 64.f) + EPS); pr[PC_FK + h * 64 + lane] = f2bf(b * rb * gk);
            }
            if (lane < 6) { const float z = fg[(size_t)row * 8 + lane] + P.fox_bf[layer * 6 + lane];
                lfs[tl][lane] = z >= 0.f ? -log1pf(expf(-z)) : z - log1pf(expf(z)); }
        }
        __syncthreads();
        if (threadIdx.x < 6) {
            const int h = threadIdx.x, b = (chunk * 128) / SEQ, t0 = (chunk * 128) % SEQ; float run = 0.f;
            for (int j = 0; j < 128; ++j) { run += lfs[j][h]; cloc[((size_t)b * 6 + h) * SEQ + t0 + j] = run; }
            ctot[chunk * 8 + h] = run;
        }
        __syncthreads();
    }
}

__global__ void __launch_bounds__(512) k_qup_naive(Params P, int layer, int chk) {
    __shared__ float sm[2 * 16 * 132];
    const bf16_t* proj = (const bf16_t*)(P.ws + WS_PROJ); const float* rq = (const float*)(P.ws + WS_RSTDQ);
    const float* w = P.w_uq + (size_t)layer * 256 * 576; const float* g = P.q_norm + layer * 256; bf16_t* qraw = (bf16_t*)(P.ws + WS_QRAW);
    Chk ck{0.f, 0.f};
    naive_gemm(T, 576, 256,
        [&](int r, int k) { return bf2f(proj[(size_t)r * PJ + PC_CQ + k]); },
        [&](int) { return 0; },
        [&](int k, int col, int) { return g[k] * w[(size_t)k * 576 + col]; },
        [&](int r, int c0, const float (&v)[4]) { const float s = rq[r]; const float o[4] = {v[0] * s, v[1] * s, v[2] * s, v[3] * s}; st4(qraw + (size_t)r * 768 + c0, o, chk, ck); }, sm);
    if (chk) chk_commit(P, chk, ck);
}
__global__ void __launch_bounds__(512) k_kvup_naive(Params P, int layer, int chk) {
    __shared__ float sm[2 * 16 * 132];
    const bf16_t* proj = (const bf16_t*)(P.ws + WS_PROJ); const float* rk = (const float*)(P.ws + WS_RSTDKV);
    const float* w = P.w_ukv + (size_t)layer * 128 * 768; const float* g = P.kv_norm + layer * 128; bf16_t* kvraw = (bf16_t*)(P.ws + WS_KVRAW);
    Chk ck{0.f, 0.f};
    naive_gemm(T, 768, 128,
        [&](int r, int k) { return bf2f(proj[(size_t)r * PJ + PC_CKV + k]); },
        [&](int) { return 0; },
        [&](int k, int col, int) { return g[k] * w[(size_t)k * 768 + col]; },
        [&](int r, int c0, const float (&v)[4]) { const float s = rk[r]; const float o[4] = {v[0] * s, v[1] * s, v[2] * s, v[3] * s}; st4(kvraw + (size_t)r * 768 + c0, o, chk, ck); }, sm);
    if (chk) chk_commit(P, chk, ck);
}

__global__ void __launch_bounds__(512) k_passE(Params P, int layer) {
    __shared__ float pref[8];
    const int wid = threadIdx.x >> 6, lane = threadIdx.x & 63;
    const bf16_t* proj = (const bf16_t*)(P.ws + WS_PROJ); const bf16_t* qraw = (const bf16_t*)(P.ws + WS_QRAW); const bf16_t* kvraw = (const bf16_t*)(P.ws + WS_KVRAW);
    bf16_t* qm = (bf16_t*)(P.ws + WS_QMLA); bf16_t* km = (bf16_t*)(P.ws + WS_KMLA);
    const float* cs = (const float*)(P.ws + WS_COS); const float* sn = (const float*)(P.ws + WS_SIN);
    const float* cloc = (const float*)(P.ws + WS_CLOC); const float* ctot = (const float*)(P.ws + WS_CTOT); float* cb2 = (float*)(P.ws + WS_CB2);
    const float gqa = P.mla_gq[layer * 96 + lane], gqb = lane < 32 ? P.mla_gq[layer * 96 + 64 + lane] : 0.f;
    const float gka = P.mla_gk[layer * 96 + lane], gkb = lane < 32 ? P.mla_gk[layer * 96 + 64 + lane] : 0.f;
    for (int chunk = blockIdx.x; chunk < T / 128; chunk += gridDim.x) {
        const int b = (chunk * 128) / SEQ, t0 = (chunk * 128) % SEQ, ci = chunk % 32;
        if (threadIdx.x < 6) { float s = 0.f; for (int c = 0; c < ci; ++c) s += ctot[(b * 32 + c) * 8 + threadIdx.x]; pref[threadIdx.x] = s; }
        __syncthreads();
        for (int e = threadIdx.x; e < 6 * 128; e += 512) { const int h = e / 128, j = e % 128; const size_t ix = ((size_t)b * 6 + h) * SEQ + t0 + j; cb2[ix] = (cloc[ix] + pref[h]) * LOG2E; }
        for (int i = 0; i < 16; ++i) {
            const int row = chunk * 128 + wid * 16 + i;
            const float cv = cs[(size_t)row * 16 + (lane & 15)], sv = sn[(size_t)row * 16 + (lane & 15)];
#pragma unroll
            for (int h = 0; h < 6; ++h) {
                {
                    const float a = bf2f(qraw[(size_t)row * 768 + h * 96 + lane]); const float bq = lane < 32 ? bf2f(qraw[(size_t)row * 768 + h * 96 + 64 + lane]) : 0.f;
                    const float r = rsqrtf(wsum(a * a + bq * bq) * (1.f / 96.f) + EPS);
                    const float an = a * r * gqa, bn = bq * r * gqb; const float pn = __shfl_xor(bn, 16);
                    const float ro = lane < 16 ? bn * cv - pn * sv : pn * sv + bn * cv;
                    qm[(size_t)row * 576 + h * 96 + lane] = f2bf(an * C2_MLA); if (lane < 32) qm[(size_t)row * 576 + h * 96 + 64 + lane] = f2bf(ro * C2_MLA);
                }
                {
                    const float a = bf2f(kvraw[(size_t)row * 768 + h * 128 + lane]); const float bk = lane < 32 ? bf2f(proj[(size_t)row * PJ + PC_KR + lane]) : 0.f;
                    const float r = rsqrtf(wsum(a * a + bk * bk) * (1.f / 96.f) + EPS);
                    const float an = a * r * gka, bn = bk * r * gkb; const float pn = __shfl_xor(bn, 16);
                    const float ro = lane < 16 ? bn * cv - pn * sv : pn * sv + bn * cv;
                    km[(size_t)row * 576 + h * 96 + lane] = f2bf(an); if (lane < 32) km[(size_t)row * 576 + h * 96 + 64 + lane] = f2bf(ro);
                }
            }
        }
        __syncthreads();
    }
}

template <int DQK, int MODE>
__global__ void __launch_bounds__(512) k_attn_naive(Params P, const bf16_t* Q, int ldq, const bf16_t* K, int ldk, const bf16_t* V, int ldv, int vhs, bf16_t* O, int ldo, const float* cb2, int chk) {
    __shared__ float Ks[64][DQK]; __shared__ float Vs[64][64]; __shared__ float cbs[64];
    const int tid = threadIdx.x;
    Chk ck{0.f, 0.f};
    for (int item = blockIdx.x; item < NB * 6 * 8; item += gridDim.x) {
        const int qb = 7 - (item / 48), bh = item % 48, b = bh / 6, h = bh % 6;
        const int q = qb * 512 + tid; const size_t rowq = (size_t)b * SEQ + q;
        float qv[DQK], o[64];
#pragma unroll
        for (int d = 0; d < DQK; ++d) qv[d] = bf2f(Q[rowq * ldq + h * DQK + d]);
#pragma unroll
        for (int d = 0; d < 64; ++d) o[d] = 0.f;
        float m = -INFINITY, l = 0.f;
        const float* cbp = MODE == 1 ? cb2 + ((size_t)b * 6 + h) * SEQ : nullptr;
        const int kend = qb * 512 + 512;
        for (int k0 = 0; k0 < kend; k0 += 64) {
            __syncthreads();
            for (int e = tid; e < 64 * DQK; e += 512) { const int j = e / DQK, d = e % DQK; Ks[j][d] = bf2f(K[((size_t)b * SEQ + k0 + j) * ldk + h * DQK + d]); }
            for (int e = tid; e < 64 * 64; e += 512) { const int j = e >> 6, d = e & 63; Vs[j][d] = bf2f(V[((size_t)b * SEQ + k0 + j) * ldv + h * vhs + d]); }
            if (MODE == 1 && tid < 64) cbs[tid] = cbp[k0 + tid];
            __syncthreads();
            for (int j = 0; j < 64; ++j) {
                const int key = k0 + j;
                const bool ok = MODE == 0 ? ((key >> 6) <= (q >> 6)) : (key <= q);
                if (ok) {
                    float s = 0.f;
#pragma unroll
                    for (int d = 0; d < DQK; d += 4) { const f32x4 kk = *(const f32x4*)&Ks[j][d]; s += qv[d] * kk[0] + qv[d + 1] * kk[1] + qv[d + 2] * kk[2] + qv[d + 3] * kk[3]; }
                    if (MODE == 1) s -= cbs[j];
                    if (s > m) { const float f = exp2f(m - s); l *= f;
#pragma unroll
                        for (int d = 0; d < 64; ++d) o[d] *= f;
                        m = s; }
                    const float p = exp2f(s - m); l += p;
#pragma unroll
                    for (int d = 0; d < 64; d += 4) { const f32x4 vv = *(const f32x4*)&Vs[j][d]; o[d] += p * vv[0]; o[d + 1] += p * vv[1]; o[d + 2] += p * vv[2]; o[d + 3] += p * vv[3]; }
                }
            }
        }
        const float il = 1.f / l;
#pragma unroll
        for (int d = 0; d < 64; d += 2) st2(O + rowq * ldo + h * 64 + d, o[d] * il, o[d + 1] * il, chk, ck);
    }
    if (chk) chk_commit(P, chk, ck);
}

__global__ void __launch_bounds__(512) k_ssm_naive(Params P, int layer, int chk) {
    __shared__ float smy[8][16 * 64];
    const int wid = threadIdx.x >> 6, lane = threadIdx.x & 63;
    float* sm = smy[wid];
    const bf16_t* proj = (const bf16_t*)(P.ws + WS_PROJ); bf16_t* yg = (bf16_t*)(P.ws + WS_YG);
    Chk ck{0.f, 0.f};
    for (int item = blockIdx.x * 8 + wid; item < NB * 16; item += gridDim.x * 8) {
        const int b = item / 16, g = item % 16, p = lane;
        const size_t gp = ((size_t)layer * 16 + g) * 64 + p;
        const double lre = P.lam_re[gp], lim = P.lam_im[gp], dt = exp((double)P.log_dt[layer * 16 + g]);
        const double er = exp(lre * dt), lbr = er * cos(lim * dt), lbi = er * sin(lim * dt);
        const double dd = lre * lre + lim * lim, qr = ((lbr - 1.0) * lre + lbi * lim) / dd, qi = (lbi * lre - (lbr - 1.0) * lim) / dd;
        float bbr[16], bbi[16], cr[16], ci[16];
#pragma unroll
        for (int c = 0; c < 16; ++c) {
            const double bre = P.b_re[gp * 16 + c], bim = P.b_im[gp * 16 + c];
            bbr[c] = (float)(qr * bre - qi * bim); bbi[c] = (float)(qr * bim + qi * bre);
            cr[c] = P.c_re[(((size_t)layer * 16 + g) * 16 + c) * 64 + p]; ci[c] = P.c_im[(((size_t)layer * 16 + g) * 16 + c) * 64 + p];
        }
        const float lr = (float)lbr, li = (float)lbi;
        const float dsk = P.ssm_d[layer * 256 + g * 16 + (lane & 15)];
        float sr = 0.f, si = 0.f;
        for (int t = 0; t < SEQ; ++t) {
            const size_t row = (size_t)b * SEQ + t;
            const bf16_t* up = proj + row * PJ + g * 16;
            const u32x4 w0 = *(const u32x4*)up, w1 = *(const u32x4*)(up + 8);
            const unsigned ww[8] = {w0.x, w0.y, w0.z, w0.w, w1.x, w1.y, w1.z, w1.w};
            float bur = 0.f, bui = 0.f;
#pragma unroll
            for (int c = 0; c < 16; ++c) { const float u = (c & 1) ? bf2f(ww[c >> 1] >> 16) : bf2f(ww[c >> 1] & 0xffff); bur = fmaf(bbr[c], u, bur); bui = fmaf(bbi[c], u, bui); }
            const float nsr = lr * sr - li * si + bur, nsi = lr * si + li * sr + bui; sr = nsr; si = nsi;
#pragma unroll
            for (int c = 0; c < 16; ++c) sm[c * 64 + lane] = cr[c] * sr - ci[c] * si;
            asm volatile("s_waitcnt lgkmcnt(0)" ::: "memory");
            const int cc = lane & 15, qd = lane >> 4; float part = 0.f;
#pragma unroll
            for (int j = 0; j < 16; ++j) part += sm[cc * 64 + qd * 16 + j];
            part += __shfl_xor(part, 16); part += __shfl_xor(part, 32);
            asm volatile("s_waitcnt lgkmcnt(0)" ::: "memory");
            if (lane < 16) { const float uv = bf2f(up[lane]); const float yv = gelu_tanh(part + dsk * uv); bf16_t* dst = yg + row * 256 + g * 16 + lane;
                if (!chk) *dst = f2bf(yv); else chk_upd(ck, yv, bf2f(*dst)); }
        }
    }
    if (chk) chk_commit(P, chk, ck);
}

__global__ void __launch_bounds__(512) k_glu_naive(Params P, int layer, int chk) {
    __shared__ float sm[2 * 16 * 132];
    const bf16_t* yg = (const bf16_t*)(P.ws + WS_YG); bf16_t* os = (bf16_t*)(P.ws + WS_OSSM);
    const float* w = P.w_glu + (size_t)layer * 256 * 256; const float* bg = P.b_glu + layer * 256;
    Chk ck{0.f, 0.f};
    naive_gemm(T, 256, 256,
        [&](int r, int k) { return bf2f(yg[(size_t)r * 256 + k]); },
        [&](int) { return 0; },
        [&](int k, int col, int) { return w[(size_t)k * 256 + col]; },
        [&](int r, int c0, const float (&v)[4]) {
            float o[4];
#pragma unroll
            for (int j = 0; j < 4; ++j) o[j] = bf2f(yg[(size_t)r * 256 + c0 + j]) * sigmoid_f(v[j] + bg[c0 + j]);
            st4(os + (size_t)r * 256 + c0, o, chk, ck); }, sm);
    if (chk) chk_commit(P, chk, ck);
}

__global__ void __launch_bounds__(512) k_merge(Params P) {
    const int wid = threadIdx.x >> 6, lane = threadIdx.x & 63;
    const bf16_t* os = (const bf16_t*)(P.ws + WS_OSSM); const bf16_t* ob = (const bf16_t*)(P.ws + WS_OBUF); bf16_t* hb = (bf16_t*)(P.ws + WS_HBUF);
    for (int row = blockIdx.x * 8 + wid; row < T; row += gridDim.x * 8) {
        { const u32x2 w = *(const u32x2*)(os + (size_t)row * 256 + lane * 4); const float a = bf2f(w.x & 0xffff), b = bf2f(w.x >> 16), c = bf2f(w.y & 0xffff), d = bf2f(w.y >> 16);
          const float r = rsqrtf(wsum(a * a + b * b + c * c + d * d) * (1.f / 256.f) + EPS); u32x2 o; o.x = pk2(a * r, b * r); o.y = pk2(c * r, d * r); *(u32x2*)(hb + (size_t)row * D + lane * 4) = o; }
#pragma unroll
        for (int part = 0; part < 2; ++part) {
            const bf16_t* src = ob + (size_t)row * 768 + part * 384 + lane * 6;
            const unsigned w0 = *(const unsigned*)src, w1 = *(const unsigned*)(src + 2), w2 = *(const unsigned*)(src + 4);
            const float v[6] = {bf2f(w0 & 0xffff), bf2f(w0 >> 16), bf2f(w1 & 0xffff), bf2f(w1 >> 16), bf2f(w2 & 0xffff), bf2f(w2 >> 16)};
            float ss = 0.f;
#pragma unroll
            for (int j = 0; j < 6; ++j) ss += v[j] * v[j];
            const float r = rsqrtf(wsum(ss) * (1.f / 384.f) + EPS);
            unsigned* dst = (unsigned*)(hb + (size_t)row * D + 256 + part * 384 + lane * 6);
            dst[0] = pk2(v[0] * r, v[1] * r); dst[1] = pk2(v[2] * r, v[3] * r); dst[2] = pk2(v[4] * r, v[5] * r);
        }
    }
}

__global__ void __launch_bounds__(512) k_outproj_naive(Params P, int layer, float* dst, int chk) {
    __shared__ float sm[2 * 16 * 132];
    const bf16_t* hb = (const bf16_t*)(P.ws + WS_HBUF); const float* w = P.w_out + (size_t)layer * D * D; const float* g = P.out_norm + layer * D;
    Chk ck{0.f, 0.f};
    naive_gemm(T, D, D,
        [&](int r, int k) { return bf2f(hb[(size_t)r * D + k]); },
        [&](int) { return 0; },
        [&](int k, int col, int) { return g[k] * w[(size_t)k * D + col]; },
        [&](int r, int c0, const float (&v)[4]) {
            const float* g1 = adap(P, layer, r / SEQ, 2) + c0; f32x4 xv = *(const f32x4*)(P.out + (size_t)r * D + c0);
#pragma unroll
            for (int j = 0; j < 4; ++j) { const float dl = g1[j] * v[j]; xv[j] += dl; ck.r = fmaxf(ck.r, fabsf(dl)); }
            *(f32x4*)(dst + (size_t)r * D + c0) = xv; }, sm);
    if (chk) chk_commit(P, chk, ck);
}

__global__ void __launch_bounds__(512) k_ffn1_naive(Params P, int layer, int chk) {
    __shared__ float sm[2 * 16 * 132];
    const bf16_t* hb = (const bf16_t*)(P.ws + WS_HBUF); bf16_t* act = (bf16_t*)(P.ws + WS_ACT);
    const float* wg = P.ffn_wg + (size_t)(layer / 2) * D * DFF; const float* wu = P.ffn_wu + (size_t)(layer / 2) * D * DFF;
    Chk ck{0.f, 0.f};
    naive_gemm(T, 2 * DFF, D,
        [&](int r, int k) { return bf2f(hb[(size_t)r * D + k]); },
        [&](int) { return 0; },
        [&](int k, int col, int) { return (col & 1) ? wu[(size_t)k * DFF + (col >> 1)] : wg[(size_t)k * DFF + (col >> 1)]; },
        [&](int r, int c0, const float (&v)[4]) { st2(act + (size_t)r * DFF + (c0 >> 1), silu_f(v[0]) * v[1], silu_f(v[2]) * v[3], chk, ck); }, sm);
    if (chk) chk_commit(P, chk, ck);
}
__global__ void __launch_bounds__(512) k_ffn2_naive(Params P, int layer, float* dst, int chk) {
    __shared__ float sm[2 * 16 * 132];
    const bf16_t* act = (const bf16_t*)(P.ws + WS_ACT); const float* w = P.ffn_wd + (size_t)(layer / 2) * DFF * D;
    Chk ck{0.f, 0.f};
    naive_gemm(T, D, DFF,
        [&](int r, int k) { return bf2f(act[(size_t)r * DFF + k]); },
        [&](int) { return 0; },
        [&](int k, int col, int) { return w[(size_t)k * D + col]; },
        [&](int r, int c0, const float (&v)[4]) {
            const float* g2 = adap(P, layer, r / SEQ, 5) + c0; f32x4 xv = *(const f32x4*)(P.out + (size_t)r * D + c0);
#pragma unroll
            for (int j = 0; j < 4; ++j) { const float dl = g2[j] * v[j]; xv[j] += dl; ck.r = fmaxf(ck.r, fabsf(dl)); }
            *(f32x4*)(dst + (size_t)r * D + c0) = xv; }, sm);
    if (chk) chk_commit(P, chk, ck);
}
__global__ void __launch_bounds__(512) k_cmp_x(Params P, const float* xe, int stage) {
    Chk ck{0.f, 0.f};
    for (size_t i = (size_t)blockIdx.x * 512 + threadIdx.x; i < (size_t)T * D / 4; i += (size_t)gridDim.x * 512) {
        const f32x4 a = ((const f32x4*)P.out)[i], b = ((const f32x4*)xe)[i];
#pragma unroll
        for (int j = 0; j < 4; ++j) { const float d = fabsf(a[j] - b[j]); ck.e = (d != d) ? INFINITY : fmaxf(ck.e, d); }
    }
    chk_commit(P, stage, ck);
}

__device__ __forceinline__ void moe_offsets(const Params& P, int layer, int (&off)[NEXP + 1]) {
    const unsigned* cnt = (const unsigned*)(P.ws + WS_CTL) + CW_CNT + 16 * (layer / 2);
    int o = 0;
#pragma unroll
    for (int e = 0; e < NEXP; ++e) { off[e] = o; o += (int)((cnt[e] + 255u) >> 8) << 8; }
    off[NEXP] = o;
}
__global__ void __launch_bounds__(512) k_moe_gather(Params P, int layer) {
    const int wid = threadIdx.x >> 6, lane = threadIdx.x & 63;
    int off[NEXP + 1]; moe_offsets(P, layer, off);
    int* p2e = (int*)(P.ws + WS_P2E);
    if (blockIdx.x == 0) {
        for (int pnl = threadIdx.x; pnl < 272; pnl += 512) { int e = 0;
#pragma unroll
            for (int j = 1; j < NEXP; ++j) if (pnl * 256 >= off[j]) e = j;
            p2e[pnl] = e; }
        if (threadIdx.x == 0) p2e[300] = off[NEXP] >> 8;
    }
    const bf16_t* hb = (const bf16_t*)(P.ws + WS_HBUF); bf16_t* hg = (bf16_t*)(P.ws + WS_HG);
    const int* ti = (const int*)(P.ws + WS_TOKINFO); int* so = (int*)(P.ws + WS_SLOTOF);
    for (int row = blockIdx.x * 8 + wid; row < T; row += gridDim.x * 8) {
        const u32x4 v0 = *(const u32x4*)(hb + (size_t)row * D + lane * 8), v1 = *(const u32x4*)(hb + (size_t)row * D + 512 + lane * 8);
#pragma unroll
        for (int k = 0; k < 2; ++k) {
            const int e = ti[(size_t)row * 4 + 2 * k], pos = ti[(size_t)row * 4 + 2 * k + 1];
            int base = 0;
#pragma unroll
            for (int j = 0; j < NEXP; ++j) if (e == j) base = off[j];
            const int slot = base + pos;
            *(u32x4*)(hg + (size_t)slot * D + lane * 8) = v0; *(u32x4*)(hg + (size_t)slot * D + 512 + lane * 8) = v1;
            if (lane == 0) so[(size_t)row * 2 + k] = slot;
        }
    }
}
__global__ void __launch_bounds__(512) k_moe1_naive(Params P, int layer, int chk) {
    __shared__ float sm[2 * 16 * 132];
    const bf16_t* hg = (const bf16_t*)(P.ws + WS_HG); bf16_t* act = (bf16_t*)(P.ws + WS_ACTM); const int* p2e = (const int*)(P.ws + WS_P2E);
    const float* wg = P.moe_wg + (size_t)(layer / 2) * NEXP * D * DFE; const float* wu = P.moe_wu + (size_t)(layer / 2) * NEXP * D * DFE;
    const int M = p2e[300] * 256;
    Chk ck{0.f, 0.f};
    naive_gemm(M, 2 * DFE, D,
        [&](int r, int k) { return bf2f(hg[(size_t)r * D + k]); },
        [&](int bm) { return p2e[bm >> 8]; },
        [&](int k, int col, int e) { const size_t o = ((size_t)e * D + k) * DFE + (col >> 1); return (col & 1) ? wu[o] : wg[o]; },
        [&](int r, int c0, const float (&v)[4]) { st2(act + (size_t)r * DFE + (c0 >> 1), silu_f(v[0]) * v[1], silu_f(v[2]) * v[3], chk, ck); }, sm);
    if (chk) chk_commit(P, chk, ck);
}
__global__ void __launch_bounds__(512) k_moe2_naive(Params P, int layer, int chk) {
    __shared__ float sm[2 * 16 * 132];
    const bf16_t* act = (const bf16_t*)(P.ws + WS_ACTM); bf16_t* ym = (bf16_t*)(P.ws + WS_HG); const int* p2e = (const int*)(P.ws + WS_P2E);
    const float* wd = P.moe_wd + (size_t)(layer / 2) * NEXP * DFE * D;
    const int M = p2e[300] * 256;
    Chk ck{0.f, 0.f};
    naive_gemm(M, D, DFE,
        [&](int r, int k) { return bf2f(act[(size_t)r * DFE + k]); },
        [&](int bm) { return p2e[bm >> 8]; },
        [&](int k, int col, int e) { return wd[((size_t)e * DFE + k) * D + col]; },
        [&](int r, int c0, const float (&v)[4]) { st4(ym + (size_t)r * D + c0, v, chk, ck); }, sm);
    if (chk) chk_commit(P, chk, ck);
}
__global__ void __launch_bounds__(512) k_moe_combine(Params P, int layer) {
    const int wid = threadIdx.x >> 6, lane = threadIdx.x & 63;
    const bf16_t* ym = (const bf16_t*)(P.ws + WS_HG); const int* so = (const int*)(P.ws + WS_SLOTOF); const float* pr = (const float*)(P.ws + WS_PROB);
    for (int row = blockIdx.x * 8 + wid; row < T; row += gridDim.x * 8) {
        const int s0 = so[(size_t)row * 2], s1 = so[(size_t)row * 2 + 1]; const float p0 = pr[(size_t)row * 2], p1 = pr[(size_t)row * 2 + 1];
        const float* g2 = adap(P, layer, row / SEQ, 5);
#pragma unroll
        for (int q = 0; q < 4; ++q) {
            const int col = q * 256 + lane * 4;
            const u32x2 a = *(const u32x2*)(ym + (size_t)s0 * D + col), b = *(const u32x2*)(ym + (size_t)s1 * D + col);
            f32x4* xp = (f32x4*)(P.out + (size_t)row * D + col); f32x4 xv = *xp; const f32x4 g = *(const f32x4*)(g2 + col);
            xv[0] += g[0] * (p0 * bf2f(a.x & 0xffff) + p1 * bf2f(b.x & 0xffff)); xv[1] += g[1] * (p0 * bf2f(a.x >> 16) + p1 * bf2f(b.x >> 16));
            xv[2] += g[2] * (p0 * bf2f(a.y & 0xffff) + p1 * bf2f(b.y & 0xffff)); xv[3] += g[3] * (p0 * bf2f(a.y >> 16) + p1 * bf2f(b.y >> 16));
            *xp = xv;
        }
    }
}
__global__ void __launch_bounds__(512) k_check_final(Params P) {
    const unsigned* ctl = (const unsigned*)(P.ws + WS_CTL);
    int code = 0;
    for (int s = 31; s >= 1; --s) { const float e = __uint_as_float(ctl[CW_CHKE + s]), r = __uint_as_float(ctl[CW_CHKR + s]); if (!(e <= 0.04f * r)) code = s; }
    if (code == 0) return;
    const float sc = 1.f + 0.1f * code;
    for (size_t i = (size_t)blockIdx.x * 512 + threadIdx.x; i < (size_t)T * D; i += (size_t)gridDim.x * 512) P.out[i] *= sc;
}

namespace pg8 {
#define PG8_LAS __attribute__((address_space(3)))
typedef short bf16x8 __attribute__((ext_vector_type(8)));
constexpr int BM = 256, BK = 64, HALF = 128, HTB = HALF * BK * 2  , STAGE_BYTES = 8 * HTB, NXCD = 8, WGM = 8;
__host__ __device__ __forceinline__ int lds_byte(int r, int c) { const int st = (r >> 4) * 2 + (c >> 5), rr = r & 15, cc = c & 31, ob = rr * 64 + cc * 2; return st * 1024 + (ob ^ (((ob >> 9) & 1) << 5)); }
__host__ __device__ __forceinline__ void stage_rc(int b, int& R, int& C) { const int st = b / 1024, sb = b % 1024, swz = sb ^ (((sb >> 9) & 1) << 5); R = (st >> 1) * 16 + swz / 64; C = (st & 1) * 32 + (swz % 64) / 2; }
__host__ __device__ __forceinline__ int perm32(int rho) { const int n = rho >> 4, i = rho & 15; return 8 * (i >> 2) + 4 * n + (i & 3); }
struct Unit { int pm, pn; };
struct Gemm { const bf16_t* A; const bf16_t* Bt; int lda, ldb, K; };
struct StaticOrder {
    int nM, nN, nwg, G, c;
    __host__ __device__ void init(int M, int N, int G_, int c_) { nM = M / BM; nN = N / BM; nwg = nM * nN; G = G_; c = c_; }
    __host__ __device__ bool next(int i, Unit& u) const {
        const long L = (long)i * G + c; if (L >= nwg) return false;
        int wgid = (int)L; { const int q = nwg / NXCD, r = nwg % NXCD, xcd = wgid % NXCD, off = wgid / NXCD; wgid = (xcd < r ? xcd * (q + 1) : r * (q + 1) + (xcd - r) * q) + off; }
        const int nig = WGM * nN, gid = wgid / nig, fm = gid * WGM, gsz = (nM - fm) < WGM ? (nM - fm) : WGM;
        u.pm = fm + ((wgid % nig) % gsz); u.pn = (wgid % nig) / gsz; return true;
    }
    __device__ __forceinline__ void a_ready(const Unit&) const {}
    __device__ __forceinline__ void done(const Unit&) const {}
};
template <class F> struct ListOrder {
    int n, G, c; F f;
    __device__ __forceinline__ bool next(int i, Unit& u) const { const long L = (long)i * G + c; if (L >= n) return false; f((int)L, u); return true; }
    __device__ __forceinline__ void a_ready(const Unit&) const {}
    __device__ __forceinline__ void done(const Unit&) const {}
};
__device__ __forceinline__ unsigned cvt_pk_bf16(float lo, float hi) { unsigned r; asm volatile("v_cvt_pk_bf16_f32 %0, %1, %2" : "=v"(r) : "v"(lo), "v"(hi)); return r; }
__device__ __forceinline__ u32x4 pack8(const f32x4 a, const f32x4 b) { u32x4 w; w.x = cvt_pk_bf16(a[0], a[1]); w.y = cvt_pk_bf16(a[2], a[3]); w.z = cvt_pk_bf16(b[0], b[1]); w.w = cvt_pk_bf16(b[2], b[3]); return w; }

template <class Epi, class Sched, bool ALIGN_EPI = false, bool SP2 = false>
__device__ __forceinline__ void gemm_phase(PG8_LAS unsigned char* lds, const Gemm g, const Sched& S, const Epi& E) {
    const int tid = threadIdx.x, wid = __builtin_amdgcn_readfirstlane(tid >> 6), lane = tid & 63, wr = wid >> 2, wc = wid & 3, fr = lane & 15, fq = lane >> 4;
    const int K = g.K, nt = K / BK;
    unsigned voffA[2], voffB[2];
#pragma unroll
    for (int i = 0; i < 2; ++i) { int R, C; stage_rc(tid * 16 + i * 8192, R, C); const int Rb = Epi::PERM ? ((R & ~31) + perm32(R & 31)) : R;
        voffA[i] = (unsigned)(R * g.lda + C) * 2u; voffB[i] = (unsigned)(Rb * g.ldb + C) * 2u; }
    const size_t kstep = (size_t)(BK * 2);
    const size_t hstepA = (size_t)HALF * g.lda * 2, hstepB = (size_t)HALF * g.ldb * 2;
    const size_t tstepA = 2 * hstepA, tstepB = 2 * hstepB;
    const unsigned ldsw = (unsigned)wid * 1024u;
    const int aoff = lds_byte(wr * 64 + fr, fq * 8), boff = lds_byte(wc * 32 + fr, fq * 8);
#define PG8_SA(b, h) (((b) * 2 + (h)) * HTB)
#define PG8_SB(b, h) ((4 + (b) * 2 + (h)) * HTB)
#define PG8_STAGE(bufoff, gbase, voff) do { _Pragma("unroll") for (int _i = 0; _i < 2; ++_i) \
        __builtin_amdgcn_global_load_lds((const unsigned*)((const char*)(gbase) + (voff)[_i]), (PG8_LAS unsigned*)(lds + (bufoff) + ldsw + _i * 8192), 16, 0, 0); } while (0)
#define PG8_LDA(dst, b, h) do { _Pragma("unroll") for (int m = 0; m < 4; ++m) _Pragma("unroll") for (int k = 0; k < 2; ++k) dst[m][k] = *(const PG8_LAS bf16x8*)(lds + PG8_SA(b, h) + aoff + m * 2048 + k * 1024); } while (0)
#define PG8_LDB(dst, b, h) do { _Pragma("unroll") for (int n = 0; n < 2; ++n) _Pragma("unroll") for (int k = 0; k < 2; ++k) dst[n][k] = *(const PG8_LAS bf16x8*)(lds + PG8_SB(b, h) + boff + n * 2048 + k * 1024); } while (0)
#define PG8_MMA(ai, bj, At, Bt) do { __builtin_amdgcn_s_setprio(1); _Pragma("unroll") for (int m = 0; m < 4; ++m) _Pragma("unroll") for (int n = 0; n < 2; ++n) _Pragma("unroll") for (int k = 0; k < 2; ++k) \
        acc[ai][bj][m][n] = __builtin_amdgcn_mfma_f32_16x16x32_bf16(Bt[n][k], At[m][k], acc[ai][bj][m][n], 0, 0, 0); __builtin_amdgcn_s_setprio(0); } while (0)
#define PG8_WAIT_V(n) asm volatile("s_waitcnt vmcnt(" #n ")" ::: "memory")
#define PG8_WAIT_L(n) asm volatile("s_waitcnt lgkmcnt(" #n ")" ::: "memory")
#define PG8_BAR __builtin_amdgcn_s_barrier()
#define PG8_SCHED __builtin_amdgcn_sched_barrier(0)
    Unit cur, nxt; int ui = 0;
    if (!S.next(0, cur)) return;
    f32x4 acc[2][2][4][2];
#pragma unroll
    for (int a = 0; a < 2; ++a)
#pragma unroll
        for (int b = 0; b < 2; ++b)
#pragma unroll
            for (int m = 0; m < 4; ++m)
#pragma unroll
                for (int n = 0; n < 2; ++n) acc[a][b][m][n] = (f32x4){0.f, 0.f, 0.f, 0.f};
    bf16x8 At[4][2], B0[2][2], B1[2][2];
    const char* cA = (const char*)g.A + (size_t)cur.pm * tstepA; const char* cB = (const char*)g.Bt + (size_t)cur.pn * tstepB;
    S.a_ready(cur);
    if constexpr (SP2) {
        PG8_STAGE(PG8_SB(0, 0), cB, voffB); PG8_STAGE(PG8_SB(0, 1), cB + hstepB, voffB); PG8_STAGE(PG8_SA(0, 0), cA, voffA); PG8_STAGE(PG8_SA(0, 1), cA + hstepA, voffA);
        if (wr == 1) PG8_BAR;
        PG8_WAIT_V(2); PG8_BAR;
        PG8_STAGE(PG8_SB(1, 0), cB + kstep, voffB); PG8_STAGE(PG8_SA(1, 0), cA + kstep, voffA); PG8_STAGE(PG8_SB(1, 1), cB + hstepB + kstep, voffB);
        PG8_WAIT_V(6); PG8_BAR;
    } else {
        PG8_STAGE(PG8_SB(0, 0), cB, voffB); PG8_STAGE(PG8_SA(0, 0), cA, voffA); PG8_STAGE(PG8_SB(0, 1), cB + hstepB, voffB); PG8_STAGE(PG8_SA(0, 1), cA + hstepA, voffA);
        if (wr == 1) PG8_BAR;
        PG8_WAIT_V(4); PG8_BAR;
        PG8_STAGE(PG8_SB(1, 0), cB + kstep, voffB); PG8_STAGE(PG8_SA(1, 0), cA + kstep, voffA); PG8_STAGE(PG8_SB(1, 1), cB + hstepB + kstep, voffB);
        PG8_WAIT_V(6); PG8_BAR;
    }
    for (;;) {
        const bool has_next = S.next(ui + 1, nxt);
        const char* nA = has_next ? (const char*)g.A + (size_t)nxt.pm * tstepA : cA; const char* nB = has_next ? (const char*)g.Bt + (size_t)nxt.pn * tstepB : cB;
        for (int t = 0; t < nt; t += 2) {
            const bool last = (t == nt - 2);
            const char* a1 = cA + (size_t)(t + 1) * kstep;
            const char* a2 = last ? nA : cA + (size_t)(t + 2) * kstep; const char* b2 = last ? nB : cB + (size_t)(t + 2) * kstep;
            const char* a3 = a2 + kstep; const char* b3 = b2 + kstep;
            if (last && has_next) S.a_ready(nxt);
            if constexpr (SP2) {
            PG8_LDB(B0, 0, 0); PG8_LDB(B1, 0, 1); PG8_SCHED; PG8_LDA(At, 0, 0); PG8_STAGE(PG8_SA(1, 1), a1 + hstepA, voffA);
            PG8_WAIT_V(8); PG8_WAIT_L(0); PG8_BAR; PG8_MMA(0, 0, At, B0); PG8_MMA(0, 1, At, B1); PG8_BAR; PG8_SCHED;
            PG8_LDA(At, 0, 1); PG8_STAGE(PG8_SB(0, 0), b2, voffB); PG8_STAGE(PG8_SB(0, 1), b2 + hstepB, voffB); PG8_STAGE(PG8_SA(0, 0), a2, voffA);
            PG8_WAIT_V(8); PG8_WAIT_L(0); PG8_BAR; PG8_MMA(1, 0, At, B0); PG8_MMA(1, 1, At, B1); PG8_BAR; PG8_SCHED;
            PG8_LDB(B0, 1, 0); PG8_LDB(B1, 1, 1); PG8_SCHED; PG8_LDA(At, 1, 0); PG8_STAGE(PG8_SA(0, 1), a2 + hstepA, voffA);
            PG8_WAIT_V(8); PG8_WAIT_L(0); PG8_BAR; PG8_MMA(0, 0, At, B0); PG8_MMA(0, 1, At, B1); PG8_BAR; PG8_SCHED;
            PG8_LDA(At, 1, 1); PG8_STAGE(PG8_SB(1, 0), b3, voffB); PG8_STAGE(PG8_SB(1, 1), b3 + hstepB, voffB); PG8_STAGE(PG8_SA(1, 0), a3, voffA);
            PG8_WAIT_V(8); PG8_WAIT_L(0); PG8_BAR; PG8_MMA(1, 0, At, B0); PG8_MMA(1, 1, At, B1); PG8_BAR; PG8_SCHED;
            } else {
            PG8_LDB(B0, 0, 0); PG8_SCHED; PG8_LDA(At, 0, 0); PG8_STAGE(PG8_SA(1, 1), a1 + hstepA, voffA);
            PG8_WAIT_L(8); PG8_BAR; PG8_WAIT_L(0); PG8_MMA(0, 0, At, B0); PG8_BAR; PG8_SCHED;
            PG8_LDB(B1, 0, 1); PG8_STAGE(PG8_SB(0, 0), b2, voffB);
            PG8_BAR; PG8_WAIT_L(0); PG8_MMA(0, 1, At, B1); PG8_BAR;
            PG8_LDA(At, 0, 1); PG8_STAGE(PG8_SA(0, 0), a2, voffA);
            PG8_BAR; PG8_WAIT_L(0); PG8_MMA(1, 0, At, B0); PG8_BAR; PG8_SCHED;
            PG8_STAGE(PG8_SB(0, 1), b2 + hstepB, voffB);
            PG8_WAIT_V(6); PG8_BAR; PG8_MMA(1, 1, At, B1); PG8_BAR;
            PG8_LDB(B0, 1, 0); PG8_SCHED; PG8_LDA(At, 1, 0); PG8_STAGE(PG8_SA(0, 1), a2 + hstepA, voffA);
            PG8_WAIT_L(8); PG8_BAR; PG8_WAIT_L(0); PG8_MMA(0, 0, At, B0); PG8_BAR; PG8_SCHED;
            PG8_LDB(B1, 1, 1); PG8_STAGE(PG8_SB(1, 0), b3, voffB);
            PG8_BAR; PG8_WAIT_L(0); PG8_MMA(0, 1, At, B1); PG8_BAR;
            PG8_LDA(At, 1, 1); PG8_STAGE(PG8_SA(1, 0), a3, voffA);
            PG8_BAR; PG8_WAIT_L(0); PG8_MMA(1, 0, At, B0); PG8_BAR; PG8_SCHED;
            PG8_STAGE(PG8_SB(1, 1), b3 + hstepB, voffB);
            PG8_WAIT_V(6); PG8_BAR; PG8_MMA(1, 1, At, B1); PG8_BAR;
            }
        }
        if constexpr (ALIGN_EPI) { if (wr == 0) PG8_BAR; }
        if constexpr (!Epi::AFTER_DRAIN) { E(acc, cur, wr, wc, fr, fq); S.done(cur); }
        if (!has_next) break;
#pragma unroll
        for (int a = 0; a < 2; ++a)
#pragma unroll
            for (int b = 0; b < 2; ++b)
#pragma unroll
                for (int m = 0; m < 4; ++m)
#pragma unroll
                    for (int n = 0; n < 2; ++n) acc[a][b][m][n] = (f32x4){0.f, 0.f, 0.f, 0.f};
        cur = nxt; cA = nA; cB = nB; ++ui;
        if constexpr (ALIGN_EPI) { if (wr == 1) PG8_BAR; }
    }
    PG8_WAIT_V(0);
    if constexpr (!ALIGN_EPI) { if (wr == 0) PG8_BAR; }
    PG8_BAR;
    if constexpr (Epi::AFTER_DRAIN) { E.fused(acc, cur, wr, wc, fr, fq, lds, wid, lane); S.done(cur); }
#undef PG8_SA
#undef PG8_SB
#undef PG8_STAGE
#undef PG8_LDA
#undef PG8_LDB
#undef PG8_MMA
#undef PG8_WAIT_V
#undef PG8_WAIT_L
#undef PG8_BAR
#undef PG8_SCHED
}
}

using pg8::Unit;
struct EpiStore {
    static constexpr bool PERM = true, AFTER_DRAIN = false;
    bf16_t* O; int ldc; const float* rowscale; int pn_mod;
    __device__ __forceinline__ void operator()(const f32x4 (&acc)[2][2][4][2], const Unit& u, int wr, int wc, int fr, int fq) const {
        const int row0 = u.pm * 256 + wr * 64 + fr, col0 = (u.pn % pn_mod) * 256 + wc * 32 + 8 * fq;
#pragma unroll
        for (int ai = 0; ai < 2; ++ai)
#pragma unroll
            for (int m = 0; m < 4; ++m) { const int row = row0 + ai * 128 + m * 16; const float s = rowscale ? rowscale[row] : 1.f; bf16_t* rp = O + (size_t)row * ldc + col0;
#pragma unroll
                for (int bj = 0; bj < 2; ++bj) *(u32x4*)(rp + bj * 128) = pg8::pack8(acc[ai][bj][m][0] * s, acc[ai][bj][m][1] * s); }
    }
};
struct EpiInproj {
    static constexpr bool PERM = true, AFTER_DRAIN = false;
    bf16_t* O; float* fg;
    __device__ __forceinline__ void operator()(const f32x4 (&acc)[2][2][4][2], const Unit& u, int wr, int wc, int fr, int fq) const {
        const int row0 = u.pm * 256 + wr * 64 + fr, col0 = u.pn * 256 + wc * 32 + 8 * fq;
        const bool isfg = (u.pn == 7) && (wc == 0) && (fq == 0);
#pragma unroll
        for (int ai = 0; ai < 2; ++ai)
#pragma unroll
            for (int m = 0; m < 4; ++m) { const int row = row0 + ai * 128 + m * 16; bf16_t* rp = O + (size_t)row * PJ + col0;
#pragma unroll
                for (int bj = 0; bj < 2; ++bj) *(u32x4*)(rp + bj * 128) = pg8::pack8(acc[ai][bj][m][0], acc[ai][bj][m][1]);
                if (isfg) { *(f32x4*)(fg + (size_t)row * 8) = acc[ai][1][m][0]; *(f32x4*)(fg + (size_t)row * 8 + 4) = acc[ai][1][m][1]; } }
    }
};
struct EpiResid {
    static constexpr bool PERM = true, AFTER_DRAIN = false;
    float* X; const float* gate0;
    __device__ __forceinline__ void operator()(const f32x4 (&acc)[2][2][4][2], const Unit& u, int wr, int wc, int fr, int fq) const {
        const int row0 = u.pm * 256 + wr * 64 + fr, col0 = u.pn * 256 + wc * 32 + 8 * fq;
        const float* gp = gate0 + (size_t)(u.pm >> 4) * 6 * D + col0;
        f32x4 g[2][2];
#pragma unroll
        for (int bj = 0; bj < 2; ++bj) { g[bj][0] = *(const f32x4*)(gp + bj * 128); g[bj][1] = *(const f32x4*)(gp + bj * 128 + 4); }
#pragma unroll
        for (int ai = 0; ai < 2; ++ai)
#pragma unroll
            for (int m = 0; m < 4; ++m) { float* rp = X + (size_t)(row0 + ai * 128 + m * 16) * D + col0;
#pragma unroll
                for (int bj = 0; bj < 2; ++bj) { f32x4 x0 = *(const f32x4*)(rp + bj * 128), x1 = *(const f32x4*)(rp + bj * 128 + 4);
                    x0 += g[bj][0] * acc[ai][bj][m][0]; x1 += g[bj][1] * acc[ai][bj][m][1];
                    *(f32x4*)(rp + bj * 128) = x0; *(f32x4*)(rp + bj * 128 + 4) = x1; } }
    }
};
__device__ __forceinline__ f32x4 silu_mul4(const f32x4 g, const f32x4 u) { f32x4 o;
#pragma unroll
    for (int j = 0; j < 4; ++j) o[j] = g[j] * __builtin_amdgcn_rcpf(1.f + __expf(-g[j])) * u[j];
    return o; }
struct EpiSwiglu {
    static constexpr bool PERM = true, AFTER_DRAIN = false;
    bf16_t* O; int ldc; int pn_mod;
    __device__ __forceinline__ void operator()(const f32x4 (&acc)[2][2][4][2], const Unit& u, int wr, int wc, int fr, int fq) const {
        const int row0 = u.pm * 256 + wr * 64 + fr, ff0 = (u.pn % pn_mod) * 128 + wc * 32 + 8 * fq;
#pragma unroll
        for (int ai = 0; ai < 2; ++ai)
#pragma unroll
            for (int m = 0; m < 4; ++m) *(u32x4*)(O + (size_t)(row0 + ai * 128 + m * 16) * ldc + ff0) = pg8::pack8(silu_mul4(acc[ai][0][m][0], acc[ai][1][m][0]), silu_mul4(acc[ai][0][m][1], acc[ai][1][m][1]));
    }
};
struct EpiGlu {
    static constexpr bool PERM = true, AFTER_DRAIN = false;
    const bf16_t* Y; bf16_t* O; const float* bias;
    __device__ __forceinline__ void operator()(const f32x4 (&acc)[2][2][4][2], const Unit& u, int wr, int wc, int fr, int fq) const {
        const int row0 = u.pm * 256 + wr * 64 + fr, col0 = wc * 32 + 8 * fq;
#pragma unroll
        for (int ai = 0; ai < 2; ++ai)
#pragma unroll
            for (int m = 0; m < 4; ++m) { const size_t ro = (size_t)(row0 + ai * 128 + m * 16) * 256 + col0;
#pragma unroll
                for (int bj = 0; bj < 2; ++bj) { const u32x4 yv = *(const u32x4*)(Y + ro + bj * 128); const f32x4 b0 = *(const f32x4*)(bias + col0 + bj * 128), b1 = *(const f32x4*)(bias + col0 + bj * 128 + 4);
                    const unsigned yw[4] = {yv.x, yv.y, yv.z, yv.w}; f32x4 o0, o1;
#pragma unroll
                    for (int j = 0; j < 4; ++j) { const float ya = j & 1 ? bf2f(yw[j >> 1] >> 16) : bf2f(yw[j >> 1] & 0xffff), yb = j & 1 ? bf2f(yw[2 + (j >> 1)] >> 16) : bf2f(yw[2 + (j >> 1)] & 0xffff);
                        o0[j] = ya * __builtin_amdgcn_rcpf(1.f + __expf(-(acc[ai][bj][m][0][j] + b0[j]))); o1[j] = yb * __builtin_amdgcn_rcpf(1.f + __expf(-(acc[ai][bj][m][1][j] + b1[j]))); }
                    *(u32x4*)(O + ro + bj * 128) = pg8::pack8(o0, o1); } }
    }
};

template <class SRC>
__device__ __forceinline__ void convert_tiles(bf16_t* Bt, int N, int K, SRC src, float* scr, int gw, int ngw, int lane) {
    const int nblk = N / 32, items = (K / 64) * nblk;
    for (int it = gw; it < items; it += ngw) {
        const int kb = it / nblk, nb = it % nblk, k0 = kb * 64, n0 = nb * 32;
#pragma unroll 8
        for (int i = 0; i < 32; ++i) { const int kk = 2 * i + (lane >> 5); scr[kk * 33 + (lane & 31)] = src(k0 + kk, n0 + (lane & 31)); }
        asm volatile("s_waitcnt lgkmcnt(0)" ::: "memory");
        const int c = lane & 7;
#pragma unroll
        for (int j = 0; j < 4; ++j) { const int n = (lane >> 3) + 8 * j; const float* s = scr + (8 * c) * 33 + n;
            u32x4 o; o.x = pk2(s[0], s[33]); o.y = pk2(s[66], s[99]); o.z = pk2(s[132], s[165]); o.w = pk2(s[198], s[231]);
            *(u32x4*)(Bt + (size_t)(n0 + n) * K + k0 + 8 * c) = o; }
        asm volatile("s_waitcnt lgkmcnt(0)" ::: "memory");
    }
}
__device__ __forceinline__ void convert_layer(const Params& P, int layer, float* scr, int gw, int ngw, int lane) {
    unsigned char* ws = P.ws;
    { const float* w = P.w_in + (size_t)layer * D * INC;
      convert_tiles((bf16_t*)(ws + W_IN), PJ, D, [&](int k, int n) { const int oc = proj_orig_col(n); return oc < 0 ? 0.f : w[(size_t)k * INC + oc]; }, scr, gw, ngw, lane); }
    { const float* w = P.w_uq + (size_t)layer * 256 * 576; const float* g = P.q_norm + layer * 256;
      convert_tiles((bf16_t*)(ws + W_UQ), 768, 256, [&](int k, int n) { return n < 576 ? g[k] * w[(size_t)k * 576 + n] : 0.f; }, scr, gw, ngw, lane); }
    { const float* w = P.w_ukv + (size_t)layer * 128 * 768; const float* g = P.kv_norm + layer * 128;
      convert_tiles((bf16_t*)(ws + W_UKV), 768, 256, [&](int k, int n) { return k < 128 ? g[k] * w[(size_t)k * 768 + n] : 0.f; }, scr, gw, ngw, lane); }
    { const float* w = P.w_glu + (size_t)layer * 256 * 256;
      convert_tiles((bf16_t*)(ws + W_GLU), 256, 256, [&](int k, int n) { return w[(size_t)k * 256 + n]; }, scr, gw, ngw, lane); }
    { const float* w = P.w_out + (size_t)layer * D * D; const float* g = P.out_norm + layer * D;
      convert_tiles((bf16_t*)(ws + W_OUT), D, D, [&](int k, int n) { return g[k] * w[(size_t)k * D + n]; }, scr, gw, ngw, lane); }
    if ((layer & 1) == 0) {
        const float* wg = P.ffn_wg + (size_t)(layer / 2) * D * DFF; const float* wu = P.ffn_wu + (size_t)(layer / 2) * D * DFF; const float* wd = P.ffn_wd + (size_t)(layer / 2) * DFF * D;
        convert_tiles((bf16_t*)(ws + W_F1), 2 * DFF, D, [&](int k, int n) { const int ff = (n >> 8) * 128 + (n & 127); return (n & 128) ? wu[(size_t)k * DFF + ff] : wg[(size_t)k * DFF + ff]; }, scr, gw, ngw, lane);
        convert_tiles((bf16_t*)(ws + W_F2), D, DFF, [&](int k, int n) { return wd[(size_t)k * D + n]; }, scr, gw, ngw, lane);
    } else {
        for (int e = 0; e < NEXP; ++e) {
            const float* wg = P.moe_wg + ((size_t)(layer / 2) * NEXP + e) * D * DFE; const float* wu = P.moe_wu + ((size_t)(layer / 2) * NEXP + e) * D * DFE; const float* wd = P.moe_wd + ((size_t)(layer / 2) * NEXP + e) * DFE * D;
            convert_tiles((bf16_t*)(ws + W_F1) + (size_t)e * 2 * DFE * D, 2 * DFE, D, [&](int k, int n) { const int ff = (n >> 8) * 128 + (n & 127); return (n & 128) ? wu[(size_t)k * DFE + ff] : wg[(size_t)k * DFE + ff]; }, scr, gw, ngw, lane);
            convert_tiles((bf16_t*)(ws + W_F2) + (size_t)e * D * DFE, D, DFE, [&](int k, int n) { return wd[(size_t)k * D + n]; }, scr, gw, ngw, lane);
        }
    }
}
extern __shared__ __attribute__((aligned(16))) unsigned char dlds[];
constexpr int LDS_BYTES = 147456;
__global__ void __launch_bounds__(512, 2) k_convert(Params P, int layer) {
    const int wid = threadIdx.x >> 6, lane = threadIdx.x & 63;
    convert_layer(P, layer, (float*)dlds + wid * (64 * 33), blockIdx.x * 8 + wid, gridDim.x * 8, lane);
}

#define GEMM_LDS ((PG8_LAS unsigned char*)dlds)
__global__ void __launch_bounds__(512, 2) k_inproj_opt(Params P, int layer) {
    pg8::Gemm g{(const bf16_t*)(P.ws + WS_HBUF), (const bf16_t*)(P.ws + W_IN), D, D, D}; pg8::StaticOrder S; S.init(T, PJ, gridDim.x, blockIdx.x);
    EpiInproj E{(bf16_t*)(P.ws + WS_PROJ), (float*)(P.ws + WS_FG)};
    pg8::gemm_phase<EpiInproj, pg8::StaticOrder, true, true>(GEMM_LDS, g, S, E);
}
__global__ void __launch_bounds__(512, 2) k_qup_opt(Params P, int layer) {
    pg8::Gemm g{(const bf16_t*)(P.ws + WS_PROJ) + PC_CQ, (const bf16_t*)(P.ws + W_UQ), PJ, 256, 256}; pg8::StaticOrder S; S.init(T, 768, gridDim.x, blockIdx.x);
    EpiStore E{(bf16_t*)(P.ws + WS_QRAW), 768, (const float*)(P.ws + WS_RSTDQ), 1 << 20};
    pg8::gemm_phase<EpiStore, pg8::StaticOrder, true, true>(GEMM_LDS, g, S, E);
}
__global__ void __launch_bounds__(512, 2) k_kvup_opt(Params P, int layer) {
    pg8::Gemm g{(const bf16_t*)(P.ws + WS_PROJ) + PC_CKV, (const bf16_t*)(P.ws + W_UKV), PJ, 256, 256}; pg8::StaticOrder S; S.init(T, 768, gridDim.x, blockIdx.x);
    EpiStore E{(bf16_t*)(P.ws + WS_KVRAW), 768, (const float*)(P.ws + WS_RSTDKV), 1 << 20};
    pg8::gemm_phase<EpiStore, pg8::StaticOrder, true, true>(GEMM_LDS, g, S, E);
}
__global__ void __launch_bounds__(512, 2) k_glu_opt(Params P, int layer) {
    pg8::Gemm g{(const bf16_t*)(P.ws + WS_YG), (const bf16_t*)(P.ws + W_GLU), 256, 256, 256}; pg8::StaticOrder S; S.init(T, 256, gridDim.x, blockIdx.x);
    EpiGlu E{(const bf16_t*)(P.ws + WS_YG), (bf16_t*)(P.ws + WS_OSSM), P.b_glu + layer * 256};
    pg8::gemm_phase<EpiGlu, pg8::StaticOrder, true, true>(GEMM_LDS, g, S, E);
}
__global__ void __launch_bounds__(512, 2) k_outproj_opt(Params P, int layer) {
    pg8::Gemm g{(const bf16_t*)(P.ws + WS_HBUF), (const bf16_t*)(P.ws + W_OUT), D, D, D}; pg8::StaticOrder S; S.init(T, D, gridDim.x, blockIdx.x);
    EpiResid E{P.out, adap(P, layer, 0, 2)};
    pg8::gemm_phase<EpiResid, pg8::StaticOrder, true, true>(GEMM_LDS, g, S, E);
}
__global__ void __launch_bounds__(512, 2) k_ffn1_opt(Params P, int layer) {
    pg8::Gemm g{(const bf16_t*)(P.ws + WS_HBUF), (const bf16_t*)(P.ws + W_F1), D, D, D}; pg8::StaticOrder S; S.init(T, 2 * DFF, gridDim.x, blockIdx.x);
    EpiSwiglu E{(bf16_t*)(P.ws + WS_ACT), DFF, 1 << 20};
    pg8::gemm_phase<EpiSwiglu, pg8::StaticOrder, true, true>(GEMM_LDS, g, S, E);
}
__global__ void __launch_bounds__(512, 2) k_ffn2_opt(Params P, int layer) {
    pg8::Gemm g{(const bf16_t*)(P.ws + WS_ACT), (const bf16_t*)(P.ws + W_F2), DFF, DFF, DFF}; pg8::StaticOrder S; S.init(T, D, gridDim.x, blockIdx.x);
    EpiResid E{P.out, adap(P, layer, 0, 5)};
    pg8::gemm_phase<EpiResid, pg8::StaticOrder, true, true>(GEMM_LDS, g, S, E);
}
struct MoeDec1 { const int* p2e; __device__ __forceinline__ void operator()(int L, Unit& u) const { const int pnl = L / 11, t = L % 11; u.pm = pnl; u.pn = p2e[pnl] * 11 + t; } };
struct MoeDec2 { const int* p2e; __device__ __forceinline__ void operator()(int L, Unit& u) const { const int pnl = L >> 2, t = L & 3; u.pm = pnl; u.pn = p2e[pnl] * 4 + t; } };
__global__ void __launch_bounds__(512, 2) k_moe1_opt(Params P, int layer) {
    const int* p2e = (const int*)(P.ws + WS_P2E); const int npan = __builtin_amdgcn_readfirstlane(p2e[300]);
    pg8::Gemm g{(const bf16_t*)(P.ws + WS_HG), (const bf16_t*)(P.ws + W_F1), D, D, D};
    pg8::ListOrder<MoeDec1> S{npan * 11, (int)gridDim.x, (int)blockIdx.x, MoeDec1{p2e}};
    EpiSwiglu E{(bf16_t*)(P.ws + WS_ACTM), DFE, 11};
    pg8::gemm_phase<EpiSwiglu, pg8::ListOrder<MoeDec1>, true, true>(GEMM_LDS, g, S, E);
}
__global__ void __launch_bounds__(512, 2) k_moe2_opt(Params P, int layer) {
    const int* p2e = (const int*)(P.ws + WS_P2E); const int npan = __builtin_amdgcn_readfirstlane(p2e[300]);
    pg8::Gemm g{(const bf16_t*)(P.ws + WS_ACTM), (const bf16_t*)(P.ws + W_F2), DFE, DFE, DFE};
    pg8::ListOrder<MoeDec2> S{npan * 4, (int)gridDim.x, (int)blockIdx.x, MoeDec2{p2e}};
    EpiStore E{(bf16_t*)(P.ws + WS_HG), D, nullptr, 4};
    pg8::gemm_phase<EpiStore, pg8::ListOrder<MoeDec2>, true, true>(GEMM_LDS, g, S, E);
}

template <class... A> static void launch_opt(void (*k)(A...), hipStream_t stream, A... a) {
    (void)hipFuncSetAttribute((const void*)k, hipFuncAttributeMaxDynamicSharedMemorySize, LDS_BYTES);
    hipLaunchKernelGGL(k, dim3(256), dim3(512), LDS_BYTES, stream, a...);
}
extern "C" void kernel_launch(void* const* d_in, const int* in_sizes, int n_in, void* d_out, int out_size, void* d_ws, size_t ws_size, hipStream_t stream) {
    if (ws_size < WS_END || n_in < 37) return;
    Params P{};
    P.x = (const float*)d_in[0]; P.c = (const float*)d_in[1]; P.pos = (const int*)d_in[2]; P.norm_mix = (const float*)d_in[3]; P.norm_ffn = (const float*)d_in[4];
    P.w_ada = (const float*)d_in[5]; P.b_ada = (const float*)d_in[6]; P.w_in = (const float*)d_in[7];
    P.lam_re = (const float*)d_in[8]; P.lam_im = (const float*)d_in[9]; P.log_dt = (const float*)d_in[10]; P.b_re = (const float*)d_in[11]; P.b_im = (const float*)d_in[12];
    P.c_re = (const float*)d_in[13]; P.c_im = (const float*)d_in[14]; P.ssm_d = (const float*)d_in[15]; P.w_glu = (const float*)d_in[16]; P.b_glu = (const float*)d_in[17];
    P.q_norm = (const float*)d_in[18]; P.kv_norm = (const float*)d_in[19]; P.w_uq = (const float*)d_in[20]; P.w_ukv = (const float*)d_in[21]; P.mla_gq = (const float*)d_in[22]; P.mla_gk = (const float*)d_in[23];
    P.fox_bf = (const float*)d_in[24]; P.fox_gq = (const float*)d_in[25]; P.fox_gk = (const float*)d_in[26]; P.out_norm = (const float*)d_in[27]; P.w_out = (const float*)d_in[28];
    P.ffn_wg = (const float*)d_in[29]; P.ffn_wu = (const float*)d_in[30]; P.ffn_wd = (const float*)d_in[31];
    P.moe_wr = (const float*)d_in[32]; P.moe_br = (const float*)d_in[33]; P.moe_wg = (const float*)d_in[34]; P.moe_wu = (const float*)d_in[35]; P.moe_wd = (const float*)d_in[36];
    P.out = (float*)d_out; P.ws = (unsigned char*)d_ws;
    (void)hipMemsetAsync(d_ws, 0, CTL_BYTES, stream);
    const bf16_t* proj = (const bf16_t*)(P.ws + WS_PROJ);
    float* xe = (float*)(P.ws + WS_XE);
    k_prologue<<<256, 512, 0, stream>>>(P);
    for (int layer = 0; layer < DEPTH; ++layer) {
        k_norm<0><<<1024, 512, 0, stream>>>(P, layer, layer == 0 ? P.x : P.out, layer == 0 ? 1 : 0);
#if OPT_GEMM
        launch_opt(k_convert, stream, P, layer);
        launch_opt(k_inproj_opt, stream, P, layer);
        if (CHECK) k_inproj_naive<<<1024, 512, 0, stream>>>(P, layer, 1);
#else
        k_inproj_naive<<<1024, 512, 0, stream>>>(P, layer, 0);
#endif
        k_passC<<<256, 512, 0, stream>>>(P, layer);
#if OPT_GEMM
        launch_opt(k_qup_opt, stream, P, layer); launch_opt(k_kvup_opt, stream, P, layer);
        if (CHECK) { k_qup_naive<<<1024, 512, 0, stream>>>(P, layer, 2); k_kvup_naive<<<1024, 512, 0, stream>>>(P, layer, 3); }
#else
        k_qup_naive<<<1024, 512, 0, stream>>>(P, layer, 0); k_kvup_naive<<<1024, 512, 0, stream>>>(P, layer, 0);
#endif
        k_passE<<<256, 512, 0, stream>>>(P, layer);
        k_attn_naive<96, 0><<<384, 512, 0, stream>>>(P, (const bf16_t*)(P.ws + WS_QMLA), 576, (const bf16_t*)(P.ws + WS_KMLA), 576, (const bf16_t*)(P.ws + WS_KVRAW) + 64, 768, 128, (bf16_t*)(P.ws + WS_OBUF), 768, nullptr, 0);
        k_attn_naive<64, 1><<<384, 512, 0, stream>>>(P, proj + PC_FQ, PJ, proj + PC_FK, PJ, proj + PC_FV, PJ, 64, (bf16_t*)(P.ws + WS_OBUF) + 384, 768, (const float*)(P.ws + WS_CB2), 0);
        k_ssm_naive<<<16, 512, 0, stream>>>(P, layer, 0);
#if OPT_GEMM
        launch_opt(k_glu_opt, stream, P, layer);
        if (CHECK) k_glu_naive<<<512, 512, 0, stream>>>(P, layer, 4);
#else
        k_glu_naive<<<512, 512, 0, stream>>>(P, layer, 0);
#endif
        k_merge<<<1024, 512, 0, stream>>>(P);
#if OPT_GEMM
        if (CHECK) k_outproj_naive<<<1024, 512, 0, stream>>>(P, layer, xe, 5);
        launch_opt(k_outproj_opt, stream, P, layer);
        if (CHECK) k_cmp_x<<<1024, 512, 0, stream>>>(P, xe, 5);
#else
        k_outproj_naive<<<1024, 512, 0, stream>>>(P, layer, P.out, 0);
#endif
        if ((layer & 1) == 0) {
            k_norm<1><<<1024, 512, 0, stream>>>(P, layer, P.out, 0);
#if OPT_GEMM
            launch_opt(k_ffn1_opt, stream, P, layer);
            if (CHECK) { k_ffn1_naive<<<2048, 512, 0, stream>>>(P, layer, 6); k_ffn2_naive<<<1024, 512, 0, stream>>>(P, layer, xe, 7); }
            launch_opt(k_ffn2_opt, stream, P, layer);
            if (CHECK) k_cmp_x<<<1024, 512, 0, stream>>>(P, xe, 7);
#else
            k_ffn1_naive<<<2048, 512, 0, stream>>>(P, layer, 0);
            k_ffn2_naive<<<1024, 512, 0, stream>>>(P, layer, P.out, 0);
#endif
        } else {
            k_norm<2><<<1024, 512, 0, stream>>>(P, layer, P.out, 0);
            k_moe_gather<<<1024, 512, 0, stream>>>(P, layer);
#if OPT_GEMM
            launch_opt(k_moe1_opt, stream, P, layer);
            if (CHECK) k_moe1_naive<<<2048, 512, 0, stream>>>(P, layer, 8);
            launch_opt(k_moe2_opt, stream, P, layer);
            if (CHECK) k_moe2_naive<<<1024, 512, 0, stream>>>(P, layer, 9);
#else
            k_moe1_naive<<<2048, 512, 0, stream>>>(P, layer, 0);
            k_moe2_naive<<<1024, 512, 0, stream>>>(P, layer, 0);
#endif
            k_moe_combine<<<1024, 512, 0, stream>>>(P, layer);
        }
    }
    if (CHECK) k_check_final<<<1024, 512, 0, stream>>>(P);
}
```

```cpp
#include <hip/hip_runtime.h>
#include <stdint.h>
#include <math.h>

typedef unsigned short bf16_t;
typedef float f32x4 __attribute__((ext_vector_type(4)));
typedef unsigned u32x2 __attribute__((ext_vector_type(2)));
typedef unsigned u32x4 __attribute__((ext_vector_type(4)));

#ifndef DUP
#define DUP 0
#endif
#ifndef CHECK
#define CHECK 0
#endif
#ifndef MEGA
#define MEGA 1
#endif
#define LATE_CONVERT 0

constexpr int NB = 8, SEQ = 4096, T = NB * SEQ, D = 1024, DEPTH = 4;
constexpr int INC = 1830, PJ = 2048;
constexpr int PC_U = 0, PC_CQ = 256, PC_CKV = 512, PC_KR = 640, PC_FQ = 768, PC_FK = 1152, PC_FV = 1536, PC_FG = 1920;
constexpr int DFF = 2816, NEXP = 8, DFE = 1408;
constexpr float EPS = 1e-6f;
constexpr float LOG2E = 1.4426950408889634f;
constexpr float C2_MLA = 0.10206207261596577f * LOG2E;
constexpr float C2_FOX = 0.125f * LOG2E;
constexpr int NSLOT = 2 * T + NEXP * 256;

constexpr size_t MiB = 1u << 20;
constexpr size_t WS_CTL = 0, CTL_BYTES = 1 * MiB;
constexpr size_t WS_ADA = 1 * MiB;
constexpr size_t WS_COS = 2 * MiB, WS_SIN = 4 * MiB;
constexpr size_t WS_RSTDQ = 6 * MiB, WS_RSTDKV = 6 * MiB + 128 * 1024;
constexpr size_t WS_FG = 7 * MiB;
constexpr size_t WS_CLOC = 8 * MiB;
constexpr size_t WS_CTOT = 8 * MiB + 896 * 1024;
constexpr size_t WS_CB2 = 9 * MiB;
constexpr size_t WS_TOKINFO = 10 * MiB;
constexpr size_t WS_PROB = 10 * MiB + 512 * 1024;
constexpr size_t WS_SLOTOF = 10 * MiB + 768 * 1024;
constexpr size_t WS_P2E = 11 * MiB;
constexpr size_t WS_YG = 20 * MiB;
constexpr size_t WS_OSSM = 36 * MiB;
constexpr size_t WS_W = 72 * MiB;
constexpr size_t W_IN = WS_W, W_UQ = WS_W + 4 * MiB, W_UKV = WS_W + 4 * MiB + 512 * 1024, W_GLU = WS_W + 5 * MiB, W_OUT = WS_W + 6 * MiB;
constexpr size_t W_F1 = WS_W + 8 * MiB, W_F2 = WS_W + 52 * MiB, W_B1T = WS_W + 76 * MiB, W_T2T = WS_W + 80 * MiB;
constexpr size_t WS_UG = 52 * MiB;
constexpr size_t WS_SLOC = 12 * MiB;
constexpr size_t WS_KM = WS_W + 90 * MiB;
constexpr size_t WS_LAMP = WS_W + 91 * MiB;
constexpr size_t WS_BBAR = WS_W + 92 * MiB;
constexpr size_t WS_SSQ = WS_W + 93 * MiB;
constexpr size_t WS_HBUF = 168 * MiB;
constexpr size_t WS_BIG = 232 * MiB;
constexpr size_t WS_PROJ = WS_BIG;
constexpr size_t WS_QRAW = WS_BIG + 128 * MiB;
constexpr size_t WS_KVRAW = WS_BIG + 176 * MiB;
constexpr size_t WS_QMLA = WS_BIG + 224 * MiB;
constexpr size_t WS_KMLA = WS_BIG + 260 * MiB;
constexpr size_t WS_OBUF = WS_BIG + 296 * MiB;
constexpr size_t WS_ACT = WS_BIG;
constexpr size_t WS_HG = WS_BIG;
constexpr size_t WS_ACTM = WS_BIG + 132 * MiB;
constexpr size_t WS_LIST = WS_BIG + 320 * MiB;
constexpr size_t WS_XE = WS_BIG + 192 * MiB;
constexpr size_t WS_END = WS_BIG + 344 * MiB;
constexpr size_t WS_SSQ2 = 36 * MiB;
constexpr size_t WS_XB2 = WS_BIG + 68 * MiB;

constexpr int CW_CNT = 1024;
constexpr int CW_ATTN = 1536;
constexpr int CW_SUB = 12288;
constexpr int CW_ATTQ = 8192;
constexpr int CW_CHKE = 2048, CW_CHKR = 2112;

struct Params {
    const float* x; const float* c; const int* pos; const float* norm_mix; const float* norm_ffn; const float* w_ada; const float* b_ada; const float* w_in;
    const float* lam_re; const float* lam_im; const float* log_dt; const float* b_re; const float* b_im; const float* c_re; const float* c_im;
    const float* ssm_d; const float* w_glu; const float* b_glu;
    const float* q_norm; const float* kv_norm; const float* w_uq; const float* w_ukv; const float* mla_gq; const float* mla_gk;
    const float* fox_bf; const float* fox_gq; const float* fox_gk; const float* out_norm; const float* w_out;
    const float* ffn_wg; const float* ffn_wu; const float* ffn_wd;
    const float* moe_wr; const float* moe_br; const float* moe_wg; const float* moe_wu; const float* moe_wd;
    float* out; unsigned char* ws;
    int wid, pad;
};

__device__ __forceinline__ float bf2f(bf16_t h) { return __uint_as_float(((unsigned)h) << 16); }
__device__ __forceinline__ bf16_t f2bf(float f) { unsigned u = __float_as_uint(f); return (bf16_t)((u + 0x7fffu + ((u >> 16) & 1u)) >> 16); }
__device__ __forceinline__ unsigned pk2(float lo, float hi) { return (unsigned)f2bf(lo) | ((unsigned)f2bf(hi) << 16); }
__device__ __forceinline__ int hidden_tid(int wid) { int t; asm volatile("v_mbcnt_lo_u32_b32 %0, -1, 0\n\tv_mbcnt_hi_u32_b32 %0, -1, %0\n\tv_lshl_add_u32 %0, %1, 6, %0" : "=&v"(t) : "s"(wid)); return t; }
__device__ __forceinline__ int launder_i(int v) { asm volatile("" : "+s"(v)); return v; }
template <class T> __device__ __forceinline__ T* launder_ptr(T* p) { asm volatile("" : "+s"(p)); return p; }
__device__ __forceinline__ float shx(float v, int o, int lane) { return __int_as_float(__builtin_amdgcn_ds_bpermute((lane ^ o) << 2, __float_as_int(v))); }
__device__ __forceinline__ float wsum(float v, int lane) {
#pragma unroll
    for (int o = 32; o > 0; o >>= 1) v += shx(v, o, lane);
    return v;
}
__device__ __forceinline__ float wmax(float v, int lane) {
#pragma unroll
    for (int o = 32; o > 0; o >>= 1) v = fmaxf(v, shx(v, o, lane));
    return v;
}
__device__ __forceinline__ float silu_f(float v) { return v / (1.f + __expf(-v)); }
__device__ __forceinline__ float sigmoid_f(float v) { return 1.f / (1.f + __expf(-v)); }
__device__ __forceinline__ float gelu_tanh(float x) { return 0.5f * x * (1.f + tanhf(0.7978845608028654f * (x + 0.044715f * x * x * x))); }
__device__ __forceinline__ bf16_t* xstream(const Params& P, int idx) { return idx >= DEPTH ? (bf16_t*)(P.ws + WS_XB2) : (bf16_t*)(P.out + (size_t)T * D / 2); }
__device__ __forceinline__ size_t ymoe_off(int layer) { return layer == DEPTH - 1 ? WS_HBUF : WS_HG; }
__device__ __forceinline__ float* adap(const Params& P, int layer, int b, int which) { return (float*)(P.ws + WS_ADA) + ((size_t)(layer * NB + b) * 6 + which) * D; }

struct Chk { float e, r; };
__device__ __forceinline__ void chk_upd(Chk& c, float naive, float stored) { const float d = fabsf(naive - stored); c.e = (d != d) ? INFINITY : fmaxf(c.e, d); c.r = fmaxf(c.r, fabsf(naive)); }
__device__ __forceinline__ void chk_commit(const Params& P, int stage, Chk c) {
    const int lane_ = (int)(threadIdx.x & 63); const float e = wmax(c.e, lane_), r = wmax(c.r, lane_);
    if (lane_ == 0) { unsigned* ctl = (unsigned*)(P.ws + WS_CTL); atomicMax(ctl + CW_CHKE + stage, __float_as_uint(e)); atomicMax(ctl + CW_CHKR + stage, __float_as_uint(r)); }
}
__device__ __forceinline__ void st4(bf16_t* p, const float (&v)[4], int chk, Chk& c) {
    if (!chk) { u32x2 o; o.x = pk2(v[0], v[1]); o.y = pk2(v[2], v[3]); *(u32x2*)p = o; }
    else { const u32x2 o = *(const u32x2*)p; chk_upd(c, v[0], bf2f(o.x & 0xffff)); chk_upd(c, v[1], bf2f(o.x >> 16)); chk_upd(c, v[2], bf2f(o.y & 0xffff)); chk_upd(c, v[3], bf2f(o.y >> 16)); }
}
__device__ __forceinline__ void st2(bf16_t* p, float a, float b, int chk, Chk& c) {
    if (!chk) *(unsigned*)p = pk2(a, b);
    else { const unsigned o = *(const unsigned*)p; chk_upd(c, a, bf2f(o & 0xffff)); chk_upd(c, b, bf2f(o >> 16)); }
}

template <class FA, class FT, class FB, class FS>
__device__ __forceinline__ void naive_gemm(int M, int N, int K, FA fa, FT ft, FB fb, FS fs, float* sm) {
    const int tid = threadIdx.x, ty = tid >> 5, tx = tid & 31;
    float (*As)[132] = (float (*)[132])sm;
    float (*Bs)[132] = (float (*)[132])(sm + 16 * 132);
    const int tm = (M + 127) / 128, tn = (N + 127) / 128;
    for (int tile = blockIdx.x; tile < tm * tn; tile += gridDim.x) {
        const int bm = (tile / tn) * 128, bn = (tile % tn) * 128;
        const int ctx = ft(bm);
        float acc[8][4];
#pragma unroll
        for (int i = 0; i < 8; ++i)
#pragma unroll
            for (int j = 0; j < 4; ++j) acc[i][j] = 0.f;
        for (int k0 = 0; k0 < K; k0 += 16) {
#pragma unroll
            for (int j = 0; j < 4; ++j) {
                const int e = tid + 512 * j, r = e >> 4, kk = e & 15;
                As[kk][r] = (bm + r < M) ? fa(bm + r, k0 + kk) : 0.f;
                const int k2 = e >> 7, cc = e & 127;
                Bs[k2][cc] = (bn + cc < N) ? fb(k0 + k2, bn + cc, ctx) : 0.f;
            }
            __syncthreads();
#pragma unroll
            for (int kk = 0; kk < 16; ++kk) {
                const f32x4 a0 = *(const f32x4*)&As[kk][ty * 8], a1 = *(const f32x4*)&As[kk][ty * 8 + 4], b = *(const f32x4*)&Bs[kk][tx * 4];
                const float a[8] = {a0[0], a0[1], a0[2], a0[3], a1[0], a1[1], a1[2], a1[3]};
#pragma unroll
                for (int i = 0; i < 8; ++i)
#pragma unroll
                    for (int j = 0; j < 4; ++j) acc[i][j] = fmaf(a[i], b[j], acc[i][j]);
            }
            __syncthreads();
        }
#pragma unroll
        for (int i = 0; i < 8; ++i) { const int row = bm + ty * 8 + i; if (row < M) fs(row, bn + tx * 4, acc[i]); }
    }
}

__device__ __forceinline__ void ph_prologue(unsigned char* lds, Params P) {
    const int TIDX = hidden_tid(P.wid), BIDX = launder_i((int)blockIdx.x), GDIM = launder_i((int)gridDim.x); P.ws = launder_ptr(P.ws); P.out = launder_ptr(P.out);
    float* cact = (float*)lds;
    float* red = cact + NB * D;
    { f32x4 cv[4];
#pragma unroll
      for (int i = 0; i < 4; ++i) cv[i] = *(const f32x4*)(P.c + (size_t)(i * 512 + TIDX) * 4);
#pragma unroll
      for (int i = 0; i < 4; ++i) *(f32x4*)(cact + (size_t)(i * 512 + TIDX) * 4) = (f32x4){silu_f(cv[i][0]), silu_f(cv[i][1]), silu_f(cv[i][2]), silu_f(cv[i][3])}; }
    __syncthreads();
    float* ada = (float*)(P.ws + WS_ADA);
    const int j4 = (TIDX & 7) * 4, ks = TIDX >> 3;
    f32x4 wv[16], wn[16];
    auto load_item = [&](int item, f32x4 (&w_)[16]) { const int layer = item / 192, c0 = (item % 192) * 32;
        const float* w = P.w_ada + (size_t)layer * D * 6 * D + (size_t)(ks * 16) * 6 * D + c0 + j4;
#pragma unroll
        for (int u = 0; u < 16; ++u) w_[u] = *(const f32x4*)(w + (size_t)u * 6 * D); };
    if (BIDX < DEPTH * 192) load_item(BIDX, wv);
    for (int item = BIDX; item < DEPTH * 192; item += GDIM) {
        const int layer = item / 192, c0 = (item % 192) * 32;
        if (item + GDIM < DEPTH * 192) load_item(item + GDIM, wn);
        f32x4 acc[NB];
#pragma unroll
        for (int b = 0; b < NB; ++b) acc[b] = (f32x4){0.f, 0.f, 0.f, 0.f};
#pragma unroll
        for (int u = 0; u < 16; ++u)
#pragma unroll
            for (int b = 0; b < NB; ++b) acc[b] += cact[b * D + ks * 16 + u] * wv[u];
#pragma unroll
        for (int b = 0; b < NB; ++b) *(f32x4*)(red + (ks * NB + b) * 32 + j4) = acc[b];
        __syncthreads();
        if (TIDX < 256) { const int b = TIDX >> 5, jj = TIDX & 31; float s = 0.f;
            for (int k2 = 0; k2 < 64; ++k2) s += red[(k2 * NB + b) * 32 + jj];
            ada[(size_t)(layer * NB + b) * 6 * D + c0 + jj] = s + P.b_ada[layer * 6 * D + c0 + jj]; }
        __syncthreads();
#pragma unroll
        for (int u = 0; u < 16; ++u) wv[u] = wn[u];
    }
    float* cs = (float*)(P.ws + WS_COS); float* sn = (float*)(P.ws + WS_SIN);
    const int gt = BIDX * 512 + TIDX, nt = GDIM * 512;
    for (int idx0 = gt; idx0 < T * 16; idx0 += 4 * nt) {
        int pp[4];
#pragma unroll
        for (int u = 0; u < 4; ++u) { const int idx = idx0 + u * nt; pp[u] = idx < T * 16 ? P.pos[idx >> 4] : 0; }
#pragma unroll
        for (int u = 0; u < 4; ++u) { const int idx = idx0 + u * nt;
            if (idx < T * 16) { const int jx = idx & 15; const float ang = (float)pp[u] * exp2f(-(float)jx * (13.287712379549449f / 16.f));
                float sv_, cv_; sincosf(ang, &sv_, &cv_); cs[idx] = cv_; sn[idx] = sv_; } }
    }
}

__device__ __forceinline__ void moe_offsets(const Params& P, int layer, int (&off)[NEXP + 1]) {
    const unsigned* cnt = (const unsigned*)(P.ws + WS_CTL) + CW_CNT + 16 * (layer / 2);
    int o = 0;
#pragma unroll
    for (int e = 0; e < NEXP; ++e) { off[e] = o; o += (int)((cnt[e] + 255u) >> 8) << 8; }
    off[NEXP] = o;
}
__device__ __forceinline__ int moe_sel(const int (&off)[NEXP + 1], int e) { int r = 0;
#pragma unroll
    for (int j = 0; j < NEXP; ++j) if (e == j) r = off[j];
    return r; }
template <int MODE, int VAR>
__device__ __forceinline__ void ph_norm(unsigned char* lds, Params P, int layer, const float* src, int comb) {
    const int TIDX = hidden_tid(P.wid), BIDX = launder_i((int)blockIdx.x), GDIM = launder_i((int)gridDim.x); P.ws = launder_ptr(P.ws); P.out = launder_ptr(P.out);
    const int wid = TIDX >> 6, lane = TIDX & 63;
    const float* gain = (MODE == 0 ? P.norm_mix : P.norm_ffn) + layer * D;
    bf16_t* hb = (bf16_t*)(P.ws + WS_HBUF); bf16_t* xs = xstream(P, (MODE == 2 && layer == DEPTH - 1) ? DEPTH : layer);
    float* wrl = (float*)(lds + 4096);
    if (MODE == 2) { if (TIDX < 16) ((unsigned*)lds)[TIDX] = 0u;
        const f32x4* src4 = (const f32x4*)(P.moe_wr + (size_t)(layer / 2) * D * NEXP); for (int i = TIDX; i < D * NEXP / 4; i += 512) ((f32x4*)wrl)[i] = src4[i];
        __syncthreads(); }
    constexpr int NR = 4;
    const int RPW = (T + GDIM * 8 - 1) / (GDIM * 8), rbeg = (BIDX * 8 + wid) * RPW;
    int off_[NEXP + 1];
    if (VAR == 2) moe_offsets(P, comb, off_);
    const bf16_t* ym = (const bf16_t*)(P.ws + WS_HG); const int* tinfo = (const int*)(P.ws + WS_TOKINFO); const float* prob = (const float*)(P.ws + WS_PROB);
    int bcur = -1; f32x4 av[4], bv[4], gq[4];
    for (int j0 = 0; j0 < RPW; j0 += NR) {
        f32x4 vf[VAR == 1 ? NR : 1][4]; u32x2 w[VAR == 1 ? 1 : NR][4], ya[VAR == 2 ? NR : 1][4], yb[VAR == 2 ? NR : 1][4]; float p0[NR], p1[NR];
        if (VAR == 1) {
#pragma unroll
            for (int k = 0; k < NR; ++k) { const int row = rbeg + j0 + k;
                if (j0 + k < RPW && row < T) {
#pragma unroll
                    for (int q = 0; q < 4; ++q) vf[VAR == 1 ? k : 0][q] = *(const f32x4*)(src + (size_t)row * D + q * 256 + lane * 4); } }
        } else {
#pragma unroll
            for (int k = 0; k < NR; ++k) { const int row = rbeg + j0 + k;
                if (j0 + k < RPW && row < T) {
#pragma unroll
                    for (int q = 0; q < 4; ++q) w[VAR == 1 ? 0 : k][q] = *(const u32x2*)(xs + (size_t)row * D + q * 256 + lane * 4); } }
            if (VAR == 2) {
                int s0[NR], s1[NR];
#pragma unroll
                for (int k = 0; k < NR; ++k) { const int row = rbeg + j0 + k;
                    if (j0 + k < RPW && row < T) { const int* ti_ = tinfo + (size_t)row * 4; s0[k] = moe_sel(off_, ti_[0]) + ti_[1]; s1[k] = moe_sel(off_, ti_[2]) + ti_[3]; p0[k] = prob[(size_t)row * 2]; p1[k] = prob[(size_t)row * 2 + 1]; } }
#pragma unroll
                for (int k = 0; k < NR; ++k) { const int row = rbeg + j0 + k;
                    if (j0 + k < RPW && row < T) {
#pragma unroll
                        for (int q = 0; q < 4; ++q) { ya[VAR == 2 ? k : 0][q] = *(const u32x2*)(ym + (size_t)s0[k] * D + q * 256 + lane * 4); yb[VAR == 2 ? k : 0][q] = *(const u32x2*)(ym + (size_t)s1[k] * D + q * 256 + lane * 4); } } }
            }
        }
#pragma unroll
        for (int k = 0; k < NR; ++k) { const int row = rbeg + j0 + k;
            if (j0 + k < RPW && row < T) {
                const int b = row / SEQ;
                f32x4 v[4];
#pragma unroll
                for (int q = 0; q < 4; ++q) { if (VAR == 1) v[q] = vf[VAR == 1 ? k : 0][q]; else { const u32x2 ww = w[VAR == 1 ? 0 : k][q]; v[q] = (f32x4){bf2f(ww.x & 0xffff), bf2f(ww.x >> 16), bf2f(ww.y & 0xffff), bf2f(ww.y >> 16)}; } }
                if (b != bcur) {
                    bcur = b; const float* sh = adap(P, layer, b, MODE == 0 ? 0 : 3); const float* sc = adap(P, layer, b, MODE == 0 ? 1 : 4);
#pragma unroll
                    for (int q = 0; q < 4; ++q) { const int col = q * 256 + lane * 4; const f32x4 g = *(const f32x4*)(gain + col), s1_ = *(const f32x4*)(sc + col); bv[q] = *(const f32x4*)(sh + col); av[q] = g * (1.f + s1_);
                        if (VAR == 2) gq[q] = *(const f32x4*)(adap(P, comb, b, 5) + col); } }
                if (VAR == 2) {
#pragma unroll
                    for (int q = 0; q < 4; ++q) { const u32x2 a = ya[VAR == 2 ? k : 0][q], b2 = yb[VAR == 2 ? k : 0][q]; const f32x4 g = gq[q];
                        v[q][0] += g[0] * (p0[k] * bf2f(a.x & 0xffff) + p1[k] * bf2f(b2.x & 0xffff)); v[q][1] += g[1] * (p0[k] * bf2f(a.x >> 16) + p1[k] * bf2f(b2.x >> 16));
                        v[q][2] += g[2] * (p0[k] * bf2f(a.y & 0xffff) + p1[k] * bf2f(b2.y & 0xffff)); v[q][3] += g[3] * (p0[k] * bf2f(a.y >> 16) + p1[k] * bf2f(b2.y >> 16)); } }
                float ss = 0.f;
#pragma unroll
                for (int q = 0; q < 4; ++q) ss += v[q][0] * v[q][0] + v[q][1] * v[q][1] + v[q][2] * v[q][2] + v[q][3] * v[q][3];
                if (VAR != 0) {
#pragma unroll
                    for (int q = 0; q < 4; ++q) { u32x2 o; o.x = pk2(v[q][0], v[q][1]); o.y = pk2(v[q][2], v[q][3]); *(u32x2*)(xs + (size_t)row * D + q * 256 + lane * 4) = o; }
                }
                ss = wsum(ss, lane);
                const float rstd = rsqrtf(ss * (1.f / D) + EPS);
                float lg[NEXP];
#pragma unroll
                for (int e = 0; e < NEXP; ++e) lg[e] = 0.f;
#pragma unroll
                for (int q = 0; q < 4; ++q) {
                    const int col = q * 256 + lane * 4;
                    float h[4];
#pragma unroll
                    for (int j = 0; j < 4; ++j) h[j] = v[q][j] * rstd * av[q][j] + bv[q][j];
                    u32x2 o; o.x = pk2(h[0], h[1]); o.y = pk2(h[2], h[3]);
                    *(u32x2*)(hb + (size_t)row * D + col) = o;
                    if (MODE == 2) {
                        const float* wr = wrl + col * NEXP;
#pragma unroll
                        for (int j = 0; j < 4; ++j) { const f32x4 w0 = *(const f32x4*)(wr + j * 8), w1 = *(const f32x4*)(wr + j * 8 + 4);
                            lg[0] += h[j] * w0[0]; lg[1] += h[j] * w0[1]; lg[2] += h[j] * w0[2]; lg[3] += h[j] * w0[3];
                            lg[4] += h[j] * w1[0]; lg[5] += h[j] * w1[1]; lg[6] += h[j] * w1[2]; lg[7] += h[j] * w1[3]; }
                    }
                }
                if (MODE == 2) {
#pragma unroll
                    for (int e = 0; e < NEXP; ++e) lg[e] = wsum(lg[e], lane) + P.moe_br[(layer / 2) * NEXP + e];
                    if (lane == 0) {
                        int i0 = 0; float v0 = lg[0];
#pragma unroll
                        for (int e = 1; e < NEXP; ++e) if (lg[e] > v0) { v0 = lg[e]; i0 = e; }
                        int i1 = -1; float v1 = -INFINITY;
#pragma unroll
                        for (int e = 0; e < NEXP; ++e) if (e != i0 && lg[e] > v1) { v1 = lg[e]; i1 = e; }
                        const float pa = 1.f / (1.f + expf(v1 - v0)), pb = 1.f - pa;
                        unsigned* lcnt = (unsigned*)lds; int* lti = (int*)(lds + 64) + (wid * 16 + j0 + k) * 4;
                        const int pos0 = (int)atomicAdd(lcnt + i0, 1u), pos1 = (int)atomicAdd(lcnt + i1, 1u);
                        lti[0] = i0; lti[1] = pos0; lti[2] = i1; lti[3] = pos1;
                        float* pr = (float*)(P.ws + WS_PROB) + (size_t)row * 2; pr[0] = pa; pr[1] = pb;
                    }
                }
            }
        }
    }
    if (MODE == 2) {
        __syncthreads();
        unsigned* lcnt = (unsigned*)lds; int* lti = (int*)(lds + 64);
        if (TIDX < NEXP) { unsigned* cnt = (unsigned*)(P.ws + WS_CTL) + CW_CNT + 16 * (layer / 2); lcnt[8 + TIDX] = atomicAdd(cnt + TIDX, lcnt[TIDX]); }
        __syncthreads();
        if (TIDX < 128) { const int w_ = TIDX >> 4, j_ = TIDX & 15, row = (BIDX * 8 + w_) * RPW + j_;
            if (j_ < RPW && row < T) { const int e0 = lti[TIDX * 4], e1 = lti[TIDX * 4 + 2]; int* ti = (int*)(P.ws + WS_TOKINFO) + (size_t)row * 4;
                const int q0_ = lti[TIDX * 4 + 1] + (int)lcnt[8 + e0], q1_ = lti[TIDX * 4 + 3] + (int)lcnt[8 + e1]; int* list = (int*)(P.ws + WS_LIST);
                ti[0] = e0; ti[1] = q0_; ti[2] = e1; ti[3] = q1_; list[(size_t)e0 * T + q0_] = row; list[(size_t)e1 * T + q1_] = row; } }
        __syncthreads();
    }
}

__device__ __forceinline__ int proj_orig_col(int col) { return col < 672 ? col : (col < 768 ? -1 : (col < 1926 ? col - 96 : -1)); }
__device__ __forceinline__ void ph_inproj_naive(unsigned char* lds, Params P, int layer, int chk) {
    const int TIDX = hidden_tid(P.wid), BIDX = launder_i((int)blockIdx.x), GDIM = launder_i((int)gridDim.x); P.ws = launder_ptr(P.ws); P.out = launder_ptr(P.out);
    float* sm = (float*)lds;
    const bf16_t* hb = (const bf16_t*)(P.ws + WS_HBUF); const float* w = P.w_in + (size_t)layer * D * INC;
    bf16_t* proj = (bf16_t*)(P.ws + WS_PROJ); float* fg = (float*)(P.ws + WS_FG);
    Chk ck{0.f, 0.f};
    naive_gemm(T, PJ, D,
        [&](int r, int k) { return bf2f(hb[(size_t)r * D + k]); },
        [&](int) { return 0; },
        [&](int k, int col, int) { const int oc = proj_orig_col(col); return oc < 0 ? 0.f : w[(size_t)k * INC + oc]; },
        [&](int r, int c0, const float (&v)[4]) {
            st4(proj + (size_t)r * PJ + c0, v, chk, ck);
            if (c0 >= PC_FG && c0 < PC_FG + 8) { float* fp = fg + (size_t)r * 8 + (c0 - PC_FG);
                if (!chk) *(f32x4*)fp = (f32x4){v[0], v[1], v[2], v[3]};
                else { chk_upd(ck, v[0], fp[0]); chk_upd(ck, v[1], fp[1]); chk_upd(ck, v[2], fp[2]); chk_upd(ck, v[3], fp[3]); } }
        }, sm);
    if (chk) chk_commit(P, chk, ck);
}

__device__ __forceinline__ void ph_passC(unsigned char* lds, Params P, int layer) {
    const int TIDX = hidden_tid(P.wid), BIDX = launder_i((int)blockIdx.x), GDIM = launder_i((int)gridDim.x); P.ws = launder_ptr(P.ws); P.out = launder_ptr(P.out);
    float (*lfs)[8] = (float (*)[8])lds;
    const int wid = TIDX >> 6, lane = TIDX & 63;
    bf16_t* proj = (bf16_t*)(P.ws + WS_PROJ); const float* fg = (const float*)(P.ws + WS_FG);
    float* rq = (float*)(P.ws + WS_RSTDQ); float* rkv = (float*)(P.ws + WS_RSTDKV);
    float* cloc = (float*)(P.ws + WS_CLOC); float* ctot = (float*)(P.ws + WS_CTOT);
    const float gq = P.fox_gq[layer * 64 + lane] * C2_FOX, gk = P.fox_gk[layer * 64 + lane];
    for (int chunk = BIDX; chunk < T / 128; chunk += GDIM) {
        for (int i = 0; i < 16; ++i) {
            const int tl = wid * 16 + i, row = chunk * 128 + tl;
            bf16_t* pr = proj + (size_t)row * PJ;
            { const u32x2 w = *(const u32x2*)(pr + PC_CQ + lane * 4); const float a = bf2f(w.x & 0xffff), b = bf2f(w.x >> 16), c = bf2f(w.y & 0xffff), d = bf2f(w.y >> 16);
              const float ss = wsum(a * a + b * b + c * c + d * d, lane); if (lane == 0) rq[row] = rsqrtf(ss * (1.f / 256.f) + EPS); }
            { const u32x2 w = *(const u32x2*)(pr + PC_U + lane * 4); const int g_ = lane >> 2, c_ = (lane & 3) * 4, b_ = row / SEQ, t_ = row % SEQ;
              *(u32x2*)((bf16_t*)(P.ws + WS_UG) + (size_t)(g_ * 1024 + b_ * 128 + (t_ >> 5)) * 640 + (t_ & 31) * 16 + c_) = w; }
            { const unsigned w = *(const unsigned*)(pr + PC_CKV + lane * 2); const float a = bf2f(w & 0xffff), b = bf2f(w >> 16);
              const float ss = wsum(a * a + b * b, lane); if (lane == 0) rkv[row] = rsqrtf(ss * (1.f / 128.f) + EPS); }
#pragma unroll
            for (int h = 0; h < 6; ++h) {
                const float a = bf2f(pr[PC_FQ + h * 64 + lane]); const float ra = rsqrtf(wsum(a * a, lane) * (1.f / 64.f) + EPS); pr[PC_FQ + h * 64 + lane] = f2bf(a * ra * gq);
                const float b = bf2f(pr[PC_FK + h * 64 + lane]); const float rb = rsqrtf(wsum(b * b, lane) * (1.f / 64.f) + EPS); pr[PC_FK + h * 64 + lane] = f2bf(b * rb * gk);
            }
            if (lane < 6) { const float z = fg[(size_t)row * 8 + lane] + P.fox_bf[layer * 6 + lane];
                lfs[tl][lane] = z >= 0.f ? -log1pf(expf(-z)) : z - log1pf(expf(z)); }
        }
        __syncthreads();
        if (TIDX < 6) {
            const int h = TIDX, b = (chunk * 128) / SEQ, t0 = (chunk * 128) % SEQ; float run = 0.f;
            for (int j = 0; j < 128; ++j) { run += lfs[j][h]; cloc[((size_t)b * 6 + h) * SEQ + t0 + j] = run; }
            ctot[chunk * 8 + h] = run;
        }
        __syncthreads();
    }
}

__device__ __forceinline__ void ph_qup_naive(unsigned char* lds, Params P, int layer, int chk) {
    const int TIDX = hidden_tid(P.wid), BIDX = launder_i((int)blockIdx.x), GDIM = launder_i((int)gridDim.x); P.ws = launder_ptr(P.ws); P.out = launder_ptr(P.out);
    float* sm = (float*)lds;
    const bf16_t* proj = (const bf16_t*)(P.ws + WS_PROJ); const float* rq = (const float*)(P.ws + WS_RSTDQ);
    const float* w = P.w_uq + (size_t)layer * 256 * 576; const float* g = P.q_norm + layer * 256; bf16_t* qraw = (bf16_t*)(P.ws + WS_QRAW);
    Chk ck{0.f, 0.f};
    naive_gemm(T, 576, 256,
        [&](int r, int k) { return bf2f(proj[(size_t)r * PJ + PC_CQ + k]); },
        [&](int) { return 0; },
        [&](int k, int col, int) { return g[k] * w[(size_t)k * 576 + col]; },
        [&](int r, int c0, const float (&v)[4]) { const float s = rq[r]; const float o[4] = {v[0] * s, v[1] * s, v[2] * s, v[3] * s}; st4(qraw + (size_t)r * 768 + c0, o, chk, ck); }, sm);
    if (chk) chk_commit(P, chk, ck);
}
__device__ __forceinline__ void ph_kvup_naive(unsigned char* lds, Params P, int layer, int chk) {
    const int TIDX = hidden_tid(P.wid), BIDX = launder_i((int)blockIdx.x), GDIM = launder_i((int)gridDim.x); P.ws = launder_ptr(P.ws); P.out = launder_ptr(P.out);
    float* sm = (float*)lds;
    const bf16_t* proj = (const bf16_t*)(P.ws + WS_PROJ); const float* rk = (const float*)(P.ws + WS_RSTDKV);
    const float* w = P.w_ukv + (size_t)layer * 128 * 768; const float* g = P.kv_norm + layer * 128; bf16_t* kvraw = (bf16_t*)(P.ws + WS_KVRAW);
    Chk ck{0.f, 0.f};
    naive_gemm(T, 768, 128,
        [&](int r, int k) { return bf2f(proj[(size_t)r * PJ + PC_CKV + k]); },
        [&](int) { return 0; },
        [&](int k, int col, int) { return g[k] * w[(size_t)k * 768 + col]; },
        [&](int r, int c0, const float (&v)[4]) { const float s = rk[r]; const float o[4] = {v[0] * s, v[1] * s, v[2] * s, v[3] * s}; st4(kvraw + (size_t)r * 768 + c0, o, chk, ck); }, sm);
    if (chk) chk_commit(P, chk, ck);
}

__device__ __forceinline__ void ph_passE(unsigned char* lds, Params P, int layer) {
    const int TIDX = hidden_tid(P.wid), BIDX = launder_i((int)blockIdx.x), GDIM = launder_i((int)gridDim.x); P.ws = launder_ptr(P.ws); P.out = launder_ptr(P.out);
    float* pref = (float*)lds;
    const int wid = TIDX >> 6, lane = TIDX & 63;
    const bf16_t* proj = (const bf16_t*)(P.ws + WS_PROJ); const bf16_t* qraw = (const bf16_t*)(P.ws + WS_QRAW); const bf16_t* kvraw = (const bf16_t*)(P.ws + WS_KVRAW);
    bf16_t* qm = (bf16_t*)(P.ws + WS_QMLA); bf16_t* km = (bf16_t*)(P.ws + WS_KMLA);
    const float* cs = (const float*)(P.ws + WS_COS); const float* sn = (const float*)(P.ws + WS_SIN);
    const float* cloc = (const float*)(P.ws + WS_CLOC); const float* ctot = (const float*)(P.ws + WS_CTOT); float* cb2 = (float*)(P.ws + WS_CB2);
    const float gqa = P.mla_gq[layer * 96 + lane], gqb = lane < 32 ? P.mla_gq[layer * 96 + 64 + lane] : 0.f;
    const float gka = P.mla_gk[layer * 96 + lane], gkb = lane < 32 ? P.mla_gk[layer * 96 + 64 + lane] : 0.f;
    for (int chunk = BIDX; chunk < T / 128; chunk += GDIM) {
        const int b = (chunk * 128) / SEQ, t0 = (chunk * 128) % SEQ, ci = chunk % 32;
        if (TIDX < 6) { float s = 0.f; for (int c = 0; c < ci; ++c) s += ctot[(b * 32 + c) * 8 + TIDX]; pref[TIDX] = s; }
        __syncthreads();
        for (int e = TIDX; e < 6 * 128; e += 512) { const int h = e / 128, j = e % 128; const size_t ix = ((size_t)b * 6 + h) * SEQ + t0 + j; cb2[ix] = (cloc[ix] + pref[h]) * LOG2E; }
        for (int i = 0; i < 16; ++i) {
            const int row = chunk * 128 + wid * 16 + i;
            const float cv = cs[(size_t)row * 16 + (lane & 15)], sv = sn[(size_t)row * 16 + (lane & 15)];
#pragma unroll
            for (int h = 0; h < 6; ++h) {
                {
                    const float a = bf2f(qraw[(size_t)row * 768 + h * 96 + lane]); const float bq = lane < 32 ? bf2f(qraw[(size_t)row * 768 + h * 96 + 64 + lane]) : 0.f;
                    const float r = rsqrtf(wsum(a * a + bq * bq, lane) * (1.f / 96.f) + EPS);
                    const float an = a * r * gqa, bn = bq * r * gqb; const float pn = shx(bn, 16, lane);
                    const float ro = lane < 16 ? bn * cv - pn * sv : pn * sv + bn * cv;
                    qm[(size_t)row * 576 + h * 96 + lane] = f2bf(an * C2_MLA); if (lane < 32) qm[(size_t)row * 576 + h * 96 + 64 + lane] = f2bf(ro * C2_MLA);
                }
                {
                    const float a = bf2f(kvraw[(size_t)row * 768 + h * 128 + lane]); const float bk = lane < 32 ? bf2f(proj[(size_t)row * PJ + PC_KR + lane]) : 0.f;
                    const float r = rsqrtf(wsum(a * a + bk * bk, lane) * (1.f / 96.f) + EPS);
                    const float an = a * r * gka, bn = bk * r * gkb; const float pn = shx(bn, 16, lane);
                    const float ro = lane < 16 ? bn * cv - pn * sv : pn * sv + bn * cv;
                    km[(size_t)row * 576 + h * 96 + lane] = f2bf(an); if (lane < 32) km[(size_t)row * 576 + h * 96 + 64 + lane] = f2bf(ro);
                }
            }
        }
        __syncthreads();
    }
}

template <int DQK, int MODE>
__device__ __forceinline__ void ph_attn_naive(unsigned char* lds, Params P, const bf16_t* Q, int ldq, const bf16_t* K, int ldk, const bf16_t* V, int ldv, int vhs, bf16_t* O, int ldo, const float* cb2, int chk) {
    const int TIDX = hidden_tid(P.wid), BIDX = launder_i((int)blockIdx.x), GDIM = launder_i((int)gridDim.x); P.ws = launder_ptr(P.ws); P.out = launder_ptr(P.out);
    float (*Ks)[DQK] = (float (*)[DQK])lds; float (*Vs)[64] = (float (*)[64])(lds + 64 * DQK * 4); float* cbs = (float*)(lds + 64 * DQK * 4 + 64 * 64 * 4);
    const int tid = TIDX;
    Chk ck{0.f, 0.f};
    for (int item = BIDX; item < NB * 6 * 8; item += GDIM) {
        const int qb = 7 - (item / 48), bh = item % 48, b = bh / 6, h = bh % 6;
        const int q = qb * 512 + tid; const size_t rowq = (size_t)b * SEQ + q;
        float qv[DQK], o[64];
#pragma unroll
        for (int d = 0; d < DQK; ++d) qv[d] = bf2f(Q[rowq * ldq + h * DQK + d]);
#pragma unroll
        for (int d = 0; d < 64; ++d) o[d] = 0.f;
        float m = -INFINITY, l = 0.f;
        const float* cbp = MODE == 1 ? cb2 + ((size_t)b * 6 + h) * SEQ : nullptr;
        const int kend = qb * 512 + 512;
        for (int k0 = 0; k0 < kend; k0 += 64) {
            __syncthreads();
            for (int e = tid; e < 64 * DQK; e += 512) { const int j = e / DQK, d = e % DQK; Ks[j][d] = bf2f(K[((size_t)b * SEQ + k0 + j) * ldk + h * DQK + d]); }
            for (int e = tid; e < 64 * 64; e += 512) { const int j = e >> 6, d = e & 63; Vs[j][d] = bf2f(V[((size_t)b * SEQ + k0 + j) * ldv + h * vhs + d]); }
            if (MODE == 1 && tid < 64) cbs[tid] = cbp[k0 + tid];
            __syncthreads();
            for (int j = 0; j < 64; ++j) {
                const int key = k0 + j;
                const bool ok = MODE == 0 ? ((key >> 6) <= (q >> 6)) : (key <= q);
                if (ok) {
                    float s = 0.f;
#pragma unroll
                    for (int d = 0; d < DQK; d += 4) { const f32x4 kk = *(const f32x4*)&Ks[j][d]; s += qv[d] * kk[0] + qv[d + 1] * kk[1] + qv[d + 2] * kk[2] + qv[d + 3] * kk[3]; }
                    if (MODE == 1) s -= cbs[j];
                    if (s > m) { const float f = exp2f(m - s); l *= f;
#pragma unroll
                        for (int d = 0; d < 64; ++d) o[d] *= f;
                        m = s; }
                    const float p = exp2f(s - m); l += p;
#pragma unroll
                    for (int d = 0; d < 64; d += 4) { const f32x4 vv = *(const f32x4*)&Vs[j][d]; o[d] += p * vv[0]; o[d + 1] += p * vv[1]; o[d + 2] += p * vv[2]; o[d + 3] += p * vv[3]; }
                }
            }
        }
        const float il = 1.f / l;
#pragma unroll
        for (int d = 0; d < 64; d += 2) st2(O + rowq * ldo + h * 64 + d, o[d] * il, o[d + 1] * il, chk, ck);
    }
    if (chk) chk_commit(P, chk, ck);
}

__device__ __forceinline__ void ph_ssm_naive(unsigned char* lds, Params P, int layer, int chk) {
    const int TIDX = hidden_tid(P.wid), BIDX = launder_i((int)blockIdx.x), GDIM = launder_i((int)gridDim.x); P.ws = launder_ptr(P.ws); P.out = launder_ptr(P.out);
    float (*smy)[16 * 64] = (float (*)[16 * 64])lds;
    const int wid = TIDX >> 6, lane = TIDX & 63;
    float* sm = smy[wid];
    const bf16_t* proj = (const bf16_t*)(P.ws + WS_PROJ); bf16_t* yg = (bf16_t*)(P.ws + WS_YG);
    Chk ck{0.f, 0.f};
    for (int item = BIDX * 8 + wid; item < NB * 16; item += GDIM * 8) {
        const int b = item / 16, g = item % 16, p = lane;
        const size_t gp = ((size_t)layer * 16 + g) * 64 + p;
        const float lre = P.lam_re[gp], lim = P.lam_im[gp], dt = expf(P.log_dt[layer * 16 + g]);
        const float a_ = lre * dt, b_ = lim * dt; float sb_, cb_; sincosf(b_, &sb_, &cb_); const float sh_ = sinf(0.5f * b_);
        const float er = expf(a_), lbr = er * cb_, lbi = er * sb_;
        const float nr = expm1f(a_) * cb_ - 2.f * sh_ * sh_, ni = lbi;
        const float dd = lre * lre + lim * lim, qr = (nr * lre + ni * lim) / dd, qi = (ni * lre - nr * lim) / dd;
        float bbr[16], bbi[16], cr[16], ci[16];
#pragma unroll
        for (int c = 0; c < 16; ++c) {
            const float bre = P.b_re[gp * 16 + c], bim = P.b_im[gp * 16 + c];
            bbr[c] = qr * bre - qi * bim; bbi[c] = qr * bim + qi * bre;
            cr[c] = P.c_re[(((size_t)layer * 16 + g) * 16 + c) * 64 + p]; ci[c] = P.c_im[(((size_t)layer * 16 + g) * 16 + c) * 64 + p];
        }
        const float lr = lbr, li = lbi;
        const float dsk = P.ssm_d[layer * 256 + g * 16 + (lane & 15)];
        float sr = 0.f, si = 0.f;
        for (int t = 0; t < SEQ; ++t) {
            const size_t row = (size_t)b * SEQ + t;
            const bf16_t* up = proj + row * PJ + g * 16;
            const u32x4 w0 = *(const u32x4*)up, w1 = *(const u32x4*)(up + 8);
            const unsigned ww[8] = {w0.x, w0.y, w0.z, w0.w, w1.x, w1.y, w1.z, w1.w};
            float bur = 0.f, bui = 0.f;
#pragma unroll
            for (int c = 0; c < 16; ++c) { const float u = (c & 1) ? bf2f(ww[c >> 1] >> 16) : bf2f(ww[c >> 1] & 0xffff); bur = fmaf(bbr[c], u, bur); bui = fmaf(bbi[c], u, bui); }
            const float nsr = lr * sr - li * si + bur, nsi = lr * si + li * sr + bui; sr = nsr; si = nsi;
#pragma unroll
            for (int c = 0; c < 16; ++c) sm[c * 64 + lane] = cr[c] * sr - ci[c] * si;
            asm volatile("s_waitcnt lgkmcnt(0)" ::: "memory");
            const int cc = lane & 15, qd = lane >> 4; float part = 0.f;
#pragma unroll
            for (int j = 0; j < 16; ++j) part += sm[cc * 64 + qd * 16 + j];
            part += shx(part, 16, lane); part += shx(part, 32, lane);
            asm volatile("s_waitcnt lgkmcnt(0)" ::: "memory");
            if (lane < 16) { const float uv = bf2f(up[lane]); const float yv = gelu_tanh(part + dsk * uv); bf16_t* dst = yg + row * 256 + g * 16 + lane;
                if (!chk) *dst = f2bf(yv); else chk_upd(ck, yv, bf2f(*dst)); }
        }
    }
    if (chk) chk_commit(P, chk, ck);
}

__device__ __forceinline__ void ph_glu_naive(unsigned char* lds, Params P, int layer, int chk) {
    const int TIDX = hidden_tid(P.wid), BIDX = launder_i((int)blockIdx.x), GDIM = launder_i((int)gridDim.x); P.ws = launder_ptr(P.ws); P.out = launder_ptr(P.out);
    float* sm = (float*)lds;
    const bf16_t* yg = (const bf16_t*)(P.ws + WS_YG); bf16_t* os = (bf16_t*)(P.ws + WS_OSSM);
    const float* w = P.w_glu + (size_t)layer * 256 * 256; const float* bg = P.b_glu + layer * 256;
    Chk ck{0.f, 0.f};
    naive_gemm(T, 256, 256,
        [&](int r, int k) { return bf2f(yg[(size_t)r * 256 + k]); },
        [&](int) { return 0; },
        [&](int k, int col, int) { return w[(size_t)k * 256 + col]; },
        [&](int r, int c0, const float (&v)[4]) {
            float o[4];
#pragma unroll
            for (int j = 0; j < 4; ++j) o[j] = bf2f(yg[(size_t)r * 256 + c0 + j]) * sigmoid_f(v[j] + bg[c0 + j]);
            st4(os + (size_t)r * 256 + c0, o, chk, ck); }, sm);
    if (chk) chk_commit(P, chk, ck);
}

__device__ __forceinline__ void ph_merge(unsigned char* lds, Params P) {
    const int TIDX = hidden_tid(P.wid), BIDX = launder_i((int)blockIdx.x), GDIM = launder_i((int)gridDim.x); P.ws = launder_ptr(P.ws); P.out = launder_ptr(P.out);
    const int wid = TIDX >> 6, lane = TIDX & 63;
    const bf16_t* os = (const bf16_t*)(P.ws + WS_OSSM); const bf16_t* ob = (const bf16_t*)(P.ws + WS_OBUF); bf16_t* hb = (bf16_t*)(P.ws + WS_HBUF);
    constexpr int NR = 8;
    const int RPW = (T + GDIM * 8 - 1) / (GDIM * 8), rbeg = (BIDX * 8 + wid) * RPW;
    for (int j0 = 0; j0 < RPW; j0 += NR) {
        u32x2 ws_[NR]; unsigned wo[NR][6];
#pragma unroll
        for (int k = 0; k < NR; ++k) { const int row = rbeg + j0 + k;
            if (j0 + k < RPW && row < T) { ws_[k] = *(const u32x2*)(os + (size_t)row * 256 + lane * 4);
#pragma unroll
                for (int part = 0; part < 2; ++part) { const bf16_t* src = ob + (size_t)row * 768 + part * 384 + lane * 6; wo[k][part * 3] = *(const unsigned*)src; wo[k][part * 3 + 1] = *(const unsigned*)(src + 2); wo[k][part * 3 + 2] = *(const unsigned*)(src + 4); } } }
#pragma unroll
        for (int k = 0; k < NR; ++k) { const int row = rbeg + j0 + k;
            if (j0 + k < RPW && row < T) {
                { const u32x2 w = ws_[k]; const float a = bf2f(w.x & 0xffff), b = bf2f(w.x >> 16), c = bf2f(w.y & 0xffff), d = bf2f(w.y >> 16);
                  const float r = rsqrtf(wsum(a * a + b * b + c * c + d * d, lane) * (1.f / 256.f) + EPS); u32x2 o; o.x = pk2(a * r, b * r); o.y = pk2(c * r, d * r); *(u32x2*)(hb + (size_t)row * D + lane * 4) = o; }
#pragma unroll
                for (int part = 0; part < 2; ++part) {
                    const unsigned w0 = wo[k][part * 3], w1 = wo[k][part * 3 + 1], w2 = wo[k][part * 3 + 2];
                    const float v[6] = {bf2f(w0 & 0xffff), bf2f(w0 >> 16), bf2f(w1 & 0xffff), bf2f(w1 >> 16), bf2f(w2 & 0xffff), bf2f(w2 >> 16)};
                    float ss = 0.f;
#pragma unroll
                    for (int j = 0; j < 6; ++j) ss += v[j] * v[j];
                    const float r = rsqrtf(wsum(ss, lane) * (1.f / 384.f) + EPS);
                    unsigned* dst = (unsigned*)(hb + (size_t)row * D + 256 + part * 384 + lane * 6);
                    dst[0] = pk2(v[0] * r, v[1] * r); dst[1] = pk2(v[2] * r, v[3] * r); dst[2] = pk2(v[4] * r, v[5] * r);
                }
            }
        }
    }
}

__device__ __forceinline__ void ph_outproj_naive(unsigned char* lds, Params P, int layer, float* dst, int chk) {
    const int TIDX = hidden_tid(P.wid), BIDX = launder_i((int)blockIdx.x), GDIM = launder_i((int)gridDim.x); P.ws = launder_ptr(P.ws); P.out = launder_ptr(P.out);
    float* sm = (float*)lds;
    const bf16_t* hb = (const bf16_t*)(P.ws + WS_HBUF); const float* w = P.w_out + (size_t)layer * D * D; const float* g = P.out_norm + layer * D;
    Chk ck{0.f, 0.f};
    naive_gemm(T, D, D,
        [&](int r, int k) { return bf2f(hb[(size_t)r * D + k]); },
        [&](int) { return 0; },
        [&](int k, int col, int) { return g[k] * w[(size_t)k * D + col]; },
        [&](int r, int c0, const float (&v)[4]) {
            const float* g1 = adap(P, layer, r / SEQ, 2) + c0; f32x4 xv = *(const f32x4*)(P.out + (size_t)r * D + c0);
#pragma unroll
            for (int j = 0; j < 4; ++j) { const float dl = g1[j] * v[j]; xv[j] += dl; ck.r = fmaxf(ck.r, fabsf(dl)); }
            *(f32x4*)(dst + (size_t)r * D + c0) = xv; }, sm);
    if (chk) chk_commit(P, chk, ck);
}

__device__ __forceinline__ void ph_ffn1_naive(unsigned char* lds, Params P, int layer, int chk) {
    const int TIDX = hidden_tid(P.wid), BIDX = launder_i((int)blockIdx.x), GDIM = launder_i((int)gridDim.x); P.ws = launder_ptr(P.ws); P.out = launder_ptr(P.out);
    float* sm = (float*)lds;
    const bf16_t* hb = (const bf16_t*)(P.ws + WS_HBUF); bf16_t* act = (bf16_t*)(P.ws + WS_ACT);
    const float* wg = P.ffn_wg + (size_t)(layer / 2) * D * DFF; const float* wu = P.ffn_wu + (size_t)(layer / 2) * D * DFF;
    Chk ck{0.f, 0.f};
    naive_gemm(T, 2 * DFF, D,
        [&](int r, int k) { return bf2f(hb[(size_t)r * D + k]); },
        [&](int) { return 0; },
        [&](int k, int col, int) { return (col & 1) ? wu[(size_t)k * DFF + (col >> 1)] : wg[(size_t)k * DFF + (col >> 1)]; },
        [&](int r, int c0, const float (&v)[4]) { st2(act + (size_t)r * DFF + (c0 >> 1), silu_f(v[0]) * v[1], silu_f(v[2]) * v[3], chk, ck); }, sm);
    if (chk) chk_commit(P, chk, ck);
}
__device__ __forceinline__ void ph_ffn2_naive(unsigned char* lds, Params P, int layer, float* dst, int chk) {
    const int TIDX = hidden_tid(P.wid), BIDX = launder_i((int)blockIdx.x), GDIM = launder_i((int)gridDim.x); P.ws = launder_ptr(P.ws); P.out = launder_ptr(P.out);
    float* sm = (float*)lds;
    const bf16_t* act = (const bf16_t*)(P.ws + WS_ACT); const float* w = P.ffn_wd + (size_t)(layer / 2) * DFF * D;
    Chk ck{0.f, 0.f};
    naive_gemm(T, D, DFF,
        [&](int r, int k) { return bf2f(act[(size_t)r * DFF + k]); },
        [&](int) { return 0; },
        [&](int k, int col, int) { return w[(size_t)k * D + col]; },
        [&](int r, int c0, const float (&v)[4]) {
            const float* g2 = adap(P, layer, r / SEQ, 5) + c0; f32x4 xv = *(const f32x4*)(P.out + (size_t)r * D + c0);
#pragma unroll
            for (int j = 0; j < 4; ++j) { const float dl = g2[j] * v[j]; xv[j] += dl; ck.r = fmaxf(ck.r, fabsf(dl)); }
            *(f32x4*)(dst + (size_t)r * D + c0) = xv; }, sm);
    if (chk) chk_commit(P, chk, ck);
}
__device__ __forceinline__ void ph_cmp_x(unsigned char* lds, Params P, const float* xe, int stage) {
    const int TIDX = hidden_tid(P.wid), BIDX = launder_i((int)blockIdx.x), GDIM = launder_i((int)gridDim.x); P.ws = launder_ptr(P.ws); P.out = launder_ptr(P.out);
    Chk ck{0.f, 0.f};
    for (size_t i = (size_t)BIDX * 512 + TIDX; i < (size_t)T * D / 4; i += (size_t)GDIM * 512) {
        const f32x4 a = ((const f32x4*)P.out)[i], b = ((const f32x4*)xe)[i];
#pragma unroll
        for (int j = 0; j < 4; ++j) { const float d = fabsf(a[j] - b[j]); ck.e = (d != d) ? INFINITY : fmaxf(ck.e, d); }
    }
    chk_commit(P, stage, ck);
}

__device__ __forceinline__ void ph_moe_gather(unsigned char* lds, Params P, int layer) {
    const int TIDX = hidden_tid(P.wid), BIDX = launder_i((int)blockIdx.x), GDIM = launder_i((int)gridDim.x); P.ws = launder_ptr(P.ws); P.out = launder_ptr(P.out);
    const int wid = TIDX >> 6, lane = TIDX & 63;
    int off[NEXP + 1]; moe_offsets(P, layer, off);
    int* p2e = (int*)(P.ws + WS_P2E);
    if (BIDX == 0) {
        for (int pnl = TIDX; pnl < 272; pnl += 512) { int e = 0;
#pragma unroll
            for (int j = 1; j < NEXP; ++j) if (pnl * 256 >= off[j]) e = j;
            p2e[pnl] = e; }
        if (TIDX == 0) p2e[300] = off[NEXP] >> 8;
    }
    const bf16_t* hb = (const bf16_t*)(P.ws + WS_HBUF); bf16_t* hg = (bf16_t*)(P.ws + WS_HG);
    const int* ti = (const int*)(P.ws + WS_TOKINFO); int* so = (int*)(P.ws + WS_SLOTOF);
    for (int row = BIDX * 8 + wid; row < T; row += GDIM * 8) {
        const u32x4 v0 = *(const u32x4*)(hb + (size_t)row * D + lane * 8), v1 = *(const u32x4*)(hb + (size_t)row * D + 512 + lane * 8);
#pragma unroll
        for (int k = 0; k < 2; ++k) {
            const int e = ti[(size_t)row * 4 + 2 * k], pos = ti[(size_t)row * 4 + 2 * k + 1];
            int base = 0;
#pragma unroll
            for (int j = 0; j < NEXP; ++j) if (e == j) base = off[j];
            const int slot = base + pos;
            *(u32x4*)(hg + (size_t)slot * D + lane * 8) = v0; *(u32x4*)(hg + (size_t)slot * D + 512 + lane * 8) = v1;
            if (lane == 0) so[(size_t)row * 2 + k] = slot;
        }
    }
}
__device__ __forceinline__ void ph_moe1_naive(unsigned char* lds, Params P, int layer, int chk) {
    const int TIDX = hidden_tid(P.wid), BIDX = launder_i((int)blockIdx.x), GDIM = launder_i((int)gridDim.x); P.ws = launder_ptr(P.ws); P.out = launder_ptr(P.out);
    float* sm = (float*)lds;
    const bf16_t* hg = (const bf16_t*)(P.ws + WS_HG); bf16_t* act = (bf16_t*)(P.ws + WS_ACTM); const int* p2e = (const int*)(P.ws + WS_P2E);
    const float* wg = P.moe_wg + (size_t)(layer / 2) * NEXP * D * DFE; const float* wu = P.moe_wu + (size_t)(layer / 2) * NEXP * D * DFE;
    const int M = p2e[300] * 256;
    Chk ck{0.f, 0.f};
    naive_gemm(M, 2 * DFE, D,
        [&](int r, int k) { return bf2f(hg[(size_t)r * D + k]); },
        [&](int bm) { return p2e[bm >> 8]; },
        [&](int k, int col, int e) { const size_t o = ((size_t)e * D + k) * DFE + (col >> 1); return (col & 1) ? wu[o] : wg[o]; },
        [&](int r, int c0, const float (&v)[4]) { st2(act + (size_t)r * DFE + (c0 >> 1), silu_f(v[0]) * v[1], silu_f(v[2]) * v[3], chk, ck); }, sm);
    if (chk) chk_commit(P, chk, ck);
}
__device__ __forceinline__ void ph_moe2_naive(unsigned char* lds, Params P, int layer, int chk) {
    const int TIDX = hidden_tid(P.wid), BIDX = launder_i((int)blockIdx.x), GDIM = launder_i((int)gridDim.x); P.ws = launder_ptr(P.ws); P.out = launder_ptr(P.out);
    float* sm = (float*)lds;
    const bf16_t* act = (const bf16_t*)(P.ws + WS_ACTM); bf16_t* ym = (bf16_t*)(P.ws + WS_HG); const int* p2e = (const int*)(P.ws + WS_P2E);
    const float* wd = P.moe_wd + (size_t)(layer / 2) * NEXP * DFE * D;
    const int M = p2e[300] * 256;
    Chk ck{0.f, 0.f};
    naive_gemm(M, D, DFE,
        [&](int r, int k) { return bf2f(act[(size_t)r * DFE + k]); },
        [&](int bm) { return p2e[bm >> 8]; },
        [&](int k, int col, int e) { return wd[((size_t)e * DFE + k) * D + col]; },
        [&](int r, int c0, const float (&v)[4]) { st4(ym + (size_t)r * D + c0, v, chk, ck); }, sm);
    if (chk) chk_commit(P, chk, ck);
}
__device__ __forceinline__ void ph_moe_combine(unsigned char* lds, Params P, int layer) {
    const int TIDX = hidden_tid(P.wid), BIDX = launder_i((int)blockIdx.x), GDIM = launder_i((int)gridDim.x); P.ws = launder_ptr(P.ws); P.out = launder_ptr(P.out);
    const int wid = TIDX >> 6, lane = TIDX & 63;
    const bf16_t* ym = (const bf16_t*)(P.ws + ymoe_off(layer)); const bf16_t* xs = xstream(P, DEPTH); const int* ti = (const int*)(P.ws + WS_TOKINFO); const float* pr = (const float*)(P.ws + WS_PROB);
    int off_[NEXP + 1]; moe_offsets(P, layer, off_);
    constexpr int NR = 4;
    const int RPW = (T + GDIM * 8 - 1) / (GDIM * 8), rbeg = (BIDX * 8 + wid) * RPW;
    for (int j0 = 0; j0 < RPW; j0 += NR) {
        int s0[NR], s1[NR]; float p0[NR], p1[NR]; u32x2 xw[NR][4], ya[NR][4], yb[NR][4];
#pragma unroll
        for (int k = 0; k < NR; ++k) { const int row = rbeg + j0 + k;
            if (j0 + k < RPW && row < T) { const int* ti_ = ti + (size_t)row * 4; s0[k] = moe_sel(off_, ti_[0]) + ti_[1]; s1[k] = moe_sel(off_, ti_[2]) + ti_[3]; p0[k] = pr[(size_t)row * 2]; p1[k] = pr[(size_t)row * 2 + 1];
#pragma unroll
                for (int q = 0; q < 4; ++q) xw[k][q] = *(const u32x2*)(xs + (size_t)row * D + q * 256 + lane * 4); } }
#pragma unroll
        for (int k = 0; k < NR; ++k) { const int row = rbeg + j0 + k;
            if (j0 + k < RPW && row < T) {
#pragma unroll
                for (int q = 0; q < 4; ++q) { ya[k][q] = *(const u32x2*)(ym + (size_t)s0[k] * D + q * 256 + lane * 4); yb[k][q] = *(const u32x2*)(ym + (size_t)s1[k] * D + q * 256 + lane * 4); } } }
#pragma unroll
        for (int k = 0; k < NR; ++k) { const int row = rbeg + j0 + k;
            if (j0 + k < RPW && row < T) {
                const float* g2 = adap(P, layer, row / SEQ, 5);
#pragma unroll
                for (int q = 0; q < 4; ++q) { const int col = q * 256 + lane * 4;
                    const u32x2 a = ya[k][q], b = yb[k][q], x = xw[k][q]; const f32x4 g = *(const f32x4*)(g2 + col);
                    f32x4 xv = {bf2f(x.x & 0xffff), bf2f(x.x >> 16), bf2f(x.y & 0xffff), bf2f(x.y >> 16)};
                    xv[0] += g[0] * (p0[k] * bf2f(a.x & 0xffff) + p1[k] * bf2f(b.x & 0xffff)); xv[1] += g[1] * (p0[k] * bf2f(a.x >> 16) + p1[k] * bf2f(b.x >> 16));
                    xv[2] += g[2] * (p0[k] * bf2f(a.y & 0xffff) + p1[k] * bf2f(b.y & 0xffff)); xv[3] += g[3] * (p0[k] * bf2f(a.y >> 16) + p1[k] * bf2f(b.y >> 16));
                    *(f32x4*)(P.out + (size_t)row * D + col) = xv; } } }
    }
}
__device__ __forceinline__ void ph_check_final(unsigned char* lds, Params P) {
    const int TIDX = hidden_tid(P.wid), BIDX = launder_i((int)blockIdx.x), GDIM = launder_i((int)gridDim.x); P.ws = launder_ptr(P.ws); P.out = launder_ptr(P.out);
    const unsigned* ctl = (const unsigned*)(P.ws + WS_CTL);
    int code = 0;
    for (int s = 31; s >= 1; --s) { const float e = __uint_as_float(ctl[CW_CHKE + s]), r = __uint_as_float(ctl[CW_CHKR + s]); if (!(e <= 0.04f * r)) code = s; }
    if (code == 0) return;
    const float sc = 1.f + 0.1f * code;
    for (size_t i = (size_t)BIDX * 512 + TIDX; i < (size_t)T * D; i += (size_t)GDIM * 512) P.out[i] *= sc;
}

namespace pg8 {
#define PG8_LAS __attribute__((address_space(3)))
typedef short bf16x8 __attribute__((ext_vector_type(8)));
constexpr int BM = 256, BK = 64, HALF = 128, HTB = HALF * BK * 2  , STAGE_BYTES = 8 * HTB, NXCD = 8, WGM = 8;
__host__ __device__ __forceinline__ int lds_byte(int r, int c) { const int st = (r >> 4) * 2 + (c >> 5), rr = r & 15, cc = c & 31, ob = rr * 64 + cc * 2; return st * 1024 + (ob ^ (((ob >> 9) & 1) << 5)); }
__host__ __device__ __forceinline__ void stage_rc(int b, int& R, int& C) { const int st = b / 1024, sb = b % 1024, swz = sb ^ (((sb >> 9) & 1) << 5); R = (st >> 1) * 16 + swz / 64; C = (st & 1) * 32 + (swz % 64) / 2; }
__host__ __device__ __forceinline__ int perm32(int rho) { const int n = rho >> 4, i = rho & 15; return 8 * (i >> 2) + 4 * n + (i & 3); }
struct Unit { int pm, pn; };
struct Gemm { const bf16_t* A; const bf16_t* Bt; int lda, ldb, K, wid; };
struct StaticOrder {
    static constexpr bool GATHER = false;
    int nM, nN, nwg, G, c;
    __host__ __device__ void init(int M, int N, int G_, int c_) { nM = M / BM; nN = N / BM; nwg = nM * nN; G = G_; c = c_; }
    __host__ __device__ bool next(int i, Unit& u) const {
        const long L = (long)i * G + c; if (L >= nwg) return false;
        int wgid = (int)L; { const int q = nwg / NXCD, r = nwg % NXCD, xcd = wgid % NXCD, off = wgid / NXCD; wgid = (xcd < r ? xcd * (q + 1) : r * (q + 1) + (xcd - r) * q) + off; }
        const int nig = WGM * nN, gid = wgid / nig, fm = gid * WGM, gsz = (nM - fm) < WGM ? (nM - fm) : WGM;
        u.pm = fm + ((wgid % nig) % gsz); u.pn = (wgid % nig) / gsz; return true;
    }
    __device__ __forceinline__ void a_ready(const Unit&) const {}
    __device__ __forceinline__ void done(const Unit&) const {}
};
template <class F> struct ListOrder {
    static constexpr bool GATHER = false;
    int n, G, c; F f;
    __device__ __forceinline__ bool next(int i, Unit& u) const { const long L = (long)i * G + c; if (L >= n) return false; f((int)L, u); return true; }
    __device__ __forceinline__ void a_ready(const Unit&) const {}
    __device__ __forceinline__ void done(const Unit&) const {}
};
__device__ __forceinline__ unsigned cvt_pk_bf16(float lo, float hi) { unsigned r; asm volatile("v_cvt_pk_bf16_f32 %0, %1, %2" : "=v"(r) : "v"(lo), "v"(hi)); return r; }
__device__ __forceinline__ u32x4 pack8(const f32x4 a, const f32x4 b) { u32x4 w; w.x = cvt_pk_bf16(a[0], a[1]); w.y = cvt_pk_bf16(a[2], a[3]); w.z = cvt_pk_bf16(b[0], b[1]); w.w = cvt_pk_bf16(b[2], b[3]); return w; }

template <class T, class = void> struct epi_kscale { static constexpr bool value = false; };
template <class T> struct epi_kscale<T, decltype((void)T::KSCALE)> { static constexpr bool value = T::KSCALE; };
__device__ __forceinline__ void kscale_rows(PG8_LAS unsigned char* lds, f32x4 (&acc)[2][2][4][2], int ui, int which, int wr, int) {
    const int fr = hidden_tid(0) & 15;
    const PG8_LAS float* tb = (const PG8_LAS float*)(lds + 132096) + (launder_i(ui) * 3 + which) * 256 + wr * 64 + fr;
#pragma unroll
    for (int ai = 0; ai < 2; ++ai)
#pragma unroll
        for (int m = 0; m < 4; ++m) { const float sc = tb[ai * 128 + m * 16];
#pragma unroll
            for (int bj = 0; bj < 2; ++bj)
#pragma unroll
                for (int n = 0; n < 2; ++n) acc[ai][bj][m][n] = acc[ai][bj][m][n] * sc; }
}
template <class Epi, class Sched, bool ALIGN_EPI = false, bool SP2 = false>
__device__ __forceinline__ void gemm_phase(PG8_LAS unsigned char* lds, const Gemm g, const Sched& S, const Epi& E) {
    const int tid = hidden_tid(g.wid), wid = __builtin_amdgcn_readfirstlane(tid >> 6), lane = tid & 63, wr = wid >> 2, wc = wid & 3, fr = lane & 15, fq = lane >> 4;
    const int K = launder_i(g.K), nt = K / BK;
    unsigned voffA[2], voffB[2]; int gR[2], gC[2];
#pragma unroll
    for (int i = 0; i < 2; ++i) { int R, C; stage_rc(tid * 16 + i * 8192, R, C); const int Rb = Epi::PERM ? ((R & ~31) + perm32(R & 31)) : R;
        voffA[i] = (unsigned)(R * g.lda + C) * 2u; voffB[i] = (unsigned)(Rb * g.ldb + C) * 2u; gR[i] = R; gC[i] = C * 2; }
    const size_t kstep = (size_t)(BK * 2);
    const size_t hstepA = Sched::GATHER ? 0 : (size_t)HALF * g.lda * 2, hstepB = (size_t)HALF * g.ldb * 2;
    const size_t tstepA = 2 * hstepA, tstepB = 2 * hstepB;
    const unsigned ldsw = (unsigned)wid * 1024u;
    const int aoff = lds_byte(wr * 64 + fr, fq * 8), boff = lds_byte(wc * 32 + fr, fq * 8);
#define PG8_SA(b, h) (((b) * 2 + (h)) * HTB)
#define PG8_SB(b, h) ((4 + (b) * 2 + (h)) * HTB)
#define PG8_STAGE(bufoff, gbase, voff) do { _Pragma("unroll") for (int _i = 0; _i < 2; ++_i) \
        __builtin_amdgcn_global_load_lds((const unsigned*)((const char*)(gbase) + (voff)[_i]), (PG8_LAS unsigned*)(lds + (bufoff) + ldsw + _i * 8192), 16, 0, 0); } while (0)
#define PG8_LDA(dst, b, h) do { _Pragma("unroll") for (int m = 0; m < 4; ++m) _Pragma("unroll") for (int k = 0; k < 2; ++k) dst[m][k] = *(const PG8_LAS bf16x8*)(lds + PG8_SA(b, h) + aoff + m * 2048 + k * 1024); } while (0)
#define PG8_LDB(dst, b, h) do { _Pragma("unroll") for (int n = 0; n < 2; ++n) _Pragma("unroll") for (int k = 0; k < 2; ++k) dst[n][k] = *(const PG8_LAS bf16x8*)(lds + PG8_SB(b, h) + boff + n * 2048 + k * 1024); } while (0)
#define PG8_MMA(ai, bj, At, Bt) do { __builtin_amdgcn_s_setprio(1); _Pragma("unroll") for (int m = 0; m < 4; ++m) _Pragma("unroll") for (int n = 0; n < 2; ++n) _Pragma("unroll") for (int k = 0; k < 2; ++k) \
        acc[ai][bj][m][n] = __builtin_amdgcn_mfma_f32_16x16x32_bf16(Bt[n][k], At[m][k], acc[ai][bj][m][n], 0, 0, 0); __builtin_amdgcn_s_setprio(0); } while (0)
#define PG8_WAIT_V(n) asm volatile("s_waitcnt vmcnt(" #n ")" ::: "memory")
#define PG8_WAIT_L(n) asm volatile("s_waitcnt lgkmcnt(" #n ")" ::: "memory")
#define PG8_BAR __builtin_amdgcn_s_barrier()
#define PG8_SCHED __builtin_amdgcn_sched_barrier(0)
    Unit cur, nxt; int ui = 0;
    if (!S.next(0, cur)) return;
    f32x4 acc[2][2][4][2];
#pragma unroll
    for (int a = 0; a < 2; ++a)
#pragma unroll
        for (int b = 0; b < 2; ++b)
#pragma unroll
            for (int m = 0; m < 4; ++m)
#pragma unroll
                for (int n = 0; n < 2; ++n) acc[a][b][m][n] = (f32x4){0.f, 0.f, 0.f, 0.f};
    bf16x8 At[4][2], B0[2][2], B1[2][2];
    const char* cA = (const char*)g.A + (size_t)cur.pm * tstepA; const char* cB = (const char*)g.Bt + (size_t)cur.pn * tstepB;
    unsigned vc0[2] = {0u, 0u}, vc1[2] = {0u, 0u}, w0[2] = {0u, 0u}, w1[2] = {0u, 0u};
    PG8_LAS u32x4* const vpark = (PG8_LAS u32x4*)(lds + 132096) + tid;
    if constexpr (Sched::GATHER) { static_assert(SP2, "row gather is wired into the SP2 loop only");
#pragma unroll
        for (int i = 0; i < 1; ++i) { S.rowoff4(cur, gR[0], vc0[0], vc0[1], vc1[0], vc1[1]); vc0[0] += (unsigned)gC[0]; vc0[1] += (unsigned)gC[0]; vc1[0] += (unsigned)gC[0]; vc1[1] += (unsigned)gC[0]; } }
#define PG8_STAGE_A(bufoff, gbase, half, v0, v1) do { if constexpr (Sched::GATHER) { if ((half) == 0) PG8_STAGE(bufoff, gbase, v0); else PG8_STAGE(bufoff, gbase, v1); } else PG8_STAGE(bufoff, (gbase) + (half) * hstepA, voffA); } while (0)
    S.a_ready(cur);
    if constexpr (SP2) {
        PG8_STAGE(PG8_SB(0, 0), cB, voffB); PG8_STAGE(PG8_SB(0, 1), cB + hstepB, voffB); PG8_STAGE_A(PG8_SA(0, 0), cA, 0, vc0, vc1); PG8_STAGE_A(PG8_SA(0, 1), cA, 1, vc0, vc1);
        if (wr == 1) PG8_BAR;
        PG8_WAIT_V(2); PG8_BAR;
        PG8_STAGE(PG8_SB(1, 0), cB + kstep, voffB); PG8_STAGE_A(PG8_SA(1, 0), cA + kstep, 0, vc0, vc1); PG8_STAGE(PG8_SB(1, 1), cB + hstepB + kstep, voffB);
        PG8_WAIT_V(6); PG8_BAR;
    } else {
        PG8_STAGE(PG8_SB(0, 0), cB, voffB); PG8_STAGE(PG8_SA(0, 0), cA, voffA); PG8_STAGE(PG8_SB(0, 1), cB + hstepB, voffB); PG8_STAGE(PG8_SA(0, 1), cA + hstepA, voffA);
        if (wr == 1) PG8_BAR;
        PG8_WAIT_V(4); PG8_BAR;
        PG8_STAGE(PG8_SB(1, 0), cB + kstep, voffB); PG8_STAGE(PG8_SA(1, 0), cA + kstep, voffA); PG8_STAGE(PG8_SB(1, 1), cB + hstepB + kstep, voffB);
        PG8_WAIT_V(6); PG8_BAR;
    }
    for (;;) {
        const bool has_next = S.next(ui + 1, nxt);
        if constexpr (Sched::GATHER) {
#pragma unroll
            for (int i = 0; i < 1; ++i) { if (has_next) { S.rowoff4(nxt, gR[0], w0[0], w0[1], w1[0], w1[1]); w0[0] += (unsigned)gC[0]; w0[1] += (unsigned)gC[0]; w1[0] += (unsigned)gC[0]; w1[1] += (unsigned)gC[0]; } else { w0[0] = vc0[0]; w0[1] = vc0[1]; w1[0] = vc1[0]; w1[1] = vc1[1]; } }
            *vpark = (u32x4){w0[0], w0[1], w1[0], w1[1]}; }
        const char* nA = has_next ? (const char*)g.A + (size_t)nxt.pm * tstepA : cA; const char* nB = has_next ? (const char*)g.Bt + (size_t)nxt.pn * tstepB : cB;
        for (int t = 0; t < nt; t += 2) {
            const bool last = (t == nt - 2);
            const char* a1 = cA + (size_t)(t + 1) * kstep;
            const char* a2 = last ? nA : cA + (size_t)(t + 2) * kstep; const char* b2 = last ? nB : cB + (size_t)(t + 2) * kstep;
            const char* a3 = a2 + kstep; const char* b3 = b2 + kstep;
            if constexpr (Sched::GATHER) { if (last) { const u32x4 q_ = *vpark; w0[0] = q_.x; w0[1] = q_.y; w1[0] = q_.z; w1[1] = q_.w; } else { w0[0] = vc0[0]; w0[1] = vc0[1]; w1[0] = vc1[0]; w1[1] = vc1[1]; } }
            if (last && has_next) S.a_ready(nxt);
            if constexpr (epi_kscale<Epi>::value) { if (t == Epi::KB0) kscale_rows(lds, acc, ui, 0, wr, fr); else if (t == Epi::KB1) kscale_rows(lds, acc, ui, 1, wr, fr); }
            if constexpr (SP2) {
            PG8_LDB(B0, 0, 0); PG8_LDB(B1, 0, 1); PG8_SCHED; PG8_LDA(At, 0, 0); PG8_STAGE_A(PG8_SA(1, 1), a1, 1, vc0, vc1);
            PG8_WAIT_V(8); PG8_WAIT_L(0); PG8_BAR; PG8_MMA(0, 0, At, B0); PG8_MMA(0, 1, At, B1); PG8_BAR; PG8_SCHED;
            PG8_LDA(At, 0, 1); PG8_STAGE(PG8_SB(0, 0), b2, voffB); PG8_STAGE(PG8_SB(0, 1), b2 + hstepB, voffB); PG8_STAGE_A(PG8_SA(0, 0), a2, 0, w0, w1);
            PG8_WAIT_V(8); PG8_WAIT_L(0); PG8_BAR; PG8_MMA(1, 0, At, B0); PG8_MMA(1, 1, At, B1); PG8_BAR; PG8_SCHED;
            PG8_LDB(B0, 1, 0); PG8_LDB(B1, 1, 1); PG8_SCHED; PG8_LDA(At, 1, 0); PG8_STAGE_A(PG8_SA(0, 1), a2, 1, w0, w1);
            PG8_WAIT_V(8); PG8_WAIT_L(0); PG8_BAR; PG8_MMA(0, 0, At, B0); PG8_MMA(0, 1, At, B1); PG8_BAR; PG8_SCHED;
            PG8_LDA(At, 1, 1); PG8_STAGE(PG8_SB(1, 0), b3, voffB); PG8_STAGE(PG8_SB(1, 1), b3 + hstepB, voffB); PG8_STAGE_A(PG8_SA(1, 0), a3, 0, w0, w1);
            PG8_WAIT_V(8); PG8_WAIT_L(0); PG8_BAR; PG8_MMA(1, 0, At, B0); PG8_MMA(1, 1, At, B1); PG8_BAR; PG8_SCHED;
            } else {
            PG8_LDB(B0, 0, 0); PG8_SCHED; PG8_LDA(At, 0, 0); PG8_STAGE(PG8_SA(1, 1), a1 + hstepA, voffA);
            PG8_WAIT_L(8); PG8_BAR; PG8_WAIT_L(0); PG8_MMA(0, 0, At, B0); PG8_BAR; PG8_SCHED;
            PG8_LDB(B1, 0, 1); PG8_STAGE(PG8_SB(0, 0), b2, voffB);
            PG8_BAR; PG8_WAIT_L(0); PG8_MMA(0, 1, At, B1); PG8_BAR;
            PG8_LDA(At, 0, 1); PG8_STAGE(PG8_SA(0, 0), a2, voffA);
            PG8_BAR; PG8_WAIT_L(0); PG8_MMA(1, 0, At, B0); PG8_BAR; PG8_SCHED;
            PG8_STAGE(PG8_SB(0, 1), b2 + hstepB, voffB);
            PG8_WAIT_V(6); PG8_BAR; PG8_MMA(1, 1, At, B1); PG8_BAR;
            PG8_LDB(B0, 1, 0); PG8_SCHED; PG8_LDA(At, 1, 0); PG8_STAGE(PG8_SA(0, 1), a2 + hstepA, voffA);
            PG8_WAIT_L(8); PG8_BAR; PG8_WAIT_L(0); PG8_MMA(0, 0, At, B0); PG8_BAR; PG8_SCHED;
            PG8_LDB(B1, 1, 1); PG8_STAGE(PG8_SB(1, 0), b3, voffB);
            PG8_BAR; PG8_WAIT_L(0); PG8_MMA(0, 1, At, B1); PG8_BAR;
            PG8_LDA(At, 1, 1); PG8_STAGE(PG8_SA(1, 0), a3, voffA);
            PG8_BAR; PG8_WAIT_L(0); PG8_MMA(1, 0, At, B0); PG8_BAR; PG8_SCHED;
            PG8_STAGE(PG8_SB(1, 1), b3 + hstepB, voffB);
            PG8_WAIT_V(6); PG8_BAR; PG8_MMA(1, 1, At, B1); PG8_BAR;
            }
        }
        if constexpr (epi_kscale<Epi>::value) kscale_rows(lds, acc, ui, 2, wr, fr);
        if constexpr (ALIGN_EPI) { if (wr == 0) PG8_BAR; }
        if constexpr (!Epi::AFTER_DRAIN) { E(acc, cur, wr, wc, fr, fq); S.done(cur); }
        if (!has_next) break;
#pragma unroll
        for (int a = 0; a < 2; ++a)
#pragma unroll
            for (int b = 0; b < 2; ++b)
#pragma unroll
                for (int m = 0; m < 4; ++m)
#pragma unroll
                    for (int n = 0; n < 2; ++n) acc[a][b][m][n] = (f32x4){0.f, 0.f, 0.f, 0.f};
        cur = nxt; cA = nA; cB = nB; ++ui;
        if constexpr (Sched::GATHER) { vc0[0] = w0[0]; vc0[1] = w0[1]; vc1[0] = w1[0]; vc1[1] = w1[1]; }
        if constexpr (ALIGN_EPI) { if (wr == 1) PG8_BAR; }
    }
    PG8_WAIT_V(0);
    if constexpr (!ALIGN_EPI) { if (wr == 0) PG8_BAR; }
    PG8_BAR;
    if constexpr (Epi::AFTER_DRAIN) { E.fused(acc, cur, wr, wc, fr, fq, lds, wid, lane); S.done(cur); }
#undef PG8_SA
#undef PG8_SB
#undef PG8_STAGE
#undef PG8_STAGE_A
#undef PG8_LDA
#undef PG8_LDB
#undef PG8_MMA
#undef PG8_WAIT_V
#undef PG8_WAIT_L
#undef PG8_BAR
#undef PG8_SCHED
}
}

using pg8::Unit;
#define GAS_ __attribute__((address_space(1)))
struct EpiStore {
    static constexpr bool PERM = true, AFTER_DRAIN = false;
    bf16_t* O; int ldc; const float* ssq; float inv_n; int pn_mod; int ncol;
    __device__ __forceinline__ void operator()(const f32x4 (&acc)[2][2][4][2], const Unit& u, int wr, int wc, int fr, int fq) const {
        const int row0 = u.pm * 256 + wr * 64 + fr, col0 = (u.pn % pn_mod) * 256 + wc * 32 + 8 * fq;
        float sc[2][4];
#pragma unroll
        for (int ai = 0; ai < 2; ++ai)
#pragma unroll
            for (int m = 0; m < 4; ++m) { sc[ai][m] = 1.f; if (ssq) { const f32x4 p4 = *(const GAS_ f32x4*)(ssq + (size_t)(row0 + ai * 128 + m * 16) * 4); sc[ai][m] = rsqrtf(((p4[0] + p4[1]) + (p4[2] + p4[3])) * inv_n + EPS); } }
#pragma unroll
        for (int ai = 0; ai < 2; ++ai)
#pragma unroll
            for (int m = 0; m < 4; ++m) { const float s = sc[ai][m]; GAS_ bf16_t* rp = (GAS_ bf16_t*)O + (size_t)(row0 + ai * 128 + m * 16) * ldc + col0;
#pragma unroll
                for (int bj = 0; bj < 2; ++bj) if (col0 + bj * 128 < ncol) *(GAS_ u32x4*)(rp + bj * 128) = pg8::pack8(acc[ai][bj][m][0] * s, acc[ai][bj][m][1] * s); }
    }
};
struct EpiInproj {
    static constexpr bool PERM = true, AFTER_DRAIN = false;
    bf16_t* O; float* fg;
    __device__ __forceinline__ void operator()(const f32x4 (&acc)[2][2][4][2], const Unit& u, int wr, int wc, int fr, int fq) const {
        const int row0 = u.pm * 256 + wr * 64 + fr, col0 = u.pn * 256 + wc * 32 + 8 * fq;
        const bool isfg = (u.pn == 7) && (wc == 0) && (fq == 0);
#pragma unroll
        for (int ai = 0; ai < 2; ++ai)
#pragma unroll
            for (int m = 0; m < 4; ++m) { const int row = row0 + ai * 128 + m * 16; bf16_t* rp = O + (size_t)row * PJ + col0;
#pragma unroll
                for (int bj = 0; bj < 2; ++bj) *(u32x4*)(rp + bj * 128) = pg8::pack8(acc[ai][bj][m][0], acc[ai][bj][m][1]);
                if (isfg) { *(f32x4*)(fg + (size_t)row * 8) = acc[ai][1][m][0]; *(f32x4*)(fg + (size_t)row * 8 + 4) = acc[ai][1][m][1]; } }
    }
};
struct EpiInproj2 {
    static constexpr bool PERM = true, AFTER_DRAIN = false;
    bf16_t* O; float* lf; bf16_t* ug; float* ssq; const float* gq; const float* gk; const float* bf;
    __device__ __forceinline__ void operator()(const f32x4 (&acc)[2][2][4][2], const Unit& u, int wr, int wc, int fr, int fq) const {
        const int lane = fq * 16 + fr, row0 = u.pm * 256 + wr * 64 + fr;
        if (u.pn >= 3 && u.pn <= 5) {
            const int hg = (u.pn - 3) * 4 + wc; const bool isq = hg < 6; const int h = isq ? hg : hg - 6;
            const float* gp = launder_ptr(isq ? gq : gk) + 8 * fq; const float gs = isq ? C2_FOX : 1.f;
            const f32x4 g00 = *(const f32x4*)gp * gs, g01 = *(const f32x4*)(gp + 4) * gs, g10 = *(const f32x4*)(gp + 32) * gs, g11 = *(const f32x4*)(gp + 36) * gs;
            bf16_t* base = O + (isq ? PC_FQ : PC_FK) + h * 64 + 8 * fq;
#pragma unroll
            for (int ai = 0; ai < 2; ++ai)
#pragma unroll
                for (int m = 0; m < 4; ++m) { const int row = row0 + ai * 128 + m * 16;
                    const f32x4 a0 = acc[ai][0][m][0], a1 = acc[ai][0][m][1], b0 = acc[ai][1][m][0], b1 = acc[ai][1][m][1];
                    float s = 0.f;
#pragma unroll
                    for (int j = 0; j < 4; ++j) s += a0[j] * a0[j] + a1[j] * a1[j] + b0[j] * b0[j] + b1[j] * b1[j];
                    s += shx(s, 16, lane); s += shx(s, 32, lane);
                    const float r = rsqrtf(s * (1.f / 64.f) + EPS);
                    bf16_t* rp = base + (size_t)row * PJ;
                    *(u32x4*)rp = pg8::pack8(a0 * g00 * r, a1 * g01 * r); *(u32x4*)(rp + 32) = pg8::pack8(b0 * g10 * r, b1 * g11 * r);
                    asm volatile("" ::: "memory"); }
            return;
        }
        const int col0 = u.pn * 256 + wc * 32 + 8 * fq;
#pragma unroll
        for (int ai = 0; ai < 2; ++ai)
#pragma unroll
            for (int m = 0; m < 4; ++m) { const int row = row0 + ai * 128 + m * 16; bf16_t* rp = O + (size_t)row * PJ + col0;
                const u32x4 w0 = pg8::pack8(acc[ai][0][m][0], acc[ai][0][m][1]), w1 = pg8::pack8(acc[ai][1][m][0], acc[ai][1][m][1]);
                *(u32x4*)rp = w0; *(u32x4*)(rp + 128) = w1;
                if (u.pn == 0) { const int b = row >> 12, t = row & 4095, c0 = wc * 32 + 8 * fq;
                    bf16_t* up = ug + (size_t)(b * 128 + (t >> 5)) * 640 + (t & 31) * 16 + (c0 & 15);
                    *(u32x4*)(up + (size_t)(c0 >> 4) * 1024 * 640) = w0; *(u32x4*)(up + (size_t)((c0 >> 4) + 8) * 1024 * 640) = w1; }
                else if (u.pn == 1 || u.pn == 2) {
                    const f32x4 a0 = acc[ai][0][m][0], a1 = acc[ai][0][m][1], b0 = acc[ai][1][m][0], b1 = acc[ai][1][m][1];
                    float s0 = 0.f, s1 = 0.f;
#pragma unroll
                    for (int j = 0; j < 4; ++j) { s0 += a0[j] * a0[j] + a1[j] * a1[j]; s1 += b0[j] * b0[j] + b1[j] * b1[j]; }
                    if (u.pn == 1) { float s = s0 + s1; s += shx(s, 16, lane); s += shx(s, 32, lane); if (fq == 0) ssq[(size_t)row * 4 + wc] = s; }
                    else { s0 += shx(s0, 16, lane); s0 += shx(s0, 32, lane); if (fq == 0) ssq[(size_t)4 * T + (size_t)row * 4 + wc] = s0;
                        if (wc == 0) { s1 += shx(s1, 16, lane); s1 += shx(s1, 32, lane); if (fq == 0) ssq[(size_t)8 * T + row] = s1; } } }
                else if (u.pn == 7 && wc == 0 && fq == 0) { const f32x4 z0 = acc[ai][1][m][0] + (f32x4){bf[0], bf[1], bf[2], bf[3]}, z1 = acc[ai][1][m][1] + (f32x4){bf[4], bf[5], 0.f, 0.f}; f32x4 l0, l1;
#pragma unroll
                    for (int j = 0; j < 4; ++j) { l0[j] = fminf(z0[j], 0.f) - __logf(1.f + __expf(-fabsf(z0[j]))); l1[j] = fminf(z1[j], 0.f) - __logf(1.f + __expf(-fabsf(z1[j]))); }
                    *(f32x4*)(lf + (size_t)row * 8) = l0; *(f32x4*)(lf + (size_t)row * 8 + 4) = l1; }
                asm volatile("" ::: "memory"); }
    }
};
struct EpiKvup {
    static constexpr bool PERM = true, AFTER_DRAIN = false;
    bf16_t* km; bf16_t* kv; const bf16_t* proj; const float* ssq; const float* gk; const float* cs; const float* sn;
    __device__ __forceinline__ void operator()(const f32x4 (&acc)[2][2][4][2], const Unit& u, int wr, int wc, int, int) const {
        const int lane = hidden_tid(0), fr = lane & 15, fq = lane >> 4, row0 = u.pm * 256 + wr * 64 + fr, head = 2 * u.pn + (wc >> 1); const bool isv = wc & 1;
        const float* gk = launder_ptr(this->gk);
        const f32x4 g00 = *(const f32x4*)(gk + 8 * fq), g01 = *(const f32x4*)(gk + 8 * fq + 4), g10 = *(const f32x4*)(gk + 32 + 8 * fq), g11 = *(const f32x4*)(gk + 36 + 8 * fq);
#pragma unroll
        for (int ai2 = 0; ai2 < 8; ++ai2) {
            const int ai = ai2 >> 2, mb = ai2 & 3;
            f32x4 p4[4], cv[4], sv[4], gr1, gr2; float krs[4]; u32x2 ka[4], kb[4];
#pragma unroll
            for (int m = mb; m < mb + 1; ++m) { const int row = row0 + ai * 128 + m * 16; p4[m] = *(const GAS_ f32x4*)(ssq + (size_t)4 * T + (size_t)row * 4);
                if (!isv) { krs[m] = *(const GAS_ float*)(ssq + (size_t)8 * T + row); ka[m] = *(const GAS_ u32x2*)(proj + (size_t)row * PJ + PC_KR + 4 * fq); kb[m] = *(const GAS_ u32x2*)(proj + (size_t)row * PJ + PC_KR + 16 + 4 * fq);
                    cv[m] = *(const GAS_ f32x4*)(cs + (size_t)row * 16 + 4 * fq); sv[m] = *(const GAS_ f32x4*)(sn + (size_t)row * 16 + 4 * fq);
                    gr1 = *(const GAS_ f32x4*)(gk + 64 + 4 * fq); gr2 = *(const GAS_ f32x4*)(gk + 80 + 4 * fq); } }
#pragma unroll
            for (int m = mb; m < mb + 1; ++m) { const int row = row0 + ai * 128 + m * 16;
                const float rkv = rsqrtf(((p4[m][0] + p4[m][1]) + (p4[m][2] + p4[m][3])) * (1.f / 128.f) + EPS);
                const f32x4 a0 = acc[ai][0][m][0], a1 = acc[ai][0][m][1], b0 = acc[ai][1][m][0], b1 = acc[ai][1][m][1];
                if (isv) { GAS_ bf16_t* vp = (GAS_ bf16_t*)kv + (size_t)row * 768 + head * 128 + 64 + 8 * fq; *(GAS_ u32x4*)vp = pg8::pack8(a0 * rkv, a1 * rkv); *(GAS_ u32x4*)(vp + 32) = pg8::pack8(b0 * rkv, b1 * rkv); }
                else {
                    float s = 0.f;
#pragma unroll
                    for (int j = 0; j < 4; ++j) s += a0[j] * a0[j] + a1[j] * a1[j] + b0[j] * b0[j] + b1[j] * b1[j];
                    s += shx(s, 16, lane); s += shx(s, 32, lane);
                    const float rh = rsqrtf((s * rkv * rkv + krs[m]) * (1.f / 96.f) + EPS), sc = rkv * rh;
                    GAS_ bf16_t* kp = (GAS_ bf16_t*)km + (size_t)row * 576 + head * 96;
                    *(GAS_ u32x4*)(kp + 8 * fq) = pg8::pack8(a0 * g00 * sc, a1 * g01 * sc); *(GAS_ u32x4*)(kp + 32 + 8 * fq) = pg8::pack8(b0 * g10 * sc, b1 * g11 * sc);
                    const f32x4 x1 = (f32x4){bf2f(ka[m].x & 0xffff), bf2f(ka[m].x >> 16), bf2f(ka[m].y & 0xffff), bf2f(ka[m].y >> 16)} * gr1 * rh, x2 = (f32x4){bf2f(kb[m].x & 0xffff), bf2f(kb[m].x >> 16), bf2f(kb[m].y & 0xffff), bf2f(kb[m].y >> 16)} * gr2 * rh;
                    const f32x4 o1 = x1 * cv[m] - x2 * sv[m], o2 = x1 * sv[m] + x2 * cv[m];
                    u32x2 w1, w2; w1.x = pg8::cvt_pk_bf16(o1[0], o1[1]); w1.y = pg8::cvt_pk_bf16(o1[2], o1[3]); w2.x = pg8::cvt_pk_bf16(o2[0], o2[1]); w2.y = pg8::cvt_pk_bf16(o2[2], o2[3]);
                    *(GAS_ u32x2*)(kp + 64 + 4 * fq) = w1; *(GAS_ u32x2*)(kp + 80 + 4 * fq) = w2; } } }
    }
};
template <bool KS>
struct EpiResidT {
    static constexpr bool KSCALE = KS; static constexpr int KB0 = 4, KB1 = 10;
    static constexpr bool PERM = true, AFTER_DRAIN = false;
    const bf16_t* X; const float* gate0; bf16_t* Xo;
    __device__ __forceinline__ void operator()(const f32x4 (&acc)[2][2][4][2], const Unit& u, int wr, int wc, int fr, int fq) const {
        const int row0 = u.pm * 256 + wr * 64 + fr, col0 = u.pn * 256 + wc * 32 + 8 * fq;
        const float* gp = gate0 + (size_t)(u.pm >> 4) * 6 * D + col0;
        f32x4 g[2][2];
#pragma unroll
        for (int bj = 0; bj < 2; ++bj) { g[bj][0] = *(const f32x4*)(gp + bj * 128); g[bj][1] = *(const f32x4*)(gp + bj * 128 + 4); }
#pragma unroll
        for (int ai = 0; ai < 2; ++ai) {
            u32x4 xv[4][2];
#pragma unroll
            for (int m = 0; m < 4; ++m) { const GAS_ bf16_t* rp = (const GAS_ bf16_t*)X + (size_t)(row0 + ai * 128 + m * 16) * D + col0;
#pragma unroll
                for (int bj = 0; bj < 2; ++bj) xv[m][bj] = *(const GAS_ u32x4*)(rp + bj * 128); }
#pragma unroll
            for (int m = 0; m < 4; ++m) { GAS_ bf16_t* wp = (GAS_ bf16_t*)Xo + (size_t)(row0 + ai * 128 + m * 16) * D + col0;
#pragma unroll
                for (int bj = 0; bj < 2; ++bj) { const u32x4 w = xv[m][bj];
                    const f32x4 x0 = {__uint_as_float(w.x << 16), __uint_as_float(w.x & 0xffff0000u), __uint_as_float(w.y << 16), __uint_as_float(w.y & 0xffff0000u)};
                    const f32x4 x1 = {__uint_as_float(w.z << 16), __uint_as_float(w.z & 0xffff0000u), __uint_as_float(w.w << 16), __uint_as_float(w.w & 0xffff0000u)};
                    *(GAS_ u32x4*)(wp + bj * 128) = pg8::pack8(x0 + g[bj][0] * acc[ai][bj][m][0], x1 + g[bj][1] * acc[ai][bj][m][1]); } } }
    }
};
using EpiResid = EpiResidT<false>; using EpiResidK = EpiResidT<true>;
__device__ __forceinline__ f32x4 silu_mul4(const f32x4 g, const f32x4 u) { f32x4 o;
#pragma unroll
    for (int j = 0; j < 4; ++j) o[j] = g[j] * __builtin_amdgcn_rcpf(1.f + __expf(-g[j])) * u[j];
    return o; }
struct EpiSwiglu {
    static constexpr bool PERM = true, AFTER_DRAIN = false;
    bf16_t* O; int ldc; int pn_mod;
    __device__ __forceinline__ void operator()(const f32x4 (&acc)[2][2][4][2], const Unit& u, int wr, int wc, int fr, int fq) const {
        const int row0 = u.pm * 256 + wr * 64 + fr, ff0 = (u.pn % pn_mod) * 128 + wc * 32 + 8 * fq;
#pragma unroll
        for (int ai = 0; ai < 2; ++ai)
#pragma unroll
            for (int m = 0; m < 4; ++m) *(u32x4*)(O + (size_t)(row0 + ai * 128 + m * 16) * ldc + ff0) = pg8::pack8(silu_mul4(acc[ai][0][m][0], acc[ai][1][m][0]), silu_mul4(acc[ai][0][m][1], acc[ai][1][m][1]));
    }
};
struct EpiGlu {
    static constexpr bool PERM = true, AFTER_DRAIN = false;
    const bf16_t* Y; bf16_t* O; const float* bias; int ldo; float* ssq;
    __device__ __forceinline__ void operator()(const f32x4 (&acc)[2][2][4][2], const Unit& u, int wr, int wc, int, int) const {
        const int lane = hidden_tid(0), fr = lane & 15, fq = lane >> 4, row0 = u.pm * 256 + wr * 64 + fr, col0 = wc * 32 + 8 * fq;
        f32x4 bb[2][2]; const float* bias = launder_ptr(this->bias);
#pragma unroll
        for (int bj = 0; bj < 2; ++bj) { bb[bj][0] = *(const f32x4*)(bias + col0 + bj * 128); bb[bj][1] = *(const f32x4*)(bias + col0 + bj * 128 + 4); }
#pragma unroll
        for (int ai = 0; ai < 2; ++ai) {
            u32x4 yv[4][2];
#pragma unroll
            for (int m = 0; m < 4; ++m)
#pragma unroll
                for (int bj = 0; bj < 2; ++bj) yv[m][bj] = *(const GAS_ u32x4*)(Y + (size_t)(row0 + ai * 128 + m * 16) * 256 + col0 + bj * 128);
#pragma unroll
            for (int m = 0; m < 4; ++m) { float ss = 0.f;
#pragma unroll
                for (int bj = 0; bj < 2; ++bj) { const unsigned yw[4] = {yv[m][bj].x, yv[m][bj].y, yv[m][bj].z, yv[m][bj].w}; f32x4 o0, o1;
#pragma unroll
                    for (int j = 0; j < 4; ++j) { const float ya = j & 1 ? bf2f(yw[j >> 1] >> 16) : bf2f(yw[j >> 1] & 0xffff), yb = j & 1 ? bf2f(yw[2 + (j >> 1)] >> 16) : bf2f(yw[2 + (j >> 1)] & 0xffff);
                        o0[j] = ya * __builtin_amdgcn_rcpf(1.f + __expf(-(acc[ai][bj][m][0][j] + bb[bj][0][j]))); o1[j] = yb * __builtin_amdgcn_rcpf(1.f + __expf(-(acc[ai][bj][m][1][j] + bb[bj][1][j]))); }
#pragma unroll
                    for (int j = 0; j < 4; ++j) ss += o0[j] * o0[j] + o1[j] * o1[j];
                    *(GAS_ u32x4*)((GAS_ bf16_t*)O + (size_t)(row0 + ai * 128 + m * 16) * ldo + col0 + bj * 128) = pg8::pack8(o0, o1); }
                ss += shx(ss, 16, lane); ss += shx(ss, 32, lane);
                if (fq == 0) ssq[(size_t)(row0 + ai * 128 + m * 16) * 16 + wc] = ss; } }
    }
};

__device__ __forceinline__ int inproj_nat_col(int n) { if (n < 768 || n >= 1536) return n; const int pn = n >> 8, c = n & 255; return 768 + ((((pn - 3) * 4 + ((c >> 5) & 3))) << 6) + ((c >> 7) << 5) + (c & 31); }
template <class SRC>
__device__ __forceinline__ void convert_tiles(bf16_t* Bt, int N, int K, SRC src, float* scr, int gw, int ngw, int lane) {
    const int nblk = N / 32, items = (K / 64) * nblk;
    for (int it = gw; it < items; it += ngw) {
        const int kb = it / nblk, nb = it % nblk, k0 = kb * 64, n0 = nb * 32;
#pragma unroll 8
        for (int i = 0; i < 32; ++i) { const int kk = 2 * i + (lane >> 5); scr[kk * 33 + (lane & 31)] = src(k0 + kk, n0 + (lane & 31)); }
        asm volatile("s_waitcnt lgkmcnt(0)" ::: "memory");
        const int c = lane & 7;
#pragma unroll
        for (int j = 0; j < 4; ++j) { const int n = (lane >> 3) + 8 * j; const float* s = scr + (8 * c) * 33 + n;
            u32x4 o; o.x = pk2(s[0], s[33]); o.y = pk2(s[66], s[99]); o.z = pk2(s[132], s[165]); o.w = pk2(s[198], s[231]);
            *(u32x4*)(Bt + (size_t)(n0 + n) * K + k0 + 8 * c) = o; }
        asm volatile("s_waitcnt lgkmcnt(0)" ::: "memory");
    }
}

struct CvtTile { const float* src; const float* gain; bf16_t* dst; int ld, K; };
__device__ __forceinline__ int cvt_count(int layer) { return 512 + ((layer & 1) == 0 ? (D / 64) * (2 * DFF / 32) + (DFF / 64) * (D / 32) : NEXP * ((D / 64) * (2 * DFE / 32) + (DFE / 64) * (D / 32))); }
__device__ __forceinline__ void cvt_decode(const Params& P, int layer, int it, int kr, int n4, CvtTile& t) {
    unsigned char* ws = P.ws;
    if (it < 512) { const int kb = it >> 5, nb = it & 31, k0 = kb * 64, n0 = nb * 32;
        t.src = P.w_out + (size_t)layer * D * D + (size_t)(k0 + kr) * D + n0 + n4; t.gain = P.out_norm + layer * D + k0 + kr; t.ld = D; t.K = D; t.dst = (bf16_t*)(ws + W_OUT) + (size_t)n0 * D + k0; return; }
    it -= 512; t.gain = nullptr;
    if ((layer & 1) == 0) {
        const int n1 = (D / 64) * (2 * DFF / 32);
        if (it < n1) { const int nblk = 2 * DFF / 32, kb = it / nblk, nb = it % nblk, k0 = kb * 64, n0 = nb * 32, ff = (n0 >> 8) * 128 + (n0 & 127);
            t.src = ((n0 & 128) ? P.ffn_wu : P.ffn_wg) + (size_t)(layer / 2) * D * DFF + (size_t)(k0 + kr) * DFF + ff + n4; t.ld = DFF; t.K = D; t.dst = (bf16_t*)(ws + W_F1) + (size_t)n0 * D + k0; }
        else { it -= n1; const int kb = it >> 5, nb = it & 31, k0 = kb * 64, n0 = nb * 32;
            t.src = P.ffn_wd + (size_t)(layer / 2) * DFF * D + (size_t)(k0 + kr) * D + n0 + n4; t.ld = D; t.K = DFF; t.dst = (bf16_t*)(ws + W_F2) + (size_t)n0 * DFF + k0; }
    } else {
        const int n1 = (D / 64) * (2 * DFE / 32), n2 = (DFE / 64) * (D / 32), e = it / (n1 + n2); it -= e * (n1 + n2);
        const size_t eo = (size_t)(layer / 2) * NEXP + e;
        if (it < n1) { const int nblk = 2 * DFE / 32, kb = it / nblk, nb = it % nblk, k0 = kb * 64, n0 = nb * 32, ff = (n0 >> 8) * 128 + (n0 & 127);
            t.src = ((n0 & 128) ? P.moe_wu : P.moe_wg) + eo * D * DFE + (size_t)(k0 + kr) * DFE + ff + n4; t.ld = DFE; t.K = D; t.dst = (bf16_t*)(ws + W_F1) + (size_t)e * 2 * DFE * D + (size_t)n0 * D + k0; }
        else { it -= n1; const int kb = it >> 5, nb = it & 31, k0 = kb * 64, n0 = nb * 32;
            t.src = P.moe_wd + eo * DFE * D + (size_t)(k0 + kr) * D + n0 + n4; t.ld = D; t.K = DFE; t.dst = (bf16_t*)(ws + W_F2) + (size_t)e * D * DFE + (size_t)n0 * DFE + k0; }
    }
}
__device__ __forceinline__ void cvt_load(const CvtTile& t, f32x4 (&v)[8], float (&g)[8]) {
#pragma unroll
    for (int i = 0; i < 8; ++i) v[i] = *(const f32x4*)(t.src + (size_t)(i * 8) * t.ld);
    if (t.gain) {
#pragma unroll
        for (int i = 0; i < 8; ++i) g[i] = t.gain[i * 8]; }
}
__device__ __forceinline__ void convert_stream(const Params& P, int layer, float* scr, int first, int items, int ngw, int lane) {
    const int kr = lane >> 3, n4 = (lane & 7) * 4, c = lane & 7;
    CvtTile t, tn; f32x4 v[8], vn[8]; float g[8], gn[8];
    if (first < items) { cvt_decode(P, layer, first, kr, n4, t); cvt_load(t, v, g); }
    for (int it = first; it < items; it += ngw) {
        const int nit = it + ngw;
        if (nit < items) { cvt_decode(P, layer, nit, kr, n4, tn); cvt_load(tn, vn, gn); }
        if (t.gain) {
#pragma unroll
            for (int i = 0; i < 8; ++i) v[i] = v[i] * g[i]; }
#pragma unroll
        for (int i = 0; i < 8; ++i)
#pragma unroll
            for (int j = 0; j < 4; ++j) scr[(n4 + j) * 68 + i * 8 + kr] = v[i][j];
        asm volatile("s_waitcnt lgkmcnt(0)" ::: "memory");
#pragma unroll
        for (int j = 0; j < 4; ++j) { const int n = (lane >> 3) + 8 * j; const float* s = scr + n * 68 + 8 * c; const f32x4 a = *(const f32x4*)s, b = *(const f32x4*)(s + 4);
            u32x4 o_; o_.x = pk2(a[0], a[1]); o_.y = pk2(a[2], a[3]); o_.z = pk2(b[0], b[1]); o_.w = pk2(b[2], b[3]);
            *(u32x4*)(t.dst + (size_t)n * t.K + 8 * c) = o_; }
        asm volatile("s_waitcnt lgkmcnt(0)" ::: "memory");
#pragma unroll
        for (int i = 0; i < 8; ++i) { v[i] = vn[i]; g[i] = gn[i]; }
        t = tn;
    }
}
__device__ __forceinline__ float cvt0_src(const Params& P, int layer, int which, int k, int n) {
    if (which == 0) { const int oc = proj_orig_col(inproj_nat_col(n)); return oc < 0 ? 0.f : P.w_in[(size_t)layer * D * INC + (size_t)k * INC + oc]; }
    if (which == 1) return n < 576 ? P.q_norm[layer * 256 + k] * P.w_uq[(size_t)layer * 256 * 576 + (size_t)k * 576 + n] : 0.f;
    if (which == 2) { const int c = n & 255, wc_ = (c >> 5) & 3, nat = (2 * (n >> 8) + (wc_ >> 1)) * 128 + (wc_ & 1) * 64 + ((c >> 7) << 5) + (c & 31); return k < 128 ? P.kv_norm[layer * 128 + k] * P.w_ukv[(size_t)layer * 128 * 768 + (size_t)k * 768 + nat] : 0.f; }
    return P.w_glu[(size_t)layer * 256 * 256 + (size_t)k * 256 + n];
}
__device__ __forceinline__ void convert_small(const Params& P, int layer, float* scr, int gw, int ngw, int lane) {
    unsigned char* ws = P.ws;
    for (int it = gw; it < 1024 + 96 + 96 + 32; it += ngw) {
        int which, r, nblk, K; bf16_t* Bt;
        if (it < 1024) { which = 0; r = it; nblk = PJ / 32; K = D; Bt = (bf16_t*)(ws + W_IN); }
        else if (it < 1120) { which = 1; r = it - 1024; nblk = 24; K = 256; Bt = (bf16_t*)(ws + W_UQ); }
        else if (it < 1216) { which = 2; r = it - 1120; nblk = 24; K = 256; Bt = (bf16_t*)(ws + W_UKV); }
        else { which = 3; r = it - 1216; nblk = 8; K = 256; Bt = (bf16_t*)(ws + W_GLU); }
        const int kb = r / nblk, nb = r % nblk, k0 = kb * 64, n0 = nb * 32;
        float v[32];
#pragma unroll
        for (int i = 0; i < 32; ++i) v[i] = cvt0_src(P, layer, which, k0 + 2 * i + (lane >> 5), n0 + (lane & 31));
#pragma unroll
        for (int i = 0; i < 32; ++i) scr[(2 * i + (lane >> 5)) * 33 + (lane & 31)] = v[i];
        asm volatile("s_waitcnt lgkmcnt(0)" ::: "memory");
        const int c = lane & 7;
#pragma unroll
        for (int j = 0; j < 4; ++j) { const int n = (lane >> 3) + 8 * j; const float* s = scr + (8 * c) * 33 + n;
            u32x4 o; o.x = pk2(s[0], s[33]); o.y = pk2(s[66], s[99]); o.z = pk2(s[132], s[165]); o.w = pk2(s[198], s[231]);
            *(u32x4*)(Bt + (size_t)(n0 + n) * K + k0 + 8 * c) = o; }
        asm volatile("s_waitcnt lgkmcnt(0)" ::: "memory");
    }
}
__device__ __forceinline__ void ph_convert(unsigned char* lds, Params P, int layer) {
    const int TIDX = hidden_tid(P.wid), BIDX = launder_i((int)blockIdx.x), GDIM = launder_i((int)gridDim.x); P.ws = launder_ptr(P.ws); P.out = launder_ptr(P.out);
    const int wid = TIDX >> 6, lane = TIDX & 63;
    convert_small(P, layer, (float*)lds + wid * 2176, BIDX * 8 + wid, GDIM * 8, lane);
    { const int ngw = GDIM * 8; int first = BIDX * 8 + wid - 1248 % ngw; if (first < 0) first += ngw;
      convert_stream(P, layer, (float*)lds + wid * 2176, first, cvt_count(layer), ngw, lane); }
}
#define GEMM_LDS ((PG8_LAS unsigned char*)lds)
__device__ __forceinline__ void ph_inproj_opt(unsigned char* lds, Params P, int layer) {
    const int TIDX = hidden_tid(P.wid), BIDX = launder_i((int)blockIdx.x), GDIM = launder_i((int)gridDim.x); P.ws = launder_ptr(P.ws); P.out = launder_ptr(P.out);
    pg8::Gemm g{(const bf16_t*)(P.ws + WS_HBUF), (const bf16_t*)(P.ws + W_IN), D, D, D, P.wid}; pg8::StaticOrder S; S.init(T, PJ, GDIM, BIDX);
    EpiInproj2 E{(bf16_t*)(P.ws + WS_PROJ), (float*)(P.ws + WS_FG), (bf16_t*)(P.ws + WS_UG), (float*)(P.ws + WS_SSQ), P.fox_gq + layer * 64, P.fox_gk + layer * 64, P.fox_bf + layer * 6};
    pg8::gemm_phase<EpiInproj2, pg8::StaticOrder, true, true>(GEMM_LDS, g, S, E);
}
__device__ __forceinline__ void ph_qup_opt(unsigned char* lds, Params P, int layer) {
    const int TIDX = hidden_tid(P.wid), BIDX = launder_i((int)blockIdx.x), GDIM = launder_i((int)gridDim.x); P.ws = launder_ptr(P.ws); P.out = launder_ptr(P.out);
    pg8::Gemm g{(const bf16_t*)(P.ws + WS_PROJ) + PC_CQ, (const bf16_t*)(P.ws + W_UQ), PJ, 256, 256, P.wid}; pg8::StaticOrder S; S.init(T, 768, GDIM, BIDX);
    EpiStore E{(bf16_t*)(P.ws + WS_QRAW), 768, (const float*)(P.ws + WS_SSQ), 1.f / 256.f, 1 << 20, 576};
    pg8::gemm_phase<EpiStore, pg8::StaticOrder, true, true>(GEMM_LDS, g, S, E);
}
__device__ __forceinline__ void ph_kvup_opt(unsigned char* lds, Params P, int layer) {
    const int TIDX = hidden_tid(P.wid), BIDX = launder_i((int)blockIdx.x), GDIM = launder_i((int)gridDim.x); P.ws = launder_ptr(P.ws); P.out = launder_ptr(P.out);
    pg8::Gemm g{(const bf16_t*)(P.ws + WS_PROJ) + PC_CKV, (const bf16_t*)(P.ws + W_UKV), PJ, 256, 128, P.wid};     pg8::StaticOrder S; S.init(T, 768, GDIM, (BIDX + (GDIM >> 1)) % GDIM);
    EpiKvup E{(bf16_t*)(P.ws + WS_KMLA), (bf16_t*)(P.ws + WS_KVRAW), (const bf16_t*)(P.ws + WS_PROJ), (const float*)(P.ws + WS_SSQ), P.mla_gk + layer * 96, (const float*)(P.ws + WS_COS), (const float*)(P.ws + WS_SIN)};
    pg8::gemm_phase<EpiKvup, pg8::StaticOrder, true, true>(GEMM_LDS, g, S, E);
}
__device__ __forceinline__ void ph_glu_opt(unsigned char* lds, Params P, int layer, int sub = 0) {
    const int TIDX = hidden_tid(P.wid), BIDX = launder_i((int)blockIdx.x), GDIM = launder_i((int)gridDim.x); P.ws = launder_ptr(P.ws); P.out = launder_ptr(P.out);
    pg8::Gemm g{(const bf16_t*)(P.ws + WS_YG), (const bf16_t*)(P.ws + W_GLU), 256, 256, 256, P.wid}; pg8::StaticOrder S; S.init(T, 256, sub ? 64 : GDIM, sub ? (BIDX < 64 ? BIDX : (1 << 20)) : BIDX);
    EpiGlu E{(const bf16_t*)(P.ws + WS_YG), (bf16_t*)(P.ws + WS_HBUF), P.b_glu + layer * 256, D, (float*)(P.ws + WS_SSQ2)};
    pg8::gemm_phase<EpiGlu, pg8::StaticOrder, true, true>(GEMM_LDS, g, S, E);
}
__device__ __forceinline__ void ph_outproj_opt(unsigned char* lds, Params P, int layer, int probe = 0) {
    const int TIDX = hidden_tid(P.wid), BIDX = launder_i((int)blockIdx.x), GDIM = launder_i((int)gridDim.x); P.ws = launder_ptr(P.ws); P.out = launder_ptr(P.out);
    pg8::Gemm g{(const bf16_t*)(P.ws + WS_HBUF), (const bf16_t*)(P.ws + W_OUT), D, D, D, P.wid}; pg8::StaticOrder S; S.init(T, D, GDIM, BIDX);
    {
        PG8_LAS float* tab = (PG8_LAS float*)(GEMM_LDS + 132096); const float* sq = (const float*)(P.ws + WS_SSQ2);
        for (int e = TIDX; e < 4 * 256; e += 512) { const int j = e >> 8, r = e & 255; pg8::Unit uu;
            if (S.next(j, uu)) { const float* p = sq + (size_t)(uu.pm * 256 + r) * 16; const f32x4 a = *(const f32x4*)p, b = *(const f32x4*)(p + 4), c = *(const f32x4*)(p + 8), d = *(const f32x4*)(p + 12);
                const float s1 = (a[0] + a[1]) + (a[2] + a[3]), s2 = ((b[0] + b[1]) + (b[2] + b[3])) + (c[0] + c[1]), s3 = ((c[2] + c[3]) + (d[0] + d[1])) + (d[2] + d[3]);
                const float r1 = rsqrtf(s1 * (1.f / 256.f) + EPS), r2 = rsqrtf(s2 * (1.f / 384.f) + EPS), r3 = rsqrtf(s3 * (1.f / 384.f) + EPS);
                tab[(j * 3 + 0) * 256 + r] = r1 / r2; tab[(j * 3 + 1) * 256 + r] = r2 / r3; tab[(j * 3 + 2) * 256 + r] = r3; } }
        __syncthreads(); }
    EpiResidK E{xstream(P, layer), adap(P, layer, 0, 2), probe ? (bf16_t*)(P.ws + WS_XE) : xstream(P, layer + (layer == DEPTH - 1))};
    pg8::gemm_phase<EpiResidK, pg8::StaticOrder, true, true>(GEMM_LDS, g, S, E);
}
__device__ __forceinline__ void ph_ffn1_opt(unsigned char* lds, Params P, int layer) {
    const int TIDX = hidden_tid(P.wid), BIDX = launder_i((int)blockIdx.x), GDIM = launder_i((int)gridDim.x); P.ws = launder_ptr(P.ws); P.out = launder_ptr(P.out);
    pg8::Gemm g{(const bf16_t*)(P.ws + WS_HBUF), (const bf16_t*)(P.ws + W_F1), D, D, D, P.wid}; pg8::StaticOrder S; S.init(T, 2 * DFF, GDIM, BIDX);
    EpiSwiglu E{(bf16_t*)(P.ws + WS_ACT), DFF, 1 << 20};
    pg8::gemm_phase<EpiSwiglu, pg8::StaticOrder, true, true>(GEMM_LDS, g, S, E);
}
__device__ __forceinline__ void ph_ffn2_opt(unsigned char* lds, Params P, int layer, int probe = 0) {
    const int TIDX = hidden_tid(P.wid), BIDX = launder_i((int)blockIdx.x), GDIM = launder_i((int)gridDim.x); P.ws = launder_ptr(P.ws); P.out = launder_ptr(P.out);
    pg8::Gemm g{(const bf16_t*)(P.ws + WS_ACT), (const bf16_t*)(P.ws + W_F2), DFF, DFF, DFF, P.wid}; pg8::StaticOrder S; S.init(T, D, GDIM, BIDX);
    EpiResid E{xstream(P, layer), adap(P, layer, 0, 5), probe ? (bf16_t*)(P.ws + WS_XE) : xstream(P, layer)};
    pg8::gemm_phase<EpiResid, pg8::StaticOrder, true, true>(GEMM_LDS, g, S, E);
}
struct MoeSlots {
    int off[NEXP + 1], cnt[NEXP];
    __device__ __forceinline__ void init(const unsigned* c) { int o_ = 0;
#pragma unroll
        for (int e = 0; e < NEXP; ++e) { cnt[e] = __builtin_amdgcn_readfirstlane((int)c[e]); off[e] = o_; o_ += ((cnt[e] + 255) >> 8) << 8; }
        off[NEXP] = o_; }
    __device__ __forceinline__ int expert_of(int pnl) const { int e = 0;
#pragma unroll
        for (int j = 1; j < NEXP; ++j) if (pnl * 256 >= off[j]) e = j;
        return e; }
    __device__ __forceinline__ int off_of(int e) const { int r = 0;
#pragma unroll
        for (int j = 0; j < NEXP; ++j) if (e == j) r = off[j];
        return r; }
    __device__ __forceinline__ int cnt_of(int e) const { int r = 0;
#pragma unroll
        for (int j = 0; j < NEXP; ++j) if (e == j) r = cnt[j];
        return r; }
};
struct MoeOrder1 {
    static constexpr bool GATHER = true;
    int n, G, c; MoeSlots sl; const int* list;
    __device__ __forceinline__ bool next(int i, Unit& u) const { const long L = (long)i * G + c; if (L >= n) return false; const int pnl = (int)L / 11, t = (int)L % 11; u.pm = pnl; u.pn = sl.expert_of(pnl) * 11 + t; return true; }
    __device__ __forceinline__ void rowoff4(const Unit& u, int R, unsigned& o0, unsigned& o1, unsigned& o2, unsigned& o3) const {
        const int e = sl.expert_of(u.pm), r = u.pm * 256 - sl.off_of(e) + R, c = sl.cnt_of(e); const int* lp = list + (size_t)e * T + r;
        const int t0 = r < c ? lp[0] : 0, t1 = r + 64 < c ? lp[64] : 0, t2 = r + 128 < c ? lp[128] : 0, t3 = r + 192 < c ? lp[192] : 0;
        o0 = (unsigned)t0 * (unsigned)(D * 2); o1 = (unsigned)t1 * (unsigned)(D * 2); o2 = (unsigned)t2 * (unsigned)(D * 2); o3 = (unsigned)t3 * (unsigned)(D * 2); }
    __device__ __forceinline__ void a_ready(const Unit&) const {}
    __device__ __forceinline__ void done(const Unit&) const {}
};
struct MoeDec2 { MoeSlots sl; __device__ __forceinline__ void operator()(int L, Unit& u) const { const int pnl = L >> 2, t = L & 3; u.pm = pnl; u.pn = sl.expert_of(pnl) * 4 + t; } };
__device__ __forceinline__ void ph_moe1_opt(unsigned char* lds, Params P, int layer) {
    const int TIDX = hidden_tid(P.wid), BIDX = launder_i((int)blockIdx.x), GDIM = launder_i((int)gridDim.x); P.ws = launder_ptr(P.ws); P.out = launder_ptr(P.out); (void)TIDX;
    MoeSlots sl; sl.init((const unsigned*)(P.ws + WS_CTL) + CW_CNT + 16 * (layer / 2));
    pg8::Gemm g{(const bf16_t*)(P.ws + WS_HBUF), (const bf16_t*)(P.ws + W_F1), D, D, D, P.wid};
    MoeOrder1 S{(sl.off[NEXP] >> 8) * 11, (int)GDIM, (int)BIDX, sl, (const int*)(P.ws + WS_LIST)};
    EpiSwiglu E{(bf16_t*)(P.ws + WS_ACTM), DFE, 11};
    pg8::gemm_phase<EpiSwiglu, MoeOrder1, true, true>(GEMM_LDS, g, S, E);
}
__device__ __forceinline__ void ph_moe2_opt(unsigned char* lds, Params P, int layer) {
    const int TIDX = hidden_tid(P.wid), BIDX = launder_i((int)blockIdx.x), GDIM = launder_i((int)gridDim.x); P.ws = launder_ptr(P.ws); P.out = launder_ptr(P.out); (void)TIDX;
    MoeSlots sl; sl.init((const unsigned*)(P.ws + WS_CTL) + CW_CNT + 16 * (layer / 2));
    pg8::Gemm g{(const bf16_t*)(P.ws + WS_ACTM), (const bf16_t*)(P.ws + W_F2), DFE, DFE, DFE, P.wid};
    pg8::ListOrder<MoeDec2> S{(sl.off[NEXP] >> 8) * 4, (int)GDIM, (int)BIDX, MoeDec2{sl}};
    EpiStore E{(bf16_t*)(P.ws + ymoe_off(layer)), D, nullptr, 0.f, 4, 1 << 20};
    pg8::gemm_phase<EpiStore, pg8::ListOrder<MoeDec2>, true, true>(GEMM_LDS, g, S, E);
}


#ifndef LAS
#define LAS __attribute__((address_space(3)))
#endif
namespace att {
typedef short bf16x8 __attribute__((ext_vector_type(8)));
typedef short s16x4 __attribute__((ext_vector_type(4)));
typedef float f32x16 __attribute__((ext_vector_type(16)));
constexpr int LDS_K = 0, LDS_V = 49152, LDS_B = 81920, LDS_WS = 82944, LDS_OST = 84992, LDS_U = 117760;
struct Args { const bf16_t* Q; int ldq; const bf16_t* K; int ldk; const bf16_t* V; int ldv; int vhs; bf16_t* O; int ldo; float* ssq; const float* cb; unsigned* ctr; float th; const float* gq; const float* cs; const float* sn; float bsh; };
__device__ __forceinline__ int crow(int r, int hi) { return (r & 3) + 8 * (r >> 2) + 4 * hi; }
#define ATT_WAITV(N) asm volatile("s_waitcnt vmcnt(" #N ")" ::: "memory")
#define ATT_GLDS16(g, l) __builtin_amdgcn_global_load_lds((const unsigned*)(g), (LAS unsigned*)(l), 16, 0, 0)
#define ATT_GLDS4(g, l) __builtin_amdgcn_global_load_lds((const unsigned*)(g), (LAS unsigned*)(l), 4, 0, 0)
__device__ __forceinline__ unsigned cvtpk(float lo, float hi) { unsigned r; asm volatile("v_cvt_pk_bf16_f32 %0, %1, %2" : "=v"(r) : "v"(lo), "v"(hi)); return r; }
__device__ __forceinline__ void pv(f32x16* o, int vb, bf16x8 pa0, bf16x8 pa1, bf16x8 pa2, bf16x8 pa3) {
#pragma unroll
    for (int d0 = 0; d0 < 2; ++d0) { s16x4 lo[4], hi[4];
#pragma unroll
        for (int ks = 0; ks < 4; ++ks) {
            asm volatile("ds_read_b64_tr_b16 %0,%1 offset:%c2" : "=&v"(lo[ks]) : "v"(vb), "i"(d0 * 4096 + ks * 1024) : "memory");
            asm volatile("ds_read_b64_tr_b16 %0,%1 offset:%c2" : "=&v"(hi[ks]) : "v"(vb), "i"(d0 * 4096 + ks * 1024 + 512) : "memory"); }
        asm volatile("s_waitcnt lgkmcnt(0)" ::: "memory"); __builtin_amdgcn_sched_barrier(0);
#define ATT_PK(k) (bf16x8){lo[k][0], lo[k][1], lo[k][2], lo[k][3], hi[k][0], hi[k][1], hi[k][2], hi[k][3]}
        o[d0] = __builtin_amdgcn_mfma_f32_32x32x16_bf16(pa0, ATT_PK(0), o[d0], 0, 0, 0);
        o[d0] = __builtin_amdgcn_mfma_f32_32x32x16_bf16(pa1, ATT_PK(1), o[d0], 0, 0, 0);
        o[d0] = __builtin_amdgcn_mfma_f32_32x32x16_bf16(pa2, ATT_PK(2), o[d0], 0, 0, 0);
        o[d0] = __builtin_amdgcn_mfma_f32_32x32x16_bf16(pa3, ATT_PK(3), o[d0], 0, 0, 0);
#undef ATT_PK
    }
}
template <int NS, int MODE, int SH>
__device__ __forceinline__ void unit(const int b, const int h, const int qb, const Args& A, unsigned char* lds, const int tid_) {
    constexpr int DQK = 16 * NS, KSLOT = NS * 2048;
    const int wid = __builtin_amdgcn_readfirstlane(tid_ >> 6), tid = hidden_tid(wid);
    const int lane = tid & 63, r32 = lane & 31, hi = lane >> 5;
    const size_t rowbase = (size_t)b * SEQ; const int q0 = qb * 256;
    const bf16_t* Qw = A.Q + (rowbase + q0 + wid * 32) * A.ldq + h * DQK;
    const bf16_t* Kh = A.K + rowbase * A.ldk + h * DQK; const bf16_t* Vh = A.V + rowbase * A.ldv + h * A.vhs;
    LAS unsigned char* L = (LAS unsigned char*)lds;
    const unsigned lds0 = (unsigned)(uintptr_t)lds;
    const bf16_t* ksrc = Kh + (size_t)lane * A.ldk + wid * 8;
    const bf16_t* vsrc = Vh + (size_t)(16 * (wid & 3) + (lane >> 2)) * A.ldv + (wid >> 2) * 32 + (lane & 3) * 8;
    const float* bsrc = MODE == 1 ? A.cb + ((size_t)b * 6 + h) * SEQ + lane : nullptr;
    const bool k2 = (NS > 4) && (wid < 2 * NS - 8), bw = (MODE == 1) && (wid == 7), n3 = k2 || bw;
    const int NT = (q0 + 256) / 64;
    int t0 = 0;
    if (MODE == 1) {
        const float* cbh = A.cb + ((size_t)b * 6 + h) * SEQ; const float cq0 = cbh[q0];
        bool sk = false; if (lane < NT - 4) sk = (cq0 - cbh[64 * lane + 63]) < -A.th;
        const unsigned long long m = __ballot(sk);
        t0 = __builtin_amdgcn_readfirstlane((int)__builtin_ctzll(~m));
    }
#define ATT_DMAV(t, s) ATT_GLDS16(vsrc + (size_t)(t) * 64 * A.ldv, L + LDS_V + (s) * 8192 + wid * 1024)
#define ATT_DMAK(t, s) do { ATT_GLDS16(ksrc + (size_t)(t) * 64 * A.ldk, L + LDS_K + (s) * KSLOT + wid * 1024); \
        if (k2) ATT_GLDS16(ksrc + (size_t)(t) * 64 * A.ldk + 64, L + LDS_K + (s) * KSLOT + (wid + 8) * 1024); \
        if (bw) ATT_GLDS4(bsrc + (t) * 64, L + LDS_B + (s) * 256); } while (0)
#define ATT_WB(N) asm volatile("s_waitcnt vmcnt(" #N ") lgkmcnt(0)\n\ts_barrier" ::: "memory")
#define ATT_WB3(a_, b_, c_) do { if (k2) ATT_WB(b_); else if (bw) ATT_WB(c_); else ATT_WB(a_); } while (0)
    bf16x8 qr[NS];
#pragma unroll
    for (int d0 = 0; d0 < NS; ++d0) qr[d0] = *(const bf16x8*)(Qw + (size_t)r32 * A.ldq + d0 * 16 + hi * 8);
    ATT_DMAV(t0, 0); ATT_DMAK(t0, 0); ATT_DMAV(t0 + 1, 1); ATT_DMAK(t0 + 1, 1); ATT_DMAK(t0 + 2, 2);
    if (MODE == 0 && A.gq) {
        float qf[NS][8]; float ss = 0.f;
#pragma unroll
        for (int d0 = 0; d0 < NS; ++d0) { const u32x4 w = __builtin_bit_cast(u32x4, qr[d0]);
            qf[d0][0] = bf2f(w.x & 0xffff); qf[d0][1] = bf2f(w.x >> 16); qf[d0][2] = bf2f(w.y & 0xffff); qf[d0][3] = bf2f(w.y >> 16);
            qf[d0][4] = bf2f(w.z & 0xffff); qf[d0][5] = bf2f(w.z >> 16); qf[d0][6] = bf2f(w.w & 0xffff); qf[d0][7] = bf2f(w.w >> 16);
#pragma unroll
            for (int j = 0; j < 8; ++j) ss = fmaf(qf[d0][j], qf[d0][j], ss); }
        { auto rr = __builtin_amdgcn_permlane32_swap(__float_as_uint(ss), __float_as_uint(ss), false, false); ss = __uint_as_float(rr[0]) + __uint_as_float(rr[1]); }
        const float rq = rsqrtf(ss * (1.f / 96.f) + EPS) * C2_MLA;
#pragma unroll
        for (int d0 = 0; d0 < NS; ++d0) { const f32x4 g0 = *(const f32x4*)(A.gq + d0 * 16 + hi * 8), g1 = *(const f32x4*)(A.gq + d0 * 16 + hi * 8 + 4);
#pragma unroll
            for (int j = 0; j < 4; ++j) { qf[d0][j] *= rq * g0[j]; qf[d0][4 + j] *= rq * g1[j]; } }
        { const size_t row = rowbase + q0 + wid * 32 + r32; const float* cp = A.cs + row * 16 + hi * 8; const float* sp = A.sn + row * 16 + hi * 8;
          const f32x4 c0 = *(const f32x4*)cp, c1 = *(const f32x4*)(cp + 4), s0 = *(const f32x4*)sp, s1 = *(const f32x4*)(sp + 4);
#pragma unroll
          for (int j = 0; j < 8; ++j) { const float cv = j < 4 ? c0[j & 3] : c1[j & 3], sv = j < 4 ? s0[j & 3] : s1[j & 3]; const float x1 = qf[4][j], x2 = qf[5][j];
              qf[4][j] = x1 * cv - x2 * sv; qf[5][j] = x1 * sv + x2 * cv; } }
#pragma unroll
        for (int d0 = 0; d0 < NS; ++d0) { u32x4 w; w.x = cvtpk(qf[d0][0], qf[d0][1]); w.y = cvtpk(qf[d0][2], qf[d0][3]); w.z = cvtpk(qf[d0][4], qf[d0][5]); w.w = cvtpk(qf[d0][6], qf[d0][7]); qr[d0] = __builtin_bit_cast(bf16x8, w); }
    }
    float l_reg = 0.f; f32x16 o[2], cinit;
    { const float nm = SH ? ((MODE == 1 ? A.cb[((size_t)b * 6 + h) * SEQ + q0 + wid * 32 + r32] : 0.f) - A.bsh) : 0.f;
#pragma unroll
      for (int r = 0; r < 16; ++r) { o[0][r] = 0.f; o[1][r] = 0.f; cinit[r] = nm; } }
#define ATT_PIN(x) asm volatile("" : "+v"(x))
#define ATT_SBAR() __builtin_amdgcn_sched_barrier(0)
#define ATT_MFMA(a_, b_, c_) __builtin_amdgcn_mfma_f32_32x32x16_bf16(a_, b_, c_, 0, 0, 0)
    ATT_PIN(cinit);
    LAS float* wsf = (LAS float*)(L + LDS_WS) + wid * 64;
    const int qrel = wid * 32 + r32;
    const LAS unsigned char* const kp0 = L + LDS_K + hi * 1024 + r32 * 16;
    const LAS unsigned char* const vp0 = L + LDS_V + ((lane >> 4) & 1) * 32 + (lane & 3) * 8 + (4 * hi + ((lane & 15) >> 2)) * 64;
    const LAS float* const bp0 = (const LAS float*)(L + LDS_B) + 4 * hi;
    f32x16 pA0, pA1, pB0, pB1; bf16x8 kf[2 * NS]; s16x4 vlo[8], vhi[8]; u32x4 pw0, pw1, pw2, pw3; f32x4 bq[8];
    typedef short v4i16_t __attribute__((ext_vector_type(4)));
#define ATT_KLOAD2(t_, d0_) do { const LAS unsigned char* kb_ = kp0 + (((t_) - t0) & 3) * KSLOT; kf[2 * (d0_)] = *(const LAS bf16x8*)(kb_ + (d0_) * 2048); kf[2 * (d0_) + 1] = *(const LAS bf16x8*)(kb_ + (d0_) * 2048 + 512); } while (0)
#define ATT_VTR(p_) __builtin_bit_cast(s16x4, __builtin_amdgcn_ds_read_tr16_b64_v4i16((LAS v4i16_t*)(p_)))
#define ATT_VRD(i_) do { vlo[i_] = ATT_VTR(vp_ + (((i_) >> 2) * 4096 + ((i_) & 3) * 1024)); vhi[i_] = ATT_VTR(vp_ + (((i_) >> 2) * 4096 + ((i_) & 3) * 1024 + 512)); } while (0)
#define ATT_VFR(i_) (bf16x8){vlo[i_][0], vlo[i_][1], vlo[i_][2], vlo[i_][3], vhi[i_][0], vhi[i_][1], vhi[i_][2], vhi[i_][3]}
#define ATT_PKW(P_, i_) cvtpk(P_[i_], P_[(i_) + 1])
#define ATT_PAF(k_) __builtin_bit_cast(bf16x8, pw##k_)
#define ATT_QKM(C0_, C1_, m_) do { if ((m_) & 1) C1_ = ATT_MFMA(kf[m_], qr[(m_) >> 1], ((m_) >> 1) == 0 ? cinit : C1_); else C0_ = ATT_MFMA(kf[m_], qr[(m_) >> 1], ((m_) >> 1) == 0 ? cinit : C0_); } while (0)
#define ATT_MASK(C0_, C1_, jb_) do { if (MODE == 0) { if ((jb_) > (wid >> 1)) { _Pragma("unroll") for (int r = 0; r < 16; ++r) { C0_[r] = -INFINITY; C1_[r] = -INFINITY; } } } \
        else { const int kb = 64 * (jb_) + 4 * hi; _Pragma("unroll") for (int r = 0; r < 16; ++r) { const int kv = kb + (r & 3) + 8 * (r >> 2); if (kv > qrel) C0_[r] = -INFINITY; if (kv + 32 > qrel) C1_[r] = -INFINITY; } } } while (0)
    constexpr int KA = 3;
    constexpr bool HOLD = NS <= 4;
#define ATT_PREA(m_, vi_) do { if (HOLD) { if ((vi_) >= 0) ATT_VRD((vi_) < 0 ? 0 : (vi_)); if (MODE == 1 && (m_) < 8) bq[(m_) & 7] = *(const LAS f32x4*)(bps_ + 8 * ((m_) & 7)); ATT_SBAR(); } \
        else { if (((m_) & 1) == 0 && ((m_) >> 1) + KA < NS) ATT_KLOAD2(t, ((m_) >> 1) + KA); if ((m_) >= 2 * NS - 8) ATT_VRD(((m_) - (2 * NS - 8)) & 1 ? 4 + (((m_) - (2 * NS - 8)) >> 1) : (((m_) - (2 * NS - 8)) >> 1)); ATT_SBAR(); } } while (0)
#define ATT_GAPA(C0_, C1_, m_, vi_, a0_, a1_, a2_, a3_, W0_, W1_, PW_) do { ATT_PREA(m_, vi_); \
        ATT_QKM(C0_, C1_, m_); sacc += a0_; sacc += a1_; sacc += a2_; sacc += a3_; W0_; W1_; ATT_PIN(PW_); ATT_PIN(sacc); ATT_SBAR(); } while (0)
#define ATT_GAPX(C0_, C1_, m_) do { ATT_PREA(m_, -1); ATT_QKM(C0_, C1_, m_); ATT_SBAR(); } while (0)
#define ATT_EX4(X_, i_, k_) do { if (MODE == 1) { X_[i_] = __builtin_amdgcn_exp2f(X_[i_] - bq[k_][0]); X_[(i_) + 1] = __builtin_amdgcn_exp2f(X_[(i_) + 1] - bq[k_][1]); X_[(i_) + 2] = __builtin_amdgcn_exp2f(X_[(i_) + 2] - bq[k_][2]); X_[(i_) + 3] = __builtin_amdgcn_exp2f(X_[(i_) + 3] - bq[k_][3]); } \
        else { X_[i_] = __builtin_amdgcn_exp2f(X_[i_]); X_[(i_) + 1] = __builtin_amdgcn_exp2f(X_[(i_) + 1]); X_[(i_) + 2] = __builtin_amdgcn_exp2f(X_[(i_) + 2]); X_[(i_) + 3] = __builtin_amdgcn_exp2f(X_[(i_) + 3]); } } while (0)
#define ATT_GAPB(k_, od_, pk_, vi_, kd_, vnext_, X_, i_) do { \
        if (HOLD) { if ((kd_) >= 0 && (kd_) < NS && kl_) { ATT_KLOAD2(t + 1, ((kd_) >= 0 && (kd_) < NS) ? (kd_) : 0); ATT_SBAR(); } } \
        else { if (MODE == 1 && (k_) + 2 < 8) bq[((k_) + 2) & 7] = *(const LAS f32x4*)(bps_ + 8 * (((k_) + 2) & 7)); \
               if ((k_) >= 8 - KA && kl_) ATT_KLOAD2(t + 1, ((k_) - (8 - KA)) < NS ? ((k_) - (8 - KA)) : 0); } \
        o[od_] = ATT_MFMA(ATT_PAF(pk_), ATT_VFR(vi_), o[od_]); ATT_EX4(X_, i_, k_); ATT_PIN(X_); ATT_SBAR(); } while (0)
#define ATT_STEP2(C0_, C1_, P0_, P1_, tt_, BAND_) do { const int t = (tt_); ATT_SBAR(); \
        const LAS unsigned char* vp_ = vp0 + ((t - 1 - t0) & 3) * 8192; const LAS float* bps_ = bp0 + ((t - t0) & 3) * 64; \
        float sacc = P0_[0] + P0_[1]; \
        ATT_GAPA(C0_, C1_, 0, 0, P0_[2], P0_[3], P0_[4], P0_[5],     pw0[0] = ATT_PKW(P0_, 0),  pw0[1] = ATT_PKW(P0_, 2),  pw0); \
        ATT_GAPA(C0_, C1_, 1, 4, P0_[6], P0_[7], P0_[8], P0_[9],     pw0[2] = ATT_PKW(P0_, 4),  pw0[3] = ATT_PKW(P0_, 6),  pw0); \
        ATT_GAPA(C0_, C1_, 2, 1, P0_[10], P0_[11], P0_[12], P0_[13], pw1[0] = ATT_PKW(P0_, 8),  pw1[1] = ATT_PKW(P0_, 10), pw1); \
        ATT_GAPA(C0_, C1_, 3, 5, P0_[14], P0_[15], P1_[0], P1_[1],   pw1[2] = ATT_PKW(P0_, 12), pw1[3] = ATT_PKW(P0_, 14), pw1); \
        ATT_GAPA(C0_, C1_, 4, 2, P1_[2], P1_[3], P1_[4], P1_[5],     pw2[0] = ATT_PKW(P1_, 0),  pw2[1] = ATT_PKW(P1_, 2),  pw2); \
        ATT_GAPA(C0_, C1_, 5, 6, P1_[6], P1_[7], P1_[8], P1_[9],     pw2[2] = ATT_PKW(P1_, 4),  pw2[3] = ATT_PKW(P1_, 6),  pw2); \
        ATT_GAPA(C0_, C1_, 6, 3, P1_[10], P1_[11], P1_[12], P1_[13], pw3[0] = ATT_PKW(P1_, 8),  pw3[1] = ATT_PKW(P1_, 10), pw3); \
        ATT_GAPA(C0_, C1_, 7, 7, P1_[14], P1_[15], 0.f, 0.f,         pw3[2] = ATT_PKW(P1_, 12), pw3[3] = ATT_PKW(P1_, 14), pw3); \
        if (NS > 4) { ATT_GAPX(C0_, C1_, (NS > 4 ? 8 : 0)); ATT_GAPX(C0_, C1_, (NS > 4 ? 9 : 1)); } \
        if (NS > 5) { ATT_GAPX(C0_, C1_, (NS > 5 ? 10 : 0)); ATT_GAPX(C0_, C1_, (NS > 5 ? 11 : 1)); } \
        l_reg += sacc; \
        if (BAND_) { if (t + 2 < NT) ATT_DMAV(t + 2, (t + 2 - t0) & 3); if (t + 3 < NT) ATT_DMAK(t + 3, (t + 3 - t0) & 3); } \
        else { ATT_DMAV(t + 2, (t + 2 - t0) & 3); ATT_DMAK(t + 3, (t + 3 - t0) & 3); } \
        if (BAND_) { const int jb = t - (NT - 4); if (jb >= 0) ATT_MASK(C0_, C1_, jb); } \
        const bool kl_ = !(BAND_) || (t + 1 < NT);     \
        if (!HOLD && MODE == 1) { bq[0] = *(const LAS f32x4*)(bps_); bq[1] = *(const LAS f32x4*)(bps_ + 8); } \
        ATT_SBAR(); \
        ATT_GAPB(0, 0, 0, 0, -1, 1, C0_, 0);  ATT_GAPB(1, 1, 0, 4, 0, 5, C0_, 4);  ATT_GAPB(2, 0, 1, 1, 1, 2, C0_, 8);  ATT_GAPB(3, 1, 1, 5, 2, 6, C0_, 12); \
        ATT_GAPB(4, 0, 2, 2, 3, 3, C1_, 0);   ATT_GAPB(5, 1, 2, 6, -1, 7, C1_, 4); ATT_GAPB(6, 0, 3, 3, -1, -1, C1_, 8); ATT_GAPB(7, 1, 3, 7, -1, -1, C1_, 12); \
    } while (0)
#define ATT_DRAIN(P0_, P1_) do { float sacc = P0_[0] + P0_[1]; \
        _Pragma("unroll") for (int r = 2; r < 16; ++r) sacc += P0_[r]; \
        _Pragma("unroll") for (int r = 0; r < 16; ++r) sacc += P1_[r]; \
        l_reg += sacc; \
        pw0 = (u32x4){ATT_PKW(P0_, 0), ATT_PKW(P0_, 2), ATT_PKW(P0_, 4), ATT_PKW(P0_, 6)}; pw1 = (u32x4){ATT_PKW(P0_, 8), ATT_PKW(P0_, 10), ATT_PKW(P0_, 12), ATT_PKW(P0_, 14)}; \
        pw2 = (u32x4){ATT_PKW(P1_, 0), ATT_PKW(P1_, 2), ATT_PKW(P1_, 4), ATT_PKW(P1_, 6)}; pw3 = (u32x4){ATT_PKW(P1_, 8), ATT_PKW(P1_, 10), ATT_PKW(P1_, 12), ATT_PKW(P1_, 14)}; \
        const LAS unsigned char* vp_ = vp0 + ((NT - 1 - t0) & 3) * 8192; \
        ATT_VRD(0); ATT_VRD(1); ATT_VRD(2); ATT_VRD(3); ATT_VRD(4); ATT_VRD(5); ATT_VRD(6); ATT_VRD(7); \
        o[0] = ATT_MFMA(ATT_PAF(0), ATT_VFR(0), o[0]); o[1] = ATT_MFMA(ATT_PAF(0), ATT_VFR(4), o[1]); o[0] = ATT_MFMA(ATT_PAF(1), ATT_VFR(1), o[0]); o[1] = ATT_MFMA(ATT_PAF(1), ATT_VFR(5), o[1]); \
        o[0] = ATT_MFMA(ATT_PAF(2), ATT_VFR(2), o[0]); o[1] = ATT_MFMA(ATT_PAF(2), ATT_VFR(6), o[1]); o[0] = ATT_MFMA(ATT_PAF(3), ATT_VFR(3), o[0]); o[1] = ATT_MFMA(ATT_PAF(3), ATT_VFR(7), o[1]); } while (0)
    ATT_WB3(3, 5, 5);
    { _Pragma("unroll") for (int d0 = 0; d0 < NS; ++d0) ATT_KLOAD2(t0, d0);
      _Pragma("unroll") for (int m = 0; m < 2 * NS; ++m) { if (m & 1) pA1 = ATT_MFMA(kf[m], qr[m >> 1], (m >> 1) == 0 ? cinit : pA1); else pA0 = ATT_MFMA(kf[m], qr[m >> 1], (m >> 1) == 0 ? cinit : pA0); }
      if (NT - 4 == t0) ATT_MASK(pA0, pA1, 0);
      if (MODE == 1) {
#pragma unroll
          for (int g = 0; g < 4; ++g) { const f32x4 b0 = *(const LAS f32x4*)(bp0 + 8 * g), b1 = *(const LAS f32x4*)(bp0 + 32 + 8 * g);
#pragma unroll
              for (int j = 0; j < 4; ++j) { pA0[4 * g + j] -= b0[j]; pA1[4 * g + j] -= b1[j]; } } }
#pragma unroll
      for (int r = 0; r < 16; ++r) { pA0[r] = __builtin_amdgcn_exp2f(pA0[r]); pA1[r] = __builtin_amdgcn_exp2f(pA1[r]); } }
    ATT_WB(0);
    ATT_DMAV(t0 + 2, 2); ATT_DMAK(t0 + 3, 3);
    { _Pragma("unroll") for (int d0 = 0; d0 < (HOLD ? NS : KA); ++d0) ATT_KLOAD2(t0 + 1, d0); }
    int tc = t0 + 1;
    for (; tc + 5 < NT; tc += 2) {
        ATT_STEP2(pB0, pB1, pA0, pA1, tc, 0);     ATT_WB3(2, 3, 4);
        ATT_STEP2(pA0, pA1, pB0, pB1, tc + 1, 0); ATT_WB3(2, 3, 4);
    }
    for (; tc + 1 < NT; tc += 2) {
        ATT_STEP2(pB0, pB1, pA0, pA1, tc, 1);     ATT_WB(0);
        ATT_STEP2(pA0, pA1, pB0, pB1, tc + 1, 1); ATT_WB(0);
    }
    if (tc < NT) { ATT_STEP2(pB0, pB1, pA0, pA1, tc, 1); ATT_WB(0); ATT_DRAIN(pB0, pB1); }
    else { ATT_DRAIN(pA0, pA1); }
    unsigned nxu = 0u;
    if (tid == 0) nxu = __hip_atomic_fetch_add((GAS_ unsigned*)A.ctr, 1u, __ATOMIC_RELAXED, __HIP_MEMORY_SCOPE_AGENT);
    { auto rr = __builtin_amdgcn_permlane32_swap(__float_as_uint(l_reg), __float_as_uint(l_reg), false, false); l_reg = __uint_as_float(rr[0]) + __uint_as_float(rr[1]); }
    if (hi == 0) wsf[32 + r32] = l_reg;
    asm volatile("s_waitcnt lgkmcnt(0)" ::: "memory");
    float rli[16];
#pragma unroll
    for (int r = 0; r < 16; ++r) rli[r] = __builtin_amdgcn_rcpf(wsf[32 + crow(r, hi)]);
    bf16_t* Ow = A.O + (rowbase + q0 + wid * 32) * A.ldo + h * 64;
    { LAS bf16_t* stg = (LAS bf16_t*)(L + LDS_OST) + wid * 2048;
#pragma unroll
      for (int r = 0; r < 16; ++r) { const int orow = crow(r, hi);
#pragma unroll
          for (int d0 = 0; d0 < 2; ++d0) stg[orow * 64 + d0 * 32 + r32] = f2bf(o[d0][r] * rli[r]); }
      asm volatile("s_waitcnt lgkmcnt(0)" ::: "memory");
#pragma unroll
      for (int i = 0; i < 4; ++i) { const int row = i * 8 + (lane >> 3), ch = lane & 7; const u32x4 v = *(const LAS u32x4*)(stg + row * 64 + ch * 8); *(u32x4*)(Ow + (size_t)row * A.ldo + ch * 8) = v;
          const unsigned vw[4] = {v.x, v.y, v.z, v.w}; float ss = 0.f;
#pragma unroll
          for (int q = 0; q < 4; ++q) { const float lo = bf2f(vw[q] & 0xffff), hi_ = bf2f(vw[q] >> 16); ss += lo * lo + hi_ * hi_; }
          ss += shx(ss, 1, lane); ss += shx(ss, 2, lane); ss += shx(ss, 4, lane);
          if (ch == 0) A.ssq[(rowbase + q0 + wid * 32 + row) * 16 + h] = ss; } }
    if (tid == 0) *(LAS unsigned*)(L + LDS_U) = nxu;
    asm volatile("s_waitcnt vmcnt(0) lgkmcnt(0)" ::: "memory");
    __builtin_amdgcn_s_barrier();
#undef ATT_DMAV
#undef ATT_DMAK
#undef ATT_STEP2
}
struct NoSide { __device__ __forceinline__ void step() {} };
template <int NS, int MODE, int SH, class Side>
__device__ __forceinline__ void phase(const Args& A, unsigned char* lds, const int tid, Side& side) {
    LAS unsigned* uw = (LAS unsigned*)((LAS unsigned char*)lds + LDS_U);
    if (tid == 0) *uw = __hip_atomic_fetch_add(A.ctr, 1u, __ATOMIC_RELAXED, __HIP_MEMORY_SCOPE_AGENT);
    __syncthreads();
    for (;;) {
        const int u = __builtin_amdgcn_readfirstlane((int)*uw);
        __syncthreads();
        if (u >= NB * 6 * 16) break;
        const int qb = 15 - u / 48, bh = u % 48;
        unit<NS, MODE, SH>(bh / 6, bh % 6, qb, A, lds, tid);
        side.step();
    }
}
#undef ATT_WAITV
#undef ATT_GLDS16
#undef ATT_GLDS4
}

__device__ __forceinline__ void ph_attn_mla(unsigned char* lds, Params P, int layer) {
    const int TIDX = hidden_tid(P.wid); P.ws = launder_ptr(P.ws);
    const int lane = TIDX & 63, lr = (layer >= 4) ? layer - 4 : layer;
    const float gqm = wmax(fmaxf(fabsf(P.mla_gq[lr * 96 + lane]), fabsf(P.mla_gq[lr * 96 + 64 + (lane & 31)])), lane), gkm = wmax(fmaxf(fabsf(P.mla_gk[lr * 96 + lane]), fabsf(P.mla_gk[lr * 96 + 64 + (lane & 31)])), lane);
    const float bm = __uint_as_float(__builtin_amdgcn_readfirstlane(__float_as_uint(96.f * C2_MLA * gqm * gkm * 1.02f)));
    att::Args A{(const bf16_t*)(P.ws + WS_QRAW), 768, (const bf16_t*)(P.ws + WS_KMLA), 576, (const bf16_t*)(P.ws + WS_KVRAW) + 64, 768, 128, (bf16_t*)(P.ws + WS_HBUF) + 256, D, (float*)(P.ws + WS_SSQ2) + 4, nullptr,
                 (unsigned*)(P.ws + WS_CTL) + CW_ATTN + layer * 2, 0.f, P.mla_gq + lr * 96, (const float*)(P.ws + WS_COS), (const float*)(P.ws + WS_SIN), bm};
    att::NoSide ns;
    if (__all(bm <= 60.f)) att::phase<6, 0, 0>(A, lds, TIDX, ns);
    else att::phase<6, 0, 1>(A, lds, TIDX, ns);
}
__device__ __forceinline__ void ph_attn_fox(unsigned char* lds, Params P, int layer) {
    const int TIDX = hidden_tid(P.wid); P.ws = launder_ptr(P.ws);
    const int lane = TIDX & 63, lr = (layer >= 4) ? layer - 4 : layer;
    const float gqm = wmax(fabsf(P.fox_gq[lr * 64 + lane]), lane), gkm = wmax(fabsf(P.fox_gk[lr * 64 + lane]), lane);
    const float bf_ = __uint_as_float(__builtin_amdgcn_readfirstlane(__float_as_uint(64.f * C2_FOX * gqm * gkm * 1.02f))), th = 2.f * bf_ + 40.f;
    att::Args A{(const bf16_t*)(P.ws + WS_PROJ) + PC_FQ, PJ, (const bf16_t*)(P.ws + WS_PROJ) + PC_FK, PJ, (const bf16_t*)(P.ws + WS_PROJ) + PC_FV, PJ, 64, (bf16_t*)(P.ws + WS_HBUF) + 640, D, (float*)(P.ws + WS_SSQ2) + 10, (const float*)(P.ws + WS_CB2),
                 (unsigned*)(P.ws + WS_CTL) + CW_ATTN + layer * 2 + 1, th, nullptr, nullptr, nullptr, bf_};
    att::NoSide ns; att::phase<4, 1, 1>(A, lds, TIDX, ns);
}
__device__ __forceinline__ void ph_attn_all(unsigned char* lds, Params P, int layer) { ph_attn_mla(lds, P, layer); ph_attn_fox(lds, P, layer); }


__device__ __forceinline__ void ssm_tables1(const Params& P, int layer, unsigned char* lds, int tid, int bid, int gdim) {
    float* lamp = (float*)lds;
    float* bbar = lamp + 64 * 33 * 2;
    float* cc = bbar + 64 * 16 * 2;
    float* qq = cc + 16 * 64 * 2;
    float* KM = (float*)(P.ws + WS_KM + (size_t)(layer & 1) * (512u << 10)); float* LAMP = (float*)(P.ws + WS_LAMP + (size_t)(layer & 1) * (512u << 10)); float* BBAR = (float*)(P.ws + WS_BBAR + (size_t)(layer & 1) * (512u << 10));
    for (int item = bid; item < 128; item += gdim) {
        const int g = item >> 3, dq = item & 7;
        __syncthreads();
        const float dt = expf(P.log_dt[layer * 16 + g]);
        for (int e = tid; e < 64 * 33; e += 512) { const int p = e / 33, d = e % 33; const size_t gp = ((size_t)layer * 16 + g) * 64 + p;
            const float a_ = P.lam_re[gp] * dt, b_ = P.lam_im[gp] * dt; float s_, c_; sincosf((float)d * b_, &s_, &c_); const float e_ = expf((float)d * a_);
            lamp[e * 2] = e_ * c_; lamp[e * 2 + 1] = e_ * s_;
            if (dq == 0) { LAMP[((size_t)g * 64 * 33 + e) * 2] = e_ * c_; LAMP[((size_t)g * 64 * 33 + e) * 2 + 1] = e_ * s_; } }
        if (tid < 64) { const int p = tid; const size_t gp = ((size_t)layer * 16 + g) * 64 + p;
            const float lre = P.lam_re[gp], lim = P.lam_im[gp], a_ = lre * dt, b_ = lim * dt; float sb_, cb_; sincosf(b_, &sb_, &cb_); const float sh_ = sinf(0.5f * b_);
            const float nr = expm1f(a_) * cb_ - 2.f * sh_ * sh_, ni = expf(a_) * sb_;
            const float dd = lre * lre + lim * lim; qq[p * 2] = (nr * lre + ni * lim) / dd; qq[p * 2 + 1] = (ni * lre - nr * lim) / dd; }
        for (int e = tid; e < 1024; e += 512) { const int c = e >> 6, p = e & 63; const size_t ix = (((size_t)layer * 16 + g) * 16 + c) * 64 + p; cc[e * 2] = P.c_re[ix]; cc[e * 2 + 1] = P.c_im[ix]; }
        __syncthreads();
        for (int e = tid; e < 1024; e += 512) { const int p = e >> 4, c = e & 15; const size_t ix = (((size_t)layer * 16 + g) * 64 + p) * 16 + c;
            const float bre = P.b_re[ix], bim = P.b_im[ix], qr = qq[p * 2], qi = qq[p * 2 + 1];
            const float br = qr * bre - qi * bim, bi = qr * bim + qi * bre; bbar[e * 2] = br; bbar[e * 2 + 1] = bi;
            if (dq == 0) { BBAR[((size_t)g * 1024 + e) * 2] = br; BBAR[((size_t)g * 1024 + e) * 2 + 1] = bi; } }
        __syncthreads();
        for (int e = tid; e < 4 * 256; e += 512) { const int d = dq * 4 + (e >> 8), c = (e >> 4) & 15, c2 = e & 15; float acc = 0.f;
            for (int p = 0; p < 64; ++p) { const float cr = cc[(c * 64 + p) * 2], ci = cc[(c * 64 + p) * 2 + 1], lr = lamp[(p * 33 + d) * 2], li = lamp[(p * 33 + d) * 2 + 1];
                const float clr = cr * lr - ci * li, cli = cr * li + ci * lr; acc += clr * bbar[(p * 16 + c2) * 2] - cli * bbar[(p * 16 + c2) * 2 + 1]; }
            KM[(size_t)g * 8192 + d * 256 + (e & 255)] = acc; }
    }
    __syncthreads();
}
__device__ __forceinline__ void ssm_tables2(const Params& P, int layer, int tid, int bid, int gdim) {
    const float* KM = (const float*)(P.ws + WS_KM + (size_t)(layer & 1) * (512u << 10)); const float* LAMP = (const float*)(P.ws + WS_LAMP + (size_t)(layer & 1) * (512u << 10)); const float* BBAR = (const float*)(P.ws + WS_BBAR + (size_t)(layer & 1) * (512u << 10));
    bf16_t* B1t = (bf16_t*)(P.ws + W_B1T); bf16_t* T2t = (bf16_t*)(P.ws + W_T2T);
    const int gt = bid * 512 + tid, nt = gdim * 512;
    for (int v0 = gt; v0 < 16 * 256 * 64; v0 += 2 * nt) {
        f32x4 bb[2][4]; float lr[2], li[2];
#pragma unroll
        for (int u = 0; u < 2; ++u) { const int v = v0 + u * nt, k0 = (v & 63) * 8, n = (v >> 6) & 255, g = v >> 14;
            if (v < 16 * 256 * 64 && n < 128) { const int p = n >> 1, i = k0 >> 4, c0 = k0 & 15;
                const float* lp = LAMP + (((size_t)g * 64 + p) * 33 + (31 - i)) * 2; lr[u] = lp[0]; li[u] = lp[1];
                const float* bp = BBAR + (((size_t)g * 64 + p) * 16 + c0) * 2;
#pragma unroll
                for (int q = 0; q < 4; ++q) bb[u][q] = *(const f32x4*)(bp + 4 * q); } }
#pragma unroll
        for (int u = 0; u < 2; ++u) { const int v = v0 + u * nt, k0 = (v & 63) * 8, n = (v >> 6) & 255, g = v >> 14;
            if (v < 16 * 256 * 64) { u32x4 o = {0u, 0u, 0u, 0u};
                if (n < 128) { const int ri = n & 1; float w[8];
#pragma unroll
                    for (int q = 0; q < 4; ++q) { const f32x4 t = bb[u][q]; w[2 * q] = ri == 0 ? (lr[u] * t[0] - li[u] * t[1]) : (lr[u] * t[1] + li[u] * t[0]); w[2 * q + 1] = ri == 0 ? (lr[u] * t[2] - li[u] * t[3]) : (lr[u] * t[3] + li[u] * t[2]); }
                    o.x = pk2(w[0], w[1]); o.y = pk2(w[2], w[3]); o.z = pk2(w[4], w[5]); o.w = pk2(w[6], w[7]); }
                *(u32x4*)(B1t + ((size_t)(g * 256 + n)) * 512 + k0) = o; } }
    }
    for (int v0 = gt; v0 < 16 * 512 * 64; v0 += 4 * nt) {
        f32x4 ka[4], kb[4];
#pragma unroll
        for (int u = 0; u < 4; ++u) { const int v = v0 + u * nt, k0 = (v & 63) * 8, n = (v >> 6) & 511, g = v >> 15, j = n >> 4, c = n & 15, i = k0 >> 4, c0 = k0 & 15;
            ka[u] = (f32x4){0.f, 0.f, 0.f, 0.f}; kb[u] = ka[u];
            if (v < 16 * 512 * 64 && j >= i) { const float* kp = KM + (size_t)g * 8192 + (j - i) * 256 + c * 16 + c0; ka[u] = *(const f32x4*)kp; kb[u] = *(const f32x4*)(kp + 4); } }
#pragma unroll
        for (int u = 0; u < 4; ++u) { const int v = v0 + u * nt, k0 = (v & 63) * 8, n = (v >> 6) & 511, g = v >> 15;
            if (v < 16 * 512 * 64) { u32x4 o; o.x = pk2(ka[u][0], ka[u][1]); o.y = pk2(ka[u][2], ka[u][3]); o.z = pk2(kb[u][0], kb[u][1]); o.w = pk2(kb[u][2], kb[u][3]);
                *(u32x4*)(T2t + ((size_t)(g * 512 + n)) * 640 + k0) = o; } }
    }
    for (int v = gt; v < 16 * 512 * 16; v += nt) {
        const int p0 = (v & 15) * 4, n = (v >> 4) & 511, g = v >> 13, j = n >> 4, c = n & 15;
        const size_t ix = (((size_t)layer * 16 + g) * 16 + c) * 64 + p0; const f32x4 cr = *(const f32x4*)(P.c_re + ix), ci = *(const f32x4*)(P.c_im + ix);
        float lr[4], li[4];
#pragma unroll
        for (int q = 0; q < 4; ++q) { const float* lp = LAMP + (((size_t)g * 64 + p0 + q) * 33 + (j + 1)) * 2; lr[q] = lp[0]; li[q] = lp[1]; }
        float w[8];
#pragma unroll
        for (int q = 0; q < 4; ++q) { w[2 * q] = cr[q] * lr[q] - ci[q] * li[q]; w[2 * q + 1] = -(cr[q] * li[q] + ci[q] * lr[q]); }
        u32x4 o; o.x = pk2(w[0], w[1]); o.y = pk2(w[2], w[3]); o.z = pk2(w[4], w[5]); o.w = pk2(w[6], w[7]);
        *(u32x4*)(T2t + ((size_t)(g * 512 + n)) * 640 + 512 + 2 * p0) = o;
    }
}
__device__ __forceinline__ void ssm_carry(const Params& P, int layer, int item, int lane) {
    const int b = item >> 4, g = item & 15;
    const float* LAMP = (const float*)(P.ws + WS_LAMP + (size_t)(layer & 1) * (512u << 10)); const float* lp = LAMP + (((size_t)g * 64 + lane) * 33 + 32) * 2; const float lr = lp[0], li = lp[1];
    const float* sl = (const float*)(P.ws + WS_SLOC) + ((size_t)g * 1024 + b * 128) * 128 + lane * 2;
    bf16_t* ug = (bf16_t*)(P.ws + WS_UG) + ((size_t)g * 1024 + b * 128) * 640 + 512 + lane * 2;
    float sr = 0.f, si = 0.f;
    for (int n0 = 0; n0 < 128; n0 += 16) {
        float xr[16], xi[16];
#pragma unroll
        for (int k = 0; k < 16; ++k) { const float* q = sl + (size_t)(n0 + k) * 128; xr[k] = q[0]; xi[k] = q[1]; }
#pragma unroll
        for (int k = 0; k < 16; ++k) { *(unsigned*)(ug + (size_t)(n0 + k) * 640) = pk2(sr, si);
            const float nr = lr * sr - li * si + xr[k], ni = lr * si + li * sr + xi[k]; sr = nr; si = ni; }
    }
}
struct EpiSloc {
    static constexpr bool PERM = true, AFTER_DRAIN = false;
    float* S;
    __device__ __forceinline__ void operator()(const f32x4 (&acc)[2][2][4][2], const Unit& u, int wr, int wc, int fr, int fq) const {
        const int row0 = u.pm * 256 + wr * 64 + fr, col0 = wc * 32 + 8 * fq;
#pragma unroll
        for (int ai = 0; ai < 2; ++ai)
#pragma unroll
            for (int m = 0; m < 4; ++m) { float* rp = S + (size_t)(row0 + ai * 128 + m * 16) * 128 + col0; *(f32x4*)rp = acc[ai][0][m][0]; *(f32x4*)(rp + 4) = acc[ai][0][m][1]; }
    }
};
struct EpiSsmY {
    static constexpr bool PERM = true, AFTER_DRAIN = false;
    const bf16_t* proj; bf16_t* yg; const float* dsk;
    __device__ __forceinline__ void operator()(const f32x4 (&acc)[2][2][4][2], const Unit& u, int wr, int wc, int fr, int fq) const {
        const int ct = u.pn & 1, g = u.pm >> 2;
        f32x4 dv[2][2]; int jj[2], cc[2]; const float* dsk = launder_ptr(this->dsk);
#pragma unroll
        for (int bj = 0; bj < 2; ++bj) { const int nc = 256 * ct + 128 * bj + 32 * wc + 8 * fq; jj[bj] = nc >> 4; cc[bj] = nc & 15; dv[bj][0] = *(const f32x4*)(dsk + g * 16 + cc[bj]); dv[bj][1] = *(const f32x4*)(dsk + g * 16 + cc[bj] + 4); }
#pragma unroll
        for (int ai = 0; ai < 2; ++ai) {
            u32x4 uv[4][2];
#pragma unroll
            for (int m = 0; m < 4; ++m) { const int R = u.pm * 256 + ai * 128 + wr * 64 + m * 16 + fr, rl = R & 1023, b = rl >> 7, ch = rl & 127;
#pragma unroll
                for (int bj = 0; bj < 2; ++bj) uv[m][bj] = *(const GAS_ u32x4*)(proj + ((size_t)b * SEQ + ch * 32 + jj[bj]) * PJ + g * 16 + cc[bj]); }
#pragma unroll
            for (int m = 0; m < 4; ++m) { const int R = u.pm * 256 + ai * 128 + wr * 64 + m * 16 + fr, rl = R & 1023, b = rl >> 7, ch = rl & 127;
#pragma unroll
                for (int bj = 0; bj < 2; ++bj) { const size_t tok = (size_t)b * SEQ + ch * 32 + jj[bj];
                    const unsigned uw[4] = {uv[m][bj].x, uv[m][bj].y, uv[m][bj].z, uv[m][bj].w}; f32x4 o0, o1;
#pragma unroll
                    for (int q = 0; q < 4; ++q) { const float ua = q & 1 ? bf2f(uw[q >> 1] >> 16) : bf2f(uw[q >> 1] & 0xffff), ub = q & 1 ? bf2f(uw[2 + (q >> 1)] >> 16) : bf2f(uw[2 + (q >> 1)] & 0xffff);
                        o0[q] = gelu_tanh(acc[ai][bj][m][0][q] + dv[bj][0][q] * ua); o1[q] = gelu_tanh(acc[ai][bj][m][1][q] + dv[bj][1][q] * ub); }
                    *(GAS_ u32x4*)((GAS_ bf16_t*)yg + tok * 256 + g * 16 + cc[bj]) = pg8::pack8(o0, o1); } } }
    }
};
struct SsmDec1 { __device__ __forceinline__ void operator()(int L, Unit& u) const { u.pm = L; u.pn = L >> 2; } };
struct SsmDec2 { __device__ __forceinline__ void operator()(int L, Unit& u) const { u.pm = L >> 1; u.pn = ((L >> 3) << 1) | (L & 1); } };
__device__ __forceinline__ void ph_ssm_tab1(unsigned char* lds, Params P, int layer, int rot = 0) {
    const int TIDX = hidden_tid(P.wid), BIDX = launder_i((int)blockIdx.x), GDIM = launder_i((int)gridDim.x); P.ws = launder_ptr(P.ws);
    ssm_tables1(P, layer, lds, TIDX, GDIM >= 256 ? (BIDX + GDIM - rot) % GDIM : BIDX, GDIM);
}
__device__ __forceinline__ void ph_ssm_tab2(unsigned char* lds, Params P, int layer) {
    const int TIDX = hidden_tid(P.wid), BIDX = launder_i((int)blockIdx.x), GDIM = launder_i((int)gridDim.x); P.ws = launder_ptr(P.ws);
    ssm_tables2(P, layer, TIDX, BIDX, GDIM);
}
__device__ __forceinline__ void ph_ssm_gemm1(unsigned char* lds, Params P, int layer) {
    const int TIDX = hidden_tid(P.wid), BIDX = launder_i((int)blockIdx.x), GDIM = launder_i((int)gridDim.x); P.ws = launder_ptr(P.ws); (void)TIDX;
    pg8::Gemm g{(const bf16_t*)(P.ws + WS_UG), (const bf16_t*)(P.ws + W_B1T), 640, 512, 512, P.wid};
    pg8::ListOrder<SsmDec1> S{64, GDIM, GDIM >= 128 ? (BIDX + GDIM - 64) % GDIM : BIDX, SsmDec1{}};
    EpiSloc E{(float*)(P.ws + WS_SLOC)};
    pg8::gemm_phase<EpiSloc, pg8::ListOrder<SsmDec1>, true, true>(GEMM_LDS, g, S, E);
}
__device__ __forceinline__ void ph_ssm_carry(unsigned char* lds, Params P, int layer) {
    const int TIDX = hidden_tid(P.wid), BIDX = launder_i((int)blockIdx.x), GDIM = launder_i((int)gridDim.x); P.ws = launder_ptr(P.ws);
    if ((TIDX >> 6) == 0) for (int item = BIDX; item < 128; item += GDIM) ssm_carry(P, layer, item, TIDX & 63);
    __syncthreads();
}
struct SsmOrder2 {
    static constexpr bool GATHER = false;
    int c;
    __device__ __forceinline__ bool next(int i, Unit& u) const { if (c >= 64 || i >= 2) return false; u.pm = c; u.pn = ((c >> 2) << 1) | i; return true; }
    __device__ __forceinline__ void a_ready(const Unit&) const {}
    __device__ __forceinline__ void done(const Unit&) const {}
};
__device__ __forceinline__ void ph_ssm_gemm2(unsigned char* lds, Params P, int layer) {
    const int TIDX = hidden_tid(P.wid), BIDX = launder_i((int)blockIdx.x), GDIM = launder_i((int)gridDim.x); P.ws = launder_ptr(P.ws);
    {
        pg8::Gemm g1{(const bf16_t*)(P.ws + WS_UG), (const bf16_t*)(P.ws + W_B1T), 640, 512, 512, P.wid};
        pg8::ListOrder<SsmDec1> S1{64, GDIM, BIDX, SsmDec1{}};
        EpiSloc E1{(float*)(P.ws + WS_SLOC)};
        pg8::gemm_phase<EpiSloc, pg8::ListOrder<SsmDec1>, true, true>(GEMM_LDS, g1, S1, E1);
        asm volatile("s_waitcnt vmcnt(0)" ::: "memory");
        __syncthreads();
    }
    if (BIDX < 64) { const int wv = TIDX >> 6; if (wv < 2) ssm_carry(P, layer, (2 * (BIDX & 3) + wv) * 16 + (BIDX >> 2), TIDX & 63); }
    asm volatile("s_waitcnt vmcnt(0)" ::: "memory");
    __syncthreads();
    pg8::Gemm g{(const bf16_t*)(P.ws + WS_UG), (const bf16_t*)(P.ws + W_T2T), 640, 640, 640, P.wid};
    SsmOrder2 S{BIDX};
    EpiSsmY E{(const bf16_t*)(P.ws + WS_PROJ), (bf16_t*)(P.ws + WS_YG), P.ssm_d + layer * 256};
    pg8::gemm_phase<EpiSsmY, SsmOrder2, true, true>(GEMM_LDS, g, S, E);
}

__device__ __forceinline__ void unpack8(const u32x4 w, float (&f)[8]) {
    f[0] = bf2f(w.x & 0xffff); f[1] = bf2f(w.x >> 16); f[2] = bf2f(w.y & 0xffff); f[3] = bf2f(w.y >> 16);
    f[4] = bf2f(w.z & 0xffff); f[5] = bf2f(w.z >> 16); f[6] = bf2f(w.w & 0xffff); f[7] = bf2f(w.w >> 16); }
__device__ __forceinline__ u32x4 pack8f(const float (&f)[8]) { u32x4 o; o.x = pg8::cvt_pk_bf16(f[0], f[1]); o.y = pg8::cvt_pk_bf16(f[2], f[3]); o.z = pg8::cvt_pk_bf16(f[4], f[5]); o.w = pg8::cvt_pk_bf16(f[6], f[7]); return o; }
__device__ __forceinline__ float ssq8(const float (&f)[8]) { float s = 0.f;
#pragma unroll
    for (int j = 0; j < 8; ++j) s = fmaf(f[j], f[j], s);
    return s; }
__device__ __forceinline__ unsigned shxu(unsigned v, int o, int lane) { return (unsigned)__builtin_amdgcn_ds_bpermute((lane ^ o) << 2, (int)v); }

__device__ __forceinline__ void ph_passC2(unsigned char* lds, Params P, int layer) {
    const int TIDX = hidden_tid(P.wid), BIDX = launder_i((int)blockIdx.x), GDIM = launder_i((int)gridDim.x); P.ws = launder_ptr(P.ws);
    float (*lfs)[8] = (float (*)[8])lds;
    const int wid = TIDX >> 6, lane = TIDX & 63;
    bf16_t* proj = (bf16_t*)(P.ws + WS_PROJ); const float* fg = (const float*)(P.ws + WS_FG);
    float* rq = (float*)(P.ws + WS_RSTDQ); float* rkv = (float*)(P.ws + WS_RSTDKV);
    float* cloc = (float*)(P.ws + WS_CLOC); float* ctot = (float*)(P.ws + WS_CTOT); bf16_t* ug = (bf16_t*)(P.ws + WS_UG);
    float gq8[8], gk8[8];
#pragma unroll
    for (int j = 0; j < 8; ++j) { gq8[j] = P.fox_gq[layer * 64 + (lane & 7) * 8 + j] * C2_FOX; gk8[j] = P.fox_gk[layer * 64 + (lane & 7) * 8 + j]; }
    const int off1 = lane < 32 ? PC_CQ + lane * 8 : PC_CKV + (lane - 32) * 8;
    const int lf = lane < 48 ? lane : 0;
    for (int chunk = BIDX; chunk < T / 128; chunk += GDIM) {
        for (int i = 0; i < 16; i += 2) {
            u32x4 w1[2], wu[2], wq[2], wk[2];
#pragma unroll
            for (int k = 0; k < 2; ++k) { const bf16_t* pr = proj + (size_t)(chunk * 128 + wid * 16 + i + k) * PJ;
                w1[k] = *(const u32x4*)(pr + off1); wu[k] = *(const u32x4*)(pr + PC_U + (lane & 31) * 8);
                wq[k] = *(const u32x4*)(pr + PC_FQ + lf * 8); wk[k] = *(const u32x4*)(pr + PC_FK + lf * 8); }
#pragma unroll
            for (int k = 0; k < 2; ++k) {
                const int tl = wid * 16 + i + k, row = chunk * 128 + tl; bf16_t* pr = proj + (size_t)row * PJ;
                float v[8]; unpack8(w1[k], v); float s1 = lane < 48 ? ssq8(v) : 0.f;
                s1 += shx(s1, 1, lane); s1 += shx(s1, 2, lane); s1 += shx(s1, 4, lane); s1 += shx(s1, 8, lane);
                const float s1b = s1 + shx(s1, 16, lane);
                if (lane == 0) rq[row] = rsqrtf(s1b * (1.f / 256.f) + EPS);
                if (lane == 32) rkv[row] = rsqrtf(s1 * (1.f / 128.f) + EPS);
                if (lane < 32) { const int b_ = row / SEQ, t_ = row % SEQ;
                    *(u32x4*)(ug + (size_t)((lane >> 1) * 1024 + b_ * 128 + (t_ >> 5)) * 640 + (t_ & 31) * 16 + (lane & 1) * 8) = wu[k]; }
                float a[8], b[8]; unpack8(wq[k], a); unpack8(wk[k], b);
                float sa = ssq8(a), sb = ssq8(b);
                sa += shx(sa, 1, lane); sb += shx(sb, 1, lane); sa += shx(sa, 2, lane); sb += shx(sb, 2, lane); sa += shx(sa, 4, lane); sb += shx(sb, 4, lane);
                const float ra = rsqrtf(sa * (1.f / 64.f) + EPS), rb = rsqrtf(sb * (1.f / 64.f) + EPS);
#pragma unroll
                for (int j = 0; j < 8; ++j) { a[j] *= ra * gq8[j]; b[j] *= rb * gk8[j]; }
                if (lane < 48) { *(u32x4*)(pr + PC_FQ + lane * 8) = pack8f(a); *(u32x4*)(pr + PC_FK + lane * 8) = pack8f(b); }
                if (lane < 6) { const float z = fg[(size_t)row * 8 + lane] + P.fox_bf[layer * 6 + lane];
                    const float e = __expf(-fabsf(z)); lfs[tl][lane] = fminf(z, 0.f) - __logf(1.f + e); }
            }
        }
        __syncthreads();
        if (TIDX < 6) {
            const int h = TIDX, b = (chunk * 128) / SEQ, t0 = (chunk * 128) % SEQ; float run = 0.f;
            for (int j = 0; j < 128; ++j) { run += lfs[j][h]; cloc[((size_t)b * 6 + h) * SEQ + t0 + j] = run; }
            ctot[chunk * 8 + h] = run;
        }
        __syncthreads();
    }
}

__device__ __forceinline__ void ph_passE2(unsigned char* lds, Params P, int layer) {
    const int TIDX = hidden_tid(P.wid), BIDX = launder_i((int)blockIdx.x), GDIM = launder_i((int)gridDim.x); P.ws = launder_ptr(P.ws);
    const int wid = TIDX >> 6, lane = TIDX & 63, grp = lane >> 4, c = lane & 15; const bool act = c < 12, rop = act && c >= 8;
    const bf16_t* proj = (const bf16_t*)(P.ws + WS_PROJ); const bf16_t* qraw = (const bf16_t*)(P.ws + WS_QRAW); const bf16_t* kvraw = (const bf16_t*)(P.ws + WS_KVRAW);
    bf16_t* qm = (bf16_t*)(P.ws + WS_QMLA); bf16_t* km = (bf16_t*)(P.ws + WS_KMLA);
    const float* cs = (const float*)(P.ws + WS_COS); const float* sn = (const float*)(P.ws + WS_SIN);
    const int cc = act ? c : 0, cp = cc ^ 2;
    float gq8[8], gk8[8], gqp[8], gkp[8];
#pragma unroll
    for (int j = 0; j < 8; ++j) { gq8[j] = P.mla_gq[layer * 96 + cc * 8 + j] * C2_MLA; gk8[j] = P.mla_gk[layer * 96 + cc * 8 + j];
        gqp[j] = rop ? P.mla_gq[layer * 96 + cp * 8 + j] * C2_MLA : 0.f; gkp[j] = rop ? P.mla_gk[layer * 96 + cp * 8 + j] : 0.f; }
    const int hC = 4 + (grp & 1); const bool kC = grp >= 2;
    const int qoffA = grp * 96 + cc * 8, qoffC = hC * 96 + cc * 8;
    const int koffA = cc < 8 ? grp * 128 + cc * 8 : -1, koffC = cc < 8 ? hC * 128 + cc * 8 : -1;
    const int kroff = PC_KR + (cc & 3) * 8, j0 = (cc & 1) * 8;
    for (int chunk = BIDX; chunk < T / 128; chunk += GDIM) {
        for (int i = 0; i < 16; ++i) {
            const size_t row = (size_t)chunk * 128 + wid * 16 + i;
            u32x4 w[3];
            w[0] = *(const u32x4*)(qraw + row * 768 + qoffA);
            w[1] = koffA >= 0 ? *(const u32x4*)(kvraw + row * 768 + koffA) : *(const u32x4*)(proj + row * PJ + kroff);
            w[2] = !kC ? *(const u32x4*)(qraw + row * 768 + qoffC) : (koffC >= 0 ? *(const u32x4*)(kvraw + row * 768 + koffC) : *(const u32x4*)(proj + row * PJ + kroff));
            f32x4 c0 = {0.f, 0.f, 0.f, 0.f}, c1 = c0, s0 = c0, s1 = c0;
            if (rop) { c0 = *(const f32x4*)(cs + row * 16 + j0); c1 = *(const f32x4*)(cs + row * 16 + j0 + 4); s0 = *(const f32x4*)(sn + row * 16 + j0); s1 = *(const f32x4*)(sn + row * 16 + j0 + 4); }
            const float cv[8] = {c0[0], c0[1], c0[2], c0[3], c1[0], c1[1], c1[2], c1[3]}, sv[8] = {s0[0], s0[1], s0[2], s0[3], s1[0], s1[1], s1[2], s1[3]};
#pragma unroll
            for (int ps = 0; ps < 3; ++ps) {
                const bool isk = (ps == 1) || (ps == 2 && kC);
                float v[8]; unpack8(w[ps], v);
                float ss = act ? ssq8(v) : 0.f;
                ss += shx(ss, 1, lane); ss += shx(ss, 2, lane); ss += shx(ss, 4, lane); ss += shx(ss, 8, lane);
                const float r = rsqrtf(ss * (1.f / 96.f) + EPS);
                u32x4 pw; pw.x = shxu(w[ps].x, 2, lane); pw.y = shxu(w[ps].y, 2, lane); pw.z = shxu(w[ps].z, 2, lane); pw.w = shxu(w[ps].w, 2, lane);
                float pv[8]; unpack8(pw, pv);
                float o[8];
#pragma unroll
                for (int j = 0; j < 8; ++j) { const float n = v[j] * r * (isk ? gk8[j] : gq8[j]), pn = pv[j] * r * (isk ? gkp[j] : gqp[j]);
                    o[j] = !rop ? n : (c < 10 ? n * cv[j] - pn * sv[j] : pn * sv[j] + n * cv[j]); }
                if (act) { bf16_t* dst = ps == 0 ? qm + row * 576 + qoffA : (ps == 1 ? km + row * 576 + qoffA : (kC ? km : qm) + row * 576 + qoffC);
                    *(u32x4*)dst = pack8f(o); }
            }
        }
    }
    __syncthreads();
}

__device__ __forceinline__ void ph_fox_cumsum(unsigned char* lds, Params P, int layer) {
    const int TIDX = hidden_tid(P.wid), BIDX = launder_i((int)blockIdx.x), GDIM = launder_i((int)gridDim.x); P.ws = launder_ptr(P.ws);
    const int wid = TIDX >> 6, lane = TIDX & 63;
    const float* lf = (const float*)(P.ws + WS_FG); float* cb2 = (float*)(P.ws + WS_CB2); float* wtot = (float*)lds;
    const int first = GDIM >= 256 ? (BIDX + GDIM - 192) % GDIM : BIDX;
    for (int item = first; item < NB * 6; item += GDIM) {
        const int b = item / 6, h = item % 6;
        float v[8];
#pragma unroll
        for (int j = 0; j < 8; ++j) v[j] = lf[((size_t)b * SEQ + TIDX * 8 + j) * 8 + h];
        float run = 0.f;
#pragma unroll
        for (int j = 0; j < 8; ++j) { run += v[j]; v[j] = run; }
        float incl = run;
#pragma unroll
        for (int o = 1; o < 64; o <<= 1) { const float t = __int_as_float(__builtin_amdgcn_ds_bpermute(((lane - o) & 63) << 2, __float_as_int(incl))); if (lane >= o) incl += t; }
        __syncthreads();
        if (lane == 63) wtot[wid] = incl;
        __syncthreads();
        float base = incl - run;
#pragma unroll
        for (int w = 0; w < 8; ++w) if (w < wid) base += wtot[w];
        float* dst = cb2 + ((size_t)b * 6 + h) * SEQ + TIDX * 8;
        *(f32x4*)dst = (f32x4){(base + v[0]) * LOG2E, (base + v[1]) * LOG2E, (base + v[2]) * LOG2E, (base + v[3]) * LOG2E};
        *(f32x4*)(dst + 4) = (f32x4){(base + v[4]) * LOG2E, (base + v[5]) * LOG2E, (base + v[6]) * LOG2E, (base + v[7]) * LOG2E};
    }
    __syncthreads();
}

#define XB_TMO      128
#define XB_XCNT(j)  (256  + 64 * (j))
#define XB_XSUB(j)  (1280 + 64 * (j))
#define XB_XGEN(j)  (2304 + 64 * (j))
#define XB_TOP      3328
#define XB_TOPGEN   3392
#define XCD_BAR_WORDS 3456
#define XB_SPIN_CAP (1u << 18)
#define LAS __attribute__((address_space(3)))

__device__ __forceinline__ unsigned xb_ld(unsigned* p)              { return __hip_atomic_load(p, __ATOMIC_RELAXED, __HIP_MEMORY_SCOPE_AGENT); }
__device__ __forceinline__ unsigned xb_add(unsigned* p, unsigned v) { return __hip_atomic_fetch_add(p, v, __ATOMIC_RELAXED, __HIP_MEMORY_SCOPE_AGENT); }
__device__ __forceinline__ unsigned xb_xcc_id() { return (unsigned)__builtin_amdgcn_s_getreg((3 << 11) | 20) & 0xFu; }
#define XB_SPIN(cond, bar) do { unsigned _sp = 0; while (cond) { __builtin_amdgcn_s_sleep(1); \
    if ((++_sp & 255u) == 0u) { if (xb_ld(&(bar)[XB_TMO])) break; if (_sp > XB_SPIN_CAP) { atomicAdd(&(bar)[XB_TMO], 1u); break; } } } } while (0)

struct XcdBarrier {
    unsigned* bar; unsigned x;
    volatile LAS unsigned* st;
};

__device__ __forceinline__ XcdBarrier xcd_barrier_post(unsigned* bar, volatile LAS unsigned* st) {
    XcdBarrier b; b.bar = bar; b.x = xb_xcc_id(); b.st = st;
    if (threadIdx.x == 0) (void)xb_add(&bar[XB_XCNT(b.x)], 1u);
    return b;
}
__device__ __forceinline__ void xcd_barrier_complete(unsigned* bar, unsigned x, unsigned& nloc, unsigned& nx) {
    const unsigned G = gridDim.x * gridDim.y * gridDim.z;
    unsigned sum, cnt, mine, sp = 0u;
    for (;;) {
        sum = 0u; cnt = 0u; mine = 0u;
#pragma unroll
        for (unsigned j = 0; j < 16; ++j) { const unsigned c = xb_ld(&bar[XB_XCNT(j)]); sum += c; cnt += (c > 0u) ? 1u : 0u; mine = (j == x) ? c : mine; }
        if (sum == G) break;
        __builtin_amdgcn_s_sleep(1);
        if ((++sp & 255u) == 0u) { if (xb_ld(&bar[XB_TMO])) break; if (sp > XB_SPIN_CAP) { atomicAdd(&bar[XB_TMO], 1u); break; } }
    }
    nloc = mine > 0u ? mine : 1u; nx = cnt > 0u ? cnt : 1u;
}

__device__ __forceinline__ void xcd_barrier(const XcdBarrier& b) {
    asm volatile("s_waitcnt vmcnt(0)" ::: "memory");
    __syncthreads();
    if (threadIdx.x == 0) {
        unsigned* bar = b.bar;
        __builtin_amdgcn_s_waitcnt(0);
        unsigned nloc = b.st[0], nx = b.st[1];
        if (nloc == 0u) { xcd_barrier_complete(bar, b.x, nloc, nx); b.st[0] = nloc; b.st[1] = nx; }
        const unsigned old = xb_add(&bar[XB_XSUB(b.x)], 1u);
        const unsigned gen = old / nloc;
        if (old + 1u == (gen + 1u) * nloc) {
            __builtin_amdgcn_fence(__ATOMIC_RELEASE, "agent");
            asm volatile("s_waitcnt vmcnt(0)" ::: "memory");
            const unsigned og = xb_add(&bar[XB_TOP], 1u);
            const unsigned tg = og / nx;
            if (og + 1u == (tg + 1u) * nx) xb_add(&bar[XB_TOPGEN], 1u);
            else XB_SPIN(xb_ld(&bar[XB_TOPGEN]) == tg, bar);
            __builtin_amdgcn_fence(__ATOMIC_ACQUIRE, "agent");
            xb_add(&bar[XB_XGEN(b.x)], 1u);
            asm volatile("s_waitcnt vmcnt(0)" ::: "memory");
        } else {
            XB_SPIN(xb_ld(&bar[XB_XGEN(b.x)]) == gen, bar);
            __builtin_amdgcn_fence(__ATOMIC_ACQUIRE, "agent");
            asm volatile("s_waitcnt vmcnt(0)" ::: "memory");
        }
    }
    __syncthreads();
}

extern __shared__ __attribute__((aligned(16))) unsigned char dlds[];
constexpr int LDS_BYTES = 147456, LDS_MISC = 131072;
constexpr int CW_BAR = 4096;

#define ATTN_MLA_ARGS(P) (const bf16_t*)((P).ws + WS_QMLA), 576, (const bf16_t*)((P).ws + WS_KMLA), 576, (const bf16_t*)((P).ws + WS_KVRAW) + 64, 768, 128, (bf16_t*)((P).ws + WS_OBUF), 768, (const float*)nullptr
#define ATTN_FOX_ARGS(P) (const bf16_t*)((P).ws + WS_PROJ) + PC_FQ, PJ, (const bf16_t*)((P).ws + WS_PROJ) + PC_FK, PJ, (const bf16_t*)((P).ws + WS_PROJ) + PC_FV, PJ, 64, (bf16_t*)((P).ws + WS_OBUF) + 384, 768, (const float*)((P).ws + WS_CB2)

typedef const __attribute__((address_space(4))) Params* KParams;
template <class T> __device__ __forceinline__ T launder_s(T p) { asm volatile("" : "+s"(p)); return p; }
__device__ __forceinline__ Params load_params(KParams kp, int wid) { Params r; r.x = kp->x; r.c = kp->c; r.pos = kp->pos; r.norm_mix = kp->norm_mix; r.norm_ffn = kp->norm_ffn; r.w_ada = kp->w_ada; r.b_ada = kp->b_ada; r.w_in = kp->w_in; r.lam_re = kp->lam_re; r.lam_im = kp->lam_im; r.log_dt = kp->log_dt; r.b_re = kp->b_re; r.b_im = kp->b_im; r.c_re = kp->c_re; r.c_im = kp->c_im; r.ssm_d = kp->ssm_d; r.w_glu = kp->w_glu; r.b_glu = kp->b_glu; r.q_norm = kp->q_norm; r.kv_norm = kp->kv_norm; r.w_uq = kp->w_uq; r.w_ukv = kp->w_ukv; r.mla_gq = kp->mla_gq; r.mla_gk = kp->mla_gk; r.fox_bf = kp->fox_bf; r.fox_gq = kp->fox_gq; r.fox_gk = kp->fox_gk; r.out_norm = kp->out_norm; r.w_out = kp->w_out; r.ffn_wg = kp->ffn_wg; r.ffn_wu = kp->ffn_wu; r.ffn_wd = kp->ffn_wd; r.moe_wr = kp->moe_wr; r.moe_br = kp->moe_br; r.moe_wg = kp->moe_wg; r.moe_wu = kp->moe_wu; r.moe_wd = kp->moe_wd; r.out = kp->out; r.ws = kp->ws; r.wid = wid; r.pad = 0; return r; }
__device__ __forceinline__ void sub64_barrier(unsigned* word) {
    asm volatile("s_waitcnt vmcnt(0)" ::: "memory");
    __syncthreads();
    if (threadIdx.x == 0) {
        __builtin_amdgcn_s_waitcnt(0);
        __builtin_amdgcn_fence(__ATOMIC_RELEASE, "agent");
        asm volatile("s_waitcnt vmcnt(0)" ::: "memory");
        (void)xb_add(word, 1u);
        unsigned sp = 0; while (xb_ld(word) < 64u) { __builtin_amdgcn_s_sleep(1); if (++sp > XB_SPIN_CAP) break; }
        __builtin_amdgcn_fence(__ATOMIC_ACQUIRE, "agent");
        asm volatile("s_waitcnt vmcnt(0)" ::: "memory");
    }
    __syncthreads();
}
__device__ __forceinline__ void ph_glu_sub(unsigned char* lds, Params P, int layer) {
    const int BIDX = launder_i((int)blockIdx.x), GDIM = launder_i((int)gridDim.x);
    if (GDIM < 64) return;
    if (BIDX < 64) { sub64_barrier((unsigned*)(launder_ptr(P.ws) + WS_CTL) + CW_SUB + (layer & 7) * 32); ph_glu_opt(lds, P, layer, 1); }
}
__global__ void __launch_bounds__(512, 2) k_mega(Params P_karg) {
    const KParams kp = (KParams)__builtin_amdgcn_kernarg_segment_ptr();
const int wid_s = __builtin_amdgcn_readfirstlane((int)(threadIdx.x >> 6));
#define P load_params(launder_s(kp), wid_s)
    unsigned char* lds = dlds;
    volatile LAS unsigned* xbw = (volatile LAS unsigned*)(dlds + LDS_MISC);
    if (threadIdx.x < 4) xbw[threadIdx.x] = 0u;
    __syncthreads();
    (void)xcd_barrier_post((unsigned*)(launder_s(kp)->ws + WS_CTL) + CW_BAR, xbw);
#define GBAR() do { XcdBarrier b_; b_.bar = (unsigned*)(launder_s(kp)->ws + WS_CTL) + CW_BAR; b_.x = xb_xcc_id(); b_.st = (volatile LAS unsigned*)(dlds + LDS_MISC); xcd_barrier(b_); if (DUP & 65536) xcd_barrier(b_); } while (0)
    ph_prologue(lds, P);
    if (DUP & (1 << 10)) { GBAR(); ph_prologue(lds, P); }
    ph_convert(lds, P, 0); ph_ssm_tab1(lds, P, 0);
    GBAR();
    for (int layer = 0; layer < DEPTH; ++layer) {
#define DUPIF(bit, ...) if (DUP & (1 << (bit))) { GBAR(); __VA_ARGS__ }
        { const Params Pl = P; if (layer == 0) ph_norm<0, 1>(lds, Pl, layer, Pl.x, -1); else if (layer == 2) ph_norm<0, 2>(lds, Pl, layer, nullptr, 1); else ph_norm<0, 0>(lds, Pl, layer, nullptr, -1); }
        if (layer != 0) { ph_convert(lds, P, layer); ph_ssm_tab1(lds, P, layer); }
        if (layer != 2) { DUPIF(19, { const Params Pl = P; if (layer == 0) ph_norm<0, 1>(lds, Pl, layer, Pl.x, -1); else ph_norm<0, 0>(lds, Pl, layer, nullptr, -1); }) }
        DUPIF(13, ph_convert(lds, P, layer);)
        DUPIF(14, ph_ssm_tab1(lds, P, layer);)
        GBAR();
        ph_inproj_opt(lds, P, layer);
        GBAR();
        ph_ssm_tab2(lds, P, layer);
        DUPIF(12, ph_ssm_tab2(lds, P, layer);)
        ph_fox_cumsum(lds, P, layer);
        ph_qup_opt(lds, P, layer); ph_kvup_opt(lds, P, layer);
        DUPIF(1, ph_qup_opt(lds, P, layer); ph_kvup_opt(lds, P, layer); ph_ssm_gemm1(lds, P, layer);)
        GBAR();
        ph_ssm_gemm2(lds, P, layer);
        ph_glu_sub(lds, P, layer);
        ph_attn_all(lds, P, layer);
        DUPIF(2, ph_ssm_gemm2(lds, P, layer); ph_attn_mla(lds, P, layer + 4); ph_attn_fox(lds, P, layer + 4);)
        GBAR();
        if (launder_i((int)gridDim.x) < 64) { ph_glu_opt(lds, P, layer); GBAR(); }
        DUPIF(17, ph_outproj_opt(lds, P, layer, 1);)
        ph_outproj_opt(lds, P, layer);
        GBAR();
        if ((layer & 1) == 0) {
            { const Params Pl = P; ph_norm<1, 0>(lds, Pl, layer, nullptr, -1); }
            DUPIF(8, { const Params Pl = P; ph_norm<1, 0>(lds, Pl, layer, nullptr, -1); })
            GBAR();
            ph_ffn1_opt(lds, P, layer);
            DUPIF(4, ph_ffn1_opt(lds, P, layer);)
            GBAR();
            DUPIF(18, ph_ffn2_opt(lds, P, layer, 1);)
            ph_ffn2_opt(lds, P, layer);
            GBAR();
        } else {
            { const Params Pl = P; ph_norm<2, 0>(lds, Pl, layer, nullptr, -1); }
            GBAR();
            ph_moe1_opt(lds, P, layer);
            DUPIF(4, ph_moe1_opt(lds, P, layer);)
            GBAR();
            ph_moe2_opt(lds, P, layer);
            DUPIF(4, ph_moe2_opt(lds, P, layer);)
            GBAR();
            if (layer == DEPTH - 1) ph_moe_combine(lds, P, layer);
        }
    }
}
#undef P

#if CHECK || !MEGA
#define KWRAP(NAME, DECL, CALL) __global__ void __launch_bounds__(512, 2) k_##NAME DECL { P.wid = __builtin_amdgcn_readfirstlane((int)(threadIdx.x >> 6)); ph_##NAME CALL; }
#define KWRAPT(NAME, TDECL, TARGS, DECL, CALL) template <TDECL> __global__ void __launch_bounds__(512, 2) k_##NAME DECL { P.wid = __builtin_amdgcn_readfirstlane((int)(threadIdx.x >> 6)); ph_##NAME<TARGS> CALL; }
KWRAP(prologue, (Params P), (dlds, P))
KWRAPT(norm, int MODE, MODE, (Params P, int layer, const float* src, int copy, int comb), (dlds, P, layer, src, copy, comb))
KWRAP(convert, (Params P, int layer), (dlds, P, layer))
KWRAP(inproj_opt, (Params P, int layer), (dlds, P, layer))
KWRAP(inproj_naive, (Params P, int layer, int chk), (dlds, P, layer, chk))
KWRAP(fox_cumsum, (Params P, int layer), (dlds, P, layer))
KWRAP(qup_opt, (Params P, int layer), (dlds, P, layer))
KWRAP(kvup_opt, (Params P, int layer), (dlds, P, layer))
KWRAP(qup_naive, (Params P, int layer, int chk), (dlds, P, layer, chk))
KWRAP(kvup_naive, (Params P, int layer, int chk), (dlds, P, layer, chk))
KWRAP(passE2, (Params P, int layer), (dlds, P, layer))
template <int DQK, int MODE> __global__ void __launch_bounds__(512, 2) k_attn_naive(Params P, const bf16_t* Q, int ldq, const bf16_t* K, int ldk, const bf16_t* V, int ldv, int vhs, bf16_t* O, int ldo, const float* cb2, int chk) {
    P.wid = __builtin_amdgcn_readfirstlane((int)(threadIdx.x >> 6)); ph_attn_naive<DQK, MODE>(dlds, P, Q, ldq, K, ldk, V, ldv, vhs, O, ldo, cb2, chk); }
KWRAP(attn_mla, (Params P, int layer), (dlds, P, layer))
KWRAP(attn_fox, (Params P, int layer), (dlds, P, layer))
KWRAP(ssm_tab1, (Params P, int layer), (dlds, P, layer))
KWRAP(ssm_tab2, (Params P, int layer), (dlds, P, layer))
KWRAP(ssm_gemm1, (Params P, int layer), (dlds, P, layer))
KWRAP(ssm_carry, (Params P, int layer), (dlds, P, layer))
KWRAP(ssm_gemm2, (Params P, int layer), (dlds, P, layer))
KWRAP(ssm_naive, (Params P, int layer, int chk), (dlds, P, layer, chk))
KWRAP(glu_opt, (Params P, int layer), (dlds, P, layer))
KWRAP(glu_naive, (Params P, int layer, int chk), (dlds, P, layer, chk))
KWRAP(merge, (Params P), (dlds, P))
KWRAP(outproj_opt, (Params P, int layer), (dlds, P, layer))
KWRAP(outproj_naive, (Params P, int layer, float* dst, int chk), (dlds, P, layer, dst, chk))
KWRAP(cmp_x, (Params P, const float* xe, int stage), (dlds, P, xe, stage))
KWRAP(ffn1_opt, (Params P, int layer), (dlds, P, layer))
KWRAP(ffn2_opt, (Params P, int layer), (dlds, P, layer))
KWRAP(ffn1_naive, (Params P, int layer, int chk), (dlds, P, layer, chk))
KWRAP(ffn2_naive, (Params P, int layer, float* dst, int chk), (dlds, P, layer, dst, chk))
KWRAP(moe_gather, (Params P, int layer), (dlds, P, layer))
KWRAP(moe1_opt, (Params P, int layer), (dlds, P, layer))
KWRAP(moe2_opt, (Params P, int layer), (dlds, P, layer))
KWRAP(moe1_naive, (Params P, int layer, int chk), (dlds, P, layer, chk))
KWRAP(moe2_naive, (Params P, int layer, int chk), (dlds, P, layer, chk))
KWRAP(moe_combine, (Params P, int layer), (dlds, P, layer))
KWRAP(check_final, (Params P), (dlds, P))
#endif

template <class... KA, class... A> static void launch(void (*k)(KA...), int grid, hipStream_t stream, A... a) {
    (void)hipFuncSetAttribute((const void*)k, hipFuncAttributeMaxDynamicSharedMemorySize, LDS_BYTES);
    hipLaunchKernelGGL(k, dim3(grid), dim3(512), LDS_BYTES, stream, a...);
}
extern "C" void kernel_launch(void* const* d_in, const int* in_sizes, int n_in, void* d_out, int out_size, void* d_ws, size_t ws_size, hipStream_t stream) {
    if (ws_size < WS_END || n_in < 37) return;
    Params P{};
    P.x = (const float*)d_in[0]; P.c = (const float*)d_in[1]; P.pos = (const int*)d_in[2]; P.norm_mix = (const float*)d_in[3]; P.norm_ffn = (const float*)d_in[4];
    P.w_ada = (const float*)d_in[5]; P.b_ada = (const float*)d_in[6]; P.w_in = (const float*)d_in[7];
    P.lam_re = (const float*)d_in[8]; P.lam_im = (const float*)d_in[9]; P.log_dt = (const float*)d_in[10]; P.b_re = (const float*)d_in[11]; P.b_im = (const float*)d_in[12];
    P.c_re = (const float*)d_in[13]; P.c_im = (const float*)d_in[14]; P.ssm_d = (const float*)d_in[15]; P.w_glu = (const float*)d_in[16]; P.b_glu = (const float*)d_in[17];
    P.q_norm = (const float*)d_in[18]; P.kv_norm = (const float*)d_in[19]; P.w_uq = (const float*)d_in[20]; P.w_ukv = (const float*)d_in[21]; P.mla_gq = (const float*)d_in[22]; P.mla_gk = (const float*)d_in[23];
    P.fox_bf = (const float*)d_in[24]; P.fox_gq = (const float*)d_in[25]; P.fox_gk = (const float*)d_in[26]; P.out_norm = (const float*)d_in[27]; P.w_out = (const float*)d_in[28];
    P.ffn_wg = (const float*)d_in[29]; P.ffn_wu = (const float*)d_in[30]; P.ffn_wd = (const float*)d_in[31];
    P.moe_wr = (const float*)d_in[32]; P.moe_br = (const float*)d_in[33]; P.moe_wg = (const float*)d_in[34]; P.moe_wu = (const float*)d_in[35]; P.moe_wd = (const float*)d_in[36];
    P.out = (float*)d_out; P.ws = (unsigned char*)d_ws;
    (void)hipMemsetAsync(d_ws, 0, CTL_BYTES, stream);
#if MEGA && !CHECK
    static int grid = 0;
    if (!grid) { int dev = 0, cus = 0; (void)hipGetDevice(&dev); (void)hipDeviceGetAttribute(&cus, hipDeviceAttributeMultiprocessorCount, dev); grid = cus > 0 ? cus : 256; }
    launch(k_mega, grid, stream, P);
#else
    float* xe = (float*)(P.ws + WS_XE);
    const int G = 256;
    launch(k_prologue, G, stream, P);
    for (int layer = 0; layer < DEPTH; ++layer) {
        launch(k_norm<0>, G * 4, stream, P, layer, layer == 0 ? P.x : (const float*)P.out, (layer == 0 || layer == 2) ? 1 : 0, layer == 2 ? 1 : -1);
        launch(k_convert, G, stream, P, layer);
        launch(k_ssm_tab1, G, stream, P, layer);
        launch(k_inproj_opt, G, stream, P, layer);
        launch(k_fox_cumsum, G, stream, P, layer);
        launch(k_ssm_tab2, G, stream, P, layer);
        launch(k_qup_opt, G, stream, P, layer); launch(k_kvup_opt, G, stream, P, layer);
        if (CHECK) { launch(k_qup_naive, G * 4, stream, P, layer, 2); launch(k_kvup_naive, G * 4, stream, P, layer, 3); }
        launch(k_ssm_gemm1, G, stream, P, layer);
        launch(k_ssm_gemm2, G, stream, P, layer);
        launch(k_attn_mla, G, stream, P, layer); launch(k_attn_fox, G, stream, P, layer);
        if (CHECK) { launch(k_attn_naive<96, 0>, 384, stream, P, ATTN_MLA_ARGS(P), 10); launch(k_attn_naive<64, 1>, 384, stream, P, ATTN_FOX_ARGS(P), 11); }
        if (CHECK) launch(k_ssm_naive, 16, stream, P, layer, 12);
        launch(k_glu_opt, G, stream, P, layer);
        if (CHECK) launch(k_glu_naive, G * 2, stream, P, layer, 4);
        launch(k_merge, G * 4, stream, P);
        if (CHECK) launch(k_outproj_naive, G * 4, stream, P, layer, xe, 5);
        launch(k_outproj_opt, G, stream, P, layer);
        if (CHECK) launch(k_cmp_x, G * 4, stream, P, (const float*)xe, 5);
        if ((layer & 1) == 0) {
            launch(k_norm<1>, G * 4, stream, P, layer, (const float*)P.out, 0, -1);
            launch(k_ffn1_opt, G, stream, P, layer);
            if (CHECK) { launch(k_ffn1_naive, G * 8, stream, P, layer, 6); launch(k_ffn2_naive, G * 4, stream, P, layer, xe, 7); }
            launch(k_ffn2_opt, G, stream, P, layer);
            if (CHECK) launch(k_cmp_x, G * 4, stream, P, (const float*)xe, 7);
        } else {
            launch(k_norm<2>, G * 4, stream, P, layer, (const float*)P.out, 0, -1);
            launch(k_moe1_opt, G, stream, P, layer);
            if (CHECK) launch(k_moe1_naive, G * 8, stream, P, layer, 8);
            launch(k_moe2_opt, G, stream, P, layer);
            if (CHECK) launch(k_moe2_naive, G * 4, stream, P, layer, 9);
            if (layer == DEPTH - 1) launch(k_moe_combine, G * 4, stream, P, layer);
        }
    }
    if (CHECK) launch(k_check_final, G * 4, stream, P);
#endif
}
```

```cpp
#include <hip/hip_runtime.h>
#include <stdint.h>
#include <math.h>

typedef unsigned short bf16_t;
typedef float f32x4 __attribute__((ext_vector_type(4)));
typedef unsigned u32x2 __attribute__((ext_vector_type(2)));
typedef unsigned u32x4 __attribute__((ext_vector_type(4)));

#ifndef DUP
#define DUP 0
#endif
#ifndef CHECK
#define CHECK 0
#endif
#ifndef MEGA
#define MEGA 1
#endif
#define LATE_CONVERT 0

constexpr int NB = 8, SEQ = 4096, T = NB * SEQ, D = 1024, DEPTH = 4;
constexpr int INC = 1830, PJ = 2048;
constexpr int PC_U = 0, PC_CQ = 256, PC_CKV = 512, PC_KR = 640, PC_FQ = 768, PC_FK = 1152, PC_FV = 1536, PC_FG = 1920;
constexpr int DFF = 2816, NEXP = 8, DFE = 1408;
constexpr float EPS = 1e-6f;
constexpr float LOG2E = 1.4426950408889634f;
constexpr float C2_MLA = 0.10206207261596577f * LOG2E;
constexpr float C2_FOX = 0.125f * LOG2E;
constexpr int NSLOT = 2 * T + NEXP * 256;

constexpr size_t MiB = 1u << 20;
constexpr size_t WS_CTL = 0, CTL_BYTES = 1 * MiB;
constexpr size_t WS_ADA = 1 * MiB;
constexpr size_t WS_COS = 2 * MiB, WS_SIN = 4 * MiB;
constexpr size_t WS_RSTDQ = 6 * MiB, WS_RSTDKV = 6 * MiB + 128 * 1024;
constexpr size_t WS_FG = 7 * MiB;
constexpr size_t WS_CLOC = 8 * MiB;
constexpr size_t WS_CTOT = 8 * MiB + 896 * 1024;
constexpr size_t WS_CB2 = 9 * MiB;
constexpr size_t WS_TOKINFO = 10 * MiB;
constexpr size_t WS_PROB = 10 * MiB + 512 * 1024;
constexpr size_t WS_SLOTOF = 10 * MiB + 768 * 1024;
constexpr size_t WS_P2E = 11 * MiB;
constexpr size_t WS_YG = 20 * MiB;
constexpr size_t WS_OSSM = 36 * MiB;
constexpr size_t WS_W = 72 * MiB;
constexpr size_t W_IN = WS_W, W_UQ = WS_W + 4 * MiB, W_UKV = WS_W + 4 * MiB + 512 * 1024, W_GLU = WS_W + 5 * MiB, W_OUT = WS_W + 6 * MiB;
constexpr size_t W_F1 = WS_W + 8 * MiB, W_F2 = WS_W + 52 * MiB, W_B1T = WS_W + 76 * MiB, W_T2T = WS_W + 80 * MiB;
constexpr size_t WS_UG = 52 * MiB;
constexpr size_t WS_SLOC = 12 * MiB;
constexpr size_t WS_KM = WS_W + 90 * MiB;
constexpr size_t WS_LAMP = WS_W + 91 * MiB;
constexpr size_t WS_BBAR = WS_W + 92 * MiB;
constexpr size_t WS_SSQ = WS_W + 93 * MiB;
constexpr size_t WS_HBUF = 168 * MiB;
constexpr size_t WS_BIG = 232 * MiB;
constexpr size_t WS_PROJ = WS_BIG;
constexpr size_t WS_QRAW = WS_BIG + 128 * MiB;
constexpr size_t WS_KVRAW = WS_BIG + 176 * MiB;
constexpr size_t WS_QMLA = WS_BIG + 224 * MiB;
constexpr size_t WS_KMLA = WS_BIG + 260 * MiB;
constexpr size_t WS_OBUF = WS_BIG + 296 * MiB;
constexpr size_t WS_ACT = WS_BIG;
constexpr size_t WS_HG = WS_BIG;
constexpr size_t WS_ACTM = WS_BIG + 132 * MiB;
constexpr size_t WS_LIST = WS_BIG + 320 * MiB;
constexpr size_t WS_XE = WS_BIG + 192 * MiB;
constexpr size_t WS_END = WS_BIG + 344 * MiB;
constexpr size_t WS_SSQ2 = 36 * MiB;
constexpr size_t WS_XB2 = WS_BIG + 68 * MiB;

constexpr int CW_CNT = 1024;
constexpr int CW_ATTN = 1536;
constexpr int CW_SUB = 12288;
constexpr int CW_ATTQ = 8192;
constexpr int CW_CHKE = 2048, CW_CHKR = 2112;

struct Params {
    const float* x; const float* c; const int* pos; const float* norm_mix; const float* norm_ffn; const float* w_ada; const float* b_ada; const float* w_in;
    const float* lam_re; const float* lam_im; const float* log_dt; const float* b_re; const float* b_im; const float* c_re; const float* c_im;
    const float* ssm_d; const float* w_glu; const float* b_glu;
    const float* q_norm; const float* kv_norm; const float* w_uq; const float* w_ukv; const float* mla_gq; const float* mla_gk;
    const float* fox_bf; const float* fox_gq; const float* fox_gk; const float* out_norm; const float* w_out;
    const float* ffn_wg; const float* ffn_wu; const float* ffn_wd;
    const float* moe_wr; const float* moe_br; const float* moe_wg; const float* moe_wu; const float* moe_wd;
    float* out; unsigned char* ws;
    int wid, pad;
};

__device__ __forceinline__ float bf2f(bf16_t h) { return __uint_as_float(((unsigned)h) << 16); }
__device__ __forceinline__ bf16_t f2bf(float f) { unsigned u = __float_as_uint(f); return (bf16_t)((u + 0x7fffu + ((u >> 16) & 1u)) >> 16); }
__device__ __forceinline__ unsigned pk2(float lo, float hi) { return (unsigned)f2bf(lo) | ((unsigned)f2bf(hi) << 16); }
__device__ __forceinline__ int hidden_tid(int wid) { int t; asm volatile("v_mbcnt_lo_u32_b32 %0, -1, 0\n\tv_mbcnt_hi_u32_b32 %0, -1, %0\n\tv_lshl_add_u32 %0, %1, 6, %0" : "=&v"(t) : "s"(wid)); return t; }
__device__ __forceinline__ int launder_i(int v) { asm volatile("" : "+s"(v)); return v; }
template <class T> __device__ __forceinline__ T* launder_ptr(T* p) { asm volatile("" : "+s"(p)); return p; }
__device__ __forceinline__ float shx(float v, int o, int lane) { return __int_as_float(__builtin_amdgcn_ds_bpermute((lane ^ o) << 2, __float_as_int(v))); }
__device__ __forceinline__ float wsum(float v, int lane) {
#pragma unroll
    for (int o = 32; o > 0; o >>= 1) v += shx(v, o, lane);
    return v;
}
__device__ __forceinline__ float wmax(float v, int lane) {
#pragma unroll
    for (int o = 32; o > 0; o >>= 1) v = fmaxf(v, shx(v, o, lane));
    return v;
}
__device__ __forceinline__ float silu_f(float v) { return v / (1.f + __expf(-v)); }
__device__ __forceinline__ float sigmoid_f(float v) { return 1.f / (1.f + __expf(-v)); }
__device__ __forceinline__ float gelu_tanh(float x) { return 0.5f * x * (1.f + tanhf(0.7978845608028654f * (x + 0.044715f * x * x * x))); }
__device__ __forceinline__ bf16_t* xstream(const Params& P, int idx) { return idx >= DEPTH ? (bf16_t*)(P.ws + WS_XB2) : (bf16_t*)(P.out + (size_t)T * D / 2); }
__device__ __forceinline__ size_t ymoe_off(int layer) { return layer == DEPTH - 1 ? WS_HBUF : WS_HG; }
__device__ __forceinline__ float* adap(const Params& P, int layer, int b, int which) { return (float*)(P.ws + WS_ADA) + ((size_t)(layer * NB + b) * 6 + which) * D; }

struct Chk { float e, r; };
__device__ __forceinline__ void chk_upd(Chk& c, float naive, float stored) { const float d = fabsf(naive - stored); c.e = (d != d) ? INFINITY : fmaxf(c.e, d); c.r = fmaxf(c.r, fabsf(naive)); }
__device__ __forceinline__ void chk_commit(const Params& P, int stage, Chk c) {
    const int lane_ = (int)(threadIdx.x & 63); const float e = wmax(c.e, lane_), r = wmax(c.r, lane_);
    if (lane_ == 0) { unsigned* ctl = (unsigned*)(P.ws + WS_CTL); atomicMax(ctl + CW_CHKE + stage, __float_as_uint(e)); atomicMax(ctl + CW_CHKR + stage, __float_as_uint(r)); }
}
__device__ __forceinline__ void st4(bf16_t* p, const float (&v)[4], int chk, Chk& c) {
    if (!chk) { u32x2 o; o.x = pk2(v[0], v[1]); o.y = pk2(v[2], v[3]); *(u32x2*)p = o; }
    else { const u32x2 o = *(const u32x2*)p; chk_upd(c, v[0], bf2f(o.x & 0xffff)); chk_upd(c, v[1], bf2f(o.x >> 16)); chk_upd(c, v[2], bf2f(o.y & 0xffff)); chk_upd(c, v[3], bf2f(o.y >> 16)); }
}
__device__ __forceinline__ void st2(bf16_t* p, float a, float b, int chk, Chk& c) {
    if (!chk) *(unsigned*)p = pk2(a, b);
    else { const unsigned o = *(const unsigned*)p; chk_upd(c, a, bf2f(o & 0xffff)); chk_upd(c, b, bf2f(o >> 16)); }
}

template <class FA, class FT, class FB, class FS>
__device__ __forceinline__ void naive_gemm(int M, int N, int K, FA fa, FT ft, FB fb, FS fs, float* sm) {
    const int tid = threadIdx.x, ty = tid >> 5, tx = tid & 31;
    float (*As)[132] = (float (*)[132])sm;
    float (*Bs)[132] = (float (*)[132])(sm + 16 * 132);
    const int tm = (M + 127) / 128, tn = (N + 127) / 128;
    for (int tile = blockIdx.x; tile < tm * tn; tile += gridDim.x) {
        const int bm = (tile / tn) * 128, bn = (tile % tn) * 128;
        const int ctx = ft(bm);
        float acc[8][4];
#pragma unroll
        for (int i = 0; i < 8; ++i)
#pragma unroll
            for (int j = 0; j < 4; ++j) acc[i][j] = 0.f;
        for (int k0 = 0; k0 < K; k0 += 16) {
#pragma unroll
            for (int j = 0; j < 4; ++j) {
                const int e = tid + 512 * j, r = e >> 4, kk = e & 15;
                As[kk][r] = (bm + r < M) ? fa(bm + r, k0 + kk) : 0.f;
                const int k2 = e >> 7, cc = e & 127;
                Bs[k2][cc] = (bn + cc < N) ? fb(k0 + k2, bn + cc, ctx) : 0.f;
            }
            __syncthreads();
#pragma unroll
            for (int kk = 0; kk < 16; ++kk) {
                const f32x4 a0 = *(const f32x4*)&As[kk][ty * 8], a1 = *(const f32x4*)&As[kk][ty * 8 + 4], b = *(const f32x4*)&Bs[kk][tx * 4];
                const float a[8] = {a0[0], a0[1], a0[2], a0[3], a1[0], a1[1], a1[2], a1[3]};
#pragma unroll
                for (int i = 0; i < 8; ++i)
#pragma unroll
                    for (int j = 0; j < 4; ++j) acc[i][j] = fmaf(a[i], b[j], acc[i][j]);
            }
            __syncthreads();
        }
#pragma unroll
        for (int i = 0; i < 8; ++i) { const int row = bm + ty * 8 + i; if (row < M) fs(row, bn + tx * 4, acc[i]); }
    }
}

__device__ __forceinline__ void ph_prologue(unsigned char* lds, Params P) {
    const int TIDX = hidden_tid(P.wid), BIDX = launder_i((int)blockIdx.x), GDIM = launder_i((int)gridDim.x); P.ws = launder_ptr(P.ws); P.out = launder_ptr(P.out);
    float* cact = (float*)lds;
    float* red = cact + NB * D;
    { f32x4 cv[4];
#pragma unroll
      for (int i = 0; i < 4; ++i) cv[i] = *(const f32x4*)(P.c + (size_t)(i * 512 + TIDX) * 4);
#pragma unroll
      for (int i = 0; i < 4; ++i) *(f32x4*)(cact + (size_t)(i * 512 + TIDX) * 4) = (f32x4){silu_f(cv[i][0]), silu_f(cv[i][1]), silu_f(cv[i][2]), silu_f(cv[i][3])}; }
    __syncthreads();
    float* ada = (float*)(P.ws + WS_ADA);
    const int j4 = (TIDX & 7) * 4, ks = TIDX >> 3;
    f32x4 wv[16], wn[16];
    auto load_item = [&](int item, f32x4 (&w_)[16]) { const int layer = item / 192, c0 = (item % 192) * 32;
        const float* w = P.w_ada + (size_t)layer * D * 6 * D + (size_t)(ks * 16) * 6 * D + c0 + j4;
#pragma unroll
        for (int u = 0; u < 16; ++u) w_[u] = *(const f32x4*)(w + (size_t)u * 6 * D); };
    if (BIDX < DEPTH * 192) load_item(BIDX, wv);
    for (int item = BIDX; item < DEPTH * 192; item += GDIM) {
        const int layer = item / 192, c0 = (item % 192) * 32;
        if (item + GDIM < DEPTH * 192) load_item(item + GDIM, wn);
        f32x4 acc[NB];
#pragma unroll
        for (int b = 0; b < NB; ++b) acc[b] = (f32x4){0.f, 0.f, 0.f, 0.f};
#pragma unroll
        for (int u = 0; u < 16; ++u)
#pragma unroll
            for (int b = 0; b < NB; ++b) acc[b] += cact[b * D + ks * 16 + u] * wv[u];
#pragma unroll
        for (int b = 0; b < NB; ++b) *(f32x4*)(red + (ks * NB + b) * 32 + j4) = acc[b];
        __syncthreads();
        if (TIDX < 256) { const int b = TIDX >> 5, jj = TIDX & 31; float s = 0.f;
            for (int k2 = 0; k2 < 64; ++k2) s += red[(k2 * NB + b) * 32 + jj];
            ada[(size_t)(layer * NB + b) * 6 * D + c0 + jj] = s + P.b_ada[layer * 6 * D + c0 + jj]; }
        __syncthreads();
#pragma unroll
        for (int u = 0; u < 16; ++u) wv[u] = wn[u];
    }
    float* cs = (float*)(P.ws + WS_COS); float* sn = (float*)(P.ws + WS_SIN);
    const int gt = BIDX * 512 + TIDX, nt = GDIM * 512;
    for (int idx0 = gt; idx0 < T * 16; idx0 += 4 * nt) {
        int pp[4];
#pragma unroll
        for (int u = 0; u < 4; ++u) { const int idx = idx0 + u * nt; pp[u] = idx < T * 16 ? P.pos[idx >> 4] : 0; }
#pragma unroll
        for (int u = 0; u < 4; ++u) { const int idx = idx0 + u * nt;
            if (idx < T * 16) { const int jx = idx & 15; const float ang = (float)pp[u] * exp2f(-(float)jx * (13.287712379549449f / 16.f));
                float sv_, cv_; sincosf(ang, &sv_, &cv_); cs[idx] = cv_; sn[idx] = sv_; } }
    }
}

__device__ __forceinline__ void moe_offsets(const Params& P, int layer, int (&off)[NEXP + 1]) {
    const unsigned* cnt = (const unsigned*)(P.ws + WS_CTL) + CW_CNT + 16 * (layer / 2);
    int o = 0;
#pragma unroll
    for (int e = 0; e < NEXP; ++e) { off[e] = o; o += (int)((cnt[e] + 255u) >> 8) << 8; }
    off[NEXP] = o;
}
__device__ __forceinline__ int moe_sel(const int (&off)[NEXP + 1], int e) { int r = 0;
#pragma unroll
    for (int j = 0; j < NEXP; ++j) if (e == j) r = off[j];
    return r; }
template <int MODE, int VAR>
__device__ __forceinline__ void ph_norm(unsigned char* lds, Params P, int layer, const float* src, int comb) {
    const int TIDX = hidden_tid(P.wid), BIDX = launder_i((int)blockIdx.x), GDIM = launder_i((int)gridDim.x); P.ws = launder_ptr(P.ws); P.out = launder_ptr(P.out);
    const int wid = TIDX >> 6, lane = TIDX & 63;
    const float* gain = (MODE == 0 ? P.norm_mix : P.norm_ffn) + layer * D;
    bf16_t* hb = (bf16_t*)(P.ws + WS_HBUF); bf16_t* xs = xstream(P, (MODE == 2 && layer == DEPTH - 1) ? DEPTH : layer);
    float* wrl = (float*)(lds + 4096);
    if (MODE == 2) { if (TIDX < 16) ((unsigned*)lds)[TIDX] = 0u;
        const f32x4* src4 = (const f32x4*)(P.moe_wr + (size_t)(layer / 2) * D * NEXP); for (int i = TIDX; i < D * NEXP / 4; i += 512) ((f32x4*)wrl)[i] = src4[i];
        __syncthreads(); }
    constexpr int NR = 4;
    const int RPW = (T + GDIM * 8 - 1) / (GDIM * 8), rbeg = (BIDX * 8 + wid) * RPW;
    int off_[NEXP + 1];
    if (VAR == 2) moe_offsets(P, comb, off_);
    const bf16_t* ym = (const bf16_t*)(P.ws + WS_HG); const int* tinfo = (const int*)(P.ws + WS_TOKINFO); const float* prob = (const float*)(P.ws + WS_PROB);
    int bcur = -1; f32x4 av[4], bv[4], gq[4];
    for (int j0 = 0; j0 < RPW; j0 += NR) {
        f32x4 vf[VAR == 1 ? NR : 1][4]; u32x2 w[VAR == 1 ? 1 : NR][4], ya[VAR == 2 ? NR : 1][4], yb[VAR == 2 ? NR : 1][4]; float p0[NR], p1[NR];
        if (VAR == 1) {
#pragma unroll
            for (int k = 0; k < NR; ++k) { const int row = rbeg + j0 + k;
                if (j0 + k < RPW && row < T) {
#pragma unroll
                    for (int q = 0; q < 4; ++q) vf[VAR == 1 ? k : 0][q] = *(const f32x4*)(src + (size_t)row * D + q * 256 + lane * 4); } }
        } else {
#pragma unroll
            for (int k = 0; k < NR; ++k) { const int row = rbeg + j0 + k;
                if (j0 + k < RPW && row < T) {
#pragma unroll
                    for (int q = 0; q < 4; ++q) w[VAR == 1 ? 0 : k][q] = *(const u32x2*)(xs + (size_t)row * D + q * 256 + lane * 4); } }
            if (VAR == 2) {
                int s0[NR], s1[NR];
#pragma unroll
                for (int k = 0; k < NR; ++k) { const int row = rbeg + j0 + k;
                    if (j0 + k < RPW && row < T) { const int* ti_ = tinfo + (size_t)row * 4; s0[k] = moe_sel(off_, ti_[0]) + ti_[1]; s1[k] = moe_sel(off_, ti_[2]) + ti_[3]; p0[k] = prob[(size_t)row * 2]; p1[k] = prob[(size_t)row * 2 + 1]; } }
#pragma unroll
                for (int k = 0; k < NR; ++k) { const int row = rbeg + j0 + k;
                    if (j0 + k < RPW && row < T) {
#pragma unroll
                        for (int q = 0; q < 4; ++q) { ya[VAR == 2 ? k : 0][q] = *(const u32x2*)(ym + (size_t)s0[k] * D + q * 256 + lane * 4); yb[VAR == 2 ? k : 0][q] = *(const u32x2*)(ym + (size_t)s1[k] * D + q * 256 + lane * 4); } } }
            }
        }
#pragma unroll
        for (int k = 0; k < NR; ++k) { const int row = rbeg + j0 + k;
            if (j0 + k < RPW && row < T) {
                const int b = row / SEQ;
                f32x4 v[4];
#pragma unroll
                for (int q = 0; q < 4; ++q) { if (VAR == 1) v[q] = vf[VAR == 1 ? k : 0][q]; else { const u32x2 ww = w[VAR == 1 ? 0 : k][q]; v[q] = (f32x4){bf2f(ww.x & 0xffff), bf2f(ww.x >> 16), bf2f(ww.y & 0xffff), bf2f(ww.y >> 16)}; } }
                if (b != bcur) {
                    bcur = b; const float* sh = adap(P, layer, b, MODE == 0 ? 0 : 3); const float* sc = adap(P, layer, b, MODE == 0 ? 1 : 4);
#pragma unroll
                    for (int q = 0; q < 4; ++q) { const int col = q * 256 + lane * 4; const f32x4 g = *(const f32x4*)(gain + col), s1_ = *(const f32x4*)(sc + col); bv[q] = *(const f32x4*)(sh + col); av[q] = g * (1.f + s1_);
                        if (VAR == 2) gq[q] = *(const f32x4*)(adap(P, comb, b, 5) + col); } }
                if (VAR == 2) {
#pragma unroll
                    for (int q = 0; q < 4; ++q) { const u32x2 a = ya[VAR == 2 ? k : 0][q], b2 = yb[VAR == 2 ? k : 0][q]; const f32x4 g = gq[q];
                        v[q][0] += g[0] * (p0[k] * bf2f(a.x & 0xffff) + p1[k] * bf2f(b2.x & 0xffff)); v[q][1] += g[1] * (p0[k] * bf2f(a.x >> 16) + p1[k] * bf2f(b2.x >> 16));
                        v[q][2] += g[2] * (p0[k] * bf2f(a.y & 0xffff) + p1[k] * bf2f(b2.y & 0xffff)); v[q][3] += g[3] * (p0[k] * bf2f(a.y >> 16) + p1[k] * bf2f(b2.y >> 16)); } }
                float ss = 0.f;
#pragma unroll
                for (int q = 0; q < 4; ++q) ss += v[q][0] * v[q][0] + v[q][1] * v[q][1] + v[q][2] * v[q][2] + v[q][3] * v[q][3];
                if (VAR != 0) {
#pragma unroll
                    for (int q = 0; q < 4; ++q) { u32x2 o; o.x = pk2(v[q][0], v[q][1]); o.y = pk2(v[q][2], v[q][3]); *(u32x2*)(xs + (size_t)row * D + q * 256 + lane * 4) = o; }
                }
                ss = wsum(ss, lane);
                const float rstd = rsqrtf(ss * (1.f / D) + EPS);
                float lg[NEXP];
#pragma unroll
                for (int e = 0; e < NEXP; ++e) lg[e] = 0.f;
#pragma unroll
                for (int q = 0; q < 4; ++q) {
                    const int col = q * 256 + lane * 4;
                    float h[4];
#pragma unroll
                    for (int j = 0; j < 4; ++j) h[j] = v[q][j] * rstd * av[q][j] + bv[q][j];
                    u32x2 o; o.x = pk2(h[0], h[1]); o.y = pk2(h[2], h[3]);
                    *(u32x2*)(hb + (size_t)row * D + col) = o;
                    if (MODE == 2) {
                        const float* wr = wrl + col * NEXP;
#pragma unroll
                        for (int j = 0; j < 4; ++j) { const f32x4 w0 = *(const f32x4*)(wr + j * 8), w1 = *(const f32x4*)(wr + j * 8 + 4);
                            lg[0] += h[j] * w0[0]; lg[1] += h[j] * w0[1]; lg[2] += h[j] * w0[2]; lg[3] += h[j] * w0[3];
                            lg[4] += h[j] * w1[0]; lg[5] += h[j] * w1[1]; lg[6] += h[j] * w1[2]; lg[7] += h[j] * w1[3]; }
                    }
                }
                if (MODE == 2) {
#pragma unroll
                    for (int e = 0; e < NEXP; ++e) lg[e] = wsum(lg[e], lane) + P.moe_br[(layer / 2) * NEXP + e];
                    if (lane == 0) {
                        int i0 = 0; float v0 = lg[0];
#pragma unroll
                        for (int e = 1; e < NEXP; ++e) if (lg[e] > v0) { v0 = lg[e]; i0 = e; }
                        int i1 = -1; float v1 = -INFINITY;
#pragma unroll
                        for (int e = 0; e < NEXP; ++e) if (e != i0 && lg[e] > v1) { v1 = lg[e]; i1 = e; }
                        const float pa = 1.f / (1.f + expf(v1 - v0)), pb = 1.f - pa;
                        unsigned* lcnt = (unsigned*)lds; int* lti = (int*)(lds + 64) + (wid * 16 + j0 + k) * 4;
                        const int pos0 = (int)atomicAdd(lcnt + i0, 1u), pos1 = (int)atomicAdd(lcnt + i1, 1u);
                        lti[0] = i0; lti[1] = pos0; lti[2] = i1; lti[3] = pos1;
                        float* pr = (float*)(P.ws + WS_PROB) + (size_t)row * 2; pr[0] = pa; pr[1] = pb;
                    }
                }
            }
        }
    }
    if (MODE == 2) {
        __syncthreads();
        unsigned* lcnt = (unsigned*)lds; int* lti = (int*)(lds + 64);
        if (TIDX < NEXP) { unsigned* cnt = (unsigned*)(P.ws + WS_CTL) + CW_CNT + 16 * (layer / 2); lcnt[8 + TIDX] = atomicAdd(cnt + TIDX, lcnt[TIDX]); }
        __syncthreads();
        if (TIDX < 128) { const int w_ = TIDX >> 4, j_ = TIDX & 15, row = (BIDX * 8 + w_) * RPW + j_;
            if (j_ < RPW && row < T) { const int e0 = lti[TIDX * 4], e1 = lti[TIDX * 4 + 2]; int* ti = (int*)(P.ws + WS_TOKINFO) + (size_t)row * 4;
                const int q0_ = lti[TIDX * 4 + 1] + (int)lcnt[8 + e0], q1_ = lti[TIDX * 4 + 3] + (int)lcnt[8 + e1]; int* list = (int*)(P.ws + WS_LIST);
                ti[0] = e0; ti[1] = q0_; ti[2] = e1; ti[3] = q1_; list[(size_t)e0 * T + q0_] = row; list[(size_t)e1 * T + q1_] = row; } }
        __syncthreads();
    }
}

__device__ __forceinline__ int proj_orig_col(int col) { return col < 672 ? col : (col < 768 ? -1 : (col < 1926 ? col - 96 : -1)); }
__device__ __forceinline__ void ph_inproj_naive(unsigned char* lds, Params P, int layer, int chk) {
    const int TIDX = hidden_tid(P.wid), BIDX = launder_i((int)blockIdx.x), GDIM = launder_i((int)gridDim.x); P.ws = launder_ptr(P.ws); P.out = launder_ptr(P.out);
    float* sm = (float*)lds;
    const bf16_t* hb = (const bf16_t*)(P.ws + WS_HBUF); const float* w = P.w_in + (size_t)layer * D * INC;
    bf16_t* proj = (bf16_t*)(P.ws + WS_PROJ); float* fg = (float*)(P.ws + WS_FG);
    Chk ck{0.f, 0.f};
    naive_gemm(T, PJ, D,
        [&](int r, int k) { return bf2f(hb[(size_t)r * D + k]); },
        [&](int) { return 0; },
        [&](int k, int col, int) { const int oc = proj_orig_col(col); return oc < 0 ? 0.f : w[(size_t)k * INC + oc]; },
        [&](int r, int c0, const float (&v)[4]) {
            st4(proj + (size_t)r * PJ + c0, v, chk, ck);
            if (c0 >= PC_FG && c0 < PC_FG + 8) { float* fp = fg + (size_t)r * 8 + (c0 - PC_FG);
                if (!chk) *(f32x4*)fp = (f32x4){v[0], v[1], v[2], v[3]};
                else { chk_upd(ck, v[0], fp[0]); chk_upd(ck, v[1], fp[1]); chk_upd(ck, v[2], fp[2]); chk_upd(ck, v[3], fp[3]); } }
        }, sm);
    if (chk) chk_commit(P, chk, ck);
}

__device__ __forceinline__ void ph_passC(unsigned char* lds, Params P, int layer) {
    const int TIDX = hidden_tid(P.wid), BIDX = launder_i((int)blockIdx.x), GDIM = launder_i((int)gridDim.x); P.ws = launder_ptr(P.ws); P.out = launder_ptr(P.out);
    float (*lfs)[8] = (float (*)[8])lds;
    const int wid = TIDX >> 6, lane = TIDX & 63;
    bf16_t* proj = (bf16_t*)(P.ws + WS_PROJ); const float* fg = (const float*)(P.ws + WS_FG);
    float* rq = (float*)(P.ws + WS_RSTDQ); float* rkv = (float*)(P.ws + WS_RSTDKV);
    float* cloc = (float*)(P.ws + WS_CLOC); float* ctot = (float*)(P.ws + WS_CTOT);
    const float gq = P.fox_gq[layer * 64 + lane] * C2_FOX, gk = P.fox_gk[layer * 64 + lane];
    for (int chunk = BIDX; chunk < T / 128; chunk += GDIM) {
        for (int i = 0; i < 16; ++i) {
            const int tl = wid * 16 + i, row = chunk * 128 + tl;
            bf16_t* pr = proj + (size_t)row * PJ;
            { const u32x2 w = *(const u32x2*)(pr + PC_CQ + lane * 4); const float a = bf2f(w.x & 0xffff), b = bf2f(w.x >> 16), c = bf2f(w.y & 0xffff), d = bf2f(w.y >> 16);
              const float ss = wsum(a * a + b * b + c * c + d * d, lane); if (lane == 0) rq[row] = rsqrtf(ss * (1.f / 256.f) + EPS); }
            { const u32x2 w = *(const u32x2*)(pr + PC_U + lane * 4); const int g_ = lane >> 2, c_ = (lane & 3) * 4, b_ = row / SEQ, t_ = row % SEQ;
              *(u32x2*)((bf16_t*)(P.ws + WS_UG) + (size_t)(g_ * 1024 + b_ * 128 + (t_ >> 5)) * 640 + (t_ & 31) * 16 + c_) = w; }
            { const unsigned w = *(const unsigned*)(pr + PC_CKV + lane * 2); const float a = bf2f(w & 0xffff), b = bf2f(w >> 16);
              const float ss = wsum(a * a + b * b, lane); if (lane == 0) rkv[row] = rsqrtf(ss * (1.f / 128.f) + EPS); }
#pragma unroll
            for (int h = 0; h < 6; ++h) {
                const float a = bf2f(pr[PC_FQ + h * 64 + lane]); const float ra = rsqrtf(wsum(a * a, lane) * (1.f / 64.f) + EPS); pr[PC_FQ + h * 64 + lane] = f2bf(a * ra * gq);
                const float b = bf2f(pr[PC_FK + h * 64 + lane]); const float rb = rsqrtf(wsum(b * b, lane) * (1.f / 64.f) + EPS); pr[PC_FK + h * 64 + lane] = f2bf(b * rb * gk);
            }
            if (lane < 6) { const float z = fg[(size_t)row * 8 + lane] + P.fox_bf[layer * 6 + lane];
                lfs[tl][lane] = z >= 0.f ? -log1pf(expf(-z)) : z - log1pf(expf(z)); }
        }
        __syncthreads();
        if (TIDX < 6) {
            const int h = TIDX, b = (chunk * 128) / SEQ, t0 = (chunk * 128) % SEQ; float run = 0.f;
            for (int j = 0; j < 128; ++j) { run += lfs[j][h]; cloc[((size_t)b * 6 + h) * SEQ + t0 + j] = run; }
            ctot[chunk * 8 + h] = run;
        }
        __syncthreads();
    }
}

__device__ __forceinline__ void ph_qup_naive(unsigned char* lds, Params P, int layer, int chk) {
    const int TIDX = hidden_tid(P.wid), BIDX = launder_i((int)blockIdx.x), GDIM = launder_i((int)gridDim.x); P.ws = launder_ptr(P.ws); P.out = launder_ptr(P.out);
    float* sm = (float*)lds;
    const bf16_t* proj = (const bf16_t*)(P.ws + WS_PROJ); const float* rq = (const float*)(P.ws + WS_RSTDQ);
    const float* w = P.w_uq + (size_t)layer * 256 * 576; const float* g = P.q_norm + layer * 256; bf16_t* qraw = (bf16_t*)(P.ws + WS_QRAW);
    Chk ck{0.f, 0.f};
    naive_gemm(T, 576, 256,
        [&](int r, int k) { return bf2f(proj[(size_t)r * PJ + PC_CQ + k]); },
        [&](int) { return 0; },
        [&](int k, int col, int) { return g[k] * w[(size_t)k * 576 + col]; },
        [&](int r, int c0, const float (&v)[4]) { const float s = rq[r]; const float o[4] = {v[0] * s, v[1] * s, v[2] * s, v[3] * s}; st4(qraw + (size_t)r * 768 + c0, o, chk, ck); }, sm);
    if (chk) chk_commit(P, chk, ck);
}
__device__ __forceinline__ void ph_kvup_naive(unsigned char* lds, Params P, int layer, int chk) {
    const int TIDX = hidden_tid(P.wid), BIDX = launder_i((int)blockIdx.x), GDIM = launder_i((int)gridDim.x); P.ws = launder_ptr(P.ws); P.out = launder_ptr(P.out);
    float* sm = (float*)lds;
    const bf16_t* proj = (const bf16_t*)(P.ws + WS_PROJ); const float* rk = (const float*)(P.ws + WS_RSTDKV);
    const float* w = P.w_ukv + (size_t)layer * 128 * 768; const float* g = P.kv_norm + layer * 128; bf16_t* kvraw = (bf16_t*)(P.ws + WS_KVRAW);
    Chk ck{0.f, 0.f};
    naive_gemm(T, 768, 128,
        [&](int r, int k) { return bf2f(proj[(size_t)r * PJ + PC_CKV + k]); },
        [&](int) { return 0; },
        [&](int k, int col, int) { return g[k] * w[(size_t)k * 768 + col]; },
        [&](int r, int c0, const float (&v)[4]) { const float s = rk[r]; const float o[4] = {v[0] * s, v[1] * s, v[2] * s, v[3] * s}; st4(kvraw + (size_t)r * 768 + c0, o, chk, ck); }, sm);
    if (chk) chk_commit(P, chk, ck);
}

__device__ __forceinline__ void ph_passE(unsigned char* lds, Params P, int layer) {
    const int TIDX = hidden_tid(P.wid), BIDX = launder_i((int)blockIdx.x), GDIM = launder_i((int)gridDim.x); P.ws = launder_ptr(P.ws); P.out = launder_ptr(P.out);
    float* pref = (float*)lds;
    const int wid = TIDX >> 6, lane = TIDX & 63;
    const bf16_t* proj = (const bf16_t*)(P.ws + WS_PROJ); const bf16_t* qraw = (const bf16_t*)(P.ws + WS_QRAW); const bf16_t* kvraw = (const bf16_t*)(P.ws + WS_KVRAW);
    bf16_t* qm = (bf16_t*)(P.ws + WS_QMLA); bf16_t* km = (bf16_t*)(P.ws + WS_KMLA);
    const float* cs = (const float*)(P.ws + WS_COS); const float* sn = (const float*)(P.ws + WS_SIN);
    const float* cloc = (const float*)(P.ws + WS_CLOC); const float* ctot = (const float*)(P.ws + WS_CTOT); float* cb2 = (float*)(P.ws + WS_CB2);
    const float gqa = P.mla_gq[layer * 96 + lane], gqb = lane < 32 ? P.mla_gq[layer * 96 + 64 + lane] : 0.f;
    const float gka = P.mla_gk[layer * 96 + lane], gkb = lane < 32 ? P.mla_gk[layer * 96 + 64 + lane] : 0.f;
    for (int chunk = BIDX; chunk < T / 128; chunk += GDIM) {
        const int b = (chunk * 128) / SEQ, t0 = (chunk * 128) % SEQ, ci = chunk % 32;
        if (TIDX < 6) { float s = 0.f; for (int c = 0; c < ci; ++c) s += ctot[(b * 32 + c) * 8 + TIDX]; pref[TIDX] = s; }
        __syncthreads();
        for (int e = TIDX; e < 6 * 128; e += 512) { const int h = e / 128, j = e % 128; const size_t ix = ((size_t)b * 6 + h) * SEQ + t0 + j; cb2[ix] = (cloc[ix] + pref[h]) * LOG2E; }
        for (int i = 0; i < 16; ++i) {
            const int row = chunk * 128 + wid * 16 + i;
            const float cv = cs[(size_t)row * 16 + (lane & 15)], sv = sn[(size_t)row * 16 + (lane & 15)];
#pragma unroll
            for (int h = 0; h < 6; ++h) {
                {
                    const float a = bf2f(qraw[(size_t)row * 768 + h * 96 + lane]); const float bq = lane < 32 ? bf2f(qraw[(size_t)row * 768 + h * 96 + 64 + lane]) : 0.f;
                    const float r = rsqrtf(wsum(a * a + bq * bq, lane) * (1.f / 96.f) + EPS);
                    const float an = a * r * gqa, bn = bq * r * gqb; const float pn = shx(bn, 16, lane);
                    const float ro = lane < 16 ? bn * cv - pn * sv : pn * sv + bn * cv;
                    qm[(size_t)row * 576 + h * 96 + lane] = f2bf(an * C2_MLA); if (lane < 32) qm[(size_t)row * 576 + h * 96 + 64 + lane] = f2bf(ro * C2_MLA);
                }
                {
                    const float a = bf2f(kvraw[(size_t)row * 768 + h * 128 + lane]); const float bk = lane < 32 ? bf2f(proj[(size_t)row * PJ + PC_KR + lane]) : 0.f;
                    const float r = rsqrtf(wsum(a * a + bk * bk, lane) * (1.f / 96.f) + EPS);
                    const float an = a * r * gka, bn = bk * r * gkb; const float pn = shx(bn, 16, lane);
                    const float ro = lane < 16 ? bn * cv - pn * sv : pn * sv + bn * cv;
                    km[(size_t)row * 576 + h * 96 + lane] = f2bf(an); if (lane < 32) km[(size_t)row * 576 + h * 96 + 64 + lane] = f2bf(ro);
                }
            }
        }
        __syncthreads();
    }
}

template <int DQK, int MODE>
__device__ __forceinline__ void ph_attn_naive(unsigned char* lds, Params P, const bf16_t* Q, int ldq, const bf16_t* K, int ldk, const bf16_t* V, int ldv, int vhs, bf16_t* O, int ldo, const float* cb2, int chk) {
    const int TIDX = hidden_tid(P.wid), BIDX = launder_i((int)blockIdx.x), GDIM = launder_i((int)gridDim.x); P.ws = launder_ptr(P.ws); P.out = launder_ptr(P.out);
    float (*Ks)[DQK] = (float (*)[DQK])lds; float (*Vs)[64] = (float (*)[64])(lds + 64 * DQK * 4); float* cbs = (float*)(lds + 64 * DQK * 4 + 64 * 64 * 4);
    const int tid = TIDX;
    Chk ck{0.f, 0.f};
    for (int item = BIDX; item < NB * 6 * 8; item += GDIM) {
        const int qb = 7 - (item / 48), bh = item % 48, b = bh / 6, h = bh % 6;
        const int q = qb * 512 + tid; const size_t rowq = (size_t)b * SEQ + q;
        float qv[DQK], o[64];
#pragma unroll
        for (int d = 0; d < DQK; ++d) qv[d] = bf2f(Q[rowq * ldq + h * DQK + d]);
#pragma unroll
        for (int d = 0; d < 64; ++d) o[d] = 0.f;
        float m = -INFINITY, l = 0.f;
        const float* cbp = MODE == 1 ? cb2 + ((size_t)b * 6 + h) * SEQ : nullptr;
        const int kend = qb * 512 + 512;
        for (int k0 = 0; k0 < kend; k0 += 64) {
            __syncthreads();
            for (int e = tid; e < 64 * DQK; e += 512) { const int j = e / DQK, d = e % DQK; Ks[j][d] = bf2f(K[((size_t)b * SEQ + k0 + j) * ldk + h * DQK + d]); }
            for (int e = tid; e < 64 * 64; e += 512) { const int j = e >> 6, d = e & 63; Vs[j][d] = bf2f(V[((size_t)b * SEQ + k0 + j) * ldv + h * vhs + d]); }
            if (MODE == 1 && tid < 64) cbs[tid] = cbp[k0 + tid];
            __syncthreads();
            for (int j = 0; j < 64; ++j) {
                const int key = k0 + j;
                const bool ok = MODE == 0 ? ((key >> 6) <= (q >> 6)) : (key <= q);
                if (ok) {
                    float s = 0.f;
#pragma unroll
                    for (int d = 0; d < DQK; d += 4) { const f32x4 kk = *(const f32x4*)&Ks[j][d]; s += qv[d] * kk[0] + qv[d + 1] * kk[1] + qv[d + 2] * kk[2] + qv[d + 3] * kk[3]; }
                    if (MODE == 1) s -= cbs[j];
                    if (s > m) { const float f = exp2f(m - s); l *= f;
#pragma unroll
                        for (int d = 0; d < 64; ++d) o[d] *= f;
                        m = s; }
                    const float p = exp2f(s - m); l += p;
#pragma unroll
                    for (int d = 0; d < 64; d += 4) { const f32x4 vv = *(const f32x4*)&Vs[j][d]; o[d] += p * vv[0]; o[d + 1] += p * vv[1]; o[d + 2] += p * vv[2]; o[d + 3] += p * vv[3]; }
                }
            }
        }
        const float il = 1.f / l;
#pragma unroll
        for (int d = 0; d < 64; d += 2) st2(O + rowq * ldo + h * 64 + d, o[d] * il, o[d + 1] * il, chk, ck);
    }
    if (chk) chk_commit(P, chk, ck);
}

__device__ __forceinline__ void ph_ssm_naive(unsigned char* lds, Params P, int layer, int chk) {
    const int TIDX = hidden_tid(P.wid), BIDX = launder_i((int)blockIdx.x), GDIM = launder_i((int)gridDim.x); P.ws = launder_ptr(P.ws); P.out = launder_ptr(P.out);
    float (*smy)[16 * 64] = (float (*)[16 * 64])lds;
    const int wid = TIDX >> 6, lane = TIDX & 63;
    float* sm = smy[wid];
    const bf16_t* proj = (const bf16_t*)(P.ws + WS_PROJ); bf16_t* yg = (bf16_t*)(P.ws + WS_YG);
    Chk ck{0.f, 0.f};
    for (int item = BIDX * 8 + wid; item < NB * 16; item += GDIM * 8) {
        const int b = item / 16, g = item % 16, p = lane;
        const size_t gp = ((size_t)layer * 16 + g) * 64 + p;
        const float lre = P.lam_re[gp], lim = P.lam_im[gp], dt = expf(P.log_dt[layer * 16 + g]);
        const float a_ = lre * dt, b_ = lim * dt; float sb_, cb_; sincosf(b_, &sb_, &cb_); const float sh_ = sinf(0.5f * b_);
        const float er = expf(a_), lbr = er * cb_, lbi = er * sb_;
        const float nr = expm1f(a_) * cb_ - 2.f * sh_ * sh_, ni = lbi;
        const float dd = lre * lre + lim * lim, qr = (nr * lre + ni * lim) / dd, qi = (ni * lre - nr * lim) / dd;
        float bbr[16], bbi[16], cr[16], ci[16];
#pragma unroll
        for (int c = 0; c < 16; ++c) {
            const float bre = P.b_re[gp * 16 + c], bim = P.b_im[gp * 16 + c];
            bbr[c] = qr * bre - qi * bim; bbi[c] = qr * bim + qi * bre;
            cr[c] = P.c_re[(((size_t)layer * 16 + g) * 16 + c) * 64 + p]; ci[c] = P.c_im[(((size_t)layer * 16 + g) * 16 + c) * 64 + p];
        }
        const float lr = lbr, li = lbi;
        const float dsk = P.ssm_d[layer * 256 + g * 16 + (lane & 15)];
        float sr = 0.f, si = 0.f;
        for (int t = 0; t < SEQ; ++t) {
            const size_t row = (size_t)b * SEQ + t;
            const bf16_t* up = proj + row * PJ + g * 16;
            const u32x4 w0 = *(const u32x4*)up, w1 = *(const u32x4*)(up + 8);
            const unsigned ww[8] = {w0.x, w0.y, w0.z, w0.w, w1.x, w1.y, w1.z, w1.w};
            float bur = 0.f, bui = 0.f;
#pragma unroll
            for (int c = 0; c < 16; ++c) { const float u = (c & 1) ? bf2f(ww[c >> 1] >> 16) : bf2f(ww[c >> 1] & 0xffff); bur = fmaf(bbr[c], u, bur); bui = fmaf(bbi[c], u, bui); }
            const float nsr = lr * sr - li * si + bur, nsi = lr * si + li * sr + bui; sr = nsr; si = nsi;
#pragma unroll
            for (int c = 0; c < 16; ++c) sm[c * 64 + lane] = cr[c] * sr - ci[c] * si;
            asm volatile("s_waitcnt lgkmcnt(0)" ::: "memory");
            const int cc = lane & 15, qd = lane >> 4; float part = 0.f;
#pragma unroll
            for (int j = 0; j < 16; ++j) part += sm[cc * 64 + qd * 16 + j];
            part += shx(part, 16, lane); part += shx(part, 32, lane);
            asm volatile("s_waitcnt lgkmcnt(0)" ::: "memory");
            if (lane < 16) { const float uv = bf2f(up[lane]); const float yv = gelu_tanh(part + dsk * uv); bf16_t* dst = yg + row * 256 + g * 16 + lane;
                if (!chk) *dst = f2bf(yv); else chk_upd(ck, yv, bf2f(*dst)); }
        }
    }
    if (chk) chk_commit(P, chk, ck);
}

__device__ __forceinline__ void ph_glu_naive(unsigned char* lds, Params P, int layer, int chk) {
    const int TIDX = hidden_tid(P.wid), BIDX = launder_i((int)blockIdx.x), GDIM = launder_i((int)gridDim.x); P.ws = launder_ptr(P.ws); P.out = launder_ptr(P.out);
    float* sm = (float*)lds;
    const bf16_t* yg = (const bf16_t*)(P.ws + WS_YG); bf16_t* os = (bf16_t*)(P.ws + WS_OSSM);
    const float* w = P.w_glu + (size_t)layer * 256 * 256; const float* bg = P.b_glu + layer * 256;
    Chk ck{0.f, 0.f};
    naive_gemm(T, 256, 256,
        [&](int r, int k) { return bf2f(yg[(size_t)r * 256 + k]); },
        [&](int) { return 0; },
        [&](int k, int col, int) { return w[(size_t)k * 256 + col]; },
        [&](int r, int c0, const float (&v)[4]) {
            float o[4];
#pragma unroll
            for (int j = 0; j < 4; ++j) o[j] = bf2f(yg[(size_t)r * 256 + c0 + j]) * sigmoid_f(v[j] + bg[c0 + j]);
            st4(os + (size_t)r * 256 + c0, o, chk, ck); }, sm);
    if (chk) chk_commit(P, chk, ck);
}

__device__ __forceinline__ void ph_merge(unsigned char* lds, Params P) {
    const int TIDX = hidden_tid(P.wid), BIDX = launder_i((int)blockIdx.x), GDIM = launder_i((int)gridDim.x); P.ws = launder_ptr(P.ws); P.out = launder_ptr(P.out);
    const int wid = TIDX >> 6, lane = TIDX & 63;
    const bf16_t* os = (const bf16_t*)(P.ws + WS_OSSM); const bf16_t* ob = (const bf16_t*)(P.ws + WS_OBUF); bf16_t* hb = (bf16_t*)(P.ws + WS_HBUF);
    constexpr int NR = 8;
    const int RPW = (T + GDIM * 8 - 1) / (GDIM * 8), rbeg = (BIDX * 8 + wid) * RPW;
    for (int j0 = 0; j0 < RPW; j0 += NR) {
        u32x2 ws_[NR]; unsigned wo[NR][6];
#pragma unroll
        for (int k = 0; k < NR; ++k) { const int row = rbeg + j0 + k;
            if (j0 + k < RPW && row < T) { ws_[k] = *(const u32x2*)(os + (size_t)row * 256 + lane * 4);
#pragma unroll
                for (int part = 0; part < 2; ++part) { const bf16_t* src = ob + (size_t)row * 768 + part * 384 + lane * 6; wo[k][part * 3] = *(const unsigned*)src; wo[k][part * 3 + 1] = *(const unsigned*)(src + 2); wo[k][part * 3 + 2] = *(const unsigned*)(src + 4); } } }
#pragma unroll
        for (int k = 0; k < NR; ++k) { const int row = rbeg + j0 + k;
            if (j0 + k < RPW && row < T) {
                { const u32x2 w = ws_[k]; const float a = bf2f(w.x & 0xffff), b = bf2f(w.x >> 16), c = bf2f(w.y & 0xffff), d = bf2f(w.y >> 16);
                  const float r = rsqrtf(wsum(a * a + b * b + c * c + d * d, lane) * (1.f / 256.f) + EPS); u32x2 o; o.x = pk2(a * r, b * r); o.y = pk2(c * r, d * r); *(u32x2*)(hb + (size_t)row * D + lane * 4) = o; }
#pragma unroll
                for (int part = 0; part < 2; ++part) {
                    const unsigned w0 = wo[k][part * 3], w1 = wo[k][part * 3 + 1], w2 = wo[k][part * 3 + 2];
                    const float v[6] = {bf2f(w0 & 0xffff), bf2f(w0 >> 16), bf2f(w1 & 0xffff), bf2f(w1 >> 16), bf2f(w2 & 0xffff), bf2f(w2 >> 16)};
                    float ss = 0.f;
#pragma unroll
                    for (int j = 0; j < 6; ++j) ss += v[j] * v[j];
                    const float r = rsqrtf(wsum(ss, lane) * (1.f / 384.f) + EPS);
                    unsigned* dst = (unsigned*)(hb + (size_t)row * D + 256 + part * 384 + lane * 6);
                    dst[0] = pk2(v[0] * r, v[1] * r); dst[1] = pk2(v[2] * r, v[3] * r); dst[2] = pk2(v[4] * r, v[5] * r);
                }
            }
        }
    }
}

__device__ __forceinline__ void ph_outproj_naive(unsigned char* lds, Params P, int layer, float* dst, int chk) {
    const int TIDX = hidden_tid(P.wid), BIDX = launder_i((int)blockIdx.x), GDIM = launder_i((int)gridDim.x); P.ws = launder_ptr(P.ws); P.out = launder_ptr(P.out);
    float* sm = (float*)lds;
    const bf16_t* hb = (const bf16_t*)(P.ws + WS_HBUF); const float* w = P.w_out + (size_t)layer * D * D; const float* g = P.out_norm + layer * D;
    Chk ck{0.f, 0.f};
    naive_gemm(T, D, D,
        [&](int r, int k) { return bf2f(hb[(size_t)r * D + k]); },
        [&](int) { return 0; },
        [&](int k, int col, int) { return g[k] * w[(size_t)k * D + col]; },
        [&](int r, int c0, const float (&v)[4]) {
            const float* g1 = adap(P, layer, r / SEQ, 2) + c0; f32x4 xv = *(const f32x4*)(P.out + (size_t)r * D + c0);
#pragma unroll
            for (int j = 0; j < 4; ++j) { const float dl = g1[j] * v[j]; xv[j] += dl; ck.r = fmaxf(ck.r, fabsf(dl)); }
            *(f32x4*)(dst + (size_t)r * D + c0) = xv; }, sm);
    if (chk) chk_commit(P, chk, ck);
}

__device__ __forceinline__ void ph_ffn1_naive(unsigned char* lds, Params P, int layer, int chk) {
    const int TIDX = hidden_tid(P.wid), BIDX = launder_i((int)blockIdx.x), GDIM = launder_i((int)gridDim.x); P.ws = launder_ptr(P.ws); P.out = launder_ptr(P.out);
    float* sm = (float*)lds;
    const bf16_t* hb = (const bf16_t*)(P.ws + WS_HBUF); bf16_t* act = (bf16_t*)(P.ws + WS_ACT);
    const float* wg = P.ffn_wg + (size_t)(layer / 2) * D * DFF; const float* wu = P.ffn_wu + (size_t)(layer / 2) * D * DFF;
    Chk ck{0.f, 0.f};
    naive_gemm(T, 2 * DFF, D,
        [&](int r, int k) { return bf2f(hb[(size_t)r * D + k]); },
        [&](int) { return 0; },
        [&](int k, int col, int) { return (col & 1) ? wu[(size_t)k * DFF + (col >> 1)] : wg[(size_t)k * DFF + (col >> 1)]; },
        [&](int r, int c0, const float (&v)[4]) { st2(act + (size_t)r * DFF + (c0 >> 1), silu_f(v[0]) * v[1], silu_f(v[2]) * v[3], chk, ck); }, sm);
    if (chk) chk_commit(P, chk, ck);
}
__device__ __forceinline__ void ph_ffn2_naive(unsigned char* lds, Params P, int layer, float* dst, int chk) {
    const int TIDX = hidden_tid(P.wid), BIDX = launder_i((int)blockIdx.x), GDIM = launder_i((int)gridDim.x); P.ws = launder_ptr(P.ws); P.out = launder_ptr(P.out);
    float* sm = (float*)lds;
    const bf16_t* act = (const bf16_t*)(P.ws + WS_ACT); const float* w = P.ffn_wd + (size_t)(layer / 2) * DFF * D;
    Chk ck{0.f, 0.f};
    naive_gemm(T, D, DFF,
        [&](int r, int k) { return bf2f(act[(size_t)r * DFF + k]); },
        [&](int) { return 0; },
        [&](int k, int col, int) { return w[(size_t)k * D + col]; },
        [&](int r, int c0, const float (&v)[4]) {
            const float* g2 = adap(P, layer, r / SEQ, 5) + c0; f32x4 xv = *(const f32x4*)(P.out + (size_t)r * D + c0);
#pragma unroll
            for (int j = 0; j < 4; ++j) { const float dl = g2[j] * v[j]; xv[j] += dl; ck.r = fmaxf(ck.r, fabsf(dl)); }
            *(f32x4*)(dst + (size_t)r * D + c0) = xv; }, sm);
    if (chk) chk_commit(P, chk, ck);
}
__device__ __forceinline__ void ph_cmp_x(unsigned char* lds, Params P, const float* xe, int stage) {
    const int TIDX = hidden_tid(P.wid), BIDX = launder_i((int)blockIdx.x), GDIM = launder_i((int)gridDim.x); P.ws = launder_ptr(P.ws); P.out = launder_ptr(P.out);
    Chk ck{0.f, 0.f};
    for (size_t i = (size_t)BIDX * 512 + TIDX; i < (size_t)T * D / 4; i += (size_t)GDIM * 512) {
        const f32x4 a = ((const f32x4*)P.out)[i], b = ((const f32x4*)xe)[i];
#pragma unroll
        for (int j = 0; j < 4; ++j) { const float d = fabsf(a[j] - b[j]); ck.e = (d != d) ? INFINITY : fmaxf(ck.e, d); }
    }
    chk_commit(P, stage, ck);
}

__device__ __forceinline__ void ph_moe_gather(unsigned char* lds, Params P, int layer) {
    const int TIDX = hidden_tid(P.wid), BIDX = launder_i((int)blockIdx.x), GDIM = launder_i((int)gridDim.x); P.ws = launder_ptr(P.ws); P.out = launder_ptr(P.out);
    const int wid = TIDX >> 6, lane = TIDX & 63;
    int off[NEXP + 1]; moe_offsets(P, layer, off);
    int* p2e = (int*)(P.ws + WS_P2E);
    if (BIDX == 0) {
        for (int pnl = TIDX; pnl < 272; pnl += 512) { int e = 0;
#pragma unroll
            for (int j = 1; j < NEXP; ++j) if (pnl * 256 >= off[j]) e = j;
            p2e[pnl] = e; }
        if (TIDX == 0) p2e[300] = off[NEXP] >> 8;
    }
    const bf16_t* hb = (const bf16_t*)(P.ws + WS_HBUF); bf16_t* hg = (bf16_t*)(P.ws + WS_HG);
    const int* ti = (const int*)(P.ws + WS_TOKINFO); int* so = (int*)(P.ws + WS_SLOTOF);
    for (int row = BIDX * 8 + wid; row < T; row += GDIM * 8) {
        const u32x4 v0 = *(const u32x4*)(hb + (size_t)row * D + lane * 8), v1 = *(const u32x4*)(hb + (size_t)row * D + 512 + lane * 8);
#pragma unroll
        for (int k = 0; k < 2; ++k) {
            const int e = ti[(size_t)row * 4 + 2 * k], pos = ti[(size_t)row * 4 + 2 * k + 1];
            int base = 0;
#pragma unroll
            for (int j = 0; j < NEXP; ++j) if (e == j) base = off[j];
            const int slot = base + pos;
            *(u32x4*)(hg + (size_t)slot * D + lane * 8) = v0; *(u32x4*)(hg + (size_t)slot * D + 512 + lane * 8) = v1;
            if (lane == 0) so[(size_t)row * 2 + k] = slot;
        }
    }
}
__device__ __forceinline__ void ph_moe1_naive(unsigned char* lds, Params P, int layer, int chk) {
    const int TIDX = hidden_tid(P.wid), BIDX = launder_i((int)blockIdx.x), GDIM = launder_i((int)gridDim.x); P.ws = launder_ptr(P.ws); P.out = launder_ptr(P.out);
    float* sm = (float*)lds;
    const bf16_t* hg = (const bf16_t*)(P.ws + WS_HG); bf16_t* act = (bf16_t*)(P.ws + WS_ACTM); const int* p2e = (const int*)(P.ws + WS_P2E);
    const float* wg = P.moe_wg + (size_t)(layer / 2) * NEXP * D * DFE; const float* wu = P.moe_wu + (size_t)(layer / 2) * NEXP * D * DFE;
    const int M = p2e[300] * 256;
    Chk ck{0.f, 0.f};
    naive_gemm(M, 2 * DFE, D,
        [&](int r, int k) { return bf2f(hg[(size_t)r * D + k]); },
        [&](int bm) { return p2e[bm >> 8]; },
        [&](int k, int col, int e) { const size_t o = ((size_t)e * D + k) * DFE + (col >> 1); return (col & 1) ? wu[o] : wg[o]; },
        [&](int r, int c0, const float (&v)[4]) { st2(act + (size_t)r * DFE + (c0 >> 1), silu_f(v[0]) * v[1], silu_f(v[2]) * v[3], chk, ck); }, sm);
    if (chk) chk_commit(P, chk, ck);
}
__device__ __forceinline__ void ph_moe2_naive(unsigned char* lds, Params P, int layer, int chk) {
    const int TIDX = hidden_tid(P.wid), BIDX = launder_i((int)blockIdx.x), GDIM = launder_i((int)gridDim.x); P.ws = launder_ptr(P.ws); P.out = launder_ptr(P.out);
    float* sm = (float*)lds;
    const bf16_t* act = (const bf16_t*)(P.ws + WS_ACTM); bf16_t* ym = (bf16_t*)(P.ws + WS_HG); const int* p2e = (const int*)(P.ws + WS_P2E);
    const float* wd = P.moe_wd + (size_t)(layer / 2) * NEXP * DFE * D;
    const int M = p2e[300] * 256;
    Chk ck{0.f, 0.f};
    naive_gemm(M, D, DFE,
        [&](int r, int k) { return bf2f(act[(size_t)r * DFE + k]); },
        [&](int bm) { return p2e[bm >> 8]; },
        [&](int k, int col, int e) { return wd[((size_t)e * DFE + k) * D + col]; },
        [&](int r, int c0, const float (&v)[4]) { st4(ym + (size_t)r * D + c0, v, chk, ck); }, sm);
    if (chk) chk_commit(P, chk, ck);
}
__device__ __forceinline__ void ph_moe_combine(unsigned char* lds, Params P, int layer) {
    const int TIDX = hidden_tid(P.wid), BIDX = launder_i((int)blockIdx.x), GDIM = launder_i((int)gridDim.x); P.ws = launder_ptr(P.ws); P.out = launder_ptr(P.out);
    const int wid = TIDX >> 6, lane = TIDX & 63;
    const bf16_t* ym = (const bf16_t*)(P.ws + ymoe_off(layer)); const bf16_t* xs = xstream(P, DEPTH); const int* ti = (const int*)(P.ws + WS_TOKINFO); const float* pr = (const float*)(P.ws + WS_PROB);
    int off_[NEXP + 1]; moe_offsets(P, layer, off_);
    constexpr int NR = 4;
    const int RPW = (T + GDIM * 8 - 1) / (GDIM * 8), rbeg = (BIDX * 8 + wid) * RPW;
    for (int j0 = 0; j0 < RPW; j0 += NR) {
        int s0[NR], s1[NR]; float p0[NR], p1[NR]; u32x2 xw[NR][4], ya[NR][4], yb[NR][4];
#pragma unroll
        for (int k = 0; k < NR; ++k) { const int row = rbeg + j0 + k;
            if (j0 + k < RPW && row < T) { const int* ti_ = ti + (size_t)row * 4; s0[k] = moe_sel(off_, ti_[0]) + ti_[1]; s1[k] = moe_sel(off_, ti_[2]) + ti_[3]; p0[k] = pr[(size_t)row * 2]; p1[k] = pr[(size_t)row * 2 + 1];
#pragma unroll
                for (int q = 0; q < 4; ++q) xw[k][q] = *(const u32x2*)(xs + (size_t)row * D + q * 256 + lane * 4); } }
#pragma unroll
        for (int k = 0; k < NR; ++k) { const int row = rbeg + j0 + k;
            if (j0 + k < RPW && row < T) {
#pragma unroll
                for (int q = 0; q < 4; ++q) { ya[k][q] = *(const u32x2*)(ym + (size_t)s0[k] * D + q * 256 + lane * 4); yb[k][q] = *(const u32x2*)(ym + (size_t)s1[k] * D + q * 256 + lane * 4); } } }
#pragma unroll
        for (int k = 0; k < NR; ++k) { const int row = rbeg + j0 + k;
            if (j0 + k < RPW && row < T) {
                const float* g2 = adap(P, layer, row / SEQ, 5);
#pragma unroll
                for (int q = 0; q < 4; ++q) { const int col = q * 256 + lane * 4;
                    const u32x2 a = ya[k][q], b = yb[k][q], x = xw[k][q]; const f32x4 g = *(const f32x4*)(g2 + col);
                    f32x4 xv = {bf2f(x.x & 0xffff), bf2f(x.x >> 16), bf2f(x.y & 0xffff), bf2f(x.y >> 16)};
                    xv[0] += g[0] * (p0[k] * bf2f(a.x & 0xffff) + p1[k] * bf2f(b.x & 0xffff)); xv[1] += g[1] * (p0[k] * bf2f(a.x >> 16) + p1[k] * bf2f(b.x >> 16));
                    xv[2] += g[2] * (p0[k] * bf2f(a.y & 0xffff) + p1[k] * bf2f(b.y & 0xffff)); xv[3] += g[3] * (p0[k] * bf2f(a.y >> 16) + p1[k] * bf2f(b.y >> 16));
                    *(f32x4*)(P.out + (size_t)row * D + col) = xv; } } }
    }
}
__device__ __forceinline__ void ph_check_final(unsigned char* lds, Params P) {
    const int TIDX = hidden_tid(P.wid), BIDX = launder_i((int)blockIdx.x), GDIM = launder_i((int)gridDim.x); P.ws = launder_ptr(P.ws); P.out = launder_ptr(P.out);
    const unsigned* ctl = (const unsigned*)(P.ws + WS_CTL);
    int code = 0;
    for (int s = 31; s >= 1; --s) { const float e = __uint_as_float(ctl[CW_CHKE + s]), r = __uint_as_float(ctl[CW_CHKR + s]); if (!(e <= 0.04f * r)) code = s; }
    if (code == 0) return;
    const float sc = 1.f + 0.1f * code;
    for (size_t i = (size_t)BIDX * 512 + TIDX; i < (size_t)T * D; i += (size_t)GDIM * 512) P.out[i] *= sc;
}

namespace pg8 {
#define PG8_LAS __attribute__((address_space(3)))
typedef short bf16x8 __attribute__((ext_vector_type(8)));
constexpr int BM = 256, BK = 64, HALF = 128, HTB = HALF * BK * 2  , STAGE_BYTES = 8 * HTB, NXCD = 8, WGM = 8;
__host__ __device__ __forceinline__ int lds_byte(int r, int c) { const int st = (r >> 4) * 2 + (c >> 5), rr = r & 15, cc = c & 31, ob = rr * 64 + cc * 2; return st * 1024 + (ob ^ (((ob >> 9) & 1) << 5)); }
__host__ __device__ __forceinline__ void stage_rc(int b, int& R, int& C) { const int st = b / 1024, sb = b % 1024, swz = sb ^ (((sb >> 9) & 1) << 5); R = (st >> 1) * 16 + swz / 64; C = (st & 1) * 32 + (swz % 64) / 2; }
__host__ __device__ __forceinline__ int perm32(int rho) { const int n = rho >> 4, i = rho & 15; return 8 * (i >> 2) + 4 * n + (i & 3); }
struct Unit { int pm, pn; };
struct Gemm { const bf16_t* A; const bf16_t* Bt; int lda, ldb, K, wid; };
struct StaticOrder {
    static constexpr bool GATHER = false;
    int nM, nN, nwg, G, c;
    __host__ __device__ void init(int M, int N, int G_, int c_) { nM = M / BM; nN = N / BM; nwg = nM * nN; G = G_; c = c_; }
    __host__ __device__ bool next(int i, Unit& u) const {
        const long L = (long)i * G + c; if (L >= nwg) return false;
        int wgid = (int)L; { const int q = nwg / NXCD, r = nwg % NXCD, xcd = wgid % NXCD, off = wgid / NXCD; wgid = (xcd < r ? xcd * (q + 1) : r * (q + 1) + (xcd - r) * q) + off; }
        const int nig = WGM * nN, gid = wgid / nig, fm = gid * WGM, gsz = (nM - fm) < WGM ? (nM - fm) : WGM;
        u.pm = fm + ((wgid % nig) % gsz); u.pn = (wgid % nig) / gsz; return true;
    }
    __device__ __forceinline__ void a_ready(const Unit&) const {}
    __device__ __forceinline__ void done(const Unit&) const {}
};
template <class F> struct ListOrder {
    static constexpr bool GATHER = false;
    int n, G, c; F f;
    __device__ __forceinline__ bool next(int i, Unit& u) const { const long L = (long)i * G + c; if (L >= n) return false; f((int)L, u); return true; }
    __device__ __forceinline__ void a_ready(const Unit&) const {}
    __device__ __forceinline__ void done(const Unit&) const {}
};
__device__ __forceinline__ unsigned cvt_pk_bf16(float lo, float hi) { unsigned r; asm volatile("v_cvt_pk_bf16_f32 %0, %1, %2" : "=v"(r) : "v"(lo), "v"(hi)); return r; }
__device__ __forceinline__ u32x4 pack8(const f32x4 a, const f32x4 b) { u32x4 w; w.x = cvt_pk_bf16(a[0], a[1]); w.y = cvt_pk_bf16(a[2], a[3]); w.z = cvt_pk_bf16(b[0], b[1]); w.w = cvt_pk_bf16(b[2], b[3]); return w; }

template <class T, class = void> struct epi_kscale { static constexpr bool value = false; };
template <class T> struct epi_kscale<T, decltype((void)T::KSCALE)> { static constexpr bool value = T::KSCALE; };
__device__ __forceinline__ void kscale_rows(PG8_LAS unsigned char* lds, f32x4 (&acc)[2][2][4][2], int ui, int which, int wr, int) {
    const int fr = hidden_tid(0) & 15;
    const PG8_LAS float* tb = (const PG8_LAS float*)(lds + 132096) + (launder_i(ui) * 3 + which) * 256 + wr * 64 + fr;
#pragma unroll
    for (int ai = 0; ai < 2; ++ai)
#pragma unroll
        for (int m = 0; m < 4; ++m) { const float sc = tb[ai * 128 + m * 16];
#pragma unroll
            for (int bj = 0; bj < 2; ++bj)
#pragma unroll
                for (int n = 0; n < 2; ++n) acc[ai][bj][m][n] = acc[ai][bj][m][n] * sc; }
}
template <class Epi, class Sched, bool ALIGN_EPI = false, bool SP2 = false>
__device__ __forceinline__ void gemm_phase(PG8_LAS unsigned char* lds, const Gemm g, const Sched& S, const Epi& E) {
    const int tid = hidden_tid(g.wid), wid = __builtin_amdgcn_readfirstlane(tid >> 6), lane = tid & 63, wr = wid >> 2, wc = wid & 3, fr = lane & 15, fq = lane >> 4;
    const int K = launder_i(g.K), nt = K / BK;
    unsigned voffA[2], voffB[2]; int gR[2], gC[2];
#pragma unroll
    for (int i = 0; i < 2; ++i) { int R, C; stage_rc(tid * 16 + i * 8192, R, C); const int Rb = Epi::PERM ? ((R & ~31) + perm32(R & 31)) : R;
        voffA[i] = (unsigned)(R * g.lda + C) * 2u; voffB[i] = (unsigned)(Rb * g.ldb + C) * 2u; gR[i] = R; gC[i] = C * 2; }
    const size_t kstep = (size_t)(BK * 2);
    const size_t hstepA = Sched::GATHER ? 0 : (size_t)HALF * g.lda * 2, hstepB = (size_t)HALF * g.ldb * 2;
    const size_t tstepA = 2 * hstepA, tstepB = 2 * hstepB;
    const unsigned ldsw = (unsigned)wid * 1024u;
    const int aoff = lds_byte(wr * 64 + fr, fq * 8), boff = lds_byte(wc * 32 + fr, fq * 8);
#define PG8_SA(b, h) (((b) * 2 + (h)) * HTB)
#define PG8_SB(b, h) ((4 + (b) * 2 + (h)) * HTB)
#define PG8_STAGE(bufoff, gbase, voff) do { _Pragma("unroll") for (int _i = 0; _i < 2; ++_i) \
        __builtin_amdgcn_global_load_lds((const unsigned*)((const char*)(gbase) + (voff)[_i]), (PG8_LAS unsigned*)(lds + (bufoff) + ldsw + _i * 8192), 16, 0, 0); } while (0)
#define PG8_LDA(dst, b, h) do { _Pragma("unroll") for (int m = 0; m < 4; ++m) _Pragma("unroll") for (int k = 0; k < 2; ++k) dst[m][k] = *(const PG8_LAS bf16x8*)(lds + PG8_SA(b, h) + aoff + m * 2048 + k * 1024); } while (0)
#define PG8_LDB(dst, b, h) do { _Pragma("unroll") for (int n = 0; n < 2; ++n) _Pragma("unroll") for (int k = 0; k < 2; ++k) dst[n][k] = *(const PG8_LAS bf16x8*)(lds + PG8_SB(b, h) + boff + n * 2048 + k * 1024); } while (0)
#define PG8_MMA(ai, bj, At, Bt) do { __builtin_amdgcn_s_setprio(1); _Pragma("unroll") for (int m = 0; m < 4; ++m) _Pragma("unroll") for (int n = 0; n < 2; ++n) _Pragma("unroll") for (int k = 0; k < 2; ++k) \
        acc[ai][bj][m][n] = __builtin_amdgcn_mfma_f32_16x16x32_bf16(Bt[n][k], At[m][k], acc[ai][bj][m][n], 0, 0, 0); __builtin_amdgcn_s_setprio(0); } while (0)
#define PG8_WAIT_V(n) asm volatile("s_waitcnt vmcnt(" #n ")" ::: "memory")
#define PG8_WAIT_L(n) asm volatile("s_waitcnt lgkmcnt(" #n ")" ::: "memory")
#define PG8_BAR __builtin_amdgcn_s_barrier()
#define PG8_SCHED __builtin_amdgcn_sched_barrier(0)
    Unit cur, nxt; int ui = 0;
    if (!S.next(0, cur)) return;
    f32x4 acc[2][2][4][2];
#pragma unroll
    for (int a = 0; a < 2; ++a)
#pragma unroll
        for (int b = 0; b < 2; ++b)
#pragma unroll
            for (int m = 0; m < 4; ++m)
#pragma unroll
                for (int n = 0; n < 2; ++n) acc[a][b][m][n] = (f32x4){0.f, 0.f, 0.f, 0.f};
    bf16x8 At[4][2], B0[2][2], B1[2][2];
    const char* cA = (const char*)g.A + (size_t)cur.pm * tstepA; const char* cB = (const char*)g.Bt + (size_t)cur.pn * tstepB;
    unsigned vc0[2] = {0u, 0u}, vc1[2] = {0u, 0u}, w0[2] = {0u, 0u}, w1[2] = {0u, 0u};
    PG8_LAS u32x4* const vpark = (PG8_LAS u32x4*)(lds + 132096) + tid;
    if constexpr (Sched::GATHER) { static_assert(SP2, "row gather is wired into the SP2 loop only");
#pragma unroll
        for (int i = 0; i < 1; ++i) { S.rowoff4(cur, gR[0], vc0[0], vc0[1], vc1[0], vc1[1]); vc0[0] += (unsigned)gC[0]; vc0[1] += (unsigned)gC[0]; vc1[0] += (unsigned)gC[0]; vc1[1] += (unsigned)gC[0]; } }
#define PG8_STAGE_A(bufoff, gbase, half, v0, v1) do { if constexpr (Sched::GATHER) { if ((half) == 0) PG8_STAGE(bufoff, gbase, v0); else PG8_STAGE(bufoff, gbase, v1); } else PG8_STAGE(bufoff, (gbase) + (half) * hstepA, voffA); } while (0)
    S.a_ready(cur);
    if constexpr (SP2) {
        PG8_STAGE(PG8_SB(0, 0), cB, voffB); PG8_STAGE(PG8_SB(0, 1), cB + hstepB, voffB); PG8_STAGE_A(PG8_SA(0, 0), cA, 0, vc0, vc1); PG8_STAGE_A(PG8_SA(0, 1), cA, 1, vc0, vc1);
        if (wr == 1) PG8_BAR;
        PG8_WAIT_V(2); PG8_BAR;
        PG8_STAGE(PG8_SB(1, 0), cB + kstep, voffB); PG8_STAGE_A(PG8_SA(1, 0), cA + kstep, 0, vc0, vc1); PG8_STAGE(PG8_SB(1, 1), cB + hstepB + kstep, voffB);
        PG8_WAIT_V(6); PG8_BAR;
    } else {
        PG8_STAGE(PG8_SB(0, 0), cB, voffB); PG8_STAGE(PG8_SA(0, 0), cA, voffA); PG8_STAGE(PG8_SB(0, 1), cB + hstepB, voffB); PG8_STAGE(PG8_SA(0, 1), cA + hstepA, voffA);
        if (wr == 1) PG8_BAR;
        PG8_WAIT_V(4); PG8_BAR;
        PG8_STAGE(PG8_SB(1, 0), cB + kstep, voffB); PG8_STAGE(PG8_SA(1, 0), cA + kstep, voffA); PG8_STAGE(PG8_SB(1, 1), cB + hstepB + kstep, voffB);
        PG8_WAIT_V(6); PG8_BAR;
    }
    for (;;) {
        const bool has_next = S.next(ui + 1, nxt);
        if constexpr (Sched::GATHER) {
#pragma unroll
            for (int i = 0; i < 1; ++i) { if (has_next) { S.rowoff4(nxt, gR[0], w0[0], w0[1], w1[0], w1[1]); w0[0] += (unsigned)gC[0]; w0[1] += (unsigned)gC[0]; w1[0] += (unsigned)gC[0]; w1[1] += (unsigned)gC[0]; } else { w0[0] = vc0[0]; w0[1] = vc0[1]; w1[0] = vc1[0]; w1[1] = vc1[1]; } }
            *vpark = (u32x4){w0[0], w0[1], w1[0], w1[1]}; }
        const char* nA = has_next ? (const char*)g.A + (size_t)nxt.pm * tstepA : cA; const char* nB = has_next ? (const char*)g.Bt + (size_t)nxt.pn * tstepB : cB;
        for (int t = 0; t < nt; t += 2) {
            const bool last = (t == nt - 2);
            const char* a1 = cA + (size_t)(t + 1) * kstep;
            const char* a2 = last ? nA : cA + (size_t)(t + 2) * kstep; const char* b2 = last ? nB : cB + (size_t)(t + 2) * kstep;
            const char* a3 = a2 + kstep; const char* b3 = b2 + kstep;
            if constexpr (Sched::GATHER) { if (last) { const u32x4 q_ = *vpark; w0[0] = q_.x; w0[1] = q_.y; w1[0] = q_.z; w1[1] = q_.w; } else { w0[0] = vc0[0]; w0[1] = vc0[1]; w1[0] = vc1[0]; w1[1] = vc1[1]; } }
            if (last && has_next) S.a_ready(nxt);
            if constexpr (epi_kscale<Epi>::value) { if (t == Epi::KB0) kscale_rows(lds, acc, ui, 0, wr, fr); else if (t == Epi::KB1) kscale_rows(lds, acc, ui, 1, wr, fr); }
            if constexpr (SP2) {
            PG8_LDB(B0, 0, 0); PG8_LDB(B1, 0, 1); PG8_SCHED; PG8_LDA(At, 0, 0); PG8_STAGE_A(PG8_SA(1, 1), a1, 1, vc0, vc1);
            PG8_WAIT_V(8); PG8_WAIT_L(0); PG8_BAR; PG8_MMA(0, 0, At, B0); PG8_MMA(0, 1, At, B1); PG8_BAR; PG8_SCHED;
            PG8_LDA(At, 0, 1); PG8_STAGE(PG8_SB(0, 0), b2, voffB); PG8_STAGE(PG8_SB(0, 1), b2 + hstepB, voffB); PG8_STAGE_A(PG8_SA(0, 0), a2, 0, w0, w1);
            PG8_WAIT_V(8); PG8_WAIT_L(0); PG8_BAR; PG8_MMA(1, 0, At, B0); PG8_MMA(1, 1, At, B1); PG8_BAR; PG8_SCHED;
            PG8_LDB(B0, 1, 0); PG8_LDB(B1, 1, 1); PG8_SCHED; PG8_LDA(At, 1, 0); PG8_STAGE_A(PG8_SA(0, 1), a2, 1, w0, w1);
            PG8_WAIT_V(8); PG8_WAIT_L(0); PG8_BAR; PG8_MMA(0, 0, At, B0); PG8_MMA(0, 1, At, B1); PG8_BAR; PG8_SCHED;
            PG8_LDA(At, 1, 1); PG8_STAGE(PG8_SB(1, 0), b3, voffB); PG8_STAGE(PG8_SB(1, 1), b3 + hstepB, voffB); PG8_STAGE_A(PG8_SA(1, 0), a3, 0, w0, w1);
            PG8_WAIT_V(8); PG8_WAIT_L(0); PG8_BAR; PG8_MMA(1, 0, At, B0); PG8_MMA(1, 1, At, B1); PG8_BAR; PG8_SCHED;
            } else {
            PG8_LDB(B0, 0, 0); PG8_SCHED; PG8_LDA(At, 0, 0); PG8_STAGE(PG8_SA(1, 1), a1 + hstepA, voffA);
            PG8_WAIT_L(8); PG8_BAR; PG8_WAIT_L(0); PG8_MMA(0, 0, At, B0); PG8_BAR; PG8_SCHED;
            PG8_LDB(B1, 0, 1); PG8_STAGE(PG8_SB(0, 0), b2, voffB);
            PG8_BAR; PG8_WAIT_L(0); PG8_MMA(0, 1, At, B1); PG8_BAR;
            PG8_LDA(At, 0, 1); PG8_STAGE(PG8_SA(0, 0), a2, voffA);
            PG8_BAR; PG8_WAIT_L(0); PG8_MMA(1, 0, At, B0); PG8_BAR; PG8_SCHED;
            PG8_STAGE(PG8_SB(0, 1), b2 + hstepB, voffB);
            PG8_WAIT_V(6); PG8_BAR; PG8_MMA(1, 1, At, B1); PG8_BAR;
            PG8_LDB(B0, 1, 0); PG8_SCHED; PG8_LDA(At, 1, 0); PG8_STAGE(PG8_SA(0, 1), a2 + hstepA, voffA);
            PG8_WAIT_L(8); PG8_BAR; PG8_WAIT_L(0); PG8_MMA(0, 0, At, B0); PG8_BAR; PG8_SCHED;
            PG8_LDB(B1, 1, 1); PG8_STAGE(PG8_SB(1, 0), b3, voffB);
            PG8_BAR; PG8_WAIT_L(0); PG8_MMA(0, 1, At, B1); PG8_BAR;
            PG8_LDA(At, 1, 1); PG8_STAGE(PG8_SA(1, 0), a3, voffA);
            PG8_BAR; PG8_WAIT_L(0); PG8_MMA(1, 0, At, B0); PG8_BAR; PG8_SCHED;
            PG8_STAGE(PG8_SB(1, 1), b3 + hstepB, voffB);
            PG8_WAIT_V(6); PG8_BAR; PG8_MMA(1, 1, At, B1); PG8_BAR;
            }
        }
        if constexpr (epi_kscale<Epi>::value) kscale_rows(lds, acc, ui, 2, wr, fr);
        if constexpr (ALIGN_EPI) { if (wr == 0) PG8_BAR; }
        if constexpr (!Epi::AFTER_DRAIN) { E(acc, cur, wr, wc, fr, fq); S.done(cur); }
        if (!has_next) break;
#pragma unroll
        for (int a = 0; a < 2; ++a)
#pragma unroll
            for (int b = 0; b < 2; ++b)
#pragma unroll
                for (int m = 0; m < 4; ++m)
#pragma unroll
                    for (int n = 0; n < 2; ++n) acc[a][b][m][n] = (f32x4){0.f, 0.f, 0.f, 0.f};
        cur = nxt; cA = nA; cB = nB; ++ui;
        if constexpr (Sched::GATHER) { vc0[0] = w0[0]; vc0[1] = w0[1]; vc1[0] = w1[0]; vc1[1] = w1[1]; }
        if constexpr (ALIGN_EPI) { if (wr == 1) PG8_BAR; }
    }
    PG8_WAIT_V(0);
    if constexpr (!ALIGN_EPI) { if (wr == 0) PG8_BAR; }
    PG8_BAR;
    if constexpr (Epi::AFTER_DRAIN) { E.fused(acc, cur, wr, wc, fr, fq, lds, wid, lane); S.done(cur); }
#undef PG8_SA
#undef PG8_SB
#undef PG8_STAGE
#undef PG8_STAGE_A
#undef PG8_LDA
#undef PG8_LDB
#undef PG8_MMA
#undef PG8_WAIT_V
#undef PG8_WAIT_L
#undef PG8_BAR
#undef PG8_SCHED
}
}

using pg8::Unit;
#define GAS_ __attribute__((address_space(1)))
struct EpiStore {
    static constexpr bool PERM = true, AFTER_DRAIN = false;
    bf16_t* O; int ldc; const float* ssq; float inv_n; int pn_mod; int ncol;
    __device__ __forceinline__ void operator()(const f32x4 (&acc)[2][2][4][2], const Unit& u, int wr, int wc, int fr, int fq) const {
        const int row0 = u.pm * 256 + wr * 64 + fr, col0 = (u.pn % pn_mod) * 256 + wc * 32 + 8 * fq;
        float sc[2][4];
#pragma unroll
        for (int ai = 0; ai < 2; ++ai)
#pragma unroll
            for (int m = 0; m < 4; ++m) { sc[ai][m] = 1.f; if (ssq) { const f32x4 p4 = *(const GAS_ f32x4*)(ssq + (size_t)(row0 + ai * 128 + m * 16) * 4); sc[ai][m] = rsqrtf(((p4[0] + p4[1]) + (p4[2] + p4[3])) * inv_n + EPS); } }
#pragma unroll
        for (int ai = 0; ai < 2; ++ai)
#pragma unroll
            for (int m = 0; m < 4; ++m) { const float s = sc[ai][m]; GAS_ bf16_t* rp = (GAS_ bf16_t*)O + (size_t)(row0 + ai * 128 + m * 16) * ldc + col0;
#pragma unroll
                for (int bj = 0; bj < 2; ++bj) if (col0 + bj * 128 < ncol) *(GAS_ u32x4*)(rp + bj * 128) = pg8::pack8(acc[ai][bj][m][0] * s, acc[ai][bj][m][1] * s); }
    }
};
struct EpiInproj {
    static constexpr bool PERM = true, AFTER_DRAIN = false;
    bf16_t* O; float* fg;
    __device__ __forceinline__ void operator()(const f32x4 (&acc)[2][2][4][2], const Unit& u, int wr, int wc, int fr, int fq) const {
        const int row0 = u.pm * 256 + wr * 64 + fr, col0 = u.pn * 256 + wc * 32 + 8 * fq;
        const bool isfg = (u.pn == 7) && (wc == 0) && (fq == 0);
#pragma unroll
        for (int ai = 0; ai < 2; ++ai)
#pragma unroll
            for (int m = 0; m < 4; ++m) { const int row = row0 + ai * 128 + m * 16; bf16_t* rp = O + (size_t)row * PJ + col0;
#pragma unroll
                for (int bj = 0; bj < 2; ++bj) *(u32x4*)(rp + bj * 128) = pg8::pack8(acc[ai][bj][m][0], acc[ai][bj][m][1]);
                if (isfg) { *(f32x4*)(fg + (size_t)row * 8) = acc[ai][1][m][0]; *(f32x4*)(fg + (size_t)row * 8 + 4) = acc[ai][1][m][1]; } }
    }
};
struct EpiInproj2 {
    static constexpr bool PERM = true, AFTER_DRAIN = false;
    bf16_t* O; float* lf; bf16_t* ug; float* ssq; const float* gq; const float* gk; const float* bf;
    __device__ __forceinline__ void operator()(const f32x4 (&acc)[2][2][4][2], const Unit& u, int wr, int wc, int fr, int fq) const {
        const int lane = fq * 16 + fr, row0 = u.pm * 256 + wr * 64 + fr;
        if (u.pn >= 3 && u.pn <= 5) {
            const int hg = (u.pn - 3) * 4 + wc; const bool isq = hg < 6; const int h = isq ? hg : hg - 6;
            const float* gp = launder_ptr(isq ? gq : gk) + 8 * fq; const float gs = isq ? C2_FOX : 1.f;
            const f32x4 g00 = *(const f32x4*)gp * gs, g01 = *(const f32x4*)(gp + 4) * gs, g10 = *(const f32x4*)(gp + 32) * gs, g11 = *(const f32x4*)(gp + 36) * gs;
            bf16_t* base = O + (isq ? PC_FQ : PC_FK) + h * 64 + 8 * fq;
#pragma unroll
            for (int ai = 0; ai < 2; ++ai)
#pragma unroll
                for (int m = 0; m < 4; ++m) { const int row = row0 + ai * 128 + m * 16;
                    const f32x4 a0 = acc[ai][0][m][0], a1 = acc[ai][0][m][1], b0 = acc[ai][1][m][0], b1 = acc[ai][1][m][1];
                    float s = 0.f;
#pragma unroll
                    for (int j = 0; j < 4; ++j) s += a0[j] * a0[j] + a1[j] * a1[j] + b0[j] * b0[j] + b1[j] * b1[j];
                    s += shx(s, 16, lane); s += shx(s, 32, lane);
                    const float r = rsqrtf(s * (1.f / 64.f) + EPS);
                    bf16_t* rp = base + (size_t)row * PJ;
                    *(u32x4*)rp = pg8::pack8(a0 * g00 * r, a1 * g01 * r); *(u32x4*)(rp + 32) = pg8::pack8(b0 * g10 * r, b1 * g11 * r);
                    asm volatile("" ::: "memory"); }
            return;
        }
        const int col0 = u.pn * 256 + wc * 32 + 8 * fq;
#pragma unroll
        for (int ai = 0; ai < 2; ++ai)
#pragma unroll
            for (int m = 0; m < 4; ++m) { const int row = row0 + ai * 128 + m * 16; bf16_t* rp = O + (size_t)row * PJ + col0;
                const u32x4 w0 = pg8::pack8(acc[ai][0][m][0], acc[ai][0][m][1]), w1 = pg8::pack8(acc[ai][1][m][0], acc[ai][1][m][1]);
                if (u.pn != 0) { *(u32x4*)rp = w0; *(u32x4*)(rp + 128) = w1; }
                if (u.pn == 0) { const int b = row >> 12, t = row & 4095, c0 = wc * 32 + 8 * fq;
                    bf16_t* up = ug + (size_t)(b * 128 + (t >> 5)) * 640 + (t & 31) * 16 + (c0 & 15);
                    *(u32x4*)(up + (size_t)(c0 >> 4) * 1024 * 640) = w0; *(u32x4*)(up + (size_t)((c0 >> 4) + 8) * 1024 * 640) = w1; }
                else if (u.pn == 1 || u.pn == 2) {
                    const f32x4 a0 = acc[ai][0][m][0], a1 = acc[ai][0][m][1], b0 = acc[ai][1][m][0], b1 = acc[ai][1][m][1];
                    float s0 = 0.f, s1 = 0.f;
#pragma unroll
                    for (int j = 0; j < 4; ++j) { s0 += a0[j] * a0[j] + a1[j] * a1[j]; s1 += b0[j] * b0[j] + b1[j] * b1[j]; }
                    if (u.pn == 1) { float s = s0 + s1; s += shx(s, 16, lane); s += shx(s, 32, lane); if (fq == 0) ssq[(size_t)row * 4 + wc] = s; }
                    else { s0 += shx(s0, 16, lane); s0 += shx(s0, 32, lane); if (fq == 0) ssq[(size_t)4 * T + (size_t)row * 4 + wc] = s0;
                        if (wc == 0) { s1 += shx(s1, 16, lane); s1 += shx(s1, 32, lane); if (fq == 0) ssq[(size_t)8 * T + row] = s1; } } }
                else if (u.pn == 7 && wc == 0 && fq == 0) { const f32x4 z0 = acc[ai][1][m][0] + (f32x4){bf[0], bf[1], bf[2], bf[3]}, z1 = acc[ai][1][m][1] + (f32x4){bf[4], bf[5], 0.f, 0.f}; f32x4 l0, l1;
#pragma unroll
                    for (int j = 0; j < 4; ++j) { l0[j] = fminf(z0[j], 0.f) - __logf(1.f + __expf(-fabsf(z0[j]))); l1[j] = fminf(z1[j], 0.f) - __logf(1.f + __expf(-fabsf(z1[j]))); }
                    *(f32x4*)(lf + (size_t)row * 8) = l0; *(f32x4*)(lf + (size_t)row * 8 + 4) = l1; }
                asm volatile("" ::: "memory"); }
    }
};
struct EpiKvup {
    static constexpr bool PERM = true, AFTER_DRAIN = false;
    bf16_t* km; bf16_t* kv; const bf16_t* proj; const float* ssq; const float* gk; const float* cs; const float* sn;
    __device__ __forceinline__ void operator()(const f32x4 (&acc)[2][2][4][2], const Unit& u, int wr, int wc, int, int) const {
        const int lane = hidden_tid(0), fr = lane & 15, fq = lane >> 4, row0 = u.pm * 256 + wr * 64 + fr, head = 2 * u.pn + (wc >> 1); const bool isv = wc & 1;
        const float* gk = launder_ptr(this->gk);
        const f32x4 g00 = *(const f32x4*)(gk + 8 * fq), g01 = *(const f32x4*)(gk + 8 * fq + 4), g10 = *(const f32x4*)(gk + 32 + 8 * fq), g11 = *(const f32x4*)(gk + 36 + 8 * fq);
#pragma unroll
        for (int ai2 = 0; ai2 < 8; ++ai2) {
            const int ai = ai2 >> 2, mb = ai2 & 3;
            f32x4 p4[4], cv[4], sv[4], gr1, gr2; float krs[4]; u32x2 ka[4], kb[4];
#pragma unroll
            for (int m = mb; m < mb + 1; ++m) { const int row = row0 + ai * 128 + m * 16; p4[m] = *(const GAS_ f32x4*)(ssq + (size_t)4 * T + (size_t)row * 4);
                if (!isv) { krs[m] = *(const GAS_ float*)(ssq + (size_t)8 * T + row); ka[m] = *(const GAS_ u32x2*)(proj + (size_t)row * PJ + PC_KR + 4 * fq); kb[m] = *(const GAS_ u32x2*)(proj + (size_t)row * PJ + PC_KR + 16 + 4 * fq);
                    cv[m] = *(const GAS_ f32x4*)(cs + (size_t)row * 16 + 4 * fq); sv[m] = *(const GAS_ f32x4*)(sn + (size_t)row * 16 + 4 * fq);
                    gr1 = *(const GAS_ f32x4*)(gk + 64 + 4 * fq); gr2 = *(const GAS_ f32x4*)(gk + 80 + 4 * fq); } }
#pragma unroll
            for (int m = mb; m < mb + 1; ++m) { const int row = row0 + ai * 128 + m * 16;
                const float rkv = rsqrtf(((p4[m][0] + p4[m][1]) + (p4[m][2] + p4[m][3])) * (1.f / 128.f) + EPS);
                const f32x4 a0 = acc[ai][0][m][0], a1 = acc[ai][0][m][1], b0 = acc[ai][1][m][0], b1 = acc[ai][1][m][1];
                if (isv) { GAS_ bf16_t* vp = (GAS_ bf16_t*)kv + (size_t)row * 768 + head * 128 + 64 + 8 * fq; *(GAS_ u32x4*)vp = pg8::pack8(a0 * rkv, a1 * rkv); *(GAS_ u32x4*)(vp + 32) = pg8::pack8(b0 * rkv, b1 * rkv); }
                else {
                    float s = 0.f;
#pragma unroll
                    for (int j = 0; j < 4; ++j) s += a0[j] * a0[j] + a1[j] * a1[j] + b0[j] * b0[j] + b1[j] * b1[j];
                    s += shx(s, 16, lane); s += shx(s, 32, lane);
                    const float rh = rsqrtf((s * rkv * rkv + krs[m]) * (1.f / 96.f) + EPS), sc = rkv * rh;
                    GAS_ bf16_t* kp = (GAS_ bf16_t*)km + (size_t)row * 576 + head * 96;
                    *(GAS_ u32x4*)(kp + 8 * fq) = pg8::pack8(a0 * g00 * sc, a1 * g01 * sc); *(GAS_ u32x4*)(kp + 32 + 8 * fq) = pg8::pack8(b0 * g10 * sc, b1 * g11 * sc);
                    const f32x4 x1 = (f32x4){bf2f(ka[m].x & 0xffff), bf2f(ka[m].x >> 16), bf2f(ka[m].y & 0xffff), bf2f(ka[m].y >> 16)} * gr1 * rh, x2 = (f32x4){bf2f(kb[m].x & 0xffff), bf2f(kb[m].x >> 16), bf2f(kb[m].y & 0xffff), bf2f(kb[m].y >> 16)} * gr2 * rh;
                    const f32x4 o1 = x1 * cv[m] - x2 * sv[m], o2 = x1 * sv[m] + x2 * cv[m];
                    u32x2 w1, w2; w1.x = pg8::cvt_pk_bf16(o1[0], o1[1]); w1.y = pg8::cvt_pk_bf16(o1[2], o1[3]); w2.x = pg8::cvt_pk_bf16(o2[0], o2[1]); w2.y = pg8::cvt_pk_bf16(o2[2], o2[3]);
                    *(GAS_ u32x2*)(kp + 64 + 4 * fq) = w1; *(GAS_ u32x2*)(kp + 80 + 4 * fq) = w2; } } }
    }
};
template <bool KS>
struct EpiResidT {
    static constexpr bool KSCALE = KS; static constexpr int KB0 = 4, KB1 = 10;
    static constexpr bool PERM = true, AFTER_DRAIN = false;
    const bf16_t* X; const float* gate0; bf16_t* Xo;
    __device__ __forceinline__ void operator()(const f32x4 (&acc)[2][2][4][2], const Unit& u, int wr, int wc, int fr, int fq) const {
        const int row0 = u.pm * 256 + wr * 64 + fr, col0 = u.pn * 256 + wc * 32 + 8 * fq;
        const float* gp = gate0 + (size_t)(u.pm >> 4) * 6 * D + col0;
        f32x4 g[2][2];
#pragma unroll
        for (int bj = 0; bj < 2; ++bj) { g[bj][0] = *(const f32x4*)(gp + bj * 128); g[bj][1] = *(const f32x4*)(gp + bj * 128 + 4); }
#pragma unroll
        for (int ai = 0; ai < 2; ++ai) {
            u32x4 xv[4][2];
#pragma unroll
            for (int m = 0; m < 4; ++m) { const GAS_ bf16_t* rp = (const GAS_ bf16_t*)X + (size_t)(row0 + ai * 128 + m * 16) * D + col0;
#pragma unroll
                for (int bj = 0; bj < 2; ++bj) xv[m][bj] = *(const GAS_ u32x4*)(rp + bj * 128); }
#pragma unroll
            for (int m = 0; m < 4; ++m) { GAS_ bf16_t* wp = (GAS_ bf16_t*)Xo + (size_t)(row0 + ai * 128 + m * 16) * D + col0;
#pragma unroll
                for (int bj = 0; bj < 2; ++bj) { const u32x4 w = xv[m][bj];
                    const f32x4 x0 = {__uint_as_float(w.x << 16), __uint_as_float(w.x & 0xffff0000u), __uint_as_float(w.y << 16), __uint_as_float(w.y & 0xffff0000u)};
                    const f32x4 x1 = {__uint_as_float(w.z << 16), __uint_as_float(w.z & 0xffff0000u), __uint_as_float(w.w << 16), __uint_as_float(w.w & 0xffff0000u)};
                    *(GAS_ u32x4*)(wp + bj * 128) = pg8::pack8(x0 + g[bj][0] * acc[ai][bj][m][0], x1 + g[bj][1] * acc[ai][bj][m][1]); } } }
    }
};
using EpiResid = EpiResidT<false>; using EpiResidK = EpiResidT<true>;
__device__ __forceinline__ f32x4 silu_mul4(const f32x4 g, const f32x4 u) { f32x4 o;
#pragma unroll
    for (int j = 0; j < 4; ++j) o[j] = g[j] * __builtin_amdgcn_rcpf(1.f + __expf(-g[j])) * u[j];
    return o; }
struct EpiSwiglu {
    static constexpr bool PERM = true, AFTER_DRAIN = false;
    bf16_t* O; int ldc; int pn_mod;
    __device__ __forceinline__ void operator()(const f32x4 (&acc)[2][2][4][2], const Unit& u, int wr, int wc, int fr, int fq) const {
        const int row0 = u.pm * 256 + wr * 64 + fr, ff0 = (u.pn % pn_mod) * 128 + wc * 32 + 8 * fq;
#pragma unroll
        for (int ai = 0; ai < 2; ++ai)
#pragma unroll
            for (int m = 0; m < 4; ++m) *(u32x4*)(O + (size_t)(row0 + ai * 128 + m * 16) * ldc + ff0) = pg8::pack8(silu_mul4(acc[ai][0][m][0], acc[ai][1][m][0]), silu_mul4(acc[ai][0][m][1], acc[ai][1][m][1]));
    }
};
struct EpiGlu {
    static constexpr bool PERM = true, AFTER_DRAIN = false;
    const bf16_t* Y; bf16_t* O; const float* bias; int ldo; float* ssq;
    __device__ __forceinline__ void operator()(const f32x4 (&acc)[2][2][4][2], const Unit& u, int wr, int wc, int, int) const {
        const int lane = hidden_tid(0), fr = lane & 15, fq = lane >> 4, row0 = u.pm * 256 + wr * 64 + fr, col0 = wc * 32 + 8 * fq;
        f32x4 bb[2][2]; const float* bias = launder_ptr(this->bias);
#pragma unroll
        for (int bj = 0; bj < 2; ++bj) { bb[bj][0] = *(const f32x4*)(bias + col0 + bj * 128); bb[bj][1] = *(const f32x4*)(bias + col0 + bj * 128 + 4); }
#pragma unroll
        for (int ai = 0; ai < 2; ++ai) {
            u32x4 yv[4][2];
#pragma unroll
            for (int m = 0; m < 4; ++m)
#pragma unroll
                for (int bj = 0; bj < 2; ++bj) yv[m][bj] = *(const GAS_ u32x4*)(Y + (size_t)(row0 + ai * 128 + m * 16) * 256 + col0 + bj * 128);
#pragma unroll
            for (int m = 0; m < 4; ++m) { float ss = 0.f;
#pragma unroll
                for (int bj = 0; bj < 2; ++bj) { const unsigned yw[4] = {yv[m][bj].x, yv[m][bj].y, yv[m][bj].z, yv[m][bj].w}; f32x4 o0, o1;
#pragma unroll
                    for (int j = 0; j < 4; ++j) { const float ya = j & 1 ? bf2f(yw[j >> 1] >> 16) : bf2f(yw[j >> 1] & 0xffff), yb = j & 1 ? bf2f(yw[2 + (j >> 1)] >> 16) : bf2f(yw[2 + (j >> 1)] & 0xffff);
                        o0[j] = ya * __builtin_amdgcn_rcpf(1.f + __expf(-(acc[ai][bj][m][0][j] + bb[bj][0][j]))); o1[j] = yb * __builtin_amdgcn_rcpf(1.f + __expf(-(acc[ai][bj][m][1][j] + bb[bj][1][j]))); }
#pragma unroll
                    for (int j = 0; j < 4; ++j) ss += o0[j] * o0[j] + o1[j] * o1[j];
                    *(GAS_ u32x4*)((GAS_ bf16_t*)O + (size_t)(row0 + ai * 128 + m * 16) * ldo + col0 + bj * 128) = pg8::pack8(o0, o1); }
                ss += shx(ss, 16, lane); ss += shx(ss, 32, lane);
                if (fq == 0) ssq[(size_t)(row0 + ai * 128 + m * 16) * 16 + wc] = ss; } }
    }
};

__device__ __forceinline__ int inproj_nat_col(int n) { if (n < 768 || n >= 1536) return n; const int pn = n >> 8, c = n & 255; return 768 + ((((pn - 3) * 4 + ((c >> 5) & 3))) << 6) + ((c >> 7) << 5) + (c & 31); }
template <class SRC>
__device__ __forceinline__ void convert_tiles(bf16_t* Bt, int N, int K, SRC src, float* scr, int gw, int ngw, int lane) {
    const int nblk = N / 32, items = (K / 64) * nblk;
    for (int it = gw; it < items; it += ngw) {
        const int kb = it / nblk, nb = it % nblk, k0 = kb * 64, n0 = nb * 32;
#pragma unroll 8
        for (int i = 0; i < 32; ++i) { const int kk = 2 * i + (lane >> 5); scr[kk * 33 + (lane & 31)] = src(k0 + kk, n0 + (lane & 31)); }
        asm volatile("s_waitcnt lgkmcnt(0)" ::: "memory");
        const int c = lane & 7;
#pragma unroll
        for (int j = 0; j < 4; ++j) { const int n = (lane >> 3) + 8 * j; const float* s = scr + (8 * c) * 33 + n;
            u32x4 o; o.x = pk2(s[0], s[33]); o.y = pk2(s[66], s[99]); o.z = pk2(s[132], s[165]); o.w = pk2(s[198], s[231]);
            *(u32x4*)(Bt + (size_t)(n0 + n) * K + k0 + 8 * c) = o; }
        asm volatile("s_waitcnt lgkmcnt(0)" ::: "memory");
    }
}

struct CvtTile { const float* src; const float* gain; bf16_t* dst; int ld, K; };
__device__ __forceinline__ int cvt_count(int layer) { return 512 + ((layer & 1) == 0 ? (D / 64) * (2 * DFF / 32) + (DFF / 64) * (D / 32) : NEXP * ((D / 64) * (2 * DFE / 32) + (DFE / 64) * (D / 32))); }
__device__ __forceinline__ void cvt_decode(const Params& P, int layer, int it, int kr, int n4, CvtTile& t) {
    unsigned char* ws = P.ws;
    if (it < 512) { const int kb = it >> 5, nb = it & 31, k0 = kb * 64, n0 = nb * 32;
        t.src = P.w_out + (size_t)layer * D * D + (size_t)(k0 + kr) * D + n0 + n4; t.gain = P.out_norm + layer * D + k0 + kr; t.ld = D; t.K = D; t.dst = (bf16_t*)(ws + W_OUT) + (size_t)n0 * D + k0; return; }
    it -= 512; t.gain = nullptr;
    if ((layer & 1) == 0) {
        const int n1 = (D / 64) * (2 * DFF / 32);
        if (it < n1) { const int nblk = 2 * DFF / 32, kb = it / nblk, nb = it % nblk, k0 = kb * 64, n0 = nb * 32, ff = (n0 >> 8) * 128 + (n0 & 127);
            t.src = ((n0 & 128) ? P.ffn_wu : P.ffn_wg) + (size_t)(layer / 2) * D * DFF + (size_t)(k0 + kr) * DFF + ff + n4; t.ld = DFF; t.K = D; t.dst = (bf16_t*)(ws + W_F1) + (size_t)n0 * D + k0; }
        else { it -= n1; const int kb = it >> 5, nb = it & 31, k0 = kb * 64, n0 = nb * 32;
            t.src = P.ffn_wd + (size_t)(layer / 2) * DFF * D + (size_t)(k0 + kr) * D + n0 + n4; t.ld = D; t.K = DFF; t.dst = (bf16_t*)(ws + W_F2) + (size_t)n0 * DFF + k0; }
    } else {
        const int n1 = (D / 64) * (2 * DFE / 32), n2 = (DFE / 64) * (D / 32), e = it / (n1 + n2); it -= e * (n1 + n2);
        const size_t eo = (size_t)(layer / 2) * NEXP + e;
        if (it < n1) { const int nblk = 2 * DFE / 32, kb = it / nblk, nb = it % nblk, k0 = kb * 64, n0 = nb * 32, ff = (n0 >> 8) * 128 + (n0 & 127);
            t.src = ((n0 & 128) ? P.moe_wu : P.moe_wg) + eo * D * DFE + (size_t)(k0 + kr) * DFE + ff + n4; t.ld = DFE; t.K = D; t.dst = (bf16_t*)(ws + W_F1) + (size_t)e * 2 * DFE * D + (size_t)n0 * D + k0; }
        else { it -= n1; const int kb = it >> 5, nb = it & 31, k0 = kb * 64, n0 = nb * 32;
            t.src = P.moe_wd + eo * DFE * D + (size_t)(k0 + kr) * D + n0 + n4; t.ld = D; t.K = DFE; t.dst = (bf16_t*)(ws + W_F2) + (size_t)e * D * DFE + (size_t)n0 * DFE + k0; }
    }
}
__device__ __forceinline__ void cvt_load(const CvtTile& t, f32x4 (&v)[8], float (&g)[8]) {
#pragma unroll
    for (int i = 0; i < 8; ++i) v[i] = *(const f32x4*)(t.src + (size_t)(i * 8) * t.ld);
    if (t.gain) {
#pragma unroll
        for (int i = 0; i < 8; ++i) g[i] = t.gain[i * 8]; }
}
__device__ __forceinline__ void convert_stream(const Params& P, int layer, float* scr, int first, int items, int ngw, int lane) {
    const int kr = lane >> 3, n4 = (lane & 7) * 4, c = lane & 7;
    CvtTile t, tn; f32x4 v[8], vn[8]; float g[8], gn[8];
    if (first < items) { cvt_decode(P, layer, first, kr, n4, t); cvt_load(t, v, g); }
    for (int it = first; it < items; it += ngw) {
        const int nit = it + ngw;
        if (nit < items) { cvt_decode(P, layer, nit, kr, n4, tn); cvt_load(tn, vn, gn); }
        if (t.gain) {
#pragma unroll
            for (int i = 0; i < 8; ++i) v[i] = v[i] * g[i]; }
#pragma unroll
        for (int i = 0; i < 8; ++i)
#pragma unroll
            for (int j = 0; j < 4; ++j) scr[(n4 + j) * 68 + i * 8 + kr] = v[i][j];
        asm volatile("s_waitcnt lgkmcnt(0)" ::: "memory");
#pragma unroll
        for (int j = 0; j < 4; ++j) { const int n = (lane >> 3) + 8 * j; const float* s = scr + n * 68 + 8 * c; const f32x4 a = *(const f32x4*)s, b = *(const f32x4*)(s + 4);
            u32x4 o_; o_.x = pk2(a[0], a[1]); o_.y = pk2(a[2], a[3]); o_.z = pk2(b[0], b[1]); o_.w = pk2(b[2], b[3]);
            *(u32x4*)(t.dst + (size_t)n * t.K + 8 * c) = o_; }
        asm volatile("s_waitcnt lgkmcnt(0)" ::: "memory");
#pragma unroll
        for (int i = 0; i < 8; ++i) { v[i] = vn[i]; g[i] = gn[i]; }
        t = tn;
    }
}
__device__ __forceinline__ float cvt0_src(const Params& P, int layer, int which, int k, int n) {
    if (which == 0) { const int oc = proj_orig_col(inproj_nat_col(n)); return oc < 0 ? 0.f : P.w_in[(size_t)layer * D * INC + (size_t)k * INC + oc]; }
    if (which == 1) return n < 576 ? P.q_norm[layer * 256 + k] * P.w_uq[(size_t)layer * 256 * 576 + (size_t)k * 576 + n] : 0.f;
    if (which == 2) { const int c = n & 255, wc_ = (c >> 5) & 3, nat = (2 * (n >> 8) + (wc_ >> 1)) * 128 + (wc_ & 1) * 64 + ((c >> 7) << 5) + (c & 31); return k < 128 ? P.kv_norm[layer * 128 + k] * P.w_ukv[(size_t)layer * 128 * 768 + (size_t)k * 768 + nat] : 0.f; }
    return P.w_glu[(size_t)layer * 256 * 256 + (size_t)k * 256 + n];
}
__device__ __forceinline__ void convert_small(const Params& P, int layer, float* scr, int gw, int ngw, int lane) {
    unsigned char* ws = P.ws;
    for (int it = gw; it < 1024 + 96 + 96 + 32; it += ngw) {
        int which, r, nblk, K; bf16_t* Bt;
        if (it < 1024) { which = 0; r = it; nblk = PJ / 32; K = D; Bt = (bf16_t*)(ws + W_IN); }
        else if (it < 1120) { which = 1; r = it - 1024; nblk = 24; K = 256; Bt = (bf16_t*)(ws + W_UQ); }
        else if (it < 1216) { which = 2; r = it - 1120; nblk = 24; K = 256; Bt = (bf16_t*)(ws + W_UKV); }
        else { which = 3; r = it - 1216; nblk = 8; K = 256; Bt = (bf16_t*)(ws + W_GLU); }
        const int kb = r / nblk, nb = r % nblk, k0 = kb * 64, n0 = nb * 32;
        float v[32];
#pragma unroll
        for (int i = 0; i < 32; ++i) v[i] = cvt0_src(P, layer, which, k0 + 2 * i + (lane >> 5), n0 + (lane & 31));
#pragma unroll
        for (int i = 0; i < 32; ++i) scr[(2 * i + (lane >> 5)) * 33 + (lane & 31)] = v[i];
        asm volatile("s_waitcnt lgkmcnt(0)" ::: "memory");
        const int c = lane & 7;
#pragma unroll
        for (int j = 0; j < 4; ++j) { const int n = (lane >> 3) + 8 * j; const float* s = scr + (8 * c) * 33 + n;
            u32x4 o; o.x = pk2(s[0], s[33]); o.y = pk2(s[66], s[99]); o.z = pk2(s[132], s[165]); o.w = pk2(s[198], s[231]);
            *(u32x4*)(Bt + (size_t)(n0 + n) * K + k0 + 8 * c) = o; }
        asm volatile("s_waitcnt lgkmcnt(0)" ::: "memory");
    }
}
__device__ __forceinline__ void ph_convert(unsigned char* lds, Params P, int layer) {
    const int TIDX = hidden_tid(P.wid), BIDX = launder_i((int)blockIdx.x), GDIM = launder_i((int)gridDim.x); P.ws = launder_ptr(P.ws); P.out = launder_ptr(P.out);
    const int wid = TIDX >> 6, lane = TIDX & 63;
    convert_small(P, layer, (float*)lds + wid * 2176, BIDX * 8 + wid, GDIM * 8, lane);
    { const int ngw = GDIM * 8; int first = BIDX * 8 + wid - 1248 % ngw; if (first < 0) first += ngw;
      convert_stream(P, layer, (float*)lds + wid * 2176, first, cvt_count(layer), ngw, lane); }
}
#define GEMM_LDS ((PG8_LAS unsigned char*)lds)
__device__ __forceinline__ void ph_inproj_opt(unsigned char* lds, Params P, int layer) {
    const int TIDX = hidden_tid(P.wid), BIDX = launder_i((int)blockIdx.x), GDIM = launder_i((int)gridDim.x); P.ws = launder_ptr(P.ws); P.out = launder_ptr(P.out);
    pg8::Gemm g{(const bf16_t*)(P.ws + WS_HBUF), (const bf16_t*)(P.ws + W_IN), D, D, D, P.wid}; pg8::StaticOrder S; S.init(T, PJ, GDIM, BIDX);
    EpiInproj2 E{(bf16_t*)(P.ws + WS_PROJ), (float*)(P.ws + WS_FG), (bf16_t*)(P.ws + WS_UG), (float*)(P.ws + WS_SSQ), P.fox_gq + layer * 64, P.fox_gk + layer * 64, P.fox_bf + layer * 6};
    pg8::gemm_phase<EpiInproj2, pg8::StaticOrder, true, true>(GEMM_LDS, g, S, E);
}
__device__ __forceinline__ void ph_qup_opt(unsigned char* lds, Params P, int layer) {
    const int TIDX = hidden_tid(P.wid), BIDX = launder_i((int)blockIdx.x), GDIM = launder_i((int)gridDim.x); P.ws = launder_ptr(P.ws); P.out = launder_ptr(P.out);
    pg8::Gemm g{(const bf16_t*)(P.ws + WS_PROJ) + PC_CQ, (const bf16_t*)(P.ws + W_UQ), PJ, 256, 256, P.wid}; pg8::StaticOrder S; S.init(T, 768, GDIM, BIDX);
    EpiStore E{(bf16_t*)(P.ws + WS_QRAW), 768, (const float*)(P.ws + WS_SSQ), 1.f / 256.f, 1 << 20, 576};
    pg8::gemm_phase<EpiStore, pg8::StaticOrder, true, true>(GEMM_LDS, g, S, E);
}
__device__ __forceinline__ void ph_kvup_opt(unsigned char* lds, Params P, int layer) {
    const int TIDX = hidden_tid(P.wid), BIDX = launder_i((int)blockIdx.x), GDIM = launder_i((int)gridDim.x); P.ws = launder_ptr(P.ws); P.out = launder_ptr(P.out);
    pg8::Gemm g{(const bf16_t*)(P.ws + WS_PROJ) + PC_CKV, (const bf16_t*)(P.ws + W_UKV), PJ, 256, 128, P.wid};     pg8::StaticOrder S; S.init(T, 768, GDIM, (BIDX + (GDIM >> 1)) % GDIM);
    EpiKvup E{(bf16_t*)(P.ws + WS_KMLA), (bf16_t*)(P.ws + WS_KVRAW), (const bf16_t*)(P.ws + WS_PROJ), (const float*)(P.ws + WS_SSQ), P.mla_gk + layer * 96, (const float*)(P.ws + WS_COS), (const float*)(P.ws + WS_SIN)};
    pg8::gemm_phase<EpiKvup, pg8::StaticOrder, true, true>(GEMM_LDS, g, S, E);
}
__device__ __forceinline__ void ph_glu_opt(unsigned char* lds, Params P, int layer, int sub = 0) {
    const int TIDX = hidden_tid(P.wid), BIDX = launder_i((int)blockIdx.x), GDIM = launder_i((int)gridDim.x); P.ws = launder_ptr(P.ws); P.out = launder_ptr(P.out);
    pg8::Gemm g{(const bf16_t*)(P.ws + WS_YG), (const bf16_t*)(P.ws + W_GLU), 256, 256, 256, P.wid}; pg8::StaticOrder S; S.init(T, 256, sub ? 64 : GDIM, sub ? (BIDX < 64 ? BIDX : (1 << 20)) : BIDX);
    EpiGlu E{(const bf16_t*)(P.ws + WS_YG), (bf16_t*)(P.ws + WS_HBUF), P.b_glu + layer * 256, D, (float*)(P.ws + WS_SSQ2)};
    pg8::gemm_phase<EpiGlu, pg8::StaticOrder, true, true>(GEMM_LDS, g, S, E);
}
__device__ __forceinline__ void ph_outproj_opt(unsigned char* lds, Params P, int layer, int probe = 0) {
    const int TIDX = hidden_tid(P.wid), BIDX = launder_i((int)blockIdx.x), GDIM = launder_i((int)gridDim.x); P.ws = launder_ptr(P.ws); P.out = launder_ptr(P.out);
    pg8::Gemm g{(const bf16_t*)(P.ws + WS_HBUF), (const bf16_t*)(P.ws + W_OUT), D, D, D, P.wid}; pg8::StaticOrder S; S.init(T, D, GDIM, BIDX);
    {
        PG8_LAS float* tab = (PG8_LAS float*)(GEMM_LDS + 132096); const float* sq = (const float*)(P.ws + WS_SSQ2);
        for (int e = TIDX; e < 4 * 256; e += 512) { const int j = e >> 8, r = e & 255; pg8::Unit uu;
            if (S.next(j, uu)) { const float* p = sq + (size_t)(uu.pm * 256 + r) * 16; const f32x4 a = *(const f32x4*)p, b = *(const f32x4*)(p + 4), c = *(const f32x4*)(p + 8), d = *(const f32x4*)(p + 12);
                const float s1 = (a[0] + a[1]) + (a[2] + a[3]), s2 = ((b[0] + b[1]) + (b[2] + b[3])) + (c[0] + c[1]), s3 = ((c[2] + c[3]) + (d[0] + d[1])) + (d[2] + d[3]);
                const float r1 = rsqrtf(s1 * (1.f / 256.f) + EPS), r2 = rsqrtf(s2 * (1.f / 384.f) + EPS), r3 = rsqrtf(s3 * (1.f / 384.f) + EPS);
                tab[(j * 3 + 0) * 256 + r] = r1 / r2; tab[(j * 3 + 1) * 256 + r] = r2 / r3; tab[(j * 3 + 2) * 256 + r] = r3; } }
        __syncthreads(); }
    EpiResidK E{xstream(P, layer), adap(P, layer, 0, 2), probe ? (bf16_t*)(P.ws + WS_XE) : xstream(P, layer + (layer == DEPTH - 1))};
    pg8::gemm_phase<EpiResidK, pg8::StaticOrder, true, true>(GEMM_LDS, g, S, E);
}
__device__ __forceinline__ void ph_ffn1_opt(unsigned char* lds, Params P, int layer) {
    const int TIDX = hidden_tid(P.wid), BIDX = launder_i((int)blockIdx.x), GDIM = launder_i((int)gridDim.x); P.ws = launder_ptr(P.ws); P.out = launder_ptr(P.out);
    pg8::Gemm g{(const bf16_t*)(P.ws + WS_HBUF), (const bf16_t*)(P.ws + W_F1), D, D, D, P.wid}; pg8::StaticOrder S; S.init(T, 2 * DFF, GDIM, BIDX);
    EpiSwiglu E{(bf16_t*)(P.ws + WS_ACT), DFF, 1 << 20};
    pg8::gemm_phase<EpiSwiglu, pg8::StaticOrder, true, true>(GEMM_LDS, g, S, E);
}
__device__ __forceinline__ void ph_ffn2_opt(unsigned char* lds, Params P, int layer, int probe = 0) {
    const int TIDX = hidden_tid(P.wid), BIDX = launder_i((int)blockIdx.x), GDIM = launder_i((int)gridDim.x); P.ws = launder_ptr(P.ws); P.out = launder_ptr(P.out);
    pg8::Gemm g{(const bf16_t*)(P.ws + WS_ACT), (const bf16_t*)(P.ws + W_F2), DFF, DFF, DFF, P.wid}; pg8::StaticOrder S; S.init(T, D, GDIM, BIDX);
    EpiResid E{xstream(P, layer), adap(P, layer, 0, 5), probe ? (bf16_t*)(P.ws + WS_XE) : xstream(P, layer)};
    pg8::gemm_phase<EpiResid, pg8::StaticOrder, true, true>(GEMM_LDS, g, S, E);
}
struct MoeSlots {
    int off[NEXP + 1], cnt[NEXP];
    __device__ __forceinline__ void init(const unsigned* c) { int o_ = 0;
#pragma unroll
        for (int e = 0; e < NEXP; ++e) { cnt[e] = __builtin_amdgcn_readfirstlane((int)c[e]); off[e] = o_; o_ += ((cnt[e] + 255) >> 8) << 8; }
        off[NEXP] = o_; }
    __device__ __forceinline__ int expert_of(int pnl) const { int e = 0;
#pragma unroll
        for (int j = 1; j < NEXP; ++j) if (pnl * 256 >= off[j]) e = j;
        return e; }
    __device__ __forceinline__ int off_of(int e) const { int r = 0;
#pragma unroll
        for (int j = 0; j < NEXP; ++j) if (e == j) r = off[j];
        return r; }
    __device__ __forceinline__ int cnt_of(int e) const { int r = 0;
#pragma unroll
        for (int j = 0; j < NEXP; ++j) if (e == j) r = cnt[j];
        return r; }
};
struct MoeOrder1 {
    static constexpr bool GATHER = true;
    int n, G, c; MoeSlots sl; const int* list;
    __device__ __forceinline__ bool next(int i, Unit& u) const { const long L = (long)i * G + c; if (L >= n) return false;
        int Lx = (int)L; { const int q = n / pg8::NXCD, r = n % pg8::NXCD, xcd = Lx % pg8::NXCD, off = Lx / pg8::NXCD; Lx = (xcd < r ? xcd * (q + 1) : r * (q + 1) + (xcd - r) * q) + off; }
        const int pnl = Lx / 11, t = Lx % 11; u.pm = pnl; u.pn = sl.expert_of(pnl) * 11 + t; return true; }
    __device__ __forceinline__ void rowoff4(const Unit& u, int R, unsigned& o0, unsigned& o1, unsigned& o2, unsigned& o3) const {
        const int e = sl.expert_of(u.pm), r = u.pm * 256 - sl.off_of(e) + R, c = sl.cnt_of(e); const int* lp = list + (size_t)e * T + r;
        const int t0 = r < c ? lp[0] : 0, t1 = r + 64 < c ? lp[64] : 0, t2 = r + 128 < c ? lp[128] : 0, t3 = r + 192 < c ? lp[192] : 0;
        o0 = (unsigned)t0 * (unsigned)(D * 2); o1 = (unsigned)t1 * (unsigned)(D * 2); o2 = (unsigned)t2 * (unsigned)(D * 2); o3 = (unsigned)t3 * (unsigned)(D * 2); }
    __device__ __forceinline__ void a_ready(const Unit&) const {}
    __device__ __forceinline__ void done(const Unit&) const {}
};
struct MoeDec2 { MoeSlots sl; __device__ __forceinline__ void operator()(int L, Unit& u) const { const int pnl = L >> 2, t = L & 3; u.pm = pnl; u.pn = sl.expert_of(pnl) * 4 + t; } };
__device__ __forceinline__ void ph_moe1_opt(unsigned char* lds, Params P, int layer) {
    const int TIDX = hidden_tid(P.wid), BIDX = launder_i((int)blockIdx.x), GDIM = launder_i((int)gridDim.x); P.ws = launder_ptr(P.ws); P.out = launder_ptr(P.out); (void)TIDX;
    MoeSlots sl; sl.init((const unsigned*)(P.ws + WS_CTL) + CW_CNT + 16 * (layer / 2));
    pg8::Gemm g{(const bf16_t*)(P.ws + WS_HBUF), (const bf16_t*)(P.ws + W_F1), D, D, D, P.wid};
    MoeOrder1 S{(sl.off[NEXP] >> 8) * 11, (int)GDIM, (int)BIDX, sl, (const int*)(P.ws + WS_LIST)};
    EpiSwiglu E{(bf16_t*)(P.ws + WS_ACTM), DFE, 11};
    pg8::gemm_phase<EpiSwiglu, MoeOrder1, true, true>(GEMM_LDS, g, S, E);
}
__device__ __forceinline__ void ph_moe2_opt(unsigned char* lds, Params P, int layer) {
    const int TIDX = hidden_tid(P.wid), BIDX = launder_i((int)blockIdx.x), GDIM = launder_i((int)gridDim.x); P.ws = launder_ptr(P.ws); P.out = launder_ptr(P.out); (void)TIDX;
    MoeSlots sl; sl.init((const unsigned*)(P.ws + WS_CTL) + CW_CNT + 16 * (layer / 2));
    pg8::Gemm g{(const bf16_t*)(P.ws + WS_ACTM), (const bf16_t*)(P.ws + W_F2), DFE, DFE, DFE, P.wid};
    pg8::ListOrder<MoeDec2> S{(sl.off[NEXP] >> 8) * 4, (int)GDIM, (int)BIDX, MoeDec2{sl}};
    EpiStore E{(bf16_t*)(P.ws + ymoe_off(layer)), D, nullptr, 0.f, 4, 1 << 20};
    pg8::gemm_phase<EpiStore, pg8::ListOrder<MoeDec2>, true, true>(GEMM_LDS, g, S, E);
}


#ifndef LAS
#define LAS __attribute__((address_space(3)))
#endif
namespace att {
typedef short bf16x8 __attribute__((ext_vector_type(8)));
typedef short s16x4 __attribute__((ext_vector_type(4)));
typedef float f32x16 __attribute__((ext_vector_type(16)));
constexpr int LDS_K = 0, LDS_V = 49152, LDS_B = 81920, LDS_WS = 82944, LDS_OST = 84992, LDS_U = 117760;
struct Args { const bf16_t* Q; int ldq; const bf16_t* K; int ldk; const bf16_t* V; int ldv; int vhs; bf16_t* O; int ldo; float* ssq; const float* cb; unsigned* ctr; float th; const float* gq; const float* cs; const float* sn; float bsh; };
__device__ __forceinline__ int crow(int r, int hi) { return (r & 3) + 8 * (r >> 2) + 4 * hi; }
#define ATT_WAITV(N) asm volatile("s_waitcnt vmcnt(" #N ")" ::: "memory")
#define ATT_GLDS16(g, l) __builtin_amdgcn_global_load_lds((const unsigned*)(g), (LAS unsigned*)(l), 16, 0, 0)
#define ATT_GLDS4(g, l) __builtin_amdgcn_global_load_lds((const unsigned*)(g), (LAS unsigned*)(l), 4, 0, 0)
__device__ __forceinline__ unsigned cvtpk(float lo, float hi) { unsigned r; asm volatile("v_cvt_pk_bf16_f32 %0, %1, %2" : "=v"(r) : "v"(lo), "v"(hi)); return r; }
__device__ __forceinline__ void pv(f32x16* o, int vb, bf16x8 pa0, bf16x8 pa1, bf16x8 pa2, bf16x8 pa3) {
#pragma unroll
    for (int d0 = 0; d0 < 2; ++d0) { s16x4 lo[4], hi[4];
#pragma unroll
        for (int ks = 0; ks < 4; ++ks) {
            asm volatile("ds_read_b64_tr_b16 %0,%1 offset:%c2" : "=&v"(lo[ks]) : "v"(vb), "i"(d0 * 4096 + ks * 1024) : "memory");
            asm volatile("ds_read_b64_tr_b16 %0,%1 offset:%c2" : "=&v"(hi[ks]) : "v"(vb), "i"(d0 * 4096 + ks * 1024 + 512) : "memory"); }
        asm volatile("s_waitcnt lgkmcnt(0)" ::: "memory"); __builtin_amdgcn_sched_barrier(0);
#define ATT_PK(k) (bf16x8){lo[k][0], lo[k][1], lo[k][2], lo[k][3], hi[k][0], hi[k][1], hi[k][2], hi[k][3]}
        o[d0] = __builtin_amdgcn_mfma_f32_32x32x16_bf16(pa0, ATT_PK(0), o[d0], 0, 0, 0);
        o[d0] = __builtin_amdgcn_mfma_f32_32x32x16_bf16(pa1, ATT_PK(1), o[d0], 0, 0, 0);
        o[d0] = __builtin_amdgcn_mfma_f32_32x32x16_bf16(pa2, ATT_PK(2), o[d0], 0, 0, 0);
        o[d0] = __builtin_amdgcn_mfma_f32_32x32x16_bf16(pa3, ATT_PK(3), o[d0], 0, 0, 0);
#undef ATT_PK
    }
}
template <int NS, int MODE, int SH>
__device__ __forceinline__ void unit(const int b, const int h, const int qb, const Args& A, unsigned char* lds, const int tid_) {
    constexpr int DQK = 16 * NS, KSLOT = NS * 2048;
    const int wid = __builtin_amdgcn_readfirstlane(tid_ >> 6), tid = hidden_tid(wid);
    const int lane = tid & 63, r32 = lane & 31, hi = lane >> 5;
    const size_t rowbase = (size_t)b * SEQ; const int q0 = qb * 256;
    const bf16_t* Qw = A.Q + (rowbase + q0 + wid * 32) * A.ldq + h * DQK;
    const bf16_t* Kh = A.K + rowbase * A.ldk + h * DQK; const bf16_t* Vh = A.V + rowbase * A.ldv + h * A.vhs;
    LAS unsigned char* L = (LAS unsigned char*)lds;
    const unsigned lds0 = (unsigned)(uintptr_t)lds;
    const bf16_t* ksrc = Kh + (size_t)lane * A.ldk + wid * 8;
    const bf16_t* vsrc = Vh + (size_t)(16 * (wid & 3) + (lane >> 2)) * A.ldv + (wid >> 2) * 32 + (lane & 3) * 8;
    const float* bsrc = MODE == 1 ? A.cb + ((size_t)b * 6 + h) * SEQ + lane : nullptr;
    const bool k2 = (NS > 4) && (wid < 2 * NS - 8), bw = (MODE == 1) && (wid == 7), n3 = k2 || bw;
    const int NT = (q0 + 256) / 64;
    int t0 = 0;
    if (MODE == 1) {
        const float* cbh = A.cb + ((size_t)b * 6 + h) * SEQ; const float cq0 = cbh[q0];
        bool sk = false; if (lane < NT - 4) sk = (cq0 - cbh[64 * lane + 63]) < -A.th;
        const unsigned long long m = __ballot(sk);
        t0 = __builtin_amdgcn_readfirstlane((int)__builtin_ctzll(~m));
    }
#define ATT_DMAV(t, s) ATT_GLDS16(vsrc + (size_t)(t) * 64 * A.ldv, L + LDS_V + (s) * 8192 + wid * 1024)
#define ATT_DMAK(t, s) do { ATT_GLDS16(ksrc + (size_t)(t) * 64 * A.ldk, L + LDS_K + (s) * KSLOT + wid * 1024); \
        if (k2) ATT_GLDS16(ksrc + (size_t)(t) * 64 * A.ldk + 64, L + LDS_K + (s) * KSLOT + (wid + 8) * 1024); \
        if (bw) ATT_GLDS4(bsrc + (t) * 64, L + LDS_B + (s) * 256); } while (0)
#define ATT_WB(N) asm volatile("s_waitcnt vmcnt(" #N ") lgkmcnt(0)\n\ts_barrier" ::: "memory")
#define ATT_WB3(a_, b_, c_) do { if (k2) ATT_WB(b_); else if (bw) ATT_WB(c_); else ATT_WB(a_); } while (0)
    bf16x8 qr[NS];
#pragma unroll
    for (int d0 = 0; d0 < NS; ++d0) qr[d0] = *(const bf16x8*)(Qw + (size_t)r32 * A.ldq + d0 * 16 + hi * 8);
    ATT_DMAV(t0, 0); ATT_DMAK(t0, 0); ATT_DMAV(t0 + 1, 1); ATT_DMAK(t0 + 1, 1); ATT_DMAK(t0 + 2, 2);
    if (MODE == 0 && A.gq) {
        float qf[NS][8]; float ss = 0.f;
#pragma unroll
        for (int d0 = 0; d0 < NS; ++d0) { const u32x4 w = __builtin_bit_cast(u32x4, qr[d0]);
            qf[d0][0] = bf2f(w.x & 0xffff); qf[d0][1] = bf2f(w.x >> 16); qf[d0][2] = bf2f(w.y & 0xffff); qf[d0][3] = bf2f(w.y >> 16);
            qf[d0][4] = bf2f(w.z & 0xffff); qf[d0][5] = bf2f(w.z >> 16); qf[d0][6] = bf2f(w.w & 0xffff); qf[d0][7] = bf2f(w.w >> 16);
#pragma unroll
            for (int j = 0; j < 8; ++j) ss = fmaf(qf[d0][j], qf[d0][j], ss); }
        { auto rr = __builtin_amdgcn_permlane32_swap(__float_as_uint(ss), __float_as_uint(ss), false, false); ss = __uint_as_float(rr[0]) + __uint_as_float(rr[1]); }
        const float rq = rsqrtf(ss * (1.f / 96.f) + EPS) * C2_MLA;
#pragma unroll
        for (int d0 = 0; d0 < NS; ++d0) { const f32x4 g0 = *(const f32x4*)(A.gq + d0 * 16 + hi * 8), g1 = *(const f32x4*)(A.gq + d0 * 16 + hi * 8 + 4);
#pragma unroll
            for (int j = 0; j < 4; ++j) { qf[d0][j] *= rq * g0[j]; qf[d0][4 + j] *= rq * g1[j]; } }
        { const size_t row = rowbase + q0 + wid * 32 + r32; const float* cp = A.cs + row * 16 + hi * 8; const float* sp = A.sn + row * 16 + hi * 8;
          const f32x4 c0 = *(const f32x4*)cp, c1 = *(const f32x4*)(cp + 4), s0 = *(const f32x4*)sp, s1 = *(const f32x4*)(sp + 4);
#pragma unroll
          for (int j = 0; j < 8; ++j) { const float cv = j < 4 ? c0[j & 3] : c1[j & 3], sv = j < 4 ? s0[j & 3] : s1[j & 3]; const float x1 = qf[4][j], x2 = qf[5][j];
              qf[4][j] = x1 * cv - x2 * sv; qf[5][j] = x1 * sv + x2 * cv; } }
#pragma unroll
        for (int d0 = 0; d0 < NS; ++d0) { u32x4 w; w.x = cvtpk(qf[d0][0], qf[d0][1]); w.y = cvtpk(qf[d0][2], qf[d0][3]); w.z = cvtpk(qf[d0][4], qf[d0][5]); w.w = cvtpk(qf[d0][6], qf[d0][7]); qr[d0] = __builtin_bit_cast(bf16x8, w); }
    }
    float l_reg = 0.f; f32x16 o[2], cinit;
    { const float nm = SH ? ((MODE == 1 ? A.cb[((size_t)b * 6 + h) * SEQ + q0 + wid * 32 + r32] : 0.f) - A.bsh) : 0.f;
#pragma unroll
      for (int r = 0; r < 16; ++r) { o[0][r] = 0.f; o[1][r] = 0.f; cinit[r] = nm; } }
#define ATT_PIN(x) asm volatile("" : "+v"(x))
#define ATT_SBAR() __builtin_amdgcn_sched_barrier(0)
#define ATT_MFMA(a_, b_, c_) __builtin_amdgcn_mfma_f32_32x32x16_bf16(a_, b_, c_, 0, 0, 0)
    ATT_PIN(cinit);
    LAS float* wsf = (LAS float*)(L + LDS_WS) + wid * 64;
    const int qrel = wid * 32 + r32;
    const LAS unsigned char* const kp0 = L + LDS_K + hi * 1024 + r32 * 16;
    const LAS unsigned char* const vp0 = L + LDS_V + ((lane >> 4) & 1) * 32 + (lane & 3) * 8 + (4 * hi + ((lane & 15) >> 2)) * 64;
    const LAS float* const bp0 = (const LAS float*)(L + LDS_B) + 4 * hi;
    f32x16 pA0, pA1, pB0, pB1; bf16x8 kf[2 * NS]; s16x4 vlo[8], vhi[8]; u32x4 pw0, pw1, pw2, pw3; f32x4 bq[8];
    typedef short v4i16_t __attribute__((ext_vector_type(4)));
#define ATT_KLOAD2(t_, d0_) do { const LAS unsigned char* kb_ = kp0 + (((t_) - t0) & 3) * KSLOT; kf[2 * (d0_)] = *(const LAS bf16x8*)(kb_ + (d0_) * 2048); kf[2 * (d0_) + 1] = *(const LAS bf16x8*)(kb_ + (d0_) * 2048 + 512); } while (0)
#define ATT_VTR(p_) __builtin_bit_cast(s16x4, __builtin_amdgcn_ds_read_tr16_b64_v4i16((LAS v4i16_t*)(p_)))
#define ATT_VRD(i_) do { vlo[i_] = ATT_VTR(vp_ + (((i_) >> 2) * 4096 + ((i_) & 3) * 1024)); vhi[i_] = ATT_VTR(vp_ + (((i_) >> 2) * 4096 + ((i_) & 3) * 1024 + 512)); } while (0)
#define ATT_VFR(i_) (bf16x8){vlo[i_][0], vlo[i_][1], vlo[i_][2], vlo[i_][3], vhi[i_][0], vhi[i_][1], vhi[i_][2], vhi[i_][3]}
#define ATT_PKW(P_, i_) cvtpk(P_[i_], P_[(i_) + 1])
#define ATT_PAF(k_) __builtin_bit_cast(bf16x8, pw##k_)
#define ATT_QKM(C0_, C1_, m_) do { if ((m_) & 1) C1_ = ATT_MFMA(kf[m_], qr[(m_) >> 1], ((m_) >> 1) == 0 ? cinit : C1_); else C0_ = ATT_MFMA(kf[m_], qr[(m_) >> 1], ((m_) >> 1) == 0 ? cinit : C0_); } while (0)
#define ATT_MASK(C0_, C1_, jb_) do { if (MODE == 0) { if ((jb_) > (wid >> 1)) { _Pragma("unroll") for (int r = 0; r < 16; ++r) { C0_[r] = -INFINITY; C1_[r] = -INFINITY; } } } \
        else { const int kb = 64 * (jb_) + 4 * hi; _Pragma("unroll") for (int r = 0; r < 16; ++r) { const int kv = kb + (r & 3) + 8 * (r >> 2); if (kv > qrel) C0_[r] = -INFINITY; if (kv + 32 > qrel) C1_[r] = -INFINITY; } } } while (0)
    constexpr int KA = 3;
    constexpr bool HOLD = NS <= 4;
#define ATT_PREA(m_, vi_) do { if (HOLD) { if ((vi_) >= 0) ATT_VRD((vi_) < 0 ? 0 : (vi_)); if (MODE == 1 && (m_) < 8) bq[(m_) & 7] = *(const LAS f32x4*)(bps_ + 8 * ((m_) & 7)); ATT_SBAR(); } \
        else { if (((m_) & 1) == 0 && ((m_) >> 1) + KA < NS) ATT_KLOAD2(t, ((m_) >> 1) + KA); if ((m_) >= 2 * NS - 8) ATT_VRD(((m_) - (2 * NS - 8)) & 1 ? 4 + (((m_) - (2 * NS - 8)) >> 1) : (((m_) - (2 * NS - 8)) >> 1)); ATT_SBAR(); } } while (0)
#define ATT_GAPA(C0_, C1_, m_, vi_, a0_, a1_, a2_, a3_, W0_, W1_, PW_) do { ATT_PREA(m_, vi_); \
        ATT_QKM(C0_, C1_, m_); sacc += a0_; sacc += a1_; sacc += a2_; sacc += a3_; W0_; W1_; ATT_PIN(PW_); ATT_PIN(sacc); ATT_SBAR(); } while (0)
#define ATT_GAPX(C0_, C1_, m_) do { ATT_PREA(m_, -1); ATT_QKM(C0_, C1_, m_); ATT_SBAR(); } while (0)
#define ATT_EX4(X_, i_, k_) do { if (MODE == 1) { X_[i_] = __builtin_amdgcn_exp2f(X_[i_] - bq[k_][0]); X_[(i_) + 1] = __builtin_amdgcn_exp2f(X_[(i_) + 1] - bq[k_][1]); X_[(i_) + 2] = __builtin_amdgcn_exp2f(X_[(i_) + 2] - bq[k_][2]); X_[(i_) + 3] = __builtin_amdgcn_exp2f(X_[(i_) + 3] - bq[k_][3]); } \
        else { X_[i_] = __builtin_amdgcn_exp2f(X_[i_]); X_[(i_) + 1] = __builtin_amdgcn_exp2f(X_[(i_) + 1]); X_[(i_) + 2] = __builtin_amdgcn_exp2f(X_[(i_) + 2]); X_[(i_) + 3] = __builtin_amdgcn_exp2f(X_[(i_) + 3]); } } while (0)
#define ATT_GAPB(k_, od_, pk_, vi_, kd_, vnext_, X_, i_) do { \
        if (HOLD) { if ((kd_) >= 0 && (kd_) < NS && kl_) { ATT_KLOAD2(t + 1, ((kd_) >= 0 && (kd_) < NS) ? (kd_) : 0); ATT_SBAR(); } } \
        else { if (MODE == 1 && (k_) + 2 < 8) bq[((k_) + 2) & 7] = *(const LAS f32x4*)(bps_ + 8 * (((k_) + 2) & 7)); \
               if ((k_) >= 8 - KA && kl_) ATT_KLOAD2(t + 1, ((k_) - (8 - KA)) < NS ? ((k_) - (8 - KA)) : 0); } \
        o[od_] = ATT_MFMA(ATT_PAF(pk_), ATT_VFR(vi_), o[od_]); ATT_EX4(X_, i_, k_); ATT_PIN(X_); ATT_SBAR(); } while (0)
#define ATT_STEP2(C0_, C1_, P0_, P1_, tt_, BAND_) do { const int t = (tt_); ATT_SBAR(); \
        const LAS unsigned char* vp_ = vp0 + ((t - 1 - t0) & 3) * 8192; const LAS float* bps_ = bp0 + ((t - t0) & 3) * 64; \
        float sacc = P0_[0] + P0_[1]; \
        ATT_GAPA(C0_, C1_, 0, 0, P0_[2], P0_[3], P0_[4], P0_[5],     pw0[0] = ATT_PKW(P0_, 0),  pw0[1] = ATT_PKW(P0_, 2),  pw0); \
        ATT_GAPA(C0_, C1_, 1, 4, P0_[6], P0_[7], P0_[8], P0_[9],     pw0[2] = ATT_PKW(P0_, 4),  pw0[3] = ATT_PKW(P0_, 6),  pw0); \
        ATT_GAPA(C0_, C1_, 2, 1, P0_[10], P0_[11], P0_[12], P0_[13], pw1[0] = ATT_PKW(P0_, 8),  pw1[1] = ATT_PKW(P0_, 10), pw1); \
        ATT_GAPA(C0_, C1_, 3, 5, P0_[14], P0_[15], P1_[0], P1_[1],   pw1[2] = ATT_PKW(P0_, 12), pw1[3] = ATT_PKW(P0_, 14), pw1); \
        ATT_GAPA(C0_, C1_, 4, 2, P1_[2], P1_[3], P1_[4], P1_[5],     pw2[0] = ATT_PKW(P1_, 0),  pw2[1] = ATT_PKW(P1_, 2),  pw2); \
        ATT_GAPA(C0_, C1_, 5, 6, P1_[6], P1_[7], P1_[8], P1_[9],     pw2[2] = ATT_PKW(P1_, 4),  pw2[3] = ATT_PKW(P1_, 6),  pw2); \
        ATT_GAPA(C0_, C1_, 6, 3, P1_[10], P1_[11], P1_[12], P1_[13], pw3[0] = ATT_PKW(P1_, 8),  pw3[1] = ATT_PKW(P1_, 10), pw3); \
        ATT_GAPA(C0_, C1_, 7, 7, P1_[14], P1_[15], 0.f, 0.f,         pw3[2] = ATT_PKW(P1_, 12), pw3[3] = ATT_PKW(P1_, 14), pw3); \
        if (NS > 4) { ATT_GAPX(C0_, C1_, (NS > 4 ? 8 : 0)); ATT_GAPX(C0_, C1_, (NS > 4 ? 9 : 1)); } \
        if (NS > 5) { ATT_GAPX(C0_, C1_, (NS > 5 ? 10 : 0)); ATT_GAPX(C0_, C1_, (NS > 5 ? 11 : 1)); } \
        l_reg += sacc; \
        if (BAND_) { if (t + 2 < NT) ATT_DMAV(t + 2, (t + 2 - t0) & 3); if (t + 3 < NT) ATT_DMAK(t + 3, (t + 3 - t0) & 3); } \
        else { ATT_DMAV(t + 2, (t + 2 - t0) & 3); ATT_DMAK(t + 3, (t + 3 - t0) & 3); } \
        if (BAND_) { const int jb = t - (NT - 4); if (jb >= 0) ATT_MASK(C0_, C1_, jb); } \
        const bool kl_ = !(BAND_) || (t + 1 < NT);     \
        if (!HOLD && MODE == 1) { bq[0] = *(const LAS f32x4*)(bps_); bq[1] = *(const LAS f32x4*)(bps_ + 8); } \
        ATT_SBAR(); \
        ATT_GAPB(0, 0, 0, 0, -1, 1, C0_, 0);  ATT_GAPB(1, 1, 0, 4, 0, 5, C0_, 4);  ATT_GAPB(2, 0, 1, 1, 1, 2, C0_, 8);  ATT_GAPB(3, 1, 1, 5, 2, 6, C0_, 12); \
        ATT_GAPB(4, 0, 2, 2, 3, 3, C1_, 0);   ATT_GAPB(5, 1, 2, 6, -1, 7, C1_, 4); ATT_GAPB(6, 0, 3, 3, -1, -1, C1_, 8); ATT_GAPB(7, 1, 3, 7, -1, -1, C1_, 12); \
    } while (0)
#define ATT_DRAIN(P0_, P1_) do { float sacc = P0_[0] + P0_[1]; \
        _Pragma("unroll") for (int r = 2; r < 16; ++r) sacc += P0_[r]; \
        _Pragma("unroll") for (int r = 0; r < 16; ++r) sacc += P1_[r]; \
        l_reg += sacc; \
        pw0 = (u32x4){ATT_PKW(P0_, 0), ATT_PKW(P0_, 2), ATT_PKW(P0_, 4), ATT_PKW(P0_, 6)}; pw1 = (u32x4){ATT_PKW(P0_, 8), ATT_PKW(P0_, 10), ATT_PKW(P0_, 12), ATT_PKW(P0_, 14)}; \
        pw2 = (u32x4){ATT_PKW(P1_, 0), ATT_PKW(P1_, 2), ATT_PKW(P1_, 4), ATT_PKW(P1_, 6)}; pw3 = (u32x4){ATT_PKW(P1_, 8), ATT_PKW(P1_, 10), ATT_PKW(P1_, 12), ATT_PKW(P1_, 14)}; \
        const LAS unsigned char* vp_ = vp0 + ((NT - 1 - t0) & 3) * 8192; \
        ATT_VRD(0); ATT_VRD(1); ATT_VRD(2); ATT_VRD(3); ATT_VRD(4); ATT_VRD(5); ATT_VRD(6); ATT_VRD(7); \
        o[0] = ATT_MFMA(ATT_PAF(0), ATT_VFR(0), o[0]); o[1] = ATT_MFMA(ATT_PAF(0), ATT_VFR(4), o[1]); o[0] = ATT_MFMA(ATT_PAF(1), ATT_VFR(1), o[0]); o[1] = ATT_MFMA(ATT_PAF(1), ATT_VFR(5), o[1]); \
        o[0] = ATT_MFMA(ATT_PAF(2), ATT_VFR(2), o[0]); o[1] = ATT_MFMA(ATT_PAF(2), ATT_VFR(6), o[1]); o[0] = ATT_MFMA(ATT_PAF(3), ATT_VFR(3), o[0]); o[1] = ATT_MFMA(ATT_PAF(3), ATT_VFR(7), o[1]); } while (0)
    ATT_WB3(3, 5, 5);
    { _Pragma("unroll") for (int d0 = 0; d0 < NS; ++d0) ATT_KLOAD2(t0, d0);
      _Pragma("unroll") for (int m = 0; m < 2 * NS; ++m) { if (m & 1) pA1 = ATT_MFMA(kf[m], qr[m >> 1], (m >> 1) == 0 ? cinit : pA1); else pA0 = ATT_MFMA(kf[m], qr[m >> 1], (m >> 1) == 0 ? cinit : pA0); }
      if (NT - 4 == t0) ATT_MASK(pA0, pA1, 0);
      if (MODE == 1) {
#pragma unroll
          for (int g = 0; g < 4; ++g) { const f32x4 b0 = *(const LAS f32x4*)(bp0 + 8 * g), b1 = *(const LAS f32x4*)(bp0 + 32 + 8 * g);
#pragma unroll
              for (int j = 0; j < 4; ++j) { pA0[4 * g + j] -= b0[j]; pA1[4 * g + j] -= b1[j]; } } }
#pragma unroll
      for (int r = 0; r < 16; ++r) { pA0[r] = __builtin_amdgcn_exp2f(pA0[r]); pA1[r] = __builtin_amdgcn_exp2f(pA1[r]); } }
    ATT_WB(0);
    ATT_DMAV(t0 + 2, 2); ATT_DMAK(t0 + 3, 3);
    { _Pragma("unroll") for (int d0 = 0; d0 < (HOLD ? NS : KA); ++d0) ATT_KLOAD2(t0 + 1, d0); }
    int tc = t0 + 1;
    for (; tc + 5 < NT; tc += 2) {
        ATT_STEP2(pB0, pB1, pA0, pA1, tc, 0);     ATT_WB3(2, 3, 4);
        ATT_STEP2(pA0, pA1, pB0, pB1, tc + 1, 0); ATT_WB3(2, 3, 4);
    }
    for (; tc + 1 < NT; tc += 2) {
        ATT_STEP2(pB0, pB1, pA0, pA1, tc, 1);     ATT_WB(0);
        ATT_STEP2(pA0, pA1, pB0, pB1, tc + 1, 1); ATT_WB(0);
    }
    if (tc < NT) { ATT_STEP2(pB0, pB1, pA0, pA1, tc, 1); ATT_WB(0); ATT_DRAIN(pB0, pB1); }
    else { ATT_DRAIN(pA0, pA1); }
    unsigned nxu = 0u;
    if (tid == 0) nxu = __hip_atomic_fetch_add((GAS_ unsigned*)A.ctr, 1u, __ATOMIC_RELAXED, __HIP_MEMORY_SCOPE_AGENT);
    { auto rr = __builtin_amdgcn_permlane32_swap(__float_as_uint(l_reg), __float_as_uint(l_reg), false, false); l_reg = __uint_as_float(rr[0]) + __uint_as_float(rr[1]); }
    if (hi == 0) wsf[32 + r32] = l_reg;
    asm volatile("s_waitcnt lgkmcnt(0)" ::: "memory");
    float rli[16];
#pragma unroll
    for (int r = 0; r < 16; ++r) rli[r] = __builtin_amdgcn_rcpf(wsf[32 + crow(r, hi)]);
    bf16_t* Ow = A.O + (rowbase + q0 + wid * 32) * A.ldo + h * 64;
    { LAS bf16_t* stg = (LAS bf16_t*)(L + LDS_OST) + wid * 2048;
#pragma unroll
      for (int r = 0; r < 16; ++r) { const int orow = crow(r, hi);
#pragma unroll
          for (int d0 = 0; d0 < 2; ++d0) stg[orow * 64 + d0 * 32 + r32] = f2bf(o[d0][r] * rli[r]); }
      asm volatile("s_waitcnt lgkmcnt(0)" ::: "memory");
#pragma unroll
      for (int i = 0; i < 4; ++i) { const int row = i * 8 + (lane >> 3), ch = lane & 7; const u32x4 v = *(const LAS u32x4*)(stg + row * 64 + ch * 8); *(u32x4*)(Ow + (size_t)row * A.ldo + ch * 8) = v;
          const unsigned vw[4] = {v.x, v.y, v.z, v.w}; float ss = 0.f;
#pragma unroll
          for (int q = 0; q < 4; ++q) { const float lo = bf2f(vw[q] & 0xffff), hi_ = bf2f(vw[q] >> 16); ss += lo * lo + hi_ * hi_; }
          ss += shx(ss, 1, lane); ss += shx(ss, 2, lane); ss += shx(ss, 4, lane);
          if (ch == 0) A.ssq[(rowbase + q0 + wid * 32 + row) * 16 + h] = ss; } }
    if (tid == 0) *(LAS unsigned*)(L + LDS_U) = nxu;
    asm volatile("s_waitcnt vmcnt(0) lgkmcnt(0)" ::: "memory");
    __builtin_amdgcn_s_barrier();
#undef ATT_DMAV
#undef ATT_DMAK
#undef ATT_STEP2
}
struct NoSide { __device__ __forceinline__ void step() {} };
template <int NS, int MODE, int SH, class Side>
__device__ __forceinline__ void phase(const Args& A, unsigned char* lds, const int tid, Side& side) {
    LAS unsigned* uw = (LAS unsigned*)((LAS unsigned char*)lds + LDS_U);
    if (tid == 0) *uw = __hip_atomic_fetch_add(A.ctr, 1u, __ATOMIC_RELAXED, __HIP_MEMORY_SCOPE_AGENT);
    __syncthreads();
    for (;;) {
        const int u = __builtin_amdgcn_readfirstlane((int)*uw);
        __syncthreads();
        if (u >= NB * 6 * 16) break;
        const int qb = 15 - u / 48, bh = u % 48;
        unit<NS, MODE, SH>(bh / 6, bh % 6, qb, A, lds, tid);
        side.step();
    }
}
#undef ATT_WAITV
#undef ATT_GLDS16
#undef ATT_GLDS4
}

__device__ __forceinline__ void ph_attn_mla(unsigned char* lds, Params P, int layer) {
    const int TIDX = hidden_tid(P.wid); P.ws = launder_ptr(P.ws);
    const int lane = TIDX & 63, lr = (layer >= 4) ? layer - 4 : layer;
    const float gqm = wmax(fmaxf(fabsf(P.mla_gq[lr * 96 + lane]), fabsf(P.mla_gq[lr * 96 + 64 + (lane & 31)])), lane), gkm = wmax(fmaxf(fabsf(P.mla_gk[lr * 96 + lane]), fabsf(P.mla_gk[lr * 96 + 64 + (lane & 31)])), lane);
    const float bm = __uint_as_float(__builtin_amdgcn_readfirstlane(__float_as_uint(96.f * C2_MLA * gqm * gkm * 1.02f)));
    att::Args A{(const bf16_t*)(P.ws + WS_QRAW), 768, (const bf16_t*)(P.ws + WS_KMLA), 576, (const bf16_t*)(P.ws + WS_KVRAW) + 64, 768, 128, (bf16_t*)(P.ws + WS_HBUF) + 256, D, (float*)(P.ws + WS_SSQ2) + 4, nullptr,
                 (unsigned*)(P.ws + WS_CTL) + CW_ATTN + layer * 2, 0.f, P.mla_gq + lr * 96, (const float*)(P.ws + WS_COS), (const float*)(P.ws + WS_SIN), bm};
    att::NoSide ns;
    if (__all(bm <= 60.f)) att::phase<6, 0, 0>(A, lds, TIDX, ns);
    else att::phase<6, 0, 1>(A, lds, TIDX, ns);
}
__device__ __forceinline__ void ph_attn_fox(unsigned char* lds, Params P, int layer) {
    const int TIDX = hidden_tid(P.wid); P.ws = launder_ptr(P.ws);
    const int lane = TIDX & 63, lr = (layer >= 4) ? layer - 4 : layer;
    const float gqm = wmax(fabsf(P.fox_gq[lr * 64 + lane]), lane), gkm = wmax(fabsf(P.fox_gk[lr * 64 + lane]), lane);
    const float bf_ = __uint_as_float(__builtin_amdgcn_readfirstlane(__float_as_uint(64.f * C2_FOX * gqm * gkm * 1.02f))), th = 2.f * bf_ + 40.f;
    att::Args A{(const bf16_t*)(P.ws + WS_PROJ) + PC_FQ, PJ, (const bf16_t*)(P.ws + WS_PROJ) + PC_FK, PJ, (const bf16_t*)(P.ws + WS_PROJ) + PC_FV, PJ, 64, (bf16_t*)(P.ws + WS_HBUF) + 640, D, (float*)(P.ws + WS_SSQ2) + 10, (const float*)(P.ws + WS_CB2),
                 (unsigned*)(P.ws + WS_CTL) + CW_ATTN + layer * 2 + 1, th, nullptr, nullptr, nullptr, bf_};
    att::NoSide ns; att::phase<4, 1, 1>(A, lds, TIDX, ns);
}
__device__ __forceinline__ void ph_attn_all(unsigned char* lds, Params P, int layer) { ph_attn_mla(lds, P, layer); ph_attn_fox(lds, P, layer); }


__device__ __forceinline__ void ssm_tables1(const Params& P, int layer, unsigned char* lds, int tid, int bid, int gdim) {
    float* lamp = (float*)lds;
    float* bbar = lamp + 64 * 33 * 2;
    float* cc = bbar + 64 * 16 * 2;
    float* qq = cc + 16 * 64 * 2;
    float* KM = (float*)(P.ws + WS_KM + (size_t)(layer & 1) * (512u << 10)); float* LAMP = (float*)(P.ws + WS_LAMP + (size_t)(layer & 1) * (512u << 10)); float* BBAR = (float*)(P.ws + WS_BBAR + (size_t)(layer & 1) * (512u << 10));
    for (int item = bid; item < 128; item += gdim) {
        const int g = item >> 3, dq = item & 7;
        __syncthreads();
        const float dt = expf(P.log_dt[layer * 16 + g]);
        for (int e = tid; e < 64 * 33; e += 512) { const int p = e / 33, d = e % 33; const size_t gp = ((size_t)layer * 16 + g) * 64 + p;
            const float a_ = P.lam_re[gp] * dt, b_ = P.lam_im[gp] * dt; float s_, c_; sincosf((float)d * b_, &s_, &c_); const float e_ = expf((float)d * a_);
            lamp[e * 2] = e_ * c_; lamp[e * 2 + 1] = e_ * s_;
            if (dq == 0) { LAMP[((size_t)g * 64 * 33 + e) * 2] = e_ * c_; LAMP[((size_t)g * 64 * 33 + e) * 2 + 1] = e_ * s_; } }
        if (tid < 64) { const int p = tid; const size_t gp = ((size_t)layer * 16 + g) * 64 + p;
            const float lre = P.lam_re[gp], lim = P.lam_im[gp], a_ = lre * dt, b_ = lim * dt; float sb_, cb_; sincosf(b_, &sb_, &cb_); const float sh_ = sinf(0.5f * b_);
            const float nr = expm1f(a_) * cb_ - 2.f * sh_ * sh_, ni = expf(a_) * sb_;
            const float dd = lre * lre + lim * lim; qq[p * 2] = (nr * lre + ni * lim) / dd; qq[p * 2 + 1] = (ni * lre - nr * lim) / dd; }
        for (int e = tid; e < 1024; e += 512) { const int c = e >> 6, p = e & 63; const size_t ix = (((size_t)layer * 16 + g) * 16 + c) * 64 + p; cc[e * 2] = P.c_re[ix]; cc[e * 2 + 1] = P.c_im[ix]; }
        __syncthreads();
        for (int e = tid; e < 1024; e += 512) { const int p = e >> 4, c = e & 15; const size_t ix = (((size_t)layer * 16 + g) * 64 + p) * 16 + c;
            const float bre = P.b_re[ix], bim = P.b_im[ix], qr = qq[p * 2], qi = qq[p * 2 + 1];
            const float br = qr * bre - qi * bim, bi = qr * bim + qi * bre; bbar[e * 2] = br; bbar[e * 2 + 1] = bi;
            if (dq == 0) { BBAR[((size_t)g * 1024 + e) * 2] = br; BBAR[((size_t)g * 1024 + e) * 2 + 1] = bi; } }
        __syncthreads();
        for (int e = tid; e < 4 * 256; e += 512) { const int d = dq * 4 + (e >> 8), c = (e >> 4) & 15, c2 = e & 15; float acc = 0.f;
            for (int p = 0; p < 64; ++p) { const float cr = cc[(c * 64 + p) * 2], ci = cc[(c * 64 + p) * 2 + 1], lr = lamp[(p * 33 + d) * 2], li = lamp[(p * 33 + d) * 2 + 1];
                const float clr = cr * lr - ci * li, cli = cr * li + ci * lr; acc += clr * bbar[(p * 16 + c2) * 2] - cli * bbar[(p * 16 + c2) * 2 + 1]; }
            KM[(size_t)g * 8192 + d * 256 + (e & 255)] = acc; }
    }
    __syncthreads();
}
__device__ __forceinline__ void ssm_tables2(const Params& P, int layer, int tid, int bid, int gdim) {
    const float* KM = (const float*)(P.ws + WS_KM + (size_t)(layer & 1) * (512u << 10)); const float* LAMP = (const float*)(P.ws + WS_LAMP + (size_t)(layer & 1) * (512u << 10)); const float* BBAR = (const float*)(P.ws + WS_BBAR + (size_t)(layer & 1) * (512u << 10));
    bf16_t* B1t = (bf16_t*)(P.ws + W_B1T); bf16_t* T2t = (bf16_t*)(P.ws + W_T2T);
    const int gt = bid * 512 + tid, nt = gdim * 512;
    for (int v0 = gt; v0 < 16 * 256 * 64; v0 += 2 * nt) {
        f32x4 bb[2][4]; float lr[2], li[2];
#pragma unroll
        for (int u = 0; u < 2; ++u) { const int v = v0 + u * nt, k0 = (v & 63) * 8, n = (v >> 6) & 255, g = v >> 14;
            if (v < 16 * 256 * 64 && n < 128) { const int p = n >> 1, i = k0 >> 4, c0 = k0 & 15;
                const float* lp = LAMP + (((size_t)g * 64 + p) * 33 + (31 - i)) * 2; lr[u] = lp[0]; li[u] = lp[1];
                const float* bp = BBAR + (((size_t)g * 64 + p) * 16 + c0) * 2;
#pragma unroll
                for (int q = 0; q < 4; ++q) bb[u][q] = *(const f32x4*)(bp + 4 * q); } }
#pragma unroll
        for (int u = 0; u < 2; ++u) { const int v = v0 + u * nt, k0 = (v & 63) * 8, n = (v >> 6) & 255, g = v >> 14;
            if (v < 16 * 256 * 64) { u32x4 o = {0u, 0u, 0u, 0u};
                if (n < 128) { const int ri = n & 1; float w[8];
#pragma unroll
                    for (int q = 0; q < 4; ++q) { const f32x4 t = bb[u][q]; w[2 * q] = ri == 0 ? (lr[u] * t[0] - li[u] * t[1]) : (lr[u] * t[1] + li[u] * t[0]); w[2 * q + 1] = ri == 0 ? (lr[u] * t[2] - li[u] * t[3]) : (lr[u] * t[3] + li[u] * t[2]); }
                    o.x = pk2(w[0], w[1]); o.y = pk2(w[2], w[3]); o.z = pk2(w[4], w[5]); o.w = pk2(w[6], w[7]); }
                *(u32x4*)(B1t + ((size_t)(g * 256 + n)) * 512 + k0) = o; } }
    }
    for (int v0 = gt; v0 < 16 * 512 * 64; v0 += 4 * nt) {
        f32x4 ka[4], kb[4];
#pragma unroll
        for (int u = 0; u < 4; ++u) { const int v = v0 + u * nt, k0 = (v & 63) * 8, n = (v >> 6) & 511, g = v >> 15, j = n >> 4, c = n & 15, i = k0 >> 4, c0 = k0 & 15;
            ka[u] = (f32x4){0.f, 0.f, 0.f, 0.f}; kb[u] = ka[u];
            if (v < 16 * 512 * 64 && j >= i) { const float* kp = KM + (size_t)g * 8192 + (j - i) * 256 + c * 16 + c0; ka[u] = *(const f32x4*)kp; kb[u] = *(const f32x4*)(kp + 4); } }
#pragma unroll
        for (int u = 0; u < 4; ++u) { const int v = v0 + u * nt, k0 = (v & 63) * 8, n = (v >> 6) & 511, g = v >> 15;
            if (v < 16 * 512 * 64) { u32x4 o; o.x = pk2(ka[u][0], ka[u][1]); o.y = pk2(ka[u][2], ka[u][3]); o.z = pk2(kb[u][0], kb[u][1]); o.w = pk2(kb[u][2], kb[u][3]);
                *(u32x4*)(T2t + ((size_t)(g * 512 + n)) * 640 + k0) = o; } }
    }
    for (int v = gt; v < 16 * 512 * 16; v += nt) {
        const int p0 = (v & 15) * 4, n = (v >> 4) & 511, g = v >> 13, j = n >> 4, c = n & 15;
        const size_t ix = (((size_t)layer * 16 + g) * 16 + c) * 64 + p0; const f32x4 cr = *(const f32x4*)(P.c_re + ix), ci = *(const f32x4*)(P.c_im + ix);
        float lr[4], li[4];
#pragma unroll
        for (int q = 0; q < 4; ++q) { const float* lp = LAMP + (((size_t)g * 64 + p0 + q) * 33 + (j + 1)) * 2; lr[q] = lp[0]; li[q] = lp[1]; }
        float w[8];
#pragma unroll
        for (int q = 0; q < 4; ++q) { w[2 * q] = cr[q] * lr[q] - ci[q] * li[q]; w[2 * q + 1] = -(cr[q] * li[q] + ci[q] * lr[q]); }
        u32x4 o; o.x = pk2(w[0], w[1]); o.y = pk2(w[2], w[3]); o.z = pk2(w[4], w[5]); o.w = pk2(w[6], w[7]);
        *(u32x4*)(T2t + ((size_t)(g * 512 + n)) * 640 + 512 + 2 * p0) = o;
    }
}
__device__ __forceinline__ void ssm_carry(const Params& P, int layer, int item, int lane) {
    const int b = item >> 4, g = item & 15;
    const float* LAMP = (const float*)(P.ws + WS_LAMP + (size_t)(layer & 1) * (512u << 10)); const float* lp = LAMP + (((size_t)g * 64 + lane) * 33 + 32) * 2; const float lr = lp[0], li = lp[1];
    const float* sl = (const float*)(P.ws + WS_SLOC) + ((size_t)g * 1024 + b * 128) * 128 + lane * 2;
    bf16_t* ug = (bf16_t*)(P.ws + WS_UG) + ((size_t)g * 1024 + b * 128) * 640 + 512 + lane * 2;
    float sr = 0.f, si = 0.f;
    for (int n0 = 0; n0 < 128; n0 += 16) {
        float xr[16], xi[16];
#pragma unroll
        for (int k = 0; k < 16; ++k) { const float* q = sl + (size_t)(n0 + k) * 128; xr[k] = q[0]; xi[k] = q[1]; }
#pragma unroll
        for (int k = 0; k < 16; ++k) { *(unsigned*)(ug + (size_t)(n0 + k) * 640) = pk2(sr, si);
            const float nr = lr * sr - li * si + xr[k], ni = lr * si + li * sr + xi[k]; sr = nr; si = ni; }
    }
}
struct EpiSloc {
    static constexpr bool PERM = true, AFTER_DRAIN = false;
    float* S;
    __device__ __forceinline__ void operator()(const f32x4 (&acc)[2][2][4][2], const Unit& u, int wr, int wc, int fr, int fq) const {
        const int row0 = u.pm * 256 + wr * 64 + fr, col0 = wc * 32 + 8 * fq;
#pragma unroll
        for (int ai = 0; ai < 2; ++ai)
#pragma unroll
            for (int m = 0; m < 4; ++m) { float* rp = S + (size_t)(row0 + ai * 128 + m * 16) * 128 + col0; *(f32x4*)rp = acc[ai][0][m][0]; *(f32x4*)(rp + 4) = acc[ai][0][m][1]; }
    }
};
struct EpiSsmY {
    static constexpr bool PERM = true, AFTER_DRAIN = false;
    const bf16_t* proj; bf16_t* yg; const float* dsk;
    __device__ __forceinline__ void operator()(const f32x4 (&acc)[2][2][4][2], const Unit& u, int wr, int wc, int fr, int fq) const {
        const int ct = u.pn & 1, g = u.pm >> 2;
        f32x4 dv[2][2]; int jj[2], cc[2]; const float* dsk = launder_ptr(this->dsk);
#pragma unroll
        for (int bj = 0; bj < 2; ++bj) { const int nc = 256 * ct + 128 * bj + 32 * wc + 8 * fq; jj[bj] = nc >> 4; cc[bj] = nc & 15; dv[bj][0] = *(const f32x4*)(dsk + g * 16 + cc[bj]); dv[bj][1] = *(const f32x4*)(dsk + g * 16 + cc[bj] + 4); }
#pragma unroll
        for (int ai = 0; ai < 2; ++ai) {
            u32x4 uv[4][2];
#pragma unroll
            for (int m = 0; m < 4; ++m) { const int R = u.pm * 256 + ai * 128 + wr * 64 + m * 16 + fr, rl = R & 1023, b = rl >> 7, ch = rl & 127;
#pragma unroll
                for (int bj = 0; bj < 2; ++bj) uv[m][bj] = *(const GAS_ u32x4*)(proj + (size_t)R * 640 + jj[bj] * 16 + cc[bj]); (void)b; (void)ch; }
#pragma unroll
            for (int m = 0; m < 4; ++m) { const int R = u.pm * 256 + ai * 128 + wr * 64 + m * 16 + fr, rl = R & 1023, b = rl >> 7, ch = rl & 127;
#pragma unroll
                for (int bj = 0; bj < 2; ++bj) { const size_t tok = (size_t)b * SEQ + ch * 32 + jj[bj];
                    const unsigned uw[4] = {uv[m][bj].x, uv[m][bj].y, uv[m][bj].z, uv[m][bj].w}; f32x4 o0, o1;
#pragma unroll
                    for (int q = 0; q < 4; ++q) { const float ua = q & 1 ? bf2f(uw[q >> 1] >> 16) : bf2f(uw[q >> 1] & 0xffff), ub = q & 1 ? bf2f(uw[2 + (q >> 1)] >> 16) : bf2f(uw[2 + (q >> 1)] & 0xffff);
                        o0[q] = gelu_tanh(acc[ai][bj][m][0][q] + dv[bj][0][q] * ua); o1[q] = gelu_tanh(acc[ai][bj][m][1][q] + dv[bj][1][q] * ub); }
                    *(GAS_ u32x4*)((GAS_ bf16_t*)yg + tok * 256 + g * 16 + cc[bj]) = pg8::pack8(o0, o1); } } }
    }
};
struct SsmDec1 { __device__ __forceinline__ void operator()(int L, Unit& u) const { u.pm = L; u.pn = L >> 2; } };
struct SsmDec2 { __device__ __forceinline__ void operator()(int L, Unit& u) const { u.pm = L >> 1; u.pn = ((L >> 3) << 1) | (L & 1); } };
__device__ __forceinline__ void ph_ssm_tab1(unsigned char* lds, Params P, int layer, int rot = 0) {
    const int TIDX = hidden_tid(P.wid), BIDX = launder_i((int)blockIdx.x), GDIM = launder_i((int)gridDim.x); P.ws = launder_ptr(P.ws);
    ssm_tables1(P, layer, lds, TIDX, GDIM >= 256 ? (BIDX + GDIM - rot) % GDIM : BIDX, GDIM);
}
__device__ __forceinline__ void ph_ssm_tab2(unsigned char* lds, Params P, int layer) {
    const int TIDX = hidden_tid(P.wid), BIDX = launder_i((int)blockIdx.x), GDIM = launder_i((int)gridDim.x); P.ws = launder_ptr(P.ws);
    ssm_tables2(P, layer, TIDX, BIDX, GDIM);
}
__device__ __forceinline__ void ph_ssm_gemm1(unsigned char* lds, Params P, int layer) {
    const int TIDX = hidden_tid(P.wid), BIDX = launder_i((int)blockIdx.x), GDIM = launder_i((int)gridDim.x); P.ws = launder_ptr(P.ws); (void)TIDX;
    pg8::Gemm g{(const bf16_t*)(P.ws + WS_UG), (const bf16_t*)(P.ws + W_B1T), 640, 512, 512, P.wid};
    pg8::ListOrder<SsmDec1> S{64, GDIM, GDIM >= 128 ? (BIDX + GDIM - 64) % GDIM : BIDX, SsmDec1{}};
    EpiSloc E{(float*)(P.ws + WS_SLOC)};
    pg8::gemm_phase<EpiSloc, pg8::ListOrder<SsmDec1>, true, true>(GEMM_LDS, g, S, E);
}
__device__ __forceinline__ void ph_ssm_carry(unsigned char* lds, Params P, int layer) {
    const int TIDX = hidden_tid(P.wid), BIDX = launder_i((int)blockIdx.x), GDIM = launder_i((int)gridDim.x); P.ws = launder_ptr(P.ws);
    if ((TIDX >> 6) == 0) for (int item = BIDX; item < 128; item += GDIM) ssm_carry(P, layer, item, TIDX & 63);
    __syncthreads();
}
struct SsmOrder2 {
    static constexpr bool GATHER = false;
    int c;
    __device__ __forceinline__ bool next(int i, Unit& u) const { if (c >= 64 || i >= 2) return false; u.pm = c; u.pn = ((c >> 2) << 1) | i; return true; }
    __device__ __forceinline__ void a_ready(const Unit&) const {}
    __device__ __forceinline__ void done(const Unit&) const {}
};
__device__ __forceinline__ void ph_ssm_gemm2(unsigned char* lds, Params P, int layer) {
    const int TIDX = hidden_tid(P.wid), BIDX = launder_i((int)blockIdx.x), GDIM = launder_i((int)gridDim.x); P.ws = launder_ptr(P.ws);
    {
        pg8::Gemm g1{(const bf16_t*)(P.ws + WS_UG), (const bf16_t*)(P.ws + W_B1T), 640, 512, 512, P.wid};
        pg8::ListOrder<SsmDec1> S1{64, GDIM, BIDX, SsmDec1{}};
        EpiSloc E1{(float*)(P.ws + WS_SLOC)};
        pg8::gemm_phase<EpiSloc, pg8::ListOrder<SsmDec1>, true, true>(GEMM_LDS, g1, S1, E1);
        asm volatile("s_waitcnt vmcnt(0)" ::: "memory");
        __syncthreads();
    }
    if (BIDX < 64) { const int wv = TIDX >> 6; if (wv < 2) ssm_carry(P, layer, (2 * (BIDX & 3) + wv) * 16 + (BIDX >> 2), TIDX & 63); }
    asm volatile("s_waitcnt vmcnt(0)" ::: "memory");
    __syncthreads();
    pg8::Gemm g{(const bf16_t*)(P.ws + WS_UG), (const bf16_t*)(P.ws + W_T2T), 640, 640, 640, P.wid};
    SsmOrder2 S{BIDX};
    EpiSsmY E{(const bf16_t*)(P.ws + WS_UG), (bf16_t*)(P.ws + WS_YG), P.ssm_d + layer * 256};
    pg8::gemm_phase<EpiSsmY, SsmOrder2, true, true>(GEMM_LDS, g, S, E);
}

__device__ __forceinline__ void unpack8(const u32x4 w, float (&f)[8]) {
    f[0] = bf2f(w.x & 0xffff); f[1] = bf2f(w.x >> 16); f[2] = bf2f(w.y & 0xffff); f[3] = bf2f(w.y >> 16);
    f[4] = bf2f(w.z & 0xffff); f[5] = bf2f(w.z >> 16); f[6] = bf2f(w.w & 0xffff); f[7] = bf2f(w.w >> 16); }
__device__ __forceinline__ u32x4 pack8f(const float (&f)[8]) { u32x4 o; o.x = pg8::cvt_pk_bf16(f[0], f[1]); o.y = pg8::cvt_pk_bf16(f[2], f[3]); o.z = pg8::cvt_pk_bf16(f[4], f[5]); o.w = pg8::cvt_pk_bf16(f[6], f[7]); return o; }
__device__ __forceinline__ float ssq8(const float (&f)[8]) { float s = 0.f;
#pragma unroll
    for (int j = 0; j < 8; ++j) s = fmaf(f[j], f[j], s);
    return s; }
__device__ __forceinline__ unsigned shxu(unsigned v, int o, int lane) { return (unsigned)__builtin_amdgcn_ds_bpermute((lane ^ o) << 2, (int)v); }

__device__ __forceinline__ void ph_passC2(unsigned char* lds, Params P, int layer) {
    const int TIDX = hidden_tid(P.wid), BIDX = launder_i((int)blockIdx.x), GDIM = launder_i((int)gridDim.x); P.ws = launder_ptr(P.ws);
    float (*lfs)[8] = (float (*)[8])lds;
    const int wid = TIDX >> 6, lane = TIDX & 63;
    bf16_t* proj = (bf16_t*)(P.ws + WS_PROJ); const float* fg = (const float*)(P.ws + WS_FG);
    float* rq = (float*)(P.ws + WS_RSTDQ); float* rkv = (float*)(P.ws + WS_RSTDKV);
    float* cloc = (float*)(P.ws + WS_CLOC); float* ctot = (float*)(P.ws + WS_CTOT); bf16_t* ug = (bf16_t*)(P.ws + WS_UG);
    float gq8[8], gk8[8];
#pragma unroll
    for (int j = 0; j < 8; ++j) { gq8[j] = P.fox_gq[layer * 64 + (lane & 7) * 8 + j] * C2_FOX; gk8[j] = P.fox_gk[layer * 64 + (lane & 7) * 8 + j]; }
    const int off1 = lane < 32 ? PC_CQ + lane * 8 : PC_CKV + (lane - 32) * 8;
    const int lf = lane < 48 ? lane : 0;
    for (int chunk = BIDX; chunk < T / 128; chunk += GDIM) {
        for (int i = 0; i < 16; i += 2) {
            u32x4 w1[2], wu[2], wq[2], wk[2];
#pragma unroll
            for (int k = 0; k < 2; ++k) { const bf16_t* pr = proj + (size_t)(chunk * 128 + wid * 16 + i + k) * PJ;
                w1[k] = *(const u32x4*)(pr + off1); wu[k] = *(const u32x4*)(pr + PC_U + (lane & 31) * 8);
                wq[k] = *(const u32x4*)(pr + PC_FQ + lf * 8); wk[k] = *(const u32x4*)(pr + PC_FK + lf * 8); }
#pragma unroll
            for (int k = 0; k < 2; ++k) {
                const int tl = wid * 16 + i + k, row = chunk * 128 + tl; bf16_t* pr = proj + (size_t)row * PJ;
                float v[8]; unpack8(w1[k], v); float s1 = lane < 48 ? ssq8(v) : 0.f;
                s1 += shx(s1, 1, lane); s1 += shx(s1, 2, lane); s1 += shx(s1, 4, lane); s1 += shx(s1, 8, lane);
                const float s1b = s1 + shx(s1, 16, lane);
                if (lane == 0) rq[row] = rsqrtf(s1b * (1.f / 256.f) + EPS);
                if (lane == 32) rkv[row] = rsqrtf(s1 * (1.f / 128.f) + EPS);
                if (lane < 32) { const int b_ = row / SEQ, t_ = row % SEQ;
                    *(u32x4*)(ug + (size_t)((lane >> 1) * 1024 + b_ * 128 + (t_ >> 5)) * 640 + (t_ & 31) * 16 + (lane & 1) * 8) = wu[k]; }
                float a[8], b[8]; unpack8(wq[k], a); unpack8(wk[k], b);
                float sa = ssq8(a), sb = ssq8(b);
                sa += shx(sa, 1, lane); sb += shx(sb, 1, lane); sa += shx(sa, 2, lane); sb += shx(sb, 2, lane); sa += shx(sa, 4, lane); sb += shx(sb, 4, lane);
                const float ra = rsqrtf(sa * (1.f / 64.f) + EPS), rb = rsqrtf(sb * (1.f / 64.f) + EPS);
#pragma unroll
                for (int j = 0; j < 8; ++j) { a[j] *= ra * gq8[j]; b[j] *= rb * gk8[j]; }
                if (lane < 48) { *(u32x4*)(pr + PC_FQ + lane * 8) = pack8f(a); *(u32x4*)(pr + PC_FK + lane * 8) = pack8f(b); }
                if (lane < 6) { const float z = fg[(size_t)row * 8 + lane] + P.fox_bf[layer * 6 + lane];
                    const float e = __expf(-fabsf(z)); lfs[tl][lane] = fminf(z, 0.f) - __logf(1.f + e); }
            }
        }
        __syncthreads();
        if (TIDX < 6) {
            const int h = TIDX, b = (chunk * 128) / SEQ, t0 = (chunk * 128) % SEQ; float run = 0.f;
            for (int j = 0; j < 128; ++j) { run += lfs[j][h]; cloc[((size_t)b * 6 + h) * SEQ + t0 + j] = run; }
            ctot[chunk * 8 + h] = run;
        }
        __syncthreads();
    }
}

__device__ __forceinline__ void ph_passE2(unsigned char* lds, Params P, int layer) {
    const int TIDX = hidden_tid(P.wid), BIDX = launder_i((int)blockIdx.x), GDIM = launder_i((int)gridDim.x); P.ws = launder_ptr(P.ws);
    const int wid = TIDX >> 6, lane = TIDX & 63, grp = lane >> 4, c = lane & 15; const bool act = c < 12, rop = act && c >= 8;
    const bf16_t* proj = (const bf16_t*)(P.ws + WS_PROJ); const bf16_t* qraw = (const bf16_t*)(P.ws + WS_QRAW); const bf16_t* kvraw = (const bf16_t*)(P.ws + WS_KVRAW);
    bf16_t* qm = (bf16_t*)(P.ws + WS_QMLA); bf16_t* km = (bf16_t*)(P.ws + WS_KMLA);
    const float* cs = (const float*)(P.ws + WS_COS); const float* sn = (const float*)(P.ws + WS_SIN);
    const int cc = act ? c : 0, cp = cc ^ 2;
    float gq8[8], gk8[8], gqp[8], gkp[8];
#pragma unroll
    for (int j = 0; j < 8; ++j) { gq8[j] = P.mla_gq[layer * 96 + cc * 8 + j] * C2_MLA; gk8[j] = P.mla_gk[layer * 96 + cc * 8 + j];
        gqp[j] = rop ? P.mla_gq[layer * 96 + cp * 8 + j] * C2_MLA : 0.f; gkp[j] = rop ? P.mla_gk[layer * 96 + cp * 8 + j] : 0.f; }
    const int hC = 4 + (grp & 1); const bool kC = grp >= 2;
    const int qoffA = grp * 96 + cc * 8, qoffC = hC * 96 + cc * 8;
    const int koffA = cc < 8 ? grp * 128 + cc * 8 : -1, koffC = cc < 8 ? hC * 128 + cc * 8 : -1;
    const int kroff = PC_KR + (cc & 3) * 8, j0 = (cc & 1) * 8;
    for (int chunk = BIDX; chunk < T / 128; chunk += GDIM) {
        for (int i = 0; i < 16; ++i) {
            const size_t row = (size_t)chunk * 128 + wid * 16 + i;
            u32x4 w[3];
            w[0] = *(const u32x4*)(qraw + row * 768 + qoffA);
            w[1] = koffA >= 0 ? *(const u32x4*)(kvraw + row * 768 + koffA) : *(const u32x4*)(proj + row * PJ + kroff);
            w[2] = !kC ? *(const u32x4*)(qraw + row * 768 + qoffC) : (koffC >= 0 ? *(const u32x4*)(kvraw + row * 768 + koffC) : *(const u32x4*)(proj + row * PJ + kroff));
            f32x4 c0 = {0.f, 0.f, 0.f, 0.f}, c1 = c0, s0 = c0, s1 = c0;
            if (rop) { c0 = *(const f32x4*)(cs + row * 16 + j0); c1 = *(const f32x4*)(cs + row * 16 + j0 + 4); s0 = *(const f32x4*)(sn + row * 16 + j0); s1 = *(const f32x4*)(sn + row * 16 + j0 + 4); }
            const float cv[8] = {c0[0], c0[1], c0[2], c0[3], c1[0], c1[1], c1[2], c1[3]}, sv[8] = {s0[0], s0[1], s0[2], s0[3], s1[0], s1[1], s1[2], s1[3]};
#pragma unroll
            for (int ps = 0; ps < 3; ++ps) {
                const bool isk = (ps == 1) || (ps == 2 && kC);
                float v[8]; unpack8(w[ps], v);
                float ss = act ? ssq8(v) : 0.f;
                ss += shx(ss, 1, lane); ss += shx(ss, 2, lane); ss += shx(ss, 4, lane); ss += shx(ss, 8, lane);
                const float r = rsqrtf(ss * (1.f / 96.f) + EPS);
                u32x4 pw; pw.x = shxu(w[ps].x, 2, lane); pw.y = shxu(w[ps].y, 2, lane); pw.z = shxu(w[ps].z, 2, lane); pw.w = shxu(w[ps].w, 2, lane);
                float pv[8]; unpack8(pw, pv);
                float o[8];
#pragma unroll
                for (int j = 0; j < 8; ++j) { const float n = v[j] * r * (isk ? gk8[j] : gq8[j]), pn = pv[j] * r * (isk ? gkp[j] : gqp[j]);
                    o[j] = !rop ? n : (c < 10 ? n * cv[j] - pn * sv[j] : pn * sv[j] + n * cv[j]); }
                if (act) { bf16_t* dst = ps == 0 ? qm + row * 576 + qoffA : (ps == 1 ? km + row * 576 + qoffA : (kC ? km : qm) + row * 576 + qoffC);
                    *(u32x4*)dst = pack8f(o); }
            }
        }
    }
    __syncthreads();
}

__device__ __forceinline__ void ph_fox_cumsum(unsigned char* lds, Params P, int layer) {
    const int TIDX = hidden_tid(P.wid), BIDX = launder_i((int)blockIdx.x), GDIM = launder_i((int)gridDim.x); P.ws = launder_ptr(P.ws);
    const int wid = TIDX >> 6, lane = TIDX & 63;
    const float* lf = (const float*)(P.ws + WS_FG); float* cb2 = (float*)(P.ws + WS_CB2); float* wtot = (float*)lds;
    const int first = GDIM >= 256 ? (BIDX + GDIM - 192) % GDIM : BIDX;
    for (int item = first; item < NB * 6; item += GDIM) {
        const int b = item / 6, h = item % 6;
        float v[8];
#pragma unroll
        for (int j = 0; j < 8; ++j) v[j] = lf[((size_t)b * SEQ + TIDX * 8 + j) * 8 + h];
        float run = 0.f;
#pragma unroll
        for (int j = 0; j < 8; ++j) { run += v[j]; v[j] = run; }
        float incl = run;
#pragma unroll
        for (int o = 1; o < 64; o <<= 1) { const float t = __int_as_float(__builtin_amdgcn_ds_bpermute(((lane - o) & 63) << 2, __float_as_int(incl))); if (lane >= o) incl += t; }
        __syncthreads();
        if (lane == 63) wtot[wid] = incl;
        __syncthreads();
        float base = incl - run;
#pragma unroll
        for (int w = 0; w < 8; ++w) if (w < wid) base += wtot[w];
        float* dst = cb2 + ((size_t)b * 6 + h) * SEQ + TIDX * 8;
        *(f32x4*)dst = (f32x4){(base + v[0]) * LOG2E, (base + v[1]) * LOG2E, (base + v[2]) * LOG2E, (base + v[3]) * LOG2E};
        *(f32x4*)(dst + 4) = (f32x4){(base + v[4]) * LOG2E, (base + v[5]) * LOG2E, (base + v[6]) * LOG2E, (base + v[7]) * LOG2E};
    }
    __syncthreads();
}

#define XB_TMO      128
#define XB_XCNT(j)  (256  + 64 * (j))
#define XB_XSUB(j)  (1280 + 64 * (j))
#define XB_XGEN(j)  (2304 + 64 * (j))
#define XB_TOP      3328
#define XB_TOPGEN   3392
#define XCD_BAR_WORDS 3456
#define XB_SPIN_CAP (1u << 18)
#define LAS __attribute__((address_space(3)))

__device__ __forceinline__ unsigned xb_ld(unsigned* p)              { return __hip_atomic_load(p, __ATOMIC_RELAXED, __HIP_MEMORY_SCOPE_AGENT); }
__device__ __forceinline__ unsigned xb_add(unsigned* p, unsigned v) { return __hip_atomic_fetch_add(p, v, __ATOMIC_RELAXED, __HIP_MEMORY_SCOPE_AGENT); }
__device__ __forceinline__ unsigned xb_xcc_id() { return (unsigned)__builtin_amdgcn_s_getreg((3 << 11) | 20) & 0xFu; }
#define XB_SPIN(cond, bar) do { unsigned _sp = 0; while (cond) { __builtin_amdgcn_s_sleep(1); \
    if ((++_sp & 255u) == 0u) { if (xb_ld(&(bar)[XB_TMO])) break; if (_sp > XB_SPIN_CAP) { atomicAdd(&(bar)[XB_TMO], 1u); break; } } } } while (0)

struct XcdBarrier {
    unsigned* bar; unsigned x;
    volatile LAS unsigned* st;
};

__device__ __forceinline__ XcdBarrier xcd_barrier_post(unsigned* bar, volatile LAS unsigned* st) {
    XcdBarrier b; b.bar = bar; b.x = xb_xcc_id(); b.st = st;
    if (threadIdx.x == 0) (void)xb_add(&bar[XB_XCNT(b.x)], 1u);
    return b;
}
__device__ __forceinline__ void xcd_barrier_complete(unsigned* bar, unsigned x, unsigned& nloc, unsigned& nx) {
    const unsigned G = gridDim.x * gridDim.y * gridDim.z;
    unsigned sum, cnt, mine, sp = 0u;
    for (;;) {
        sum = 0u; cnt = 0u; mine = 0u;
#pragma unroll
        for (unsigned j = 0; j < 16; ++j) { const unsigned c = xb_ld(&bar[XB_XCNT(j)]); sum += c; cnt += (c > 0u) ? 1u : 0u; mine = (j == x) ? c : mine; }
        if (sum == G) break;
        __builtin_amdgcn_s_sleep(1);
        if ((++sp & 255u) == 0u) { if (xb_ld(&bar[XB_TMO])) break; if (sp > XB_SPIN_CAP) { atomicAdd(&bar[XB_TMO], 1u); break; } }
    }
    nloc = mine > 0u ? mine : 1u; nx = cnt > 0u ? cnt : 1u;
}

__device__ __forceinline__ void xcd_barrier(const XcdBarrier& b) {
    asm volatile("s_waitcnt vmcnt(0)" ::: "memory");
    __syncthreads();
    if (threadIdx.x == 0) {
        unsigned* bar = b.bar;
        __builtin_amdgcn_s_waitcnt(0);
        unsigned nloc = b.st[0], nx = b.st[1];
        if (nloc == 0u) { xcd_barrier_complete(bar, b.x, nloc, nx); b.st[0] = nloc; b.st[1] = nx; }
        const unsigned old = xb_add(&bar[XB_XSUB(b.x)], 1u);
        const unsigned gen = old / nloc;
        if (old + 1u == (gen + 1u) * nloc) {
            __builtin_amdgcn_fence(__ATOMIC_RELEASE, "agent");
            asm volatile("s_waitcnt vmcnt(0)" ::: "memory");
            const unsigned og = xb_add(&bar[XB_TOP], 1u);
            const unsigned tg = og / nx;
            if (og + 1u == (tg + 1u) * nx) xb_add(&bar[XB_TOPGEN], 1u);
            else XB_SPIN(xb_ld(&bar[XB_TOPGEN]) == tg, bar);
            __builtin_amdgcn_fence(__ATOMIC_ACQUIRE, "agent");
            xb_add(&bar[XB_XGEN(b.x)], 1u);
            asm volatile("s_waitcnt vmcnt(0)" ::: "memory");
        } else {
            XB_SPIN(xb_ld(&bar[XB_XGEN(b.x)]) == gen, bar);
            __builtin_amdgcn_fence(__ATOMIC_ACQUIRE, "agent");
            asm volatile("s_waitcnt vmcnt(0)" ::: "memory");
        }
    }
    __syncthreads();
}

extern __shared__ __attribute__((aligned(16))) unsigned char dlds[];
constexpr int LDS_BYTES = 147456, LDS_MISC = 131072;
constexpr int CW_BAR = 4096;

#define ATTN_MLA_ARGS(P) (const bf16_t*)((P).ws + WS_QMLA), 576, (const bf16_t*)((P).ws + WS_KMLA), 576, (const bf16_t*)((P).ws + WS_KVRAW) + 64, 768, 128, (bf16_t*)((P).ws + WS_OBUF), 768, (const float*)nullptr
#define ATTN_FOX_ARGS(P) (const bf16_t*)((P).ws + WS_PROJ) + PC_FQ, PJ, (const bf16_t*)((P).ws + WS_PROJ) + PC_FK, PJ, (const bf16_t*)((P).ws + WS_PROJ) + PC_FV, PJ, 64, (bf16_t*)((P).ws + WS_OBUF) + 384, 768, (const float*)((P).ws + WS_CB2)

typedef const __attribute__((address_space(4))) Params* KParams;
template <class T> __device__ __forceinline__ T launder_s(T p) { asm volatile("" : "+s"(p)); return p; }
__device__ __forceinline__ Params load_params(KParams kp, int wid) { Params r; r.x = kp->x; r.c = kp->c; r.pos = kp->pos; r.norm_mix = kp->norm_mix; r.norm_ffn = kp->norm_ffn; r.w_ada = kp->w_ada; r.b_ada = kp->b_ada; r.w_in = kp->w_in; r.lam_re = kp->lam_re; r.lam_im = kp->lam_im; r.log_dt = kp->log_dt; r.b_re = kp->b_re; r.b_im = kp->b_im; r.c_re = kp->c_re; r.c_im = kp->c_im; r.ssm_d = kp->ssm_d; r.w_glu = kp->w_glu; r.b_glu = kp->b_glu; r.q_norm = kp->q_norm; r.kv_norm = kp->kv_norm; r.w_uq = kp->w_uq; r.w_ukv = kp->w_ukv; r.mla_gq = kp->mla_gq; r.mla_gk = kp->mla_gk; r.fox_bf = kp->fox_bf; r.fox_gq = kp->fox_gq; r.fox_gk = kp->fox_gk; r.out_norm = kp->out_norm; r.w_out = kp->w_out; r.ffn_wg = kp->ffn_wg; r.ffn_wu = kp->ffn_wu; r.ffn_wd = kp->ffn_wd; r.moe_wr = kp->moe_wr; r.moe_br = kp->moe_br; r.moe_wg = kp->moe_wg; r.moe_wu = kp->moe_wu; r.moe_wd = kp->moe_wd; r.out = kp->out; r.ws = kp->ws; r.wid = wid; r.pad = 0; return r; }
__device__ __forceinline__ void sub64_barrier(unsigned* word) {
    asm volatile("s_waitcnt vmcnt(0)" ::: "memory");
    __syncthreads();
    if (threadIdx.x == 0) {
        __builtin_amdgcn_s_waitcnt(0);
        __builtin_amdgcn_fence(__ATOMIC_RELEASE, "agent");
        asm volatile("s_waitcnt vmcnt(0)" ::: "memory");
        (void)xb_add(word, 1u);
        unsigned sp = 0; while (xb_ld(word) < 64u) { __builtin_amdgcn_s_sleep(1); if (++sp > XB_SPIN_CAP) break; }
        __builtin_amdgcn_fence(__ATOMIC_ACQUIRE, "agent");
        asm volatile("s_waitcnt vmcnt(0)" ::: "memory");
    }
    __syncthreads();
}
__device__ __forceinline__ void ph_glu_sub(unsigned char* lds, Params P, int layer) {
    const int BIDX = launder_i((int)blockIdx.x), GDIM = launder_i((int)gridDim.x);
    if (GDIM < 64) return;
    if (BIDX < 64) { sub64_barrier((unsigned*)(launder_ptr(P.ws) + WS_CTL) + CW_SUB + (layer & 7) * 32); ph_glu_opt(lds, P, layer, 1); }
}
__global__ void __launch_bounds__(512, 2) k_mega(Params P_karg) {
    const KParams kp = (KParams)__builtin_amdgcn_kernarg_segment_ptr();
const int wid_s = __builtin_amdgcn_readfirstlane((int)(threadIdx.x >> 6));
#define P load_params(launder_s(kp), wid_s)
    unsigned char* lds = dlds;
    volatile LAS unsigned* xbw = (volatile LAS unsigned*)(dlds + LDS_MISC);
    if (threadIdx.x < 4) xbw[threadIdx.x] = 0u;
    __syncthreads();
    (void)xcd_barrier_post((unsigned*)(launder_s(kp)->ws + WS_CTL) + CW_BAR, xbw);
#define GBAR() do { XcdBarrier b_; b_.bar = (unsigned*)(launder_s(kp)->ws + WS_CTL) + CW_BAR; b_.x = xb_xcc_id(); b_.st = (volatile LAS unsigned*)(dlds + LDS_MISC); xcd_barrier(b_); if (DUP & 65536) xcd_barrier(b_); } while (0)
    ph_prologue(lds, P);
    if (DUP & (1 << 10)) { GBAR(); ph_prologue(lds, P); }
    ph_convert(lds, P, 0); ph_ssm_tab1(lds, P, 0);
    GBAR();
    for (int layer = 0; layer < DEPTH; ++layer) {
#define DUPIF(bit, ...) if (DUP & (1 << (bit))) { GBAR(); __VA_ARGS__ }
        { const Params Pl = P; if (layer == 0) ph_norm<0, 1>(lds, Pl, layer, Pl.x, -1); else if (layer == 2) ph_norm<0, 2>(lds, Pl, layer, nullptr, 1); else ph_norm<0, 0>(lds, Pl, layer, nullptr, -1); }
        if (layer != 0) { ph_convert(lds, P, layer); ph_ssm_tab1(lds, P, layer); }
        if (layer != 2) { DUPIF(19, { const Params Pl = P; if (layer == 0) ph_norm<0, 1>(lds, Pl, layer, Pl.x, -1); else ph_norm<0, 0>(lds, Pl, layer, nullptr, -1); }) }
        DUPIF(13, ph_convert(lds, P, layer);)
        DUPIF(14, ph_ssm_tab1(lds, P, layer);)
        GBAR();
        ph_inproj_opt(lds, P, layer);
        GBAR();
        ph_ssm_tab2(lds, P, layer);
        DUPIF(12, ph_ssm_tab2(lds, P, layer);)
        ph_fox_cumsum(lds, P, layer);
        ph_qup_opt(lds, P, layer); ph_kvup_opt(lds, P, layer);
        DUPIF(1, ph_qup_opt(lds, P, layer); ph_kvup_opt(lds, P, layer); ph_ssm_gemm1(lds, P, layer);)
        GBAR();
        ph_ssm_gemm2(lds, P, layer);
        ph_glu_sub(lds, P, layer);
        ph_attn_all(lds, P, layer);
        DUPIF(2, ph_ssm_gemm2(lds, P, layer); ph_attn_mla(lds, P, layer + 4); ph_attn_fox(lds, P, layer + 4);)
        GBAR();
        if (launder_i((int)gridDim.x) < 64) { ph_glu_opt(lds, P, layer); GBAR(); }
        DUPIF(17, ph_outproj_opt(lds, P, layer, 1);)
        ph_outproj_opt(lds, P, layer);
        GBAR();
        if ((layer & 1) == 0) {
            { const Params Pl = P; ph_norm<1, 0>(lds, Pl, layer, nullptr, -1); }
            DUPIF(8, { const Params Pl = P; ph_norm<1, 0>(lds, Pl, layer, nullptr, -1); })
            GBAR();
            ph_ffn1_opt(lds, P, layer);
            DUPIF(4, ph_ffn1_opt(lds, P, layer);)
            GBAR();
            DUPIF(18, ph_ffn2_opt(lds, P, layer, 1);)
            ph_ffn2_opt(lds, P, layer);
            GBAR();
        } else {
            { const Params Pl = P; ph_norm<2, 0>(lds, Pl, layer, nullptr, -1); }
            GBAR();
            ph_moe1_opt(lds, P, layer);
            DUPIF(4, ph_moe1_opt(lds, P, layer);)
            GBAR();
            ph_moe2_opt(lds, P, layer);
            DUPIF(4, ph_moe2_opt(lds, P, layer);)
            GBAR();
            if (layer == DEPTH - 1) ph_moe_combine(lds, P, layer);
        }
    }
}
#undef P

#if CHECK || !MEGA
#define KWRAP(NAME, DECL, CALL) __global__ void __launch_bounds__(512, 2) k_##NAME DECL { P.wid = __builtin_amdgcn_readfirstlane((int)(threadIdx.x >> 6)); ph_##NAME CALL; }
#define KWRAPT(NAME, TDECL, TARGS, DECL, CALL) template <TDECL> __global__ void __launch_bounds__(512, 2) k_##NAME DECL { P.wid = __builtin_amdgcn_readfirstlane((int)(threadIdx.x >> 6)); ph_##NAME<TARGS> CALL; }
KWRAP(prologue, (Params P), (dlds, P))
KWRAPT(norm, int MODE, MODE, (Params P, int layer, const float* src, int copy, int comb), (dlds, P, layer, src, copy, comb))
KWRAP(convert, (Params P, int layer), (dlds, P, layer))
KWRAP(inproj_opt, (Params P, int layer), (dlds, P, layer))
KWRAP(inproj_naive, (Params P, int layer, int chk), (dlds, P, layer, chk))
KWRAP(fox_cumsum, (Params P, int layer), (dlds, P, layer))
KWRAP(qup_opt, (Params P, int layer), (dlds, P, layer))
KWRAP(kvup_opt, (Params P, int layer), (dlds, P, layer))
KWRAP(qup_naive, (Params P, int layer, int chk), (dlds, P, layer, chk))
KWRAP(kvup_naive, (Params P, int layer, int chk), (dlds, P, layer, chk))
KWRAP(passE2, (Params P, int layer), (dlds, P, layer))
template <int DQK, int MODE> __global__ void __launch_bounds__(512, 2) k_attn_naive(Params P, const bf16_t* Q, int ldq, const bf16_t* K, int ldk, const bf16_t* V, int ldv, int vhs, bf16_t* O, int ldo, const float* cb2, int chk) {
    P.wid = __builtin_amdgcn_readfirstlane((int)(threadIdx.x >> 6)); ph_attn_naive<DQK, MODE>(dlds, P, Q, ldq, K, ldk, V, ldv, vhs, O, ldo, cb2, chk); }
KWRAP(attn_mla, (Params P, int layer), (dlds, P, layer))
KWRAP(attn_fox, (Params P, int layer), (dlds, P, layer))
KWRAP(ssm_tab1, (Params P, int layer), (dlds, P, layer))
KWRAP(ssm_tab2, (Params P, int layer), (dlds, P, layer))
KWRAP(ssm_gemm1, (Params P, int layer), (dlds, P, layer))
KWRAP(ssm_carry, (Params P, int layer), (dlds, P, layer))
KWRAP(ssm_gemm2, (Params P, int layer), (dlds, P, layer))
KWRAP(ssm_naive, (Params P, int layer, int chk), (dlds, P, layer, chk))
KWRAP(glu_opt, (Params P, int layer), (dlds, P, layer))
KWRAP(glu_naive, (Params P, int layer, int chk), (dlds, P, layer, chk))
KWRAP(merge, (Params P), (dlds, P))
KWRAP(outproj_opt, (Params P, int layer), (dlds, P, layer))
KWRAP(outproj_naive, (Params P, int layer, float* dst, int chk), (dlds, P, layer, dst, chk))
KWRAP(cmp_x, (Params P, const float* xe, int stage), (dlds, P, xe, stage))
KWRAP(ffn1_opt, (Params P, int layer), (dlds, P, layer))
KWRAP(ffn2_opt, (Params P, int layer), (dlds, P, layer))
KWRAP(ffn1_naive, (Params P, int layer, int chk), (dlds, P, layer, chk))
KWRAP(ffn2_naive, (Params P, int layer, float* dst, int chk), (dlds, P, layer, dst, chk))
KWRAP(moe_gather, (Params P, int layer), (dlds, P, layer))
KWRAP(moe1_opt, (Params P, int layer), (dlds, P, layer))
KWRAP(moe2_opt, (Params P, int layer), (dlds, P, layer))
KWRAP(moe1_naive, (Params P, int layer, int chk), (dlds, P, layer, chk))
KWRAP(moe2_naive, (Params P, int layer, int chk), (dlds, P, layer, chk))
KWRAP(moe_combine, (Params P, int layer), (dlds, P, layer))
KWRAP(check_final, (Params P), (dlds, P))
#endif

template <class... KA, class... A> static void launch(void (*k)(KA...), int grid, hipStream_t stream, A... a) {
    (void)hipFuncSetAttribute((const void*)k, hipFuncAttributeMaxDynamicSharedMemorySize, LDS_BYTES);
    hipLaunchKernelGGL(k, dim3(grid), dim3(512), LDS_BYTES, stream, a...);
}
extern "C" void kernel_launch(void* const* d_in, const int* in_sizes, int n_in, void* d_out, int out_size, void* d_ws, size_t ws_size, hipStream_t stream) {
    if (ws_size < WS_END || n_in < 37) return;
    Params P{};
    P.x = (const float*)d_in[0]; P.c = (const float*)d_in[1]; P.pos = (const int*)d_in[2]; P.norm_mix = (const float*)d_in[3]; P.norm_ffn = (const float*)d_in[4];
    P.w_ada = (const float*)d_in[5]; P.b_ada = (const float*)d_in[6]; P.w_in = (const float*)d_in[7];
    P.lam_re = (const float*)d_in[8]; P.lam_im = (const float*)d_in[9]; P.log_dt = (const float*)d_in[10]; P.b_re = (const float*)d_in[11]; P.b_im = (const float*)d_in[12];
    P.c_re = (const float*)d_in[13]; P.c_im = (const float*)d_in[14]; P.ssm_d = (const float*)d_in[15]; P.w_glu = (const float*)d_in[16]; P.b_glu = (const float*)d_in[17];
    P.q_norm = (const float*)d_in[18]; P.kv_norm = (const float*)d_in[19]; P.w_uq = (const float*)d_in[20]; P.w_ukv = (const float*)d_in[21]; P.mla_gq = (const float*)d_in[22]; P.mla_gk = (const float*)d_in[23];
    P.fox_bf = (const float*)d_in[24]; P.fox_gq = (const float*)d_in[25]; P.fox_gk = (const float*)d_in[26]; P.out_norm = (const float*)d_in[27]; P.w_out = (const float*)d_in[28];
    P.ffn_wg = (const float*)d_in[29]; P.ffn_wu = (const float*)d_in[30]; P.ffn_wd = (const float*)d_in[31];
    P.moe_wr = (const float*)d_in[32]; P.moe_br = (const float*)d_in[33]; P.moe_wg = (const float*)d_in[34]; P.moe_wu = (const float*)d_in[35]; P.moe_wd = (const float*)d_in[36];
    P.out = (float*)d_out; P.ws = (unsigned char*)d_ws;
    (void)hipMemsetAsync(d_ws, 0, CTL_BYTES, stream);
#if MEGA && !CHECK
    static int grid = 0;
    if (!grid) { int dev = 0, cus = 0; (void)hipGetDevice(&dev); (void)hipDeviceGetAttribute(&cus, hipDeviceAttributeMultiprocessorCount, dev); grid = cus > 0 ? cus : 256; }
    launch(k_mega, grid, stream, P);
#else
    float* xe = (float*)(P.ws + WS_XE);
    const int G = 256;
    launch(k_prologue, G, stream, P);
    for (int layer = 0; layer < DEPTH; ++layer) {
        launch(k_norm<0>, G * 4, stream, P, layer, layer == 0 ? P.x : (const float*)P.out, (layer == 0 || layer == 2) ? 1 : 0, layer == 2 ? 1 : -1);
        launch(k_convert, G, stream, P, layer);
        launch(k_ssm_tab1, G, stream, P, layer);
        launch(k_inproj_opt, G, stream, P, layer);
        launch(k_fox_cumsum, G, stream, P, layer);
        launch(k_ssm_tab2, G, stream, P, layer);
        launch(k_qup_opt, G, stream, P, layer); launch(k_kvup_opt, G, stream, P, layer);
        if (CHECK) { launch(k_qup_naive, G * 4, stream, P, layer, 2); launch(k_kvup_naive, G * 4, stream, P, layer, 3); }
        launch(k_ssm_gemm1, G, stream, P, layer);
        launch(k_ssm_gemm2, G, stream, P, layer);
        launch(k_attn_mla, G, stream, P, layer); launch(k_attn_fox, G, stream, P, layer);
        if (CHECK) { launch(k_attn_naive<96, 0>, 384, stream, P, ATTN_MLA_ARGS(P), 10); launch(k_attn_naive<64, 1>, 384, stream, P, ATTN_FOX_ARGS(P), 11); }
        if (CHECK) launch(k_ssm_naive, 16, stream, P, layer, 12);
        launch(k_glu_opt, G, stream, P, layer);
        if (CHECK) launch(k_glu_naive, G * 2, stream, P, layer, 4);
        launch(k_merge, G * 4, stream, P);
        if (CHECK) launch(k_outproj_naive, G * 4, stream, P, layer, xe, 5);
        launch(k_outproj_opt, G, stream, P, layer);
        if (CHECK) launch(k_cmp_x, G * 4, stream, P, (const float*)xe, 5);
        if ((layer & 1) == 0) {
            launch(k_norm<1>, G * 4, stream, P, layer, (const float*)P.out, 0, -1);
            launch(k_ffn1_opt, G, stream, P, layer);
            if (CHECK) { launch(k_ffn1_naive, G * 8, stream, P, layer, 6); launch(k_ffn2_naive, G * 4, stream, P, layer, xe, 7); }
            launch(k_ffn2_opt, G, stream, P, layer);
            if (CHECK) launch(k_cmp_x, G * 4, stream, P, (const float*)xe, 7);
        } else {
            launch(k_norm<2>, G * 4, stream, P, layer, (const float*)P.out, 0, -1);
            launch(k_moe1_opt, G, stream, P, layer);
            if (CHECK) launch(k_moe1_naive, G * 8, stream, P, layer, 8);
            launch(k_moe2_opt, G, stream, P, layer);
            if (CHECK) launch(k_moe2_naive, G * 4, stream, P, layer, 9);
            if (layer == DEPTH - 1) launch(k_moe_combine, G * 4, stream, P, layer);
        }
    }
    if (CHECK) launch(k_check_final, G * 4, stream, P);
#endif
}
```

```cpp
#include <hip/hip_runtime.h>
#include <stdint.h>
#include <math.h>

typedef unsigned short bf16_t;
typedef float f32x4 __attribute__((ext_vector_type(4)));
typedef unsigned u32x2 __attribute__((ext_vector_type(2)));
typedef unsigned u32x4 __attribute__((ext_vector_type(4)));

#ifndef DUP
#define DUP 0
#endif
#ifndef CHECK
#define CHECK 0
#endif
#ifndef MEGA
#define MEGA 1
#endif
#define LATE_CONVERT 0

constexpr int NB = 8, SEQ = 4096, T = NB * SEQ, D = 1024, DEPTH = 4;
constexpr int INC = 1830, PJ = 2048;
constexpr int PC_U = 0, PC_CQ = 256, PC_CKV = 512, PC_KR = 640, PC_FQ = 768, PC_FK = 1152, PC_FV = 1536, PC_FG = 1920;
constexpr int DFF = 2816, NEXP = 8, DFE = 1408;
constexpr float EPS = 1e-6f;
constexpr float LOG2E = 1.4426950408889634f;
constexpr float C2_MLA = 0.10206207261596577f * LOG2E;
constexpr float C2_FOX = 0.125f * LOG2E;
constexpr int NSLOT = 2 * T + NEXP * 256;

constexpr size_t MiB = 1u << 20;
constexpr size_t WS_CTL = 0, CTL_BYTES = 1 * MiB;
constexpr size_t WS_ADA = 1 * MiB;
constexpr size_t WS_COS = 2 * MiB, WS_SIN = 4 * MiB;
constexpr size_t WS_RSTDQ = 6 * MiB, WS_RSTDKV = 6 * MiB + 128 * 1024;
constexpr size_t WS_FG = 7 * MiB;
constexpr size_t WS_CLOC = 8 * MiB;
constexpr size_t WS_CTOT = 8 * MiB + 896 * 1024;
constexpr size_t WS_CB2 = 9 * MiB;
constexpr size_t WS_TOKINFO = 10 * MiB;
constexpr size_t WS_PROB = 10 * MiB + 512 * 1024;
constexpr size_t WS_SLOTOF = 10 * MiB + 768 * 1024;
constexpr size_t WS_P2E = 11 * MiB;
constexpr size_t WS_YG = 20 * MiB;
constexpr size_t WS_OSSM = 36 * MiB;
constexpr size_t WS_W = 72 * MiB;
constexpr size_t W_IN = WS_W, W_UQ = WS_W + 4 * MiB, W_UKV = WS_W + 4 * MiB + 512 * 1024, W_GLU = WS_W + 5 * MiB, W_OUT = WS_W + 6 * MiB;
constexpr size_t W_F1 = WS_W + 8 * MiB, W_F2 = WS_W + 52 * MiB, W_B1T = WS_W + 76 * MiB, W_T2T = WS_W + 80 * MiB;
constexpr size_t WS_UG = 52 * MiB;
constexpr size_t WS_SLOC = 12 * MiB;
constexpr size_t WS_KM = WS_W + 90 * MiB;
constexpr size_t WS_LAMP = WS_W + 91 * MiB;
constexpr size_t WS_BBAR = WS_W + 92 * MiB;
constexpr size_t WS_SSQ = WS_W + 93 * MiB;
constexpr size_t WS_HBUF = 168 * MiB;
constexpr size_t WS_BIG = 232 * MiB;
constexpr size_t WS_PROJ = WS_BIG;
constexpr size_t WS_QRAW = WS_BIG + 128 * MiB;
constexpr size_t WS_KVRAW = WS_BIG + 176 * MiB;
constexpr size_t WS_QMLA = WS_BIG + 224 * MiB;
constexpr size_t WS_KMLA = WS_BIG + 260 * MiB;
constexpr size_t WS_OBUF = WS_BIG + 296 * MiB;
constexpr size_t WS_ACT = WS_BIG;
constexpr size_t WS_HG = WS_BIG;
constexpr size_t WS_ACTM = WS_BIG + 132 * MiB;
constexpr size_t WS_LIST = WS_BIG + 320 * MiB;
constexpr size_t WS_XE = WS_BIG + 192 * MiB;
constexpr size_t WS_END = WS_BIG + 344 * MiB;
constexpr size_t WS_SSQ2 = 36 * MiB;
constexpr size_t WS_XB2 = WS_BIG + 68 * MiB;

constexpr int CW_CNT = 1024;
constexpr int CW_ATTN = 1536;
constexpr int CW_SUB = 12288;
constexpr int CW_ATTQ = 8192;
constexpr int CW_CHKE = 2048, CW_CHKR = 2112;

struct Params {
    const float* x; const float* c; const int* pos; const float* norm_mix; const float* norm_ffn; const float* w_ada; const float* b_ada; const float* w_in;
    const float* lam_re; const float* lam_im; const float* log_dt; const float* b_re; const float* b_im; const float* c_re; const float* c_im;
    const float* ssm_d; const float* w_glu; const float* b_glu;
    const float* q_norm; const float* kv_norm; const float* w_uq; const float* w_ukv; const float* mla_gq; const float* mla_gk;
    const float* fox_bf; const float* fox_gq; const float* fox_gk; const float* out_norm; const float* w_out;
    const float* ffn_wg; const float* ffn_wu; const float* ffn_wd;
    const float* moe_wr; const float* moe_br; const float* moe_wg; const float* moe_wu; const float* moe_wd;
    float* out; unsigned char* ws;
    int wid, pad;
};

__device__ __forceinline__ float bf2f(bf16_t h) { return __uint_as_float(((unsigned)h) << 16); }
__device__ __forceinline__ bf16_t f2bf(float f) { unsigned u = __float_as_uint(f); return (bf16_t)((u + 0x7fffu + ((u >> 16) & 1u)) >> 16); }
__device__ __forceinline__ unsigned pk2(float lo, float hi) { return (unsigned)f2bf(lo) | ((unsigned)f2bf(hi) << 16); }
__device__ __forceinline__ int hidden_tid(int wid) { int t; asm volatile("v_mbcnt_lo_u32_b32 %0, -1, 0\n\tv_mbcnt_hi_u32_b32 %0, -1, %0\n\tv_lshl_add_u32 %0, %1, 6, %0" : "=&v"(t) : "s"(wid)); return t; }
__device__ __forceinline__ int launder_i(int v) { asm volatile("" : "+s"(v)); return v; }
template <class T> __device__ __forceinline__ T* launder_ptr(T* p) { asm volatile("" : "+s"(p)); return p; }
__device__ __forceinline__ float shx(float v, int o, int lane) { return __int_as_float(__builtin_amdgcn_ds_bpermute((lane ^ o) << 2, __float_as_int(v))); }
__device__ __forceinline__ float wsum(float v, int lane) {
#pragma unroll
    for (int o = 32; o > 0; o >>= 1) v += shx(v, o, lane);
    return v;
}
__device__ __forceinline__ float wmax(float v, int lane) {
#pragma unroll
    for (int o = 32; o > 0; o >>= 1) v = fmaxf(v, shx(v, o, lane));
    return v;
}
__device__ __forceinline__ float silu_f(float v) { return v / (1.f + __expf(-v)); }
__device__ __forceinline__ float sigmoid_f(float v) { return 1.f / (1.f + __expf(-v)); }
__device__ __forceinline__ float gelu_tanh(float x) { return 0.5f * x * (1.f + tanhf(0.7978845608028654f * (x + 0.044715f * x * x * x))); }
__device__ __forceinline__ bf16_t* xstream(const Params& P, int idx) { return idx >= DEPTH ? (bf16_t*)(P.ws + WS_XB2) : (bf16_t*)(P.out + (size_t)T * D / 2); }
__device__ __forceinline__ size_t ymoe_off(int layer) { return layer == DEPTH - 1 ? WS_HBUF : WS_HG; }
__device__ __forceinline__ float* adap(const Params& P, int layer, int b, int which) { return (float*)(P.ws + WS_ADA) + ((size_t)(layer * NB + b) * 6 + which) * D; }

struct Chk { float e, r; };
__device__ __forceinline__ void chk_upd(Chk& c, float naive, float stored) { const float d = fabsf(naive - stored); c.e = (d != d) ? INFINITY : fmaxf(c.e, d); c.r = fmaxf(c.r, fabsf(naive)); }
__device__ __forceinline__ void chk_commit(const Params& P, int stage, Chk c) {
    const int lane_ = (int)(threadIdx.x & 63); const float e = wmax(c.e, lane_), r = wmax(c.r, lane_);
    if (lane_ == 0) { unsigned* ctl = (unsigned*)(P.ws + WS_CTL); atomicMax(ctl + CW_CHKE + stage, __float_as_uint(e)); atomicMax(ctl + CW_CHKR + stage, __float_as_uint(r)); }
}
__device__ __forceinline__ void st4(bf16_t* p, const float (&v)[4], int chk, Chk& c) {
    if (!chk) { u32x2 o; o.x = pk2(v[0], v[1]); o.y = pk2(v[2], v[3]); *(u32x2*)p = o; }
    else { const u32x2 o = *(const u32x2*)p; chk_upd(c, v[0], bf2f(o.x & 0xffff)); chk_upd(c, v[1], bf2f(o.x >> 16)); chk_upd(c, v[2], bf2f(o.y & 0xffff)); chk_upd(c, v[3], bf2f(o.y >> 16)); }
}
__device__ __forceinline__ void st2(bf16_t* p, float a, float b, int chk, Chk& c) {
    if (!chk) *(unsigned*)p = pk2(a, b);
    else { const unsigned o = *(const unsigned*)p; chk_upd(c, a, bf2f(o & 0xffff)); chk_upd(c, b, bf2f(o >> 16)); }
}

template <class FA, class FT, class FB, class FS>
__device__ __forceinline__ void naive_gemm(int M, int N, int K, FA fa, FT ft, FB fb, FS fs, float* sm) {
    const int tid = threadIdx.x, ty = tid >> 5, tx = tid & 31;
    float (*As)[132] = (float (*)[132])sm;
    float (*Bs)[132] = (float (*)[132])(sm + 16 * 132);
    const int tm = (M + 127) / 128, tn = (N + 127) / 128;
    for (int tile = blockIdx.x; tile < tm * tn; tile += gridDim.x) {
        const int bm = (tile / tn) * 128, bn = (tile % tn) * 128;
        const int ctx = ft(bm);
        float acc[8][4];
#pragma unroll
        for (int i = 0; i < 8; ++i)
#pragma unroll
            for (int j = 0; j < 4; ++j) acc[i][j] = 0.f;
        for (int k0 = 0; k0 < K; k0 += 16) {
#pragma unroll
            for (int j = 0; j < 4; ++j) {
                const int e = tid + 512 * j, r = e >> 4, kk = e & 15;
                As[kk][r] = (bm + r < M) ? fa(bm + r, k0 + kk) : 0.f;
                const int k2 = e >> 7, cc = e & 127;
                Bs[k2][cc] = (bn + cc < N) ? fb(k0 + k2, bn + cc, ctx) : 0.f;
            }
            __syncthreads();
#pragma unroll
            for (int kk = 0; kk < 16; ++kk) {
                const f32x4 a0 = *(const f32x4*)&As[kk][ty * 8], a1 = *(const f32x4*)&As[kk][ty * 8 + 4], b = *(const f32x4*)&Bs[kk][tx * 4];
                const float a[8] = {a0[0], a0[1], a0[2], a0[3], a1[0], a1[1], a1[2], a1[3]};
#pragma unroll
                for (int i = 0; i < 8; ++i)
#pragma unroll
                    for (int j = 0; j < 4; ++j) acc[i][j] = fmaf(a[i], b[j], acc[i][j]);
            }
            __syncthreads();
        }
#pragma unroll
        for (int i = 0; i < 8; ++i) { const int row = bm + ty * 8 + i; if (row < M) fs(row, bn + tx * 4, acc[i]); }
    }
}

__device__ __forceinline__ void ph_prologue(unsigned char* lds, Params P) {
    const int TIDX = hidden_tid(P.wid), BIDX = launder_i((int)blockIdx.x), GDIM = launder_i((int)gridDim.x); P.ws = launder_ptr(P.ws); P.out = launder_ptr(P.out);
    float* cact = (float*)lds;
    float* red = cact + NB * D;
    { f32x4 cv[4];
#pragma unroll
      for (int i = 0; i < 4; ++i) cv[i] = *(const f32x4*)(P.c + (size_t)(i * 512 + TIDX) * 4);
#pragma unroll
      for (int i = 0; i < 4; ++i) *(f32x4*)(cact + (size_t)(i * 512 + TIDX) * 4) = (f32x4){silu_f(cv[i][0]), silu_f(cv[i][1]), silu_f(cv[i][2]), silu_f(cv[i][3])}; }
    __syncthreads();
    float* ada = (float*)(P.ws + WS_ADA);
    const int j4 = (TIDX & 7) * 4, ks = TIDX >> 3;
    f32x4 wv[16], wn[16];
    auto load_item = [&](int item, f32x4 (&w_)[16]) { const int layer = item / 192, c0 = (item % 192) * 32;
        const float* w = P.w_ada + (size_t)layer * D * 6 * D + (size_t)(ks * 16) * 6 * D + c0 + j4;
#pragma unroll
        for (int u = 0; u < 16; ++u) w_[u] = *(const f32x4*)(w + (size_t)u * 6 * D); };
    if (BIDX < DEPTH * 192) load_item(BIDX, wv);
    for (int item = BIDX; item < DEPTH * 192; item += GDIM) {
        const int layer = item / 192, c0 = (item % 192) * 32;
        if (item + GDIM < DEPTH * 192) load_item(item + GDIM, wn);
        f32x4 acc[NB];
#pragma unroll
        for (int b = 0; b < NB; ++b) acc[b] = (f32x4){0.f, 0.f, 0.f, 0.f};
#pragma unroll
        for (int u = 0; u < 16; ++u)
#pragma unroll
            for (int b = 0; b < NB; ++b) acc[b] += cact[b * D + ks * 16 + u] * wv[u];
#pragma unroll
        for (int b = 0; b < NB; ++b) *(f32x4*)(red + (ks * NB + b) * 32 + j4) = acc[b];
        __syncthreads();
        if (TIDX < 256) { const int b = TIDX >> 5, jj = TIDX & 31; float s = 0.f;
            for (int k2 = 0; k2 < 64; ++k2) s += red[(k2 * NB + b) * 32 + jj];
            ada[(size_t)(layer * NB + b) * 6 * D + c0 + jj] = s + P.b_ada[layer * 6 * D + c0 + jj]; }
        __syncthreads();
#pragma unroll
        for (int u = 0; u < 16; ++u) wv[u] = wn[u];
    }
    float* cs = (float*)(P.ws + WS_COS); float* sn = (float*)(P.ws + WS_SIN);
    const int gt = BIDX * 512 + TIDX, nt = GDIM * 512;
    for (int idx0 = gt; idx0 < T * 16; idx0 += 4 * nt) {
        int pp[4];
#pragma unroll
        for (int u = 0; u < 4; ++u) { const int idx = idx0 + u * nt; pp[u] = idx < T * 16 ? P.pos[idx >> 4] : 0; }
#pragma unroll
        for (int u = 0; u < 4; ++u) { const int idx = idx0 + u * nt;
            if (idx < T * 16) { const int jx = idx & 15; const float ang = (float)pp[u] * exp2f(-(float)jx * (13.287712379549449f / 16.f));
                float sv_, cv_; sincosf(ang, &sv_, &cv_); cs[idx] = cv_; sn[idx] = sv_; } }
    }
}

__device__ __forceinline__ void moe_offsets(const Params& P, int layer, int (&off)[NEXP + 1]) {
    const unsigned* cnt = (const unsigned*)(P.ws + WS_CTL) + CW_CNT + 16 * (layer / 2);
    int o = 0;
#pragma unroll
    for (int e = 0; e < NEXP; ++e) { off[e] = o; o += (int)((cnt[e] + 255u) >> 8) << 8; }
    off[NEXP] = o;
}
__device__ __forceinline__ int moe_sel(const int (&off)[NEXP + 1], int e) { int r = 0;
#pragma unroll
    for (int j = 0; j < NEXP; ++j) if (e == j) r = off[j];
    return r; }
template <int MODE, int VAR>
__device__ __forceinline__ void ph_norm(unsigned char* lds, Params P, int layer, const float* src, int comb) {
    const int TIDX = hidden_tid(P.wid), BIDX = launder_i((int)blockIdx.x), GDIM = launder_i((int)gridDim.x); P.ws = launder_ptr(P.ws); P.out = launder_ptr(P.out);
    const int wid = TIDX >> 6, lane = TIDX & 63;
    const float* gain = (MODE == 0 ? P.norm_mix : P.norm_ffn) + layer * D;
    bf16_t* hb = (bf16_t*)(P.ws + WS_HBUF); bf16_t* xs = xstream(P, (MODE == 2 && layer == DEPTH - 1) ? DEPTH : layer);
    float* wrl = (float*)(lds + 4096);
    if (MODE == 2) { if (TIDX < 16) ((unsigned*)lds)[TIDX] = 0u;
        const f32x4* src4 = (const f32x4*)(P.moe_wr + (size_t)(layer / 2) * D * NEXP); for (int i = TIDX; i < D * NEXP / 4; i += 512) ((f32x4*)wrl)[i] = src4[i];
        __syncthreads(); }
    constexpr int NR = 4;
    const int RPW = (T + GDIM * 8 - 1) / (GDIM * 8), rbeg = (BIDX * 8 + wid) * RPW;
    int off_[NEXP + 1];
    if (VAR == 2) moe_offsets(P, comb, off_);
    const bf16_t* ym = (const bf16_t*)(P.ws + WS_HG); const int* tinfo = (const int*)(P.ws + WS_TOKINFO); const float* prob = (const float*)(P.ws + WS_PROB);
    int bcur = -1; f32x4 av[4], bv[4], gq[4];
    for (int j0 = 0; j0 < RPW; j0 += NR) {
        f32x4 vf[VAR == 1 ? NR : 1][4]; u32x2 w[VAR == 1 ? 1 : NR][4], ya[VAR == 2 ? NR : 1][4], yb[VAR == 2 ? NR : 1][4]; float p0[NR], p1[NR];
        if (VAR == 1) {
#pragma unroll
            for (int k = 0; k < NR; ++k) { const int row = rbeg + j0 + k;
                if (j0 + k < RPW && row < T) {
#pragma unroll
                    for (int q = 0; q < 4; ++q) vf[VAR == 1 ? k : 0][q] = *(const f32x4*)(src + (size_t)row * D + q * 256 + lane * 4); } }
        } else {
#pragma unroll
            for (int k = 0; k < NR; ++k) { const int row = rbeg + j0 + k;
                if (j0 + k < RPW && row < T) {
#pragma unroll
                    for (int q = 0; q < 4; ++q) w[VAR == 1 ? 0 : k][q] = *(const u32x2*)(xs + (size_t)row * D + q * 256 + lane * 4); } }
            if (VAR == 2) {
                int s0[NR], s1[NR];
#pragma unroll
                for (int k = 0; k < NR; ++k) { const int row = rbeg + j0 + k;
                    if (j0 + k < RPW && row < T) { const int* ti_ = tinfo + (size_t)row * 4; s0[k] = moe_sel(off_, ti_[0]) + ti_[1]; s1[k] = moe_sel(off_, ti_[2]) + ti_[3]; p0[k] = prob[(size_t)row * 2]; p1[k] = prob[(size_t)row * 2 + 1]; } }
#pragma unroll
                for (int k = 0; k < NR; ++k) { const int row = rbeg + j0 + k;
                    if (j0 + k < RPW && row < T) {
#pragma unroll
                        for (int q = 0; q < 4; ++q) { ya[VAR == 2 ? k : 0][q] = *(const u32x2*)(ym + (size_t)s0[k] * D + q * 256 + lane * 4); yb[VAR == 2 ? k : 0][q] = *(const u32x2*)(ym + (size_t)s1[k] * D + q * 256 + lane * 4); } } }
            }
        }
#pragma unroll
        for (int k = 0; k < NR; ++k) { const int row = rbeg + j0 + k;
            if (j0 + k < RPW && row < T) {
                const int b = row / SEQ;
                f32x4 v[4];
#pragma unroll
                for (int q = 0; q < 4; ++q) { if (VAR == 1) v[q] = vf[VAR == 1 ? k : 0][q]; else { const u32x2 ww = w[VAR == 1 ? 0 : k][q]; v[q] = (f32x4){bf2f(ww.x & 0xffff), bf2f(ww.x >> 16), bf2f(ww.y & 0xffff), bf2f(ww.y >> 16)}; } }
                if (b != bcur) {
                    bcur = b; const float* sh = adap(P, layer, b, MODE == 0 ? 0 : 3); const float* sc = adap(P, layer, b, MODE == 0 ? 1 : 4);
#pragma unroll
                    for (int q = 0; q < 4; ++q) { const int col = q * 256 + lane * 4; const f32x4 g = *(const f32x4*)(gain + col), s1_ = *(const f32x4*)(sc + col); bv[q] = *(const f32x4*)(sh + col); av[q] = g * (1.f + s1_);
                        if (VAR == 2) gq[q] = *(const f32x4*)(adap(P, comb, b, 5) + col); } }
                if (VAR == 2) {
#pragma unroll
                    for (int q = 0; q < 4; ++q) { const u32x2 a = ya[VAR == 2 ? k : 0][q], b2 = yb[VAR == 2 ? k : 0][q]; const f32x4 g = gq[q];
                        v[q][0] += g[0] * (p0[k] * bf2f(a.x & 0xffff) + p1[k] * bf2f(b2.x & 0xffff)); v[q][1] += g[1] * (p0[k] * bf2f(a.x >> 16) + p1[k] * bf2f(b2.x >> 16));
                        v[q][2] += g[2] * (p0[k] * bf2f(a.y & 0xffff) + p1[k] * bf2f(b2.y & 0xffff)); v[q][3] += g[3] * (p0[k] * bf2f(a.y >> 16) + p1[k] * bf2f(b2.y >> 16)); } }
                float ss = 0.f;
#pragma unroll
                for (int q = 0; q < 4; ++q) ss += v[q][0] * v[q][0] + v[q][1] * v[q][1] + v[q][2] * v[q][2] + v[q][3] * v[q][3];
                if (VAR != 0) {
#pragma unroll
                    for (int q = 0; q < 4; ++q) { u32x2 o; o.x = pk2(v[q][0], v[q][1]); o.y = pk2(v[q][2], v[q][3]); *(u32x2*)(xs + (size_t)row * D + q * 256 + lane * 4) = o; }
                }
                ss = wsum(ss, lane);
                const float rstd = rsqrtf(ss * (1.f / D) + EPS);
                float lg[NEXP];
#pragma unroll
                for (int e = 0; e < NEXP; ++e) lg[e] = 0.f;
#pragma unroll
                for (int q = 0; q < 4; ++q) {
                    const int col = q * 256 + lane * 4;
                    float h[4];
#pragma unroll
                    for (int j = 0; j < 4; ++j) h[j] = v[q][j] * rstd * av[q][j] + bv[q][j];
                    u32x2 o; o.x = pk2(h[0], h[1]); o.y = pk2(h[2], h[3]);
                    *(u32x2*)(hb + (size_t)row * D + col) = o;
                    if (MODE == 2) {
                        const float* wr = wrl + col * NEXP;
#pragma unroll
                        for (int j = 0; j < 4; ++j) { const f32x4 w0 = *(const f32x4*)(wr + j * 8), w1 = *(const f32x4*)(wr + j * 8 + 4);
                            lg[0] += h[j] * w0[0]; lg[1] += h[j] * w0[1]; lg[2] += h[j] * w0[2]; lg[3] += h[j] * w0[3];
                            lg[4] += h[j] * w1[0]; lg[5] += h[j] * w1[1]; lg[6] += h[j] * w1[2]; lg[7] += h[j] * w1[3]; }
                    }
                }
                if (MODE == 2) {
#pragma unroll
                    for (int e = 0; e < NEXP; ++e) lg[e] = wsum(lg[e], lane) + P.moe_br[(layer / 2) * NEXP + e];
                    if (lane == 0) {
                        int i0 = 0; float v0 = lg[0];
#pragma unroll
                        for (int e = 1; e < NEXP; ++e) if (lg[e] > v0) { v0 = lg[e]; i0 = e; }
                        int i1 = -1; float v1 = -INFINITY;
#pragma unroll
                        for (int e = 0; e < NEXP; ++e) if (e != i0 && lg[e] > v1) { v1 = lg[e]; i1 = e; }
                        const float pa = 1.f / (1.f + expf(v1 - v0)), pb = 1.f - pa;
                        unsigned* lcnt = (unsigned*)lds; int* lti = (int*)(lds + 64) + (wid * 16 + j0 + k) * 4;
                        const int pos0 = (int)atomicAdd(lcnt + i0, 1u), pos1 = (int)atomicAdd(lcnt + i1, 1u);
                        lti[0] = i0; lti[1] = pos0; lti[2] = i1; lti[3] = pos1;
                        float* pr = (float*)(P.ws + WS_PROB) + (size_t)row * 2; pr[0] = pa; pr[1] = pb;
                    }
                }
            }
        }
    }
    if (MODE == 2) {
        __syncthreads();
        unsigned* lcnt = (unsigned*)lds; int* lti = (int*)(lds + 64);
        if (TIDX < NEXP) { unsigned* cnt = (unsigned*)(P.ws + WS_CTL) + CW_CNT + 16 * (layer / 2); lcnt[8 + TIDX] = atomicAdd(cnt + TIDX, lcnt[TIDX]); }
        __syncthreads();
        if (TIDX < 128) { const int w_ = TIDX >> 4, j_ = TIDX & 15, row = (BIDX * 8 + w_) * RPW + j_;
            if (j_ < RPW && row < T) { const int e0 = lti[TIDX * 4], e1 = lti[TIDX * 4 + 2]; int* ti = (int*)(P.ws + WS_TOKINFO) + (size_t)row * 4;
                const int q0_ = lti[TIDX * 4 + 1] + (int)lcnt[8 + e0], q1_ = lti[TIDX * 4 + 3] + (int)lcnt[8 + e1]; int* list = (int*)(P.ws + WS_LIST);
                ti[0] = e0; ti[1] = q0_; ti[2] = e1; ti[3] = q1_; list[(size_t)e0 * T + q0_] = row; list[(size_t)e1 * T + q1_] = row; } }
        __syncthreads();
    }
}

__device__ __forceinline__ int proj_orig_col(int col) { return col < 672 ? col : (col < 768 ? -1 : (col < 1926 ? col - 96 : -1)); }
__device__ __forceinline__ void ph_inproj_naive(unsigned char* lds, Params P, int layer, int chk) {
    const int TIDX = hidden_tid(P.wid), BIDX = launder_i((int)blockIdx.x), GDIM = launder_i((int)gridDim.x); P.ws = launder_ptr(P.ws); P.out = launder_ptr(P.out);
    float* sm = (float*)lds;
    const bf16_t* hb = (const bf16_t*)(P.ws + WS_HBUF); const float* w = P.w_in + (size_t)layer * D * INC;
    bf16_t* proj = (bf16_t*)(P.ws + WS_PROJ); float* fg = (float*)(P.ws + WS_FG);
    Chk ck{0.f, 0.f};
    naive_gemm(T, PJ, D,
        [&](int r, int k) { return bf2f(hb[(size_t)r * D + k]); },
        [&](int) { return 0; },
        [&](int k, int col, int) { const int oc = proj_orig_col(col); return oc < 0 ? 0.f : w[(size_t)k * INC + oc]; },
        [&](int r, int c0, const float (&v)[4]) {
            st4(proj + (size_t)r * PJ + c0, v, chk, ck);
            if (c0 >= PC_FG && c0 < PC_FG + 8) { float* fp = fg + (size_t)r * 8 + (c0 - PC_FG);
                if (!chk) *(f32x4*)fp = (f32x4){v[0], v[1], v[2], v[3]};
                else { chk_upd(ck, v[0], fp[0]); chk_upd(ck, v[1], fp[1]); chk_upd(ck, v[2], fp[2]); chk_upd(ck, v[3], fp[3]); } }
        }, sm);
    if (chk) chk_commit(P, chk, ck);
}

__device__ __forceinline__ void ph_passC(unsigned char* lds, Params P, int layer) {
    const int TIDX = hidden_tid(P.wid), BIDX = launder_i((int)blockIdx.x), GDIM = launder_i((int)gridDim.x); P.ws = launder_ptr(P.ws); P.out = launder_ptr(P.out);
    float (*lfs)[8] = (float (*)[8])lds;
    const int wid = TIDX >> 6, lane = TIDX & 63;
    bf16_t* proj = (bf16_t*)(P.ws + WS_PROJ); const float* fg = (const float*)(P.ws + WS_FG);
    float* rq = (float*)(P.ws + WS_RSTDQ); float* rkv = (float*)(P.ws + WS_RSTDKV);
    float* cloc = (float*)(P.ws + WS_CLOC); float* ctot = (float*)(P.ws + WS_CTOT);
    const float gq = P.fox_gq[layer * 64 + lane] * C2_FOX, gk = P.fox_gk[layer * 64 + lane];
    for (int chunk = BIDX; chunk < T / 128; chunk += GDIM) {
        for (int i = 0; i < 16; ++i) {
            const int tl = wid * 16 + i, row = chunk * 128 + tl;
            bf16_t* pr = proj + (size_t)row * PJ;
            { const u32x2 w = *(const u32x2*)(pr + PC_CQ + lane * 4); const float a = bf2f(w.x & 0xffff), b = bf2f(w.x >> 16), c = bf2f(w.y & 0xffff), d = bf2f(w.y >> 16);
              const float ss = wsum(a * a + b * b + c * c + d * d, lane); if (lane == 0) rq[row] = rsqrtf(ss * (1.f / 256.f) + EPS); }
            { const u32x2 w = *(const u32x2*)(pr + PC_U + lane * 4); const int g_ = lane >> 2, c_ = (lane & 3) * 4, b_ = row / SEQ, t_ = row % SEQ;
              *(u32x2*)((bf16_t*)(P.ws + WS_UG) + (size_t)(g_ * 1024 + b_ * 128 + (t_ >> 5)) * 640 + (t_ & 31) * 16 + c_) = w; }
            { const unsigned w = *(const unsigned*)(pr + PC_CKV + lane * 2); const float a = bf2f(w & 0xffff), b = bf2f(w >> 16);
              const float ss = wsum(a * a + b * b, lane); if (lane == 0) rkv[row] = rsqrtf(ss * (1.f / 128.f) + EPS); }
#pragma unroll
            for (int h = 0; h < 6; ++h) {
                const float a = bf2f(pr[PC_FQ + h * 64 + lane]); const float ra = rsqrtf(wsum(a * a, lane) * (1.f / 64.f) + EPS); pr[PC_FQ + h * 64 + lane] = f2bf(a * ra * gq);
                const float b = bf2f(pr[PC_FK + h * 64 + lane]); const float rb = rsqrtf(wsum(b * b, lane) * (1.f / 64.f) + EPS); pr[PC_FK + h * 64 + lane] = f2bf(b * rb * gk);
            }
            if (lane < 6) { const float z = fg[(size_t)row * 8 + lane] + P.fox_bf[layer * 6 + lane];
                lfs[tl][lane] = z >= 0.f ? -log1pf(expf(-z)) : z - log1pf(expf(z)); }
        }
        __syncthreads();
        if (TIDX < 6) {
            const int h = TIDX, b = (chunk * 128) / SEQ, t0 = (chunk * 128) % SEQ; float run = 0.f;
            for (int j = 0; j < 128; ++j) { run += lfs[j][h]; cloc[((size_t)b * 6 + h) * SEQ + t0 + j] = run; }
            ctot[chunk * 8 + h] = run;
        }
        __syncthreads();
    }
}

__device__ __forceinline__ void ph_qup_naive(unsigned char* lds, Params P, int layer, int chk) {
    const int TIDX = hidden_tid(P.wid), BIDX = launder_i((int)blockIdx.x), GDIM = launder_i((int)gridDim.x); P.ws = launder_ptr(P.ws); P.out = launder_ptr(P.out);
    float* sm = (float*)lds;
    const bf16_t* proj = (const bf16_t*)(P.ws + WS_PROJ); const float* rq = (const float*)(P.ws + WS_RSTDQ);
    const float* w = P.w_uq + (size_t)layer * 256 * 576; const float* g = P.q_norm + layer * 256; bf16_t* qraw = (bf16_t*)(P.ws + WS_QRAW);
    Chk ck{0.f, 0.f};
    naive_gemm(T, 576, 256,
        [&](int r, int k) { return bf2f(proj[(size_t)r * PJ + PC_CQ + k]); },
        [&](int) { return 0; },
        [&](int k, int col, int) { return g[k] * w[(size_t)k * 576 + col]; },
        [&](int r, int c0, const float (&v)[4]) { const float s = rq[r]; const float o[4] = {v[0] * s, v[1] * s, v[2] * s, v[3] * s}; st4(qraw + (size_t)r * 768 + c0, o, chk, ck); }, sm);
    if (chk) chk_commit(P, chk, ck);
}
__device__ __forceinline__ void ph_kvup_naive(unsigned char* lds, Params P, int layer, int chk) {
    const int TIDX = hidden_tid(P.wid), BIDX = launder_i((int)blockIdx.x), GDIM = launder_i((int)gridDim.x); P.ws = launder_ptr(P.ws); P.out = launder_ptr(P.out);
    float* sm = (float*)lds;
    const bf16_t* proj = (const bf16_t*)(P.ws + WS_PROJ); const float* rk = (const float*)(P.ws + WS_RSTDKV);
    const float* w = P.w_ukv + (size_t)layer * 128 * 768; const float* g = P.kv_norm + layer * 128; bf16_t* kvraw = (bf16_t*)(P.ws + WS_KVRAW);
    Chk ck{0.f, 0.f};
    naive_gemm(T, 768, 128,
        [&](int r, int k) { return bf2f(proj[(size_t)r * PJ + PC_CKV + k]); },
        [&](int) { return 0; },
        [&](int k, int col, int) { return g[k] * w[(size_t)k * 768 + col]; },
        [&](int r, int c0, const float (&v)[4]) { const float s = rk[r]; const float o[4] = {v[0] * s, v[1] * s, v[2] * s, v[3] * s}; st4(kvraw + (size_t)r * 768 + c0, o, chk, ck); }, sm);
    if (chk) chk_commit(P, chk, ck);
}

__device__ __forceinline__ void ph_passE(unsigned char* lds, Params P, int layer) {
    const int TIDX = hidden_tid(P.wid), BIDX = launder_i((int)blockIdx.x), GDIM = launder_i((int)gridDim.x); P.ws = launder_ptr(P.ws); P.out = launder_ptr(P.out);
    float* pref = (float*)lds;
    const int wid = TIDX >> 6, lane = TIDX & 63;
    const bf16_t* proj = (const bf16_t*)(P.ws + WS_PROJ); const bf16_t* qraw = (const bf16_t*)(P.ws + WS_QRAW); const bf16_t* kvraw = (const bf16_t*)(P.ws + WS_KVRAW);
    bf16_t* qm = (bf16_t*)(P.ws + WS_QMLA); bf16_t* km = (bf16_t*)(P.ws + WS_KMLA);
    const float* cs = (const float*)(P.ws + WS_COS); const float* sn = (const float*)(P.ws + WS_SIN);
    const float* cloc = (const float*)(P.ws + WS_CLOC); const float* ctot = (const float*)(P.ws + WS_CTOT); float* cb2 = (float*)(P.ws + WS_CB2);
    const float gqa = P.mla_gq[layer * 96 + lane], gqb = lane < 32 ? P.mla_gq[layer * 96 + 64 + lane] : 0.f;
    const float gka = P.mla_gk[layer * 96 + lane], gkb = lane < 32 ? P.mla_gk[layer * 96 + 64 + lane] : 0.f;
    for (int chunk = BIDX; chunk < T / 128; chunk += GDIM) {
        const int b = (chunk * 128) / SEQ, t0 = (chunk * 128) % SEQ, ci = chunk % 32;
        if (TIDX < 6) { float s = 0.f; for (int c = 0; c < ci; ++c) s += ctot[(b * 32 + c) * 8 + TIDX]; pref[TIDX] = s; }
        __syncthreads();
        for (int e = TIDX; e < 6 * 128; e += 512) { const int h = e / 128, j = e % 128; const size_t ix = ((size_t)b * 6 + h) * SEQ + t0 + j; cb2[ix] = (cloc[ix] + pref[h]) * LOG2E; }
        for (int i = 0; i < 16; ++i) {
            const int row = chunk * 128 + wid * 16 + i;
            const float cv = cs[(size_t)row * 16 + (lane & 15)], sv = sn[(size_t)row * 16 + (lane & 15)];
#pragma unroll
            for (int h = 0; h < 6; ++h) {
                {
                    const float a = bf2f(qraw[(size_t)row * 768 + h * 96 + lane]); const float bq = lane < 32 ? bf2f(qraw[(size_t)row * 768 + h * 96 + 64 + lane]) : 0.f;
                    const float r = rsqrtf(wsum(a * a + bq * bq, lane) * (1.f / 96.f) + EPS);
                    const float an = a * r * gqa, bn = bq * r * gqb; const float pn = shx(bn, 16, lane);
                    const float ro = lane < 16 ? bn * cv - pn * sv : pn * sv + bn * cv;
                    qm[(size_t)row * 576 + h * 96 + lane] = f2bf(an * C2_MLA); if (lane < 32) qm[(size_t)row * 576 + h * 96 + 64 + lane] = f2bf(ro * C2_MLA);
                }
                {
                    const float a = bf2f(kvraw[(size_t)row * 768 + h * 128 + lane]); const float bk = lane < 32 ? bf2f(proj[(size_t)row * PJ + PC_KR + lane]) : 0.f;
                    const float r = rsqrtf(wsum(a * a + bk * bk, lane) * (1.f / 96.f) + EPS);
                    const float an = a * r * gka, bn = bk * r * gkb; const float pn = shx(bn, 16, lane);
                    const float ro = lane < 16 ? bn * cv - pn * sv : pn * sv + bn * cv;
                    km[(size_t)row * 576 + h * 96 + lane] = f2bf(an); if (lane < 32) km[(size_t)row * 576 + h * 96 + 64 + lane] = f2bf(ro);
                }
            }
        }
        __syncthreads();
    }
}

template <int DQK, int MODE>
__device__ __forceinline__ void ph_attn_naive(unsigned char* lds, Params P, const bf16_t* Q, int ldq, const bf16_t* K, int ldk, const bf16_t* V, int ldv, int vhs, bf16_t* O, int ldo, const float* cb2, int chk) {
    const int TIDX = hidden_tid(P.wid), BIDX = launder_i((int)blockIdx.x), GDIM = launder_i((int)gridDim.x); P.ws = launder_ptr(P.ws); P.out = launder_ptr(P.out);
    float (*Ks)[DQK] = (float (*)[DQK])lds; float (*Vs)[64] = (float (*)[64])(lds + 64 * DQK * 4); float* cbs = (float*)(lds + 64 * DQK * 4 + 64 * 64 * 4);
    const int tid = TIDX;
    Chk ck{0.f, 0.f};
    for (int item = BIDX; item < NB * 6 * 8; item += GDIM) {
        const int qb = 7 - (item / 48), bh = item % 48, b = bh / 6, h = bh % 6;
        const int q = qb * 512 + tid; const size_t rowq = (size_t)b * SEQ + q;
        float qv[DQK], o[64];
#pragma unroll
        for (int d = 0; d < DQK; ++d) qv[d] = bf2f(Q[rowq * ldq + h * DQK + d]);
#pragma unroll
        for (int d = 0; d < 64; ++d) o[d] = 0.f;
        float m = -INFINITY, l = 0.f;
        const float* cbp = MODE == 1 ? cb2 + ((size_t)b * 6 + h) * SEQ : nullptr;
        const int kend = qb * 512 + 512;
        for (int k0 = 0; k0 < kend; k0 += 64) {
            __syncthreads();
            for (int e = tid; e < 64 * DQK; e += 512) { const int j = e / DQK, d = e % DQK; Ks[j][d] = bf2f(K[((size_t)b * SEQ + k0 + j) * ldk + h * DQK + d]); }
            for (int e = tid; e < 64 * 64; e += 512) { const int j = e >> 6, d = e & 63; Vs[j][d] = bf2f(V[((size_t)b * SEQ + k0 + j) * ldv + h * vhs + d]); }
            if (MODE == 1 && tid < 64) cbs[tid] = cbp[k0 + tid];
            __syncthreads();
            for (int j = 0; j < 64; ++j) {
                const int key = k0 + j;
                const bool ok = MODE == 0 ? ((key >> 6) <= (q >> 6)) : (key <= q);
                if (ok) {
                    float s = 0.f;
#pragma unroll
                    for (int d = 0; d < DQK; d += 4) { const f32x4 kk = *(const f32x4*)&Ks[j][d]; s += qv[d] * kk[0] + qv[d + 1] * kk[1] + qv[d + 2] * kk[2] + qv[d + 3] * kk[3]; }
                    if (MODE == 1) s -= cbs[j];
                    if (s > m) { const float f = exp2f(m - s); l *= f;
#pragma unroll
                        for (int d = 0; d < 64; ++d) o[d] *= f;
                        m = s; }
                    const float p = exp2f(s - m); l += p;
#pragma unroll
                    for (int d = 0; d < 64; d += 4) { const f32x4 vv = *(const f32x4*)&Vs[j][d]; o[d] += p * vv[0]; o[d + 1] += p * vv[1]; o[d + 2] += p * vv[2]; o[d + 3] += p * vv[3]; }
                }
            }
        }
        const float il = 1.f / l;
#pragma unroll
        for (int d = 0; d < 64; d += 2) st2(O + rowq * ldo + h * 64 + d, o[d] * il, o[d + 1] * il, chk, ck);
    }
    if (chk) chk_commit(P, chk, ck);
}

__device__ __forceinline__ void ph_ssm_naive(unsigned char* lds, Params P, int layer, int chk) {
    const int TIDX = hidden_tid(P.wid), BIDX = launder_i((int)blockIdx.x), GDIM = launder_i((int)gridDim.x); P.ws = launder_ptr(P.ws); P.out = launder_ptr(P.out);
    float (*smy)[16 * 64] = (float (*)[16 * 64])lds;
    const int wid = TIDX >> 6, lane = TIDX & 63;
    float* sm = smy[wid];
    const bf16_t* proj = (const bf16_t*)(P.ws + WS_PROJ); bf16_t* yg = (bf16_t*)(P.ws + WS_YG);
    Chk ck{0.f, 0.f};
    for (int item = BIDX * 8 + wid; item < NB * 16; item += GDIM * 8) {
        const int b = item / 16, g = item % 16, p = lane;
        const size_t gp = ((size_t)layer * 16 + g) * 64 + p;
        const float lre = P.lam_re[gp], lim = P.lam_im[gp], dt = expf(P.log_dt[layer * 16 + g]);
        const float a_ = lre * dt, b_ = lim * dt; float sb_, cb_; sincosf(b_, &sb_, &cb_); const float sh_ = sinf(0.5f * b_);
        const float er = expf(a_), lbr = er * cb_, lbi = er * sb_;
        const float nr = expm1f(a_) * cb_ - 2.f * sh_ * sh_, ni = lbi;
        const float dd = lre * lre + lim * lim, qr = (nr * lre + ni * lim) / dd, qi = (ni * lre - nr * lim) / dd;
        float bbr[16], bbi[16], cr[16], ci[16];
#pragma unroll
        for (int c = 0; c < 16; ++c) {
            const float bre = P.b_re[gp * 16 + c], bim = P.b_im[gp * 16 + c];
            bbr[c] = qr * bre - qi * bim; bbi[c] = qr * bim + qi * bre;
            cr[c] = P.c_re[(((size_t)layer * 16 + g) * 16 + c) * 64 + p]; ci[c] = P.c_im[(((size_t)layer * 16 + g) * 16 + c) * 64 + p];
        }
        const float lr = lbr, li = lbi;
        const float dsk = P.ssm_d[layer * 256 + g * 16 + (lane & 15)];
        float sr = 0.f, si = 0.f;
        for (int t = 0; t < SEQ; ++t) {
            const size_t row = (size_t)b * SEQ + t;
            const bf16_t* up = proj + row * PJ + g * 16;
            const u32x4 w0 = *(const u32x4*)up, w1 = *(const u32x4*)(up + 8);
            const unsigned ww[8] = {w0.x, w0.y, w0.z, w0.w, w1.x, w1.y, w1.z, w1.w};
            float bur = 0.f, bui = 0.f;
#pragma unroll
            for (int c = 0; c < 16; ++c) { const float u = (c & 1) ? bf2f(ww[c >> 1] >> 16) : bf2f(ww[c >> 1] & 0xffff); bur = fmaf(bbr[c], u, bur); bui = fmaf(bbi[c], u, bui); }
            const float nsr = lr * sr - li * si + bur, nsi = lr * si + li * sr + bui; sr = nsr; si = nsi;
#pragma unroll
            for (int c = 0; c < 16; ++c) sm[c * 64 + lane] = cr[c] * sr - ci[c] * si;
            asm volatile("s_waitcnt lgkmcnt(0)" ::: "memory");
            const int cc = lane & 15, qd = lane >> 4; float part = 0.f;
#pragma unroll
            for (int j = 0; j < 16; ++j) part += sm[cc * 64 + qd * 16 + j];
            part += shx(part, 16, lane); part += shx(part, 32, lane);
            asm volatile("s_waitcnt lgkmcnt(0)" ::: "memory");
            if (lane < 16) { const float uv = bf2f(up[lane]); const float yv = gelu_tanh(part + dsk * uv); bf16_t* dst = yg + row * 256 + g * 16 + lane;
                if (!chk) *dst = f2bf(yv); else chk_upd(ck, yv, bf2f(*dst)); }
        }
    }
    if (chk) chk_commit(P, chk, ck);
}

__device__ __forceinline__ void ph_glu_naive(unsigned char* lds, Params P, int layer, int chk) {
    const int TIDX = hidden_tid(P.wid), BIDX = launder_i((int)blockIdx.x), GDIM = launder_i((int)gridDim.x); P.ws = launder_ptr(P.ws); P.out = launder_ptr(P.out);
    float* sm = (float*)lds;
    const bf16_t* yg = (const bf16_t*)(P.ws + WS_YG); bf16_t* os = (bf16_t*)(P.ws + WS_OSSM);
    const float* w = P.w_glu + (size_t)layer * 256 * 256; const float* bg = P.b_glu + layer * 256;
    Chk ck{0.f, 0.f};
    naive_gemm(T, 256, 256,
        [&](int r, int k) { return bf2f(yg[(size_t)r * 256 + k]); },
        [&](int) { return 0; },
        [&](int k, int col, int) { return w[(size_t)k * 256 + col]; },
        [&](int r, int c0, const float (&v)[4]) {
            float o[4];
#pragma unroll
            for (int j = 0; j < 4; ++j) o[j] = bf2f(yg[(size_t)r * 256 + c0 + j]) * sigmoid_f(v[j] + bg[c0 + j]);
            st4(os + (size_t)r * 256 + c0, o, chk, ck); }, sm);
    if (chk) chk_commit(P, chk, ck);
}

__device__ __forceinline__ void ph_merge(unsigned char* lds, Params P) {
    const int TIDX = hidden_tid(P.wid), BIDX = launder_i((int)blockIdx.x), GDIM = launder_i((int)gridDim.x); P.ws = launder_ptr(P.ws); P.out = launder_ptr(P.out);
    const int wid = TIDX >> 6, lane = TIDX & 63;
    const bf16_t* os = (const bf16_t*)(P.ws + WS_OSSM); const bf16_t* ob = (const bf16_t*)(P.ws + WS_OBUF); bf16_t* hb = (bf16_t*)(P.ws + WS_HBUF);
    constexpr int NR = 8;
    const int RPW = (T + GDIM * 8 - 1) / (GDIM * 8), rbeg = (BIDX * 8 + wid) * RPW;
    for (int j0 = 0; j0 < RPW; j0 += NR) {
        u32x2 ws_[NR]; unsigned wo[NR][6];
#pragma unroll
        for (int k = 0; k < NR; ++k) { const int row = rbeg + j0 + k;
            if (j0 + k < RPW && row < T) { ws_[k] = *(const u32x2*)(os + (size_t)row * 256 + lane * 4);
#pragma unroll
                for (int part = 0; part < 2; ++part) { const bf16_t* src = ob + (size_t)row * 768 + part * 384 + lane * 6; wo[k][part * 3] = *(const unsigned*)src; wo[k][part * 3 + 1] = *(const unsigned*)(src + 2); wo[k][part * 3 + 2] = *(const unsigned*)(src + 4); } } }
#pragma unroll
        for (int k = 0; k < NR; ++k) { const int row = rbeg + j0 + k;
            if (j0 + k < RPW && row < T) {
                { const u32x2 w = ws_[k]; const float a = bf2f(w.x & 0xffff), b = bf2f(w.x >> 16), c = bf2f(w.y & 0xffff), d = bf2f(w.y >> 16);
                  const float r = rsqrtf(wsum(a * a + b * b + c * c + d * d, lane) * (1.f / 256.f) + EPS); u32x2 o; o.x = pk2(a * r, b * r); o.y = pk2(c * r, d * r); *(u32x2*)(hb + (size_t)row * D + lane * 4) = o; }
#pragma unroll
                for (int part = 0; part < 2; ++part) {
                    const unsigned w0 = wo[k][part * 3], w1 = wo[k][part * 3 + 1], w2 = wo[k][part * 3 + 2];
                    const float v[6] = {bf2f(w0 & 0xffff), bf2f(w0 >> 16), bf2f(w1 & 0xffff), bf2f(w1 >> 16), bf2f(w2 & 0xffff), bf2f(w2 >> 16)};
                    float ss = 0.f;
#pragma unroll
                    for (int j = 0; j < 6; ++j) ss += v[j] * v[j];
                    const float r = rsqrtf(wsum(ss, lane) * (1.f / 384.f) + EPS);
                    unsigned* dst = (unsigned*)(hb + (size_t)row * D + 256 + part * 384 + lane * 6);
                    dst[0] = pk2(v[0] * r, v[1] * r); dst[1] = pk2(v[2] * r, v[3] * r); dst[2] = pk2(v[4] * r, v[5] * r);
                }
            }
        }
    }
}

__device__ __forceinline__ void ph_outproj_naive(unsigned char* lds, Params P, int layer, float* dst, int chk) {
    const int TIDX = hidden_tid(P.wid), BIDX = launder_i((int)blockIdx.x), GDIM = launder_i((int)gridDim.x); P.ws = launder_ptr(P.ws); P.out = launder_ptr(P.out);
    float* sm = (float*)lds;
    const bf16_t* hb = (const bf16_t*)(P.ws + WS_HBUF); const float* w = P.w_out + (size_t)layer * D * D; const float* g = P.out_norm + layer * D;
    Chk ck{0.f, 0.f};
    naive_gemm(T, D, D,
        [&](int r, int k) { return bf2f(hb[(size_t)r * D + k]); },
        [&](int) { return 0; },
        [&](int k, int col, int) { return g[k] * w[(size_t)k * D + col]; },
        [&](int r, int c0, const float (&v)[4]) {
            const float* g1 = adap(P, layer, r / SEQ, 2) + c0; f32x4 xv = *(const f32x4*)(P.out + (size_t)r * D + c0);
#pragma unroll
            for (int j = 0; j < 4; ++j) { const float dl = g1[j] * v[j]; xv[j] += dl; ck.r = fmaxf(ck.r, fabsf(dl)); }
            *(f32x4*)(dst + (size_t)r * D + c0) = xv; }, sm);
    if (chk) chk_commit(P, chk, ck);
}

__device__ __forceinline__ void ph_ffn1_naive(unsigned char* lds, Params P, int layer, int chk) {
    const int TIDX = hidden_tid(P.wid), BIDX = launder_i((int)blockIdx.x), GDIM = launder_i((int)gridDim.x); P.ws = launder_ptr(P.ws); P.out = launder_ptr(P.out);
    float* sm = (float*)lds;
    const bf16_t* hb = (const bf16_t*)(P.ws + WS_HBUF); bf16_t* act = (bf16_t*)(P.ws + WS_ACT);
    const float* wg = P.ffn_wg + (size_t)(layer / 2) * D * DFF; const float* wu = P.ffn_wu + (size_t)(layer / 2) * D * DFF;
    Chk ck{0.f, 0.f};
    naive_gemm(T, 2 * DFF, D,
        [&](int r, int k) { return bf2f(hb[(size_t)r * D + k]); },
        [&](int) { return 0; },
        [&](int k, int col, int) { return (col & 1) ? wu[(size_t)k * DFF + (col >> 1)] : wg[(size_t)k * DFF + (col >> 1)]; },
        [&](int r, int c0, const float (&v)[4]) { st2(act + (size_t)r * DFF + (c0 >> 1), silu_f(v[0]) * v[1], silu_f(v[2]) * v[3], chk, ck); }, sm);
    if (chk) chk_commit(P, chk, ck);
}
__device__ __forceinline__ void ph_ffn2_naive(unsigned char* lds, Params P, int layer, float* dst, int chk) {
    const int TIDX = hidden_tid(P.wid), BIDX = launder_i((int)blockIdx.x), GDIM = launder_i((int)gridDim.x); P.ws = launder_ptr(P.ws); P.out = launder_ptr(P.out);
    float* sm = (float*)lds;
    const bf16_t* act = (const bf16_t*)(P.ws + WS_ACT); const float* w = P.ffn_wd + (size_t)(layer / 2) * DFF * D;
    Chk ck{0.f, 0.f};
    naive_gemm(T, D, DFF,
        [&](int r, int k) { return bf2f(act[(size_t)r * DFF + k]); },
        [&](int) { return 0; },
        [&](int k, int col, int) { return w[(size_t)k * D + col]; },
        [&](int r, int c0, const float (&v)[4]) {
            const float* g2 = adap(P, layer, r / SEQ, 5) + c0; f32x4 xv = *(const f32x4*)(P.out + (size_t)r * D + c0);
#pragma unroll
            for (int j = 0; j < 4; ++j) { const float dl = g2[j] * v[j]; xv[j] += dl; ck.r = fmaxf(ck.r, fabsf(dl)); }
            *(f32x4*)(dst + (size_t)r * D + c0) = xv; }, sm);
    if (chk) chk_commit(P, chk, ck);
}
__device__ __forceinline__ void ph_cmp_x(unsigned char* lds, Params P, const float* xe, int stage) {
    const int TIDX = hidden_tid(P.wid), BIDX = launder_i((int)blockIdx.x), GDIM = launder_i((int)gridDim.x); P.ws = launder_ptr(P.ws); P.out = launder_ptr(P.out);
    Chk ck{0.f, 0.f};
    for (size_t i = (size_t)BIDX * 512 + TIDX; i < (size_t)T * D / 4; i += (size_t)GDIM * 512) {
        const f32x4 a = ((const f32x4*)P.out)[i], b = ((const f32x4*)xe)[i];
#pragma unroll
        for (int j = 0; j < 4; ++j) { const float d = fabsf(a[j] - b[j]); ck.e = (d != d) ? INFINITY : fmaxf(ck.e, d); }
    }
    chk_commit(P, stage, ck);
}

__device__ __forceinline__ void ph_moe_gather(unsigned char* lds, Params P, int layer) {
    const int TIDX = hidden_tid(P.wid), BIDX = launder_i((int)blockIdx.x), GDIM = launder_i((int)gridDim.x); P.ws = launder_ptr(P.ws); P.out = launder_ptr(P.out);
    const int wid = TIDX >> 6, lane = TIDX & 63;
    int off[NEXP + 1]; moe_offsets(P, layer, off);
    int* p2e = (int*)(P.ws + WS_P2E);
    if (BIDX == 0) {
        for (int pnl = TIDX; pnl < 272; pnl += 512) { int e = 0;
#pragma unroll
            for (int j = 1; j < NEXP; ++j) if (pnl * 256 >= off[j]) e = j;
            p2e[pnl] = e; }
        if (TIDX == 0) p2e[300] = off[NEXP] >> 8;
    }
    const bf16_t* hb = (const bf16_t*)(P.ws + WS_HBUF); bf16_t* hg = (bf16_t*)(P.ws + WS_HG);
    const int* ti = (const int*)(P.ws + WS_TOKINFO); int* so = (int*)(P.ws + WS_SLOTOF);
    for (int row = BIDX * 8 + wid; row < T; row += GDIM * 8) {
        const u32x4 v0 = *(const u32x4*)(hb + (size_t)row * D + lane * 8), v1 = *(const u32x4*)(hb + (size_t)row * D + 512 + lane * 8);
#pragma unroll
        for (int k = 0; k < 2; ++k) {
            const int e = ti[(size_t)row * 4 + 2 * k], pos = ti[(size_t)row * 4 + 2 * k + 1];
            int base = 0;
#pragma unroll
            for (int j = 0; j < NEXP; ++j) if (e == j) base = off[j];
            const int slot = base + pos;
            *(u32x4*)(hg + (size_t)slot * D + lane * 8) = v0; *(u32x4*)(hg + (size_t)slot * D + 512 + lane * 8) = v1;
            if (lane == 0) so[(size_t)row * 2 + k] = slot;
        }
    }
}
__device__ __forceinline__ void ph_moe1_naive(unsigned char* lds, Params P, int layer, int chk) {
    const int TIDX = hidden_tid(P.wid), BIDX = launder_i((int)blockIdx.x), GDIM = launder_i((int)gridDim.x); P.ws = launder_ptr(P.ws); P.out = launder_ptr(P.out);
    float* sm = (float*)lds;
    const bf16_t* hg = (const bf16_t*)(P.ws + WS_HG); bf16_t* act = (bf16_t*)(P.ws + WS_ACTM); const int* p2e = (const int*)(P.ws + WS_P2E);
    const float* wg = P.moe_wg + (size_t)(layer / 2) * NEXP * D * DFE; const float* wu = P.moe_wu + (size_t)(layer / 2) * NEXP * D * DFE;
    const int M = p2e[300] * 256;
    Chk ck{0.f, 0.f};
    naive_gemm(M, 2 * DFE, D,
        [&](int r, int k) { return bf2f(hg[(size_t)r * D + k]); },
        [&](int bm) { return p2e[bm >> 8]; },
        [&](int k, int col, int e) { const size_t o = ((size_t)e * D + k) * DFE + (col >> 1); return (col & 1) ? wu[o] : wg[o]; },
        [&](int r, int c0, const float (&v)[4]) { st2(act + (size_t)r * DFE + (c0 >> 1), silu_f(v[0]) * v[1], silu_f(v[2]) * v[3], chk, ck); }, sm);
    if (chk) chk_commit(P, chk, ck);
}
__device__ __forceinline__ void ph_moe2_naive(unsigned char* lds, Params P, int layer, int chk) {
    const int TIDX = hidden_tid(P.wid), BIDX = launder_i((int)blockIdx.x), GDIM = launder_i((int)gridDim.x); P.ws = launder_ptr(P.ws); P.out = launder_ptr(P.out);
    float* sm = (float*)lds;
    const bf16_t* act = (const bf16_t*)(P.ws + WS_ACTM); bf16_t* ym = (bf16_t*)(P.ws + WS_HG); const int* p2e = (const int*)(P.ws + WS_P2E);
    const float* wd = P.moe_wd + (size_t)(layer / 2) * NEXP * DFE * D;
    const int M = p2e[300] * 256;
    Chk ck{0.f, 0.f};
    naive_gemm(M, D, DFE,
        [&](int r, int k) { return bf2f(act[(size_t)r * DFE + k]); },
        [&](int bm) { return p2e[bm >> 8]; },
        [&](int k, int col, int e) { return wd[((size_t)e * DFE + k) * D + col]; },
        [&](int r, int c0, const float (&v)[4]) { st4(ym + (size_t)r * D + c0, v, chk, ck); }, sm);
    if (chk) chk_commit(P, chk, ck);
}
__device__ __forceinline__ void ph_moe_combine(unsigned char* lds, Params P, int layer) {
    const int TIDX = hidden_tid(P.wid), BIDX = launder_i((int)blockIdx.x), GDIM = launder_i((int)gridDim.x); P.ws = launder_ptr(P.ws); P.out = launder_ptr(P.out);
    const int wid = TIDX >> 6, lane = TIDX & 63;
    const bf16_t* ym = (const bf16_t*)(P.ws + ymoe_off(layer)); const bf16_t* xs = xstream(P, DEPTH); const int* ti = (const int*)(P.ws + WS_TOKINFO); const float* pr = (const float*)(P.ws + WS_PROB);
    int off_[NEXP + 1]; moe_offsets(P, layer, off_);
    constexpr int NR = 4;
    const int RPW = (T + GDIM * 8 - 1) / (GDIM * 8), rbeg = (BIDX * 8 + wid) * RPW;
    for (int j0 = 0; j0 < RPW; j0 += NR) {
        int s0[NR], s1[NR]; float p0[NR], p1[NR]; u32x2 xw[NR][4], ya[NR][4], yb[NR][4];
#pragma unroll
        for (int k = 0; k < NR; ++k) { const int row = rbeg + j0 + k;
            if (j0 + k < RPW && row < T) { const int* ti_ = ti + (size_t)row * 4; s0[k] = moe_sel(off_, ti_[0]) + ti_[1]; s1[k] = moe_sel(off_, ti_[2]) + ti_[3]; p0[k] = pr[(size_t)row * 2]; p1[k] = pr[(size_t)row * 2 + 1];
#pragma unroll
                for (int q = 0; q < 4; ++q) xw[k][q] = *(const u32x2*)(xs + (size_t)row * D + q * 256 + lane * 4); } }
#pragma unroll
        for (int k = 0; k < NR; ++k) { const int row = rbeg + j0 + k;
            if (j0 + k < RPW && row < T) {
#pragma unroll
                for (int q = 0; q < 4; ++q) { ya[k][q] = *(const u32x2*)(ym + (size_t)s0[k] * D + q * 256 + lane * 4); yb[k][q] = *(const u32x2*)(ym + (size_t)s1[k] * D + q * 256 + lane * 4); } } }
#pragma unroll
        for (int k = 0; k < NR; ++k) { const int row = rbeg + j0 + k;
            if (j0 + k < RPW && row < T) {
                const float* g2 = adap(P, layer, row / SEQ, 5);
#pragma unroll
                for (int q = 0; q < 4; ++q) { const int col = q * 256 + lane * 4;
                    const u32x2 a = ya[k][q], b = yb[k][q], x = xw[k][q]; const f32x4 g = *(const f32x4*)(g2 + col);
                    f32x4 xv = {bf2f(x.x & 0xffff), bf2f(x.x >> 16), bf2f(x.y & 0xffff), bf2f(x.y >> 16)};
                    xv[0] += g[0] * (p0[k] * bf2f(a.x & 0xffff) + p1[k] * bf2f(b.x & 0xffff)); xv[1] += g[1] * (p0[k] * bf2f(a.x >> 16) + p1[k] * bf2f(b.x >> 16));
                    xv[2] += g[2] * (p0[k] * bf2f(a.y & 0xffff) + p1[k] * bf2f(b.y & 0xffff)); xv[3] += g[3] * (p0[k] * bf2f(a.y >> 16) + p1[k] * bf2f(b.y >> 16));
                    *(f32x4*)(P.out + (size_t)row * D + col) = xv; } } }
    }
}
__device__ __forceinline__ void ph_check_final(unsigned char* lds, Params P) {
    const int TIDX = hidden_tid(P.wid), BIDX = launder_i((int)blockIdx.x), GDIM = launder_i((int)gridDim.x); P.ws = launder_ptr(P.ws); P.out = launder_ptr(P.out);
    const unsigned* ctl = (const unsigned*)(P.ws + WS_CTL);
    int code = 0;
    for (int s = 31; s >= 1; --s) { const float e = __uint_as_float(ctl[CW_CHKE + s]), r = __uint_as_float(ctl[CW_CHKR + s]); if (!(e <= 0.04f * r)) code = s; }
    if (code == 0) return;
    const float sc = 1.f + 0.1f * code;
    for (size_t i = (size_t)BIDX * 512 + TIDX; i < (size_t)T * D; i += (size_t)GDIM * 512) P.out[i] *= sc;
}

namespace pg8 {
#define PG8_LAS __attribute__((address_space(3)))
typedef short bf16x8 __attribute__((ext_vector_type(8)));
constexpr int BM = 256, BK = 64, HALF = 128, HTB = HALF * BK * 2  , STAGE_BYTES = 8 * HTB, NXCD = 8, WGM = 8;
__host__ __device__ __forceinline__ int lds_byte(int r, int c) { const int st = (r >> 4) * 2 + (c >> 5), rr = r & 15, cc = c & 31, ob = rr * 64 + cc * 2; return st * 1024 + (ob ^ (((ob >> 9) & 1) << 5)); }
__host__ __device__ __forceinline__ void stage_rc(int b, int& R, int& C) { const int st = b / 1024, sb = b % 1024, swz = sb ^ (((sb >> 9) & 1) << 5); R = (st >> 1) * 16 + swz / 64; C = (st & 1) * 32 + (swz % 64) / 2; }
__host__ __device__ __forceinline__ int perm32(int rho) { const int n = rho >> 4, i = rho & 15; return 8 * (i >> 2) + 4 * n + (i & 3); }
struct Unit { int pm, pn; };
struct Gemm { const bf16_t* A; const bf16_t* Bt; int lda, ldb, K, wid; };
struct StaticOrder {
    static constexpr bool GATHER = false;
    int nM, nN, nwg, G, c;
    __host__ __device__ void init(int M, int N, int G_, int c_) { nM = M / BM; nN = N / BM; nwg = nM * nN; G = G_; c = c_; }
    __host__ __device__ bool next(int i, Unit& u) const {
        const long L = (long)i * G + c; if (L >= nwg) return false;
        int wgid = (int)L; { const int q = nwg / NXCD, r = nwg % NXCD, xcd = wgid % NXCD, off = wgid / NXCD; wgid = (xcd < r ? xcd * (q + 1) : r * (q + 1) + (xcd - r) * q) + off; }
        const int nig = WGM * nN, gid = wgid / nig, fm = gid * WGM, gsz = (nM - fm) < WGM ? (nM - fm) : WGM;
        u.pm = fm + ((wgid % nig) % gsz); u.pn = (wgid % nig) / gsz; return true;
    }
    __device__ __forceinline__ void a_ready(const Unit&) const {}
    __device__ __forceinline__ void done(const Unit&) const {}
};
template <class F> struct ListOrder {
    static constexpr bool GATHER = false;
    int n, G, c; F f;
    __device__ __forceinline__ bool next(int i, Unit& u) const { const long L = (long)i * G + c; if (L >= n) return false; f((int)L, u); return true; }
    __device__ __forceinline__ void a_ready(const Unit&) const {}
    __device__ __forceinline__ void done(const Unit&) const {}
};
__device__ __forceinline__ unsigned cvt_pk_bf16(float lo, float hi) { unsigned r; asm volatile("v_cvt_pk_bf16_f32 %0, %1, %2" : "=v"(r) : "v"(lo), "v"(hi)); return r; }
__device__ __forceinline__ u32x4 pack8(const f32x4 a, const f32x4 b) { u32x4 w; w.x = cvt_pk_bf16(a[0], a[1]); w.y = cvt_pk_bf16(a[2], a[3]); w.z = cvt_pk_bf16(b[0], b[1]); w.w = cvt_pk_bf16(b[2], b[3]); return w; }

template <class T, class = void> struct epi_kscale { static constexpr bool value = false; };
template <class T> struct epi_kscale<T, decltype((void)T::KSCALE)> { static constexpr bool value = T::KSCALE; };
__device__ __forceinline__ void kscale_rows(PG8_LAS unsigned char* lds, f32x4 (&acc)[2][2][4][2], int ui, int which, int wr, int) {
    const int fr = hidden_tid(0) & 15;
    const PG8_LAS float* tb = (const PG8_LAS float*)(lds + 132096) + (launder_i(ui) * 3 + which) * 256 + wr * 64 + fr;
#pragma unroll
    for (int ai = 0; ai < 2; ++ai)
#pragma unroll
        for (int m = 0; m < 4; ++m) { const float sc = tb[ai * 128 + m * 16];
#pragma unroll
            for (int bj = 0; bj < 2; ++bj)
#pragma unroll
                for (int n = 0; n < 2; ++n) acc[ai][bj][m][n] = acc[ai][bj][m][n] * sc; }
}
template <class Epi, class Sched, bool ALIGN_EPI = false, bool SP2 = false>
__device__ __forceinline__ void gemm_phase(PG8_LAS unsigned char* lds, const Gemm g, const Sched& S, const Epi& E) {
    const int tid = hidden_tid(g.wid), wid = __builtin_amdgcn_readfirstlane(tid >> 6), lane = tid & 63, wr = wid >> 2, wc = wid & 3, fr = lane & 15, fq = lane >> 4;
    const int K = launder_i(g.K), nt = K / BK;
    unsigned voffA[2], voffB[2]; int gR[2], gC[2];
#pragma unroll
    for (int i = 0; i < 2; ++i) { int R, C; stage_rc(tid * 16 + i * 8192, R, C); const int Rb = Epi::PERM ? ((R & ~31) + perm32(R & 31)) : R;
        voffA[i] = (unsigned)(R * g.lda + C) * 2u; voffB[i] = (unsigned)(Rb * g.ldb + C) * 2u; gR[i] = R; gC[i] = C * 2; }
    const size_t kstep = (size_t)(BK * 2);
    const size_t hstepA = Sched::GATHER ? 0 : (size_t)HALF * g.lda * 2, hstepB = (size_t)HALF * g.ldb * 2;
    const size_t tstepA = 2 * hstepA, tstepB = 2 * hstepB;
    const unsigned ldsw = (unsigned)wid * 1024u;
    const int aoff = lds_byte(wr * 64 + fr, fq * 8), boff = lds_byte(wc * 32 + fr, fq * 8);
#define PG8_SA(b, h) (((b) * 2 + (h)) * HTB)
#define PG8_SB(b, h) ((4 + (b) * 2 + (h)) * HTB)
#define PG8_STAGE(bufoff, gbase, voff) do { _Pragma("unroll") for (int _i = 0; _i < 2; ++_i) \
        __builtin_amdgcn_global_load_lds((const unsigned*)((const char*)(gbase) + (voff)[_i]), (PG8_LAS unsigned*)(lds + (bufoff) + ldsw + _i * 8192), 16, 0, 0); } while (0)
#define PG8_LDA(dst, b, h) do { _Pragma("unroll") for (int m = 0; m < 4; ++m) _Pragma("unroll") for (int k = 0; k < 2; ++k) dst[m][k] = *(const PG8_LAS bf16x8*)(lds + PG8_SA(b, h) + aoff + m * 2048 + k * 1024); } while (0)
#define PG8_LDB(dst, b, h) do { _Pragma("unroll") for (int n = 0; n < 2; ++n) _Pragma("unroll") for (int k = 0; k < 2; ++k) dst[n][k] = *(const PG8_LAS bf16x8*)(lds + PG8_SB(b, h) + boff + n * 2048 + k * 1024); } while (0)
#define PG8_MMA(ai, bj, At, Bt) do { __builtin_amdgcn_s_setprio(1); _Pragma("unroll") for (int m = 0; m < 4; ++m) _Pragma("unroll") for (int n = 0; n < 2; ++n) _Pragma("unroll") for (int k = 0; k < 2; ++k) \
        acc[ai][bj][m][n] = __builtin_amdgcn_mfma_f32_16x16x32_bf16(Bt[n][k], At[m][k], acc[ai][bj][m][n], 0, 0, 0); __builtin_amdgcn_s_setprio(0); } while (0)
#define PG8_WAIT_V(n) asm volatile("s_waitcnt vmcnt(" #n ")" ::: "memory")
#define PG8_WAIT_L(n) asm volatile("s_waitcnt lgkmcnt(" #n ")" ::: "memory")
#define PG8_BAR __builtin_amdgcn_s_barrier()
#define PG8_SCHED __builtin_amdgcn_sched_barrier(0)
    Unit cur, nxt; int ui = 0;
    if (!S.next(0, cur)) return;
    f32x4 acc[2][2][4][2];
#pragma unroll
    for (int a = 0; a < 2; ++a)
#pragma unroll
        for (int b = 0; b < 2; ++b)
#pragma unroll
            for (int m = 0; m < 4; ++m)
#pragma unroll
                for (int n = 0; n < 2; ++n) acc[a][b][m][n] = (f32x4){0.f, 0.f, 0.f, 0.f};
    bf16x8 At[4][2], B0[2][2], B1[2][2];
    const char* cA = (const char*)g.A + (size_t)cur.pm * tstepA; const char* cB = (const char*)g.Bt + (size_t)cur.pn * tstepB;
    unsigned vc0[2] = {0u, 0u}, vc1[2] = {0u, 0u}, w0[2] = {0u, 0u}, w1[2] = {0u, 0u};
    PG8_LAS u32x4* const vpark = (PG8_LAS u32x4*)(lds + 132096) + tid;
    if constexpr (Sched::GATHER) { static_assert(SP2, "row gather is wired into the SP2 loop only");
#pragma unroll
        for (int i = 0; i < 1; ++i) { S.rowoff4(cur, gR[0], vc0[0], vc0[1], vc1[0], vc1[1]); vc0[0] += (unsigned)gC[0]; vc0[1] += (unsigned)gC[0]; vc1[0] += (unsigned)gC[0]; vc1[1] += (unsigned)gC[0]; } }
#define PG8_STAGE_A(bufoff, gbase, half, v0, v1) do { if constexpr (Sched::GATHER) { if ((half) == 0) PG8_STAGE(bufoff, gbase, v0); else PG8_STAGE(bufoff, gbase, v1); } else PG8_STAGE(bufoff, (gbase) + (half) * hstepA, voffA); } while (0)
    S.a_ready(cur);
    if constexpr (SP2) {
        PG8_STAGE(PG8_SB(0, 0), cB, voffB); PG8_STAGE(PG8_SB(0, 1), cB + hstepB, voffB); PG8_STAGE_A(PG8_SA(0, 0), cA, 0, vc0, vc1); PG8_STAGE_A(PG8_SA(0, 1), cA, 1, vc0, vc1);
        if (wr == 1) PG8_BAR;
        PG8_WAIT_V(2); PG8_BAR;
        PG8_STAGE(PG8_SB(1, 0), cB + kstep, voffB); PG8_STAGE_A(PG8_SA(1, 0), cA + kstep, 0, vc0, vc1); PG8_STAGE(PG8_SB(1, 1), cB + hstepB + kstep, voffB);
        PG8_WAIT_V(6); PG8_BAR;
    } else {
        PG8_STAGE(PG8_SB(0, 0), cB, voffB); PG8_STAGE(PG8_SA(0, 0), cA, voffA); PG8_STAGE(PG8_SB(0, 1), cB + hstepB, voffB); PG8_STAGE(PG8_SA(0, 1), cA + hstepA, voffA);
        if (wr == 1) PG8_BAR;
        PG8_WAIT_V(4); PG8_BAR;
        PG8_STAGE(PG8_SB(1, 0), cB + kstep, voffB); PG8_STAGE(PG8_SA(1, 0), cA + kstep, voffA); PG8_STAGE(PG8_SB(1, 1), cB + hstepB + kstep, voffB);
        PG8_WAIT_V(6); PG8_BAR;
    }
    for (;;) {
        const bool has_next = S.next(ui + 1, nxt);
        if constexpr (Sched::GATHER) {
#pragma unroll
            for (int i = 0; i < 1; ++i) { if (has_next) { S.rowoff4(nxt, gR[0], w0[0], w0[1], w1[0], w1[1]); w0[0] += (unsigned)gC[0]; w0[1] += (unsigned)gC[0]; w1[0] += (unsigned)gC[0]; w1[1] += (unsigned)gC[0]; } else { w0[0] = vc0[0]; w0[1] = vc0[1]; w1[0] = vc1[0]; w1[1] = vc1[1]; } }
            *vpark = (u32x4){w0[0], w0[1], w1[0], w1[1]}; }
        const char* nA = has_next ? (const char*)g.A + (size_t)nxt.pm * tstepA : cA; const char* nB = has_next ? (const char*)g.Bt + (size_t)nxt.pn * tstepB : cB;
        for (int t = 0; t < nt; t += 2) {
            const bool last = (t == nt - 2);
            const char* a1 = cA + (size_t)(t + 1) * kstep;
            const char* a2 = last ? nA : cA + (size_t)(t + 2) * kstep; const char* b2 = last ? nB : cB + (size_t)(t + 2) * kstep;
            const char* a3 = a2 + kstep; const char* b3 = b2 + kstep;
            if constexpr (Sched::GATHER) { if (last) { const u32x4 q_ = *vpark; w0[0] = q_.x; w0[1] = q_.y; w1[0] = q_.z; w1[1] = q_.w; } else { w0[0] = vc0[0]; w0[1] = vc0[1]; w1[0] = vc1[0]; w1[1] = vc1[1]; } }
            if (last && has_next) S.a_ready(nxt);
            if constexpr (epi_kscale<Epi>::value) { if (t == Epi::KB0) kscale_rows(lds, acc, ui, 0, wr, fr); else if (t == Epi::KB1) kscale_rows(lds, acc, ui, 1, wr, fr); }
            if constexpr (SP2) {
            PG8_LDB(B0, 0, 0); PG8_LDB(B1, 0, 1); PG8_SCHED; PG8_LDA(At, 0, 0); PG8_STAGE_A(PG8_SA(1, 1), a1, 1, vc0, vc1);
            PG8_WAIT_V(8); PG8_WAIT_L(0); PG8_BAR; PG8_MMA(0, 0, At, B0); PG8_MMA(0, 1, At, B1); PG8_BAR; PG8_SCHED;
            PG8_LDA(At, 0, 1); PG8_STAGE(PG8_SB(0, 0), b2, voffB); PG8_STAGE(PG8_SB(0, 1), b2 + hstepB, voffB); PG8_STAGE_A(PG8_SA(0, 0), a2, 0, w0, w1);
            PG8_WAIT_V(8); PG8_WAIT_L(0); PG8_BAR; PG8_MMA(1, 0, At, B0); PG8_MMA(1, 1, At, B1); PG8_BAR; PG8_SCHED;
            PG8_LDB(B0, 1, 0); PG8_LDB(B1, 1, 1); PG8_SCHED; PG8_LDA(At, 1, 0); PG8_STAGE_A(PG8_SA(0, 1), a2, 1, w0, w1);
            PG8_WAIT_V(8); PG8_WAIT_L(0); PG8_BAR; PG8_MMA(0, 0, At, B0); PG8_MMA(0, 1, At, B1); PG8_BAR; PG8_SCHED;
            PG8_LDA(At, 1, 1); PG8_STAGE(PG8_SB(1, 0), b3, voffB); PG8_STAGE(PG8_SB(1, 1), b3 + hstepB, voffB); PG8_STAGE_A(PG8_SA(1, 0), a3, 0, w0, w1);
            PG8_WAIT_V(8); PG8_WAIT_L(0); PG8_BAR; PG8_MMA(1, 0, At, B0); PG8_MMA(1, 1, At, B1); PG8_BAR; PG8_SCHED;
            } else {
            PG8_LDB(B0, 0, 0); PG8_SCHED; PG8_LDA(At, 0, 0); PG8_STAGE(PG8_SA(1, 1), a1 + hstepA, voffA);
            PG8_WAIT_L(8); PG8_BAR; PG8_WAIT_L(0); PG8_MMA(0, 0, At, B0); PG8_BAR; PG8_SCHED;
            PG8_LDB(B1, 0, 1); PG8_STAGE(PG8_SB(0, 0), b2, voffB);
            PG8_BAR; PG8_WAIT_L(0); PG8_MMA(0, 1, At, B1); PG8_BAR;
            PG8_LDA(At, 0, 1); PG8_STAGE(PG8_SA(0, 0), a2, voffA);
            PG8_BAR; PG8_WAIT_L(0); PG8_MMA(1, 0, At, B0); PG8_BAR; PG8_SCHED;
            PG8_STAGE(PG8_SB(0, 1), b2 + hstepB, voffB);
            PG8_WAIT_V(6); PG8_BAR; PG8_MMA(1, 1, At, B1); PG8_BAR;
            PG8_LDB(B0, 1, 0); PG8_SCHED; PG8_LDA(At, 1, 0); PG8_STAGE(PG8_SA(0, 1), a2 + hstepA, voffA);
            PG8_WAIT_L(8); PG8_BAR; PG8_WAIT_L(0); PG8_MMA(0, 0, At, B0); PG8_BAR; PG8_SCHED;
            PG8_LDB(B1, 1, 1); PG8_STAGE(PG8_SB(1, 0), b3, voffB);
            PG8_BAR; PG8_WAIT_L(0); PG8_MMA(0, 1, At, B1); PG8_BAR;
            PG8_LDA(At, 1, 1); PG8_STAGE(PG8_SA(1, 0), a3, voffA);
            PG8_BAR; PG8_WAIT_L(0); PG8_MMA(1, 0, At, B0); PG8_BAR; PG8_SCHED;
            PG8_STAGE(PG8_SB(1, 1), b3 + hstepB, voffB);
            PG8_WAIT_V(6); PG8_BAR; PG8_MMA(1, 1, At, B1); PG8_BAR;
            }
        }
        if constexpr (epi_kscale<Epi>::value) kscale_rows(lds, acc, ui, 2, wr, fr);
        if constexpr (ALIGN_EPI) { if (wr == 0) PG8_BAR; }
        if constexpr (!Epi::AFTER_DRAIN) { E(acc, cur, wr, wc, fr, fq); S.done(cur); }
        if (!has_next) break;
#pragma unroll
        for (int a = 0; a < 2; ++a)
#pragma unroll
            for (int b = 0; b < 2; ++b)
#pragma unroll
                for (int m = 0; m < 4; ++m)
#pragma unroll
                    for (int n = 0; n < 2; ++n) acc[a][b][m][n] = (f32x4){0.f, 0.f, 0.f, 0.f};
        cur = nxt; cA = nA; cB = nB; ++ui;
        if constexpr (Sched::GATHER) { vc0[0] = w0[0]; vc0[1] = w0[1]; vc1[0] = w1[0]; vc1[1] = w1[1]; }
        if constexpr (ALIGN_EPI) { if (wr == 1) PG8_BAR; }
    }
    PG8_WAIT_V(0);
    if constexpr (!ALIGN_EPI) { if (wr == 0) PG8_BAR; }
    PG8_BAR;
    if constexpr (Epi::AFTER_DRAIN) { E.fused(acc, cur, wr, wc, fr, fq, lds, wid, lane); S.done(cur); }
#undef PG8_SA
#undef PG8_SB
#undef PG8_STAGE
#undef PG8_STAGE_A
#undef PG8_LDA
#undef PG8_LDB
#undef PG8_MMA
#undef PG8_WAIT_V
#undef PG8_WAIT_L
#undef PG8_BAR
#undef PG8_SCHED
}
}

using pg8::Unit;
#define GAS_ __attribute__((address_space(1)))
struct EpiStore {
    static constexpr bool PERM = true, AFTER_DRAIN = false;
    bf16_t* O; int ldc; const float* ssq; float inv_n; int pn_mod; int ncol;
    __device__ __forceinline__ void operator()(const f32x4 (&acc)[2][2][4][2], const Unit& u, int wr, int wc, int fr, int fq) const {
        const int row0 = u.pm * 256 + wr * 64 + fr, col0 = (u.pn % pn_mod) * 256 + wc * 32 + 8 * fq;
        float sc[2][4];
#pragma unroll
        for (int ai = 0; ai < 2; ++ai)
#pragma unroll
            for (int m = 0; m < 4; ++m) { sc[ai][m] = 1.f; if (ssq) { const f32x4 p4 = *(const GAS_ f32x4*)(ssq + (size_t)(row0 + ai * 128 + m * 16) * 4); sc[ai][m] = rsqrtf(((p4[0] + p4[1]) + (p4[2] + p4[3])) * inv_n + EPS); } }
#pragma unroll
        for (int ai = 0; ai < 2; ++ai)
#pragma unroll
            for (int m = 0; m < 4; ++m) { const float s = sc[ai][m]; GAS_ bf16_t* rp = (GAS_ bf16_t*)O + (size_t)(row0 + ai * 128 + m * 16) * ldc + col0;
#pragma unroll
                for (int bj = 0; bj < 2; ++bj) if (col0 + bj * 128 < ncol) *(GAS_ u32x4*)(rp + bj * 128) = pg8::pack8(acc[ai][bj][m][0] * s, acc[ai][bj][m][1] * s); }
    }
};
struct EpiInproj {
    static constexpr bool PERM = true, AFTER_DRAIN = false;
    bf16_t* O; float* fg;
    __device__ __forceinline__ void operator()(const f32x4 (&acc)[2][2][4][2], const Unit& u, int wr, int wc, int fr, int fq) const {
        const int row0 = u.pm * 256 + wr * 64 + fr, col0 = u.pn * 256 + wc * 32 + 8 * fq;
        const bool isfg = (u.pn == 7) && (wc == 0) && (fq == 0);
#pragma unroll
        for (int ai = 0; ai < 2; ++ai)
#pragma unroll
            for (int m = 0; m < 4; ++m) { const int row = row0 + ai * 128 + m * 16; bf16_t* rp = O + (size_t)row * PJ + col0;
#pragma unroll
                for (int bj = 0; bj < 2; ++bj) *(u32x4*)(rp + bj * 128) = pg8::pack8(acc[ai][bj][m][0], acc[ai][bj][m][1]);
                if (isfg) { *(f32x4*)(fg + (size_t)row * 8) = acc[ai][1][m][0]; *(f32x4*)(fg + (size_t)row * 8 + 4) = acc[ai][1][m][1]; } }
    }
};
struct EpiInproj2 {
    static constexpr bool PERM = true, AFTER_DRAIN = false;
    bf16_t* O; float* lf; bf16_t* ug; float* ssq; const float* gq; const float* gk; const float* bf;
    __device__ __forceinline__ void operator()(const f32x4 (&acc)[2][2][4][2], const Unit& u, int wr, int wc, int fr, int fq) const {
        const int lane = fq * 16 + fr, row0 = u.pm * 256 + wr * 64 + fr;
        if (u.pn >= 3 && u.pn <= 5) {
            const int hg = (u.pn - 3) * 4 + wc; const bool isq = hg < 6; const int h = isq ? hg : hg - 6;
            const float* gp = launder_ptr(isq ? gq : gk) + 8 * fq; const float gs = isq ? C2_FOX : 1.f;
            const f32x4 g00 = *(const f32x4*)gp * gs, g01 = *(const f32x4*)(gp + 4) * gs, g10 = *(const f32x4*)(gp + 32) * gs, g11 = *(const f32x4*)(gp + 36) * gs;
            bf16_t* base = O + (isq ? PC_FQ : PC_FK) + h * 64 + 8 * fq;
#pragma unroll
            for (int ai = 0; ai < 2; ++ai)
#pragma unroll
                for (int m = 0; m < 4; ++m) { const int row = row0 + ai * 128 + m * 16;
                    const f32x4 a0 = acc[ai][0][m][0], a1 = acc[ai][0][m][1], b0 = acc[ai][1][m][0], b1 = acc[ai][1][m][1];
                    float s = 0.f;
#pragma unroll
                    for (int j = 0; j < 4; ++j) s += a0[j] * a0[j] + a1[j] * a1[j] + b0[j] * b0[j] + b1[j] * b1[j];
                    s += shx(s, 16, lane); s += shx(s, 32, lane);
                    const float r = rsqrtf(s * (1.f / 64.f) + EPS);
                    bf16_t* rp = base + (size_t)row * PJ;
                    *(u32x4*)rp = pg8::pack8(a0 * g00 * r, a1 * g01 * r); *(u32x4*)(rp + 32) = pg8::pack8(b0 * g10 * r, b1 * g11 * r);
                    asm volatile("" ::: "memory"); }
            return;
        }
        const int col0 = u.pn * 256 + wc * 32 + 8 * fq;
#pragma unroll
        for (int ai = 0; ai < 2; ++ai)
#pragma unroll
            for (int m = 0; m < 4; ++m) { const int row = row0 + ai * 128 + m * 16; bf16_t* rp = O + (size_t)row * PJ + col0;
                const u32x4 w0 = pg8::pack8(acc[ai][0][m][0], acc[ai][0][m][1]), w1 = pg8::pack8(acc[ai][1][m][0], acc[ai][1][m][1]);
                if (u.pn != 0) { *(u32x4*)rp = w0; *(u32x4*)(rp + 128) = w1; }
                if (u.pn == 0) { const int b = row >> 12, t = row & 4095, c0 = wc * 32 + 8 * fq;
                    bf16_t* up = ug + (size_t)(b * 128 + (t >> 5)) * 640 + (t & 31) * 16 + (c0 & 15);
                    *(u32x4*)(up + (size_t)(c0 >> 4) * 1024 * 640) = w0; *(u32x4*)(up + (size_t)((c0 >> 4) + 8) * 1024 * 640) = w1; }
                else if (u.pn == 1 || u.pn == 2) {
                    const f32x4 a0 = acc[ai][0][m][0], a1 = acc[ai][0][m][1], b0 = acc[ai][1][m][0], b1 = acc[ai][1][m][1];
                    float s0 = 0.f, s1 = 0.f;
#pragma unroll
                    for (int j = 0; j < 4; ++j) { s0 += a0[j] * a0[j] + a1[j] * a1[j]; s1 += b0[j] * b0[j] + b1[j] * b1[j]; }
                    if (u.pn == 1) { float s = s0 + s1; s += shx(s, 16, lane); s += shx(s, 32, lane); if (fq == 0) ssq[(size_t)row * 4 + wc] = s; }
                    else { s0 += shx(s0, 16, lane); s0 += shx(s0, 32, lane); if (fq == 0) ssq[(size_t)4 * T + (size_t)row * 4 + wc] = s0;
                        if (wc == 0) { s1 += shx(s1, 16, lane); s1 += shx(s1, 32, lane); if (fq == 0) ssq[(size_t)8 * T + row] = s1; } } }
                else if (u.pn == 7 && wc == 0 && fq == 0) { const f32x4 z0 = acc[ai][1][m][0] + (f32x4){bf[0], bf[1], bf[2], bf[3]}, z1 = acc[ai][1][m][1] + (f32x4){bf[4], bf[5], 0.f, 0.f}; f32x4 l0, l1;
#pragma unroll
                    for (int j = 0; j < 4; ++j) { l0[j] = fminf(z0[j], 0.f) - __logf(1.f + __expf(-fabsf(z0[j]))); l1[j] = fminf(z1[j], 0.f) - __logf(1.f + __expf(-fabsf(z1[j]))); }
                    *(f32x4*)(lf + (size_t)row * 8) = l0; *(f32x4*)(lf + (size_t)row * 8 + 4) = l1; }
                asm volatile("" ::: "memory"); }
    }
};
struct EpiKvup {
    static constexpr bool PERM = true, AFTER_DRAIN = false;
    bf16_t* km; bf16_t* kv; const bf16_t* proj; const float* ssq; const float* gk; const float* cs; const float* sn;
    __device__ __forceinline__ void operator()(const f32x4 (&acc)[2][2][4][2], const Unit& u, int wr, int wc, int, int) const {
        const int lane = hidden_tid(0), fr = lane & 15, fq = lane >> 4, row0 = u.pm * 256 + wr * 64 + fr, head = 2 * u.pn + (wc >> 1); const bool isv = wc & 1;
        const float* gk = launder_ptr(this->gk);
        const f32x4 g00 = *(const f32x4*)(gk + 8 * fq), g01 = *(const f32x4*)(gk + 8 * fq + 4), g10 = *(const f32x4*)(gk + 32 + 8 * fq), g11 = *(const f32x4*)(gk + 36 + 8 * fq);
#pragma unroll
        for (int ai2 = 0; ai2 < 8; ++ai2) {
            const int ai = ai2 >> 2, mb = ai2 & 3;
            f32x4 p4[4], cv[4], sv[4], gr1, gr2; float krs[4]; u32x2 ka[4], kb[4];
#pragma unroll
            for (int m = mb; m < mb + 1; ++m) { const int row = row0 + ai * 128 + m * 16; p4[m] = *(const GAS_ f32x4*)(ssq + (size_t)4 * T + (size_t)row * 4);
                if (!isv) { krs[m] = *(const GAS_ float*)(ssq + (size_t)8 * T + row); ka[m] = *(const GAS_ u32x2*)(proj + (size_t)row * PJ + PC_KR + 4 * fq); kb[m] = *(const GAS_ u32x2*)(proj + (size_t)row * PJ + PC_KR + 16 + 4 * fq);
                    cv[m] = *(const GAS_ f32x4*)(cs + (size_t)row * 16 + 4 * fq); sv[m] = *(const GAS_ f32x4*)(sn + (size_t)row * 16 + 4 * fq);
                    gr1 = *(const GAS_ f32x4*)(gk + 64 + 4 * fq); gr2 = *(const GAS_ f32x4*)(gk + 80 + 4 * fq); } }
#pragma unroll
            for (int m = mb; m < mb + 1; ++m) { const int row = row0 + ai * 128 + m * 16;
                const float rkv = rsqrtf(((p4[m][0] + p4[m][1]) + (p4[m][2] + p4[m][3])) * (1.f / 128.f) + EPS);
                const f32x4 a0 = acc[ai][0][m][0], a1 = acc[ai][0][m][1], b0 = acc[ai][1][m][0], b1 = acc[ai][1][m][1];
                if (isv) { GAS_ bf16_t* vp = (GAS_ bf16_t*)kv + (size_t)row * 768 + head * 128 + 64 + 8 * fq; *(GAS_ u32x4*)vp = pg8::pack8(a0 * rkv, a1 * rkv); *(GAS_ u32x4*)(vp + 32) = pg8::pack8(b0 * rkv, b1 * rkv); }
                else {
                    float s = 0.f;
#pragma unroll
                    for (int j = 0; j < 4; ++j) s += a0[j] * a0[j] + a1[j] * a1[j] + b0[j] * b0[j] + b1[j] * b1[j];
                    s += shx(s, 16, lane); s += shx(s, 32, lane);
                    const float rh = rsqrtf((s * rkv * rkv + krs[m]) * (1.f / 96.f) + EPS), sc = rkv * rh;
                    GAS_ bf16_t* kp = (GAS_ bf16_t*)km + (size_t)row * 576 + head * 96;
                    *(GAS_ u32x4*)(kp + 8 * fq) = pg8::pack8(a0 * g00 * sc, a1 * g01 * sc); *(GAS_ u32x4*)(kp + 32 + 8 * fq) = pg8::pack8(b0 * g10 * sc, b1 * g11 * sc);
                    const f32x4 x1 = (f32x4){bf2f(ka[m].x & 0xffff), bf2f(ka[m].x >> 16), bf2f(ka[m].y & 0xffff), bf2f(ka[m].y >> 16)} * gr1 * rh, x2 = (f32x4){bf2f(kb[m].x & 0xffff), bf2f(kb[m].x >> 16), bf2f(kb[m].y & 0xffff), bf2f(kb[m].y >> 16)} * gr2 * rh;
                    const f32x4 o1 = x1 * cv[m] - x2 * sv[m], o2 = x1 * sv[m] + x2 * cv[m];
                    u32x2 w1, w2; w1.x = pg8::cvt_pk_bf16(o1[0], o1[1]); w1.y = pg8::cvt_pk_bf16(o1[2], o1[3]); w2.x = pg8::cvt_pk_bf16(o2[0], o2[1]); w2.y = pg8::cvt_pk_bf16(o2[2], o2[3]);
                    *(GAS_ u32x2*)(kp + 64 + 4 * fq) = w1; *(GAS_ u32x2*)(kp + 80 + 4 * fq) = w2; } } }
    }
};
template <bool KS>
struct EpiResidT {
    static constexpr bool KSCALE = KS; static constexpr int KB0 = 4, KB1 = 10;
    static constexpr bool PERM = true, AFTER_DRAIN = false;
    const bf16_t* X; const float* gate0; bf16_t* Xo;
    __device__ __forceinline__ void operator()(const f32x4 (&acc)[2][2][4][2], const Unit& u, int wr, int wc, int fr, int fq) const {
        const int row0 = u.pm * 256 + wr * 64 + fr, col0 = u.pn * 256 + wc * 32 + 8 * fq;
        const float* gp = gate0 + (size_t)(u.pm >> 4) * 6 * D + col0;
        f32x4 g[2][2];
#pragma unroll
        for (int bj = 0; bj < 2; ++bj) { g[bj][0] = *(const f32x4*)(gp + bj * 128); g[bj][1] = *(const f32x4*)(gp + bj * 128 + 4); }
#pragma unroll
        for (int ai = 0; ai < 2; ++ai) {
            u32x4 xv[4][2];
#pragma unroll
            for (int m = 0; m < 4; ++m) { const GAS_ bf16_t* rp = (const GAS_ bf16_t*)X + (size_t)(row0 + ai * 128 + m * 16) * D + col0;
#pragma unroll
                for (int bj = 0; bj < 2; ++bj) xv[m][bj] = *(const GAS_ u32x4*)(rp + bj * 128); }
#pragma unroll
            for (int m = 0; m < 4; ++m) { GAS_ bf16_t* wp = (GAS_ bf16_t*)Xo + (size_t)(row0 + ai * 128 + m * 16) * D + col0;
#pragma unroll
                for (int bj = 0; bj < 2; ++bj) { const u32x4 w = xv[m][bj];
                    const f32x4 x0 = {__uint_as_float(w.x << 16), __uint_as_float(w.x & 0xffff0000u), __uint_as_float(w.y << 16), __uint_as_float(w.y & 0xffff0000u)};
                    const f32x4 x1 = {__uint_as_float(w.z << 16), __uint_as_float(w.z & 0xffff0000u), __uint_as_float(w.w << 16), __uint_as_float(w.w & 0xffff0000u)};
                    *(GAS_ u32x4*)(wp + bj * 128) = pg8::pack8(x0 + g[bj][0] * acc[ai][bj][m][0], x1 + g[bj][1] * acc[ai][bj][m][1]); } } }
    }
};
using EpiResid = EpiResidT<false>; using EpiResidK = EpiResidT<true>;
__device__ __forceinline__ f32x4 silu_mul4(const f32x4 g, const f32x4 u) { f32x4 o;
#pragma unroll
    for (int j = 0; j < 4; ++j) o[j] = g[j] * __builtin_amdgcn_rcpf(1.f + __expf(-g[j])) * u[j];
    return o; }
struct EpiSwiglu {
    static constexpr bool PERM = true, AFTER_DRAIN = false;
    bf16_t* O; int ldc; int pn_mod;
    __device__ __forceinline__ void operator()(const f32x4 (&acc)[2][2][4][2], const Unit& u, int wr, int wc, int fr, int fq) const {
        const int row0 = u.pm * 256 + wr * 64 + fr, ff0 = (u.pn % pn_mod) * 128 + wc * 32 + 8 * fq;
#pragma unroll
        for (int ai = 0; ai < 2; ++ai)
#pragma unroll
            for (int m = 0; m < 4; ++m) *(u32x4*)(O + (size_t)(row0 + ai * 128 + m * 16) * ldc + ff0) = pg8::pack8(silu_mul4(acc[ai][0][m][0], acc[ai][1][m][0]), silu_mul4(acc[ai][0][m][1], acc[ai][1][m][1]));
    }
};
struct EpiGlu {
    static constexpr bool PERM = true, AFTER_DRAIN = false;
    const bf16_t* Y; bf16_t* O; const float* bias; int ldo; float* ssq;
    __device__ __forceinline__ void operator()(const f32x4 (&acc)[2][2][4][2], const Unit& u, int wr, int wc, int, int) const {
        const int lane = hidden_tid(0), fr = lane & 15, fq = lane >> 4, row0 = u.pm * 256 + wr * 64 + fr, col0 = wc * 32 + 8 * fq;
        f32x4 bb[2][2]; const float* bias = launder_ptr(this->bias);
#pragma unroll
        for (int bj = 0; bj < 2; ++bj) { bb[bj][0] = *(const f32x4*)(bias + col0 + bj * 128); bb[bj][1] = *(const f32x4*)(bias + col0 + bj * 128 + 4); }
#pragma unroll
        for (int ai = 0; ai < 2; ++ai) {
            u32x4 yv[4][2];
#pragma unroll
            for (int m = 0; m < 4; ++m)
#pragma unroll
                for (int bj = 0; bj < 2; ++bj) yv[m][bj] = *(const GAS_ u32x4*)(Y + (size_t)(row0 + ai * 128 + m * 16) * 256 + col0 + bj * 128);
#pragma unroll
            for (int m = 0; m < 4; ++m) { float ss = 0.f;
#pragma unroll
                for (int bj = 0; bj < 2; ++bj) { const unsigned yw[4] = {yv[m][bj].x, yv[m][bj].y, yv[m][bj].z, yv[m][bj].w}; f32x4 o0, o1;
#pragma unroll
                    for (int j = 0; j < 4; ++j) { const float ya = j & 1 ? bf2f(yw[j >> 1] >> 16) : bf2f(yw[j >> 1] & 0xffff), yb = j & 1 ? bf2f(yw[2 + (j >> 1)] >> 16) : bf2f(yw[2 + (j >> 1)] & 0xffff);
                        o0[j] = ya * __builtin_amdgcn_rcpf(1.f + __expf(-(acc[ai][bj][m][0][j] + bb[bj][0][j]))); o1[j] = yb * __builtin_amdgcn_rcpf(1.f + __expf(-(acc[ai][bj][m][1][j] + bb[bj][1][j]))); }
#pragma unroll
                    for (int j = 0; j < 4; ++j) ss += o0[j] * o0[j] + o1[j] * o1[j];
                    *(GAS_ u32x4*)((GAS_ bf16_t*)O + (size_t)(row0 + ai * 128 + m * 16) * ldo + col0 + bj * 128) = pg8::pack8(o0, o1); }
                ss += shx(ss, 16, lane); ss += shx(ss, 32, lane);
                if (fq == 0) ssq[(size_t)(row0 + ai * 128 + m * 16) * 16 + wc] = ss; } }
    }
};

__device__ __forceinline__ int inproj_nat_col(int n) { if (n < 768 || n >= 1536) return n; const int pn = n >> 8, c = n & 255; return 768 + ((((pn - 3) * 4 + ((c >> 5) & 3))) << 6) + ((c >> 7) << 5) + (c & 31); }
template <class SRC>
__device__ __forceinline__ void convert_tiles(bf16_t* Bt, int N, int K, SRC src, float* scr, int gw, int ngw, int lane) {
    const int nblk = N / 32, items = (K / 64) * nblk;
    for (int it = gw; it < items; it += ngw) {
        const int kb = it / nblk, nb = it % nblk, k0 = kb * 64, n0 = nb * 32;
#pragma unroll 8
        for (int i = 0; i < 32; ++i) { const int kk = 2 * i + (lane >> 5); scr[kk * 33 + (lane & 31)] = src(k0 + kk, n0 + (lane & 31)); }
        asm volatile("s_waitcnt lgkmcnt(0)" ::: "memory");
        const int c = lane & 7;
#pragma unroll
        for (int j = 0; j < 4; ++j) { const int n = (lane >> 3) + 8 * j; const float* s = scr + (8 * c) * 33 + n;
            u32x4 o; o.x = pk2(s[0], s[33]); o.y = pk2(s[66], s[99]); o.z = pk2(s[132], s[165]); o.w = pk2(s[198], s[231]);
            *(u32x4*)(Bt + (size_t)(n0 + n) * K + k0 + 8 * c) = o; }
        asm volatile("s_waitcnt lgkmcnt(0)" ::: "memory");
    }
}

struct CvtTile { const float* src; const float* gain; bf16_t* dst; int ld, K; };
__device__ __forceinline__ int cvt_count(int layer) { return 512 + ((layer & 1) == 0 ? (D / 64) * (2 * DFF / 32) + (DFF / 64) * (D / 32) : NEXP * ((D / 64) * (2 * DFE / 32) + (DFE / 64) * (D / 32))); }
__device__ __forceinline__ void cvt_decode(const Params& P, int layer, int it, int kr, int n4, CvtTile& t) {
    unsigned char* ws = P.ws;
    if (it < 512) { const int kb = it >> 5, nb = it & 31, k0 = kb * 64, n0 = nb * 32;
        t.src = P.w_out + (size_t)layer * D * D + (size_t)(k0 + kr) * D + n0 + n4; t.gain = P.out_norm + layer * D + k0 + kr; t.ld = D; t.K = D; t.dst = (bf16_t*)(ws + W_OUT) + (size_t)n0 * D + k0; return; }
    it -= 512; t.gain = nullptr;
    if ((layer & 1) == 0) {
        const int n1 = (D / 64) * (2 * DFF / 32);
        if (it < n1) { const int nblk = 2 * DFF / 32, kb = it / nblk, nb = it % nblk, k0 = kb * 64, n0 = nb * 32, ff = (n0 >> 8) * 128 + (n0 & 127);
            t.src = ((n0 & 128) ? P.ffn_wu : P.ffn_wg) + (size_t)(layer / 2) * D * DFF + (size_t)(k0 + kr) * DFF + ff + n4; t.ld = DFF; t.K = D; t.dst = (bf16_t*)(ws + W_F1) + (size_t)n0 * D + k0; }
        else { it -= n1; const int kb = it >> 5, nb = it & 31, k0 = kb * 64, n0 = nb * 32;
            t.src = P.ffn_wd + (size_t)(layer / 2) * DFF * D + (size_t)(k0 + kr) * D + n0 + n4; t.ld = D; t.K = DFF; t.dst = (bf16_t*)(ws + W_F2) + (size_t)n0 * DFF + k0; }
    } else {
        const int n1 = (D / 64) * (2 * DFE / 32), n2 = (DFE / 64) * (D / 32), e = it / (n1 + n2); it -= e * (n1 + n2);
        const size_t eo = (size_t)(layer / 2) * NEXP + e;
        if (it < n1) { const int nblk = 2 * DFE / 32, kb = it / nblk, nb = it % nblk, k0 = kb * 64, n0 = nb * 32, ff = (n0 >> 8) * 128 + (n0 & 127);
            t.src = ((n0 & 128) ? P.moe_wu : P.moe_wg) + eo * D * DFE + (size_t)(k0 + kr) * DFE + ff + n4; t.ld = DFE; t.K = D; t.dst = (bf16_t*)(ws + W_F1) + (size_t)e * 2 * DFE * D + (size_t)n0 * D + k0; }
        else { it -= n1; const int kb = it >> 5, nb = it & 31, k0 = kb * 64, n0 = nb * 32;
            t.src = P.moe_wd + eo * DFE * D + (size_t)(k0 + kr) * D + n0 + n4; t.ld = D; t.K = DFE; t.dst = (bf16_t*)(ws + W_F2) + (size_t)e * D * DFE + (size_t)n0 * DFE + k0; }
    }
}
__device__ __forceinline__ void cvt_load(const CvtTile& t, f32x4 (&v)[8], float (&g)[8]) {
#pragma unroll
    for (int i = 0; i < 8; ++i) v[i] = *(const f32x4*)(t.src + (size_t)(i * 8) * t.ld);
    if (t.gain) {
#pragma unroll
        for (int i = 0; i < 8; ++i) g[i] = t.gain[i * 8]; }
}
__device__ __forceinline__ void convert_stream(const Params& P, int layer, float* scr, int first, int items, int ngw, int lane) {
    const int kr = lane >> 3, n4 = (lane & 7) * 4, c = lane & 7;
    CvtTile t, tn; f32x4 v[8], vn[8]; float g[8], gn[8];
    if (first < items) { cvt_decode(P, layer, first, kr, n4, t); cvt_load(t, v, g); }
    for (int it = first; it < items; it += ngw) {
        const int nit = it + ngw;
        if (nit < items) { cvt_decode(P, layer, nit, kr, n4, tn); cvt_load(tn, vn, gn); }
        if (t.gain) {
#pragma unroll
            for (int i = 0; i < 8; ++i) v[i] = v[i] * g[i]; }
#pragma unroll
        for (int i = 0; i < 8; ++i)
#pragma unroll
            for (int j = 0; j < 4; ++j) scr[(n4 + j) * 68 + i * 8 + kr] = v[i][j];
        asm volatile("s_waitcnt lgkmcnt(0)" ::: "memory");
#pragma unroll
        for (int j = 0; j < 4; ++j) { const int n = (lane >> 3) + 8 * j; const float* s = scr + n * 68 + 8 * c; const f32x4 a = *(const f32x4*)s, b = *(const f32x4*)(s + 4);
            u32x4 o_; o_.x = pk2(a[0], a[1]); o_.y = pk2(a[2], a[3]); o_.z = pk2(b[0], b[1]); o_.w = pk2(b[2], b[3]);
            *(u32x4*)(t.dst + (size_t)n * t.K + 8 * c) = o_; }
        asm volatile("s_waitcnt lgkmcnt(0)" ::: "memory");
#pragma unroll
        for (int i = 0; i < 8; ++i) { v[i] = vn[i]; g[i] = gn[i]; }
        t = tn;
    }
}
__device__ __forceinline__ float cvt0_src(const Params& P, int layer, int which, int k, int n) {
    if (which == 0) { const int oc = proj_orig_col(inproj_nat_col(n)); return oc < 0 ? 0.f : P.w_in[(size_t)layer * D * INC + (size_t)k * INC + oc]; }
    if (which == 1) return n < 576 ? P.q_norm[layer * 256 + k] * P.w_uq[(size_t)layer * 256 * 576 + (size_t)k * 576 + n] : 0.f;
    if (which == 2) { const int c = n & 255, wc_ = (c >> 5) & 3, nat = (2 * (n >> 8) + (wc_ >> 1)) * 128 + (wc_ & 1) * 64 + ((c >> 7) << 5) + (c & 31); return k < 128 ? P.kv_norm[layer * 128 + k] * P.w_ukv[(size_t)layer * 128 * 768 + (size_t)k * 768 + nat] : 0.f; }
    return P.w_glu[(size_t)layer * 256 * 256 + (size_t)k * 256 + n];
}
__device__ __forceinline__ void convert_small(const Params& P, int layer, float* scr, int gw, int ngw, int lane) {
    unsigned char* ws = P.ws;
    for (int it = gw; it < 1024 + 96 + 96 + 32; it += ngw) {
        int which, r, nblk, K; bf16_t* Bt;
        if (it < 1024) { which = 0; r = it; nblk = PJ / 32; K = D; Bt = (bf16_t*)(ws + W_IN); }
        else if (it < 1120) { which = 1; r = it - 1024; nblk = 24; K = 256; Bt = (bf16_t*)(ws + W_UQ); }
        else if (it < 1216) { which = 2; r = it - 1120; nblk = 24; K = 256; Bt = (bf16_t*)(ws + W_UKV); }
        else { which = 3; r = it - 1216; nblk = 8; K = 256; Bt = (bf16_t*)(ws + W_GLU); }
        const int kb = r / nblk, nb = r % nblk, k0 = kb * 64, n0 = nb * 32;
        float v[32];
#pragma unroll
        for (int i = 0; i < 32; ++i) v[i] = cvt0_src(P, layer, which, k0 + 2 * i + (lane >> 5), n0 + (lane & 31));
#pragma unroll
        for (int i = 0; i < 32; ++i) scr[(2 * i + (lane >> 5)) * 33 + (lane & 31)] = v[i];
        asm volatile("s_waitcnt lgkmcnt(0)" ::: "memory");
        const int c = lane & 7;
#pragma unroll
        for (int j = 0; j < 4; ++j) { const int n = (lane >> 3) + 8 * j; const float* s = scr + (8 * c) * 33 + n;
            u32x4 o; o.x = pk2(s[0], s[33]); o.y = pk2(s[66], s[99]); o.z = pk2(s[132], s[165]); o.w = pk2(s[198], s[231]);
            *(u32x4*)(Bt + (size_t)(n0 + n) * K + k0 + 8 * c) = o; }
        asm volatile("s_waitcnt lgkmcnt(0)" ::: "memory");
    }
}
__device__ __forceinline__ void ph_convert(unsigned char* lds, Params P, int layer) {
    const int TIDX = hidden_tid(P.wid), BIDX = launder_i((int)blockIdx.x), GDIM = launder_i((int)gridDim.x); P.ws = launder_ptr(P.ws); P.out = launder_ptr(P.out);
    const int wid = TIDX >> 6, lane = TIDX & 63;
    convert_small(P, layer, (float*)lds + wid * 2176, BIDX * 8 + wid, GDIM * 8, lane);
    { const int ngw = GDIM * 8; int first = BIDX * 8 + wid - 1248 % ngw; if (first < 0) first += ngw;
      convert_stream(P, layer, (float*)lds + wid * 2176, first, cvt_count(layer), ngw, lane); }
}
#define GEMM_LDS ((PG8_LAS unsigned char*)lds)
__device__ __forceinline__ void ph_inproj_opt(unsigned char* lds, Params P, int layer) {
    const int TIDX = hidden_tid(P.wid), BIDX = launder_i((int)blockIdx.x), GDIM = launder_i((int)gridDim.x); P.ws = launder_ptr(P.ws); P.out = launder_ptr(P.out);
    pg8::Gemm g{(const bf16_t*)(P.ws + WS_HBUF), (const bf16_t*)(P.ws + W_IN), D, D, D, P.wid}; pg8::StaticOrder S; S.init(T, PJ, GDIM, BIDX);
    EpiInproj2 E{(bf16_t*)(P.ws + WS_PROJ), (float*)(P.ws + WS_FG), (bf16_t*)(P.ws + WS_UG), (float*)(P.ws + WS_SSQ), P.fox_gq + layer * 64, P.fox_gk + layer * 64, P.fox_bf + layer * 6};
    pg8::gemm_phase<EpiInproj2, pg8::StaticOrder, true, true>(GEMM_LDS, g, S, E);
}
__device__ __forceinline__ void ph_qup_opt(unsigned char* lds, Params P, int layer) {
    const int TIDX = hidden_tid(P.wid), BIDX = launder_i((int)blockIdx.x), GDIM = launder_i((int)gridDim.x); P.ws = launder_ptr(P.ws); P.out = launder_ptr(P.out);
    pg8::Gemm g{(const bf16_t*)(P.ws + WS_PROJ) + PC_CQ, (const bf16_t*)(P.ws + W_UQ), PJ, 256, 256, P.wid}; pg8::StaticOrder S; S.init(T, 768, GDIM, BIDX);
    EpiStore E{(bf16_t*)(P.ws + WS_QRAW), 768, (const float*)(P.ws + WS_SSQ), 1.f / 256.f, 1 << 20, 576};
    pg8::gemm_phase<EpiStore, pg8::StaticOrder, true, true>(GEMM_LDS, g, S, E);
}
__device__ __forceinline__ void ph_kvup_opt(unsigned char* lds, Params P, int layer) {
    const int TIDX = hidden_tid(P.wid), BIDX = launder_i((int)blockIdx.x), GDIM = launder_i((int)gridDim.x); P.ws = launder_ptr(P.ws); P.out = launder_ptr(P.out);
    pg8::Gemm g{(const bf16_t*)(P.ws + WS_PROJ) + PC_CKV, (const bf16_t*)(P.ws + W_UKV), PJ, 256, 128, P.wid};     pg8::StaticOrder S; S.init(T, 768, GDIM, (BIDX + (GDIM >> 1)) % GDIM);
    EpiKvup E{(bf16_t*)(P.ws + WS_KMLA), (bf16_t*)(P.ws + WS_KVRAW), (const bf16_t*)(P.ws + WS_PROJ), (const float*)(P.ws + WS_SSQ), P.mla_gk + layer * 96, (const float*)(P.ws + WS_COS), (const float*)(P.ws + WS_SIN)};
    pg8::gemm_phase<EpiKvup, pg8::StaticOrder, true, true>(GEMM_LDS, g, S, E);
}
__device__ __forceinline__ void ph_glu_opt(unsigned char* lds, Params P, int layer, int sub = 0) {
    const int TIDX = hidden_tid(P.wid), BIDX = launder_i((int)blockIdx.x), GDIM = launder_i((int)gridDim.x); P.ws = launder_ptr(P.ws); P.out = launder_ptr(P.out);
    pg8::Gemm g{(const bf16_t*)(P.ws + WS_YG), (const bf16_t*)(P.ws + W_GLU), 256, 256, 256, P.wid}; pg8::StaticOrder S; S.init(T, 256, sub ? 64 : GDIM, sub ? (BIDX < 64 ? BIDX : (1 << 20)) : BIDX);
    EpiGlu E{(const bf16_t*)(P.ws + WS_YG), (bf16_t*)(P.ws + WS_HBUF), P.b_glu + layer * 256, D, (float*)(P.ws + WS_SSQ2)};
    pg8::gemm_phase<EpiGlu, pg8::StaticOrder, true, true>(GEMM_LDS, g, S, E);
}
__device__ __forceinline__ void ph_outproj_opt(unsigned char* lds, Params P, int layer, int probe = 0) {
    const int TIDX = hidden_tid(P.wid), BIDX = launder_i((int)blockIdx.x), GDIM = launder_i((int)gridDim.x); P.ws = launder_ptr(P.ws); P.out = launder_ptr(P.out);
    pg8::Gemm g{(const bf16_t*)(P.ws + WS_HBUF), (const bf16_t*)(P.ws + W_OUT), D, D, D, P.wid}; pg8::StaticOrder S; S.init(T, D, GDIM, BIDX);
    {
        PG8_LAS float* tab = (PG8_LAS float*)(GEMM_LDS + 132096); const float* sq = (const float*)(P.ws + WS_SSQ2);
        for (int e = TIDX; e < 4 * 256; e += 512) { const int j = e >> 8, r = e & 255; pg8::Unit uu;
            if (S.next(j, uu)) { const float* p = sq + (size_t)(uu.pm * 256 + r) * 16; const f32x4 a = *(const f32x4*)p, b = *(const f32x4*)(p + 4), c = *(const f32x4*)(p + 8), d = *(const f32x4*)(p + 12);
                const float s1 = (a[0] + a[1]) + (a[2] + a[3]), s2 = ((b[0] + b[1]) + (b[2] + b[3])) + (c[0] + c[1]), s3 = ((c[2] + c[3]) + (d[0] + d[1])) + (d[2] + d[3]);
                const float r1 = rsqrtf(s1 * (1.f / 256.f) + EPS), r2 = rsqrtf(s2 * (1.f / 384.f) + EPS), r3 = rsqrtf(s3 * (1.f / 384.f) + EPS);
                tab[(j * 3 + 0) * 256 + r] = r1 / r2; tab[(j * 3 + 1) * 256 + r] = r2 / r3; tab[(j * 3 + 2) * 256 + r] = r3; } }
        __syncthreads(); }
    EpiResidK E{xstream(P, layer), adap(P, layer, 0, 2), probe ? (bf16_t*)(P.ws + WS_XE) : xstream(P, layer + (layer == DEPTH - 1))};
    pg8::gemm_phase<EpiResidK, pg8::StaticOrder, true, true>(GEMM_LDS, g, S, E);
}
__device__ __forceinline__ void ph_ffn1_opt(unsigned char* lds, Params P, int layer) {
    const int TIDX = hidden_tid(P.wid), BIDX = launder_i((int)blockIdx.x), GDIM = launder_i((int)gridDim.x); P.ws = launder_ptr(P.ws); P.out = launder_ptr(P.out);
    pg8::Gemm g{(const bf16_t*)(P.ws + WS_HBUF), (const bf16_t*)(P.ws + W_F1), D, D, D, P.wid}; pg8::StaticOrder S; S.init(T, 2 * DFF, GDIM, BIDX);
    EpiSwiglu E{(bf16_t*)(P.ws + WS_ACT), DFF, 1 << 20};
    pg8::gemm_phase<EpiSwiglu, pg8::StaticOrder, true, true>(GEMM_LDS, g, S, E);
}
__device__ __forceinline__ void ph_ffn2_opt(unsigned char* lds, Params P, int layer, int probe = 0) {
    const int TIDX = hidden_tid(P.wid), BIDX = launder_i((int)blockIdx.x), GDIM = launder_i((int)gridDim.x); P.ws = launder_ptr(P.ws); P.out = launder_ptr(P.out);
    pg8::Gemm g{(const bf16_t*)(P.ws + WS_ACT), (const bf16_t*)(P.ws + W_F2), DFF, DFF, DFF, P.wid}; pg8::StaticOrder S; S.init(T, D, GDIM, BIDX);
    EpiResid E{xstream(P, layer), adap(P, layer, 0, 5), probe ? (bf16_t*)(P.ws + WS_XE) : xstream(P, layer)};
    pg8::gemm_phase<EpiResid, pg8::StaticOrder, true, true>(GEMM_LDS, g, S, E);
}
struct MoeSlots {
    int off[NEXP + 1], cnt[NEXP];
    __device__ __forceinline__ void init(const unsigned* c) { int o_ = 0;
#pragma unroll
        for (int e = 0; e < NEXP; ++e) { cnt[e] = __builtin_amdgcn_readfirstlane((int)c[e]); off[e] = o_; o_ += ((cnt[e] + 255) >> 8) << 8; }
        off[NEXP] = o_; }
    __device__ __forceinline__ int expert_of(int pnl) const { int e = 0;
#pragma unroll
        for (int j = 1; j < NEXP; ++j) if (pnl * 256 >= off[j]) e = j;
        return e; }
    __device__ __forceinline__ int off_of(int e) const { int r = 0;
#pragma unroll
        for (int j = 0; j < NEXP; ++j) if (e == j) r = off[j];
        return r; }
    __device__ __forceinline__ int cnt_of(int e) const { int r = 0;
#pragma unroll
        for (int j = 0; j < NEXP; ++j) if (e == j) r = cnt[j];
        return r; }
};
struct MoeOrder1 {
    static constexpr bool GATHER = true;
    int n, G, c; MoeSlots sl; const int* list;
    __device__ __forceinline__ bool next(int i, Unit& u) const { const long L = (long)i * G + c; if (L >= n) return false;
        int Lx = (int)L; { const int q = n / pg8::NXCD, r = n % pg8::NXCD, xcd = Lx % pg8::NXCD, off = Lx / pg8::NXCD; Lx = (xcd < r ? xcd * (q + 1) : r * (q + 1) + (xcd - r) * q) + off; }
        const int pnl = Lx / 11, t = Lx % 11; u.pm = pnl; u.pn = sl.expert_of(pnl) * 11 + t; return true; }
    __device__ __forceinline__ void rowoff4(const Unit& u, int R, unsigned& o0, unsigned& o1, unsigned& o2, unsigned& o3) const {
        const int e = sl.expert_of(u.pm), r = u.pm * 256 - sl.off_of(e) + R, c = sl.cnt_of(e); const int* lp = list + (size_t)e * T + r;
        const int t0 = r < c ? lp[0] : 0, t1 = r + 64 < c ? lp[64] : 0, t2 = r + 128 < c ? lp[128] : 0, t3 = r + 192 < c ? lp[192] : 0;
        o0 = (unsigned)t0 * (unsigned)(D * 2); o1 = (unsigned)t1 * (unsigned)(D * 2); o2 = (unsigned)t2 * (unsigned)(D * 2); o3 = (unsigned)t3 * (unsigned)(D * 2); }
    __device__ __forceinline__ void a_ready(const Unit&) const {}
    __device__ __forceinline__ void done(const Unit&) const {}
};
struct MoeDec2 { MoeSlots sl; __device__ __forceinline__ void operator()(int L, Unit& u) const { const int pnl = L >> 2, t = L & 3; u.pm = pnl; u.pn = sl.expert_of(pnl) * 4 + t; } };
__device__ __forceinline__ void ph_moe1_opt(unsigned char* lds, Params P, int layer) {
    const int TIDX = hidden_tid(P.wid), BIDX = launder_i((int)blockIdx.x), GDIM = launder_i((int)gridDim.x); P.ws = launder_ptr(P.ws); P.out = launder_ptr(P.out); (void)TIDX;
    MoeSlots sl; sl.init((const unsigned*)(P.ws + WS_CTL) + CW_CNT + 16 * (layer / 2));
    pg8::Gemm g{(const bf16_t*)(P.ws + WS_HBUF), (const bf16_t*)(P.ws + W_F1), D, D, D, P.wid};
    MoeOrder1 S{(sl.off[NEXP] >> 8) * 11, (int)GDIM, (int)BIDX, sl, (const int*)(P.ws + WS_LIST)};
    EpiSwiglu E{(bf16_t*)(P.ws + WS_ACTM), DFE, 11};
    pg8::gemm_phase<EpiSwiglu, MoeOrder1, true, true>(GEMM_LDS, g, S, E);
}
__device__ __forceinline__ void ph_moe2_opt(unsigned char* lds, Params P, int layer) {
    const int TIDX = hidden_tid(P.wid), BIDX = launder_i((int)blockIdx.x), GDIM = launder_i((int)gridDim.x); P.ws = launder_ptr(P.ws); P.out = launder_ptr(P.out); (void)TIDX;
    MoeSlots sl; sl.init((const unsigned*)(P.ws + WS_CTL) + CW_CNT + 16 * (layer / 2));
    pg8::Gemm g{(const bf16_t*)(P.ws + WS_ACTM), (const bf16_t*)(P.ws + W_F2), DFE, DFE, DFE, P.wid};
    pg8::ListOrder<MoeDec2> S{(sl.off[NEXP] >> 8) * 4, (int)GDIM, (int)BIDX, MoeDec2{sl}};
    EpiStore E{(bf16_t*)(P.ws + ymoe_off(layer)), D, nullptr, 0.f, 4, 1 << 20};
    pg8::gemm_phase<EpiStore, pg8::ListOrder<MoeDec2>, true, true>(GEMM_LDS, g, S, E);
}


#ifndef LAS
#define LAS __attribute__((address_space(3)))
#endif
namespace att {
typedef short bf16x8 __attribute__((ext_vector_type(8)));
typedef short s16x4 __attribute__((ext_vector_type(4)));
typedef float f32x16 __attribute__((ext_vector_type(16)));
constexpr int LDS_K = 0, LDS_V = 49152, LDS_B = 81920, LDS_WS = 82944, LDS_OST = 84992, LDS_U = 117760;
struct Args { const bf16_t* Q; int ldq; const bf16_t* K; int ldk; const bf16_t* V; int ldv; int vhs; bf16_t* O; int ldo; float* ssq; const float* cb; unsigned* ctr; float th; const float* gq; const float* cs; const float* sn; float bsh; };
__device__ __forceinline__ int crow(int r, int hi) { return (r & 3) + 8 * (r >> 2) + 4 * hi; }
#define ATT_WAITV(N) asm volatile("s_waitcnt vmcnt(" #N ")" ::: "memory")
__device__ __forceinline__ void glds16_asm(const void* g, unsigned lds_base) {
    unsigned sv; asm volatile("s_mov_b32 %0, m0\n\ts_mov_b32 m0, %2\n\ts_nop 0\n\tglobal_load_lds_dwordx4 %1, off\n\ts_mov_b32 m0, %0" : "=&s"(sv) : "v"(g), "s"(lds_base) : "memory"); }
__device__ __forceinline__ void glds4_asm(const void* g, unsigned lds_base) {
    unsigned sv; asm volatile("s_mov_b32 %0, m0\n\ts_mov_b32 m0, %2\n\ts_nop 0\n\tglobal_load_lds_dword %1, off\n\ts_mov_b32 m0, %0" : "=&s"(sv) : "v"(g), "s"(lds_base) : "memory"); }
#define ATT_GLDS16(g, l) glds16_asm((const void*)(g), (unsigned)__builtin_amdgcn_readfirstlane((int)(unsigned)(uintptr_t)(LAS unsigned char*)(l)))
#define ATT_GLDS4(g, l) glds4_asm((const void*)(g), (unsigned)__builtin_amdgcn_readfirstlane((int)(unsigned)(uintptr_t)(LAS unsigned char*)(l)))
__device__ __forceinline__ unsigned cvtpk(float lo, float hi) { unsigned r; asm volatile("v_cvt_pk_bf16_f32 %0, %1, %2" : "=v"(r) : "v"(lo), "v"(hi)); return r; }
__device__ __forceinline__ void pv(f32x16* o, int vb, bf16x8 pa0, bf16x8 pa1, bf16x8 pa2, bf16x8 pa3) {
#pragma unroll
    for (int d0 = 0; d0 < 2; ++d0) { s16x4 lo[4], hi[4];
#pragma unroll
        for (int ks = 0; ks < 4; ++ks) {
            asm volatile("ds_read_b64_tr_b16 %0,%1 offset:%c2" : "=&v"(lo[ks]) : "v"(vb), "i"(d0 * 4096 + ks * 1024) : "memory");
            asm volatile("ds_read_b64_tr_b16 %0,%1 offset:%c2" : "=&v"(hi[ks]) : "v"(vb), "i"(d0 * 4096 + ks * 1024 + 512) : "memory"); }
        asm volatile("s_waitcnt lgkmcnt(0)" ::: "memory"); __builtin_amdgcn_sched_barrier(0);
#define ATT_PK(k) (bf16x8){lo[k][0], lo[k][1], lo[k][2], lo[k][3], hi[k][0], hi[k][1], hi[k][2], hi[k][3]}
        o[d0] = __builtin_amdgcn_mfma_f32_32x32x16_bf16(pa0, ATT_PK(0), o[d0], 0, 0, 0);
        o[d0] = __builtin_amdgcn_mfma_f32_32x32x16_bf16(pa1, ATT_PK(1), o[d0], 0, 0, 0);
        o[d0] = __builtin_amdgcn_mfma_f32_32x32x16_bf16(pa2, ATT_PK(2), o[d0], 0, 0, 0);
        o[d0] = __builtin_amdgcn_mfma_f32_32x32x16_bf16(pa3, ATT_PK(3), o[d0], 0, 0, 0);
#undef ATT_PK
    }
}
template <int NS, int MODE, int SH>
__device__ __forceinline__ void unit(const int b, const int h, const int qb, const Args& A, unsigned char* lds, const int tid_) {
    constexpr int DQK = 16 * NS, KSLOT = NS * 2048;
    const int wid = __builtin_amdgcn_readfirstlane(tid_ >> 6), tid = hidden_tid(wid);
    const int lane = tid & 63, r32 = lane & 31, hi = lane >> 5;
    const size_t rowbase = (size_t)b * SEQ; const int q0 = qb * 256;
    const bf16_t* Qw = A.Q + (rowbase + q0 + wid * 32) * A.ldq + h * DQK;
    const bf16_t* Kh = A.K + rowbase * A.ldk + h * DQK; const bf16_t* Vh = A.V + rowbase * A.ldv + h * A.vhs;
    LAS unsigned char* L = (LAS unsigned char*)lds;
    const unsigned lds0 = (unsigned)(uintptr_t)lds;
    const bf16_t* ksrc = Kh + (size_t)lane * A.ldk + wid * 8;
    const bf16_t* vsrc = Vh + (size_t)(16 * (wid & 3) + (lane >> 2)) * A.ldv + (wid >> 2) * 32 + (lane & 3) * 8;
    const float* bsrc = MODE == 1 ? A.cb + ((size_t)b * 6 + h) * SEQ + lane : nullptr;
    const bool k2 = (NS > 4) && (wid < 2 * NS - 8), bw = (MODE == 1) && (wid == 7), n3 = k2 || bw;
    const int NT = (q0 + 256) / 64;
    int t0 = 0;
    if (MODE == 1) {
        const float* cbh = A.cb + ((size_t)b * 6 + h) * SEQ; const float cq0 = cbh[q0];
        bool sk = false; if (lane < NT - 4) sk = (cq0 - cbh[64 * lane + 63]) < -A.th;
        const unsigned long long m = __ballot(sk);
        t0 = __builtin_amdgcn_readfirstlane((int)__builtin_ctzll(~m));
    }
#define ATT_DMAV(t, s) ATT_GLDS16(vsrc + (size_t)(t) * 64 * A.ldv, L + LDS_V + (s) * 8192 + wid * 1024)
#define ATT_DMAK(t, s) do { ATT_GLDS16(ksrc + (size_t)(t) * 64 * A.ldk, L + LDS_K + (s) * KSLOT + wid * 1024); \
        if (k2) ATT_GLDS16(ksrc + (size_t)(t) * 64 * A.ldk + 64, L + LDS_K + (s) * KSLOT + (wid + 8) * 1024); \
        if (bw) ATT_GLDS4(bsrc + (t) * 64, L + LDS_B + (s) * 256); } while (0)
#define ATT_WB(N) asm volatile("s_waitcnt vmcnt(" #N ") lgkmcnt(0)\n\ts_barrier" ::: "memory")
#define ATT_WB3(a_, b_, c_) do { if (k2) ATT_WB(b_); else if (bw) ATT_WB(c_); else ATT_WB(a_); } while (0)
    bf16x8 qr[NS];
#pragma unroll
    for (int d0 = 0; d0 < NS; ++d0) qr[d0] = *(const bf16x8*)(Qw + (size_t)r32 * A.ldq + d0 * 16 + hi * 8);
    ATT_DMAV(t0, 0); ATT_DMAK(t0, 0); ATT_DMAV(t0 + 1, 1); ATT_DMAK(t0 + 1, 1); ATT_DMAK(t0 + 2, 2);
    if (MODE == 0 && A.gq) {
        float qf[NS][8]; float ss = 0.f;
#pragma unroll
        for (int d0 = 0; d0 < NS; ++d0) { const u32x4 w = __builtin_bit_cast(u32x4, qr[d0]);
            qf[d0][0] = bf2f(w.x & 0xffff); qf[d0][1] = bf2f(w.x >> 16); qf[d0][2] = bf2f(w.y & 0xffff); qf[d0][3] = bf2f(w.y >> 16);
            qf[d0][4] = bf2f(w.z & 0xffff); qf[d0][5] = bf2f(w.z >> 16); qf[d0][6] = bf2f(w.w & 0xffff); qf[d0][7] = bf2f(w.w >> 16);
#pragma unroll
            for (int j = 0; j < 8; ++j) ss = fmaf(qf[d0][j], qf[d0][j], ss); }
        { auto rr = __builtin_amdgcn_permlane32_swap(__float_as_uint(ss), __float_as_uint(ss), false, false); ss = __uint_as_float(rr[0]) + __uint_as_float(rr[1]); }
        const float rq = rsqrtf(ss * (1.f / 96.f) + EPS) * C2_MLA;
#pragma unroll
        for (int d0 = 0; d0 < NS; ++d0) { const f32x4 g0 = *(const f32x4*)(A.gq + d0 * 16 + hi * 8), g1 = *(const f32x4*)(A.gq + d0 * 16 + hi * 8 + 4);
#pragma unroll
            for (int j = 0; j < 4; ++j) { qf[d0][j] *= rq * g0[j]; qf[d0][4 + j] *= rq * g1[j]; } }
        { const size_t row = rowbase + q0 + wid * 32 + r32; const float* cp = A.cs + row * 16 + hi * 8; const float* sp = A.sn + row * 16 + hi * 8;
          const f32x4 c0 = *(const f32x4*)cp, c1 = *(const f32x4*)(cp + 4), s0 = *(const f32x4*)sp, s1 = *(const f32x4*)(sp + 4);
#pragma unroll
          for (int j = 0; j < 8; ++j) { const float cv = j < 4 ? c0[j & 3] : c1[j & 3], sv = j < 4 ? s0[j & 3] : s1[j & 3]; const float x1 = qf[4][j], x2 = qf[5][j];
              qf[4][j] = x1 * cv - x2 * sv; qf[5][j] = x1 * sv + x2 * cv; } }
#pragma unroll
        for (int d0 = 0; d0 < NS; ++d0) { u32x4 w; w.x = cvtpk(qf[d0][0], qf[d0][1]); w.y = cvtpk(qf[d0][2], qf[d0][3]); w.z = cvtpk(qf[d0][4], qf[d0][5]); w.w = cvtpk(qf[d0][6], qf[d0][7]); qr[d0] = __builtin_bit_cast(bf16x8, w); }
    }
    float l_reg = 0.f; f32x16 o[2], cinit;
    { const float nm = SH ? ((MODE == 1 ? A.cb[((size_t)b * 6 + h) * SEQ + q0 + wid * 32 + r32] : 0.f) - A.bsh) : 0.f;
#pragma unroll
      for (int r = 0; r < 16; ++r) { o[0][r] = 0.f; o[1][r] = 0.f; cinit[r] = nm; } }
#define ATT_PIN(x) asm volatile("" : "+v"(x))
#define ATT_SBAR() __builtin_amdgcn_sched_barrier(0)
#define ATT_MFMA(a_, b_, c_) __builtin_amdgcn_mfma_f32_32x32x16_bf16(a_, b_, c_, 0, 0, 0)
    ATT_PIN(cinit);
    LAS float* wsf = (LAS float*)(L + LDS_WS) + wid * 64;
    const int qrel = wid * 32 + r32;
    const LAS unsigned char* const kp0 = L + LDS_K + hi * 1024 + r32 * 16;
    const LAS unsigned char* const vp0 = L + LDS_V + ((lane >> 4) & 1) * 32 + (lane & 3) * 8 + (4 * hi + ((lane & 15) >> 2)) * 64;
    const LAS float* const bp0 = (const LAS float*)(L + LDS_B) + 4 * hi;
    f32x16 pA0, pA1, pB0, pB1; bf16x8 kf[2 * NS]; s16x4 vlo[8], vhi[8]; u32x4 pw0, pw1, pw2, pw3; f32x4 bq[8];
    typedef short v4i16_t __attribute__((ext_vector_type(4)));
#define ATT_KLOAD2(t_, d0_) do { const LAS unsigned char* kb_ = kp0 + (((t_) - t0) & 3) * KSLOT; kf[2 * (d0_)] = *(const LAS bf16x8*)(kb_ + (d0_) * 2048); kf[2 * (d0_) + 1] = *(const LAS bf16x8*)(kb_ + (d0_) * 2048 + 512); } while (0)
#define ATT_VTR(p_) __builtin_bit_cast(s16x4, __builtin_amdgcn_ds_read_tr16_b64_v4i16((LAS v4i16_t*)(p_)))
#define ATT_VRD(i_) do { vlo[i_] = ATT_VTR(vp_ + (((i_) >> 2) * 4096 + ((i_) & 3) * 1024)); vhi[i_] = ATT_VTR(vp_ + (((i_) >> 2) * 4096 + ((i_) & 3) * 1024 + 512)); } while (0)
#define ATT_VFR(i_) (bf16x8){vlo[i_][0], vlo[i_][1], vlo[i_][2], vlo[i_][3], vhi[i_][0], vhi[i_][1], vhi[i_][2], vhi[i_][3]}
#define ATT_PKW(P_, i_) cvtpk(P_[i_], P_[(i_) + 1])
#define ATT_PAF(k_) __builtin_bit_cast(bf16x8, pw##k_)
#define ATT_QKM(C0_, C1_, m_) do { if ((m_) & 1) C1_ = ATT_MFMA(kf[m_], qr[(m_) >> 1], ((m_) >> 1) == 0 ? cinit : C1_); else C0_ = ATT_MFMA(kf[m_], qr[(m_) >> 1], ((m_) >> 1) == 0 ? cinit : C0_); } while (0)
#define ATT_MASK(C0_, C1_, jb_) do { if (MODE == 0) { if ((jb_) > (wid >> 1)) { _Pragma("unroll") for (int r = 0; r < 16; ++r) { C0_[r] = -INFINITY; C1_[r] = -INFINITY; } } } \
        else { const int kb = 64 * (jb_) + 4 * hi; _Pragma("unroll") for (int r = 0; r < 16; ++r) { const int kv = kb + (r & 3) + 8 * (r >> 2); if (kv > qrel) C0_[r] = -INFINITY; if (kv + 32 > qrel) C1_[r] = -INFINITY; } } } while (0)
    constexpr int KA = 3;
    constexpr bool HOLD = NS <= 4;
#define ATT_PREA(m_, vi_) do { if (HOLD) { if ((vi_) >= 0) ATT_VRD((vi_) < 0 ? 0 : (vi_)); if (MODE == 1 && (m_) < 8) bq[(m_) & 7] = *(const LAS f32x4*)(bps_ + 8 * ((m_) & 7)); ATT_SBAR(); } \
        else { if (((m_) & 1) == 0 && ((m_) >> 1) + KA < NS) ATT_KLOAD2(t, ((m_) >> 1) + KA); if ((m_) >= 2 * NS - 8) ATT_VRD(((m_) - (2 * NS - 8)) & 1 ? 4 + (((m_) - (2 * NS - 8)) >> 1) : (((m_) - (2 * NS - 8)) >> 1)); ATT_SBAR(); } } while (0)
#define ATT_GAPA(C0_, C1_, m_, vi_, a0_, a1_, a2_, a3_, W0_, W1_, PW_) do { ATT_PREA(m_, vi_); \
        ATT_QKM(C0_, C1_, m_); sacc += a0_; sacc += a1_; sacc += a2_; sacc += a3_; W0_; W1_; ATT_PIN(PW_); ATT_PIN(sacc); ATT_SBAR(); } while (0)
#define ATT_GAPX(C0_, C1_, m_) do { ATT_PREA(m_, -1); ATT_QKM(C0_, C1_, m_); ATT_SBAR(); } while (0)
#define ATT_EX4(X_, i_, k_) do { if (MODE == 1) { X_[i_] = __builtin_amdgcn_exp2f(X_[i_] - bq[k_][0]); X_[(i_) + 1] = __builtin_amdgcn_exp2f(X_[(i_) + 1] - bq[k_][1]); X_[(i_) + 2] = __builtin_amdgcn_exp2f(X_[(i_) + 2] - bq[k_][2]); X_[(i_) + 3] = __builtin_amdgcn_exp2f(X_[(i_) + 3] - bq[k_][3]); } \
        else { X_[i_] = __builtin_amdgcn_exp2f(X_[i_]); X_[(i_) + 1] = __builtin_amdgcn_exp2f(X_[(i_) + 1]); X_[(i_) + 2] = __builtin_amdgcn_exp2f(X_[(i_) + 2]); X_[(i_) + 3] = __builtin_amdgcn_exp2f(X_[(i_) + 3]); } } while (0)
#define ATT_GAPB(k_, od_, pk_, vi_, kd_, vnext_, X_, i_) do { \
        if (HOLD) { if ((kd_) >= 0 && (kd_) < NS && kl_) { ATT_KLOAD2(t + 1, ((kd_) >= 0 && (kd_) < NS) ? (kd_) : 0); ATT_SBAR(); } } \
        else { if (MODE == 1 && (k_) + 2 < 8) bq[((k_) + 2) & 7] = *(const LAS f32x4*)(bps_ + 8 * (((k_) + 2) & 7)); \
               if ((k_) >= 8 - KA && kl_) ATT_KLOAD2(t + 1, ((k_) - (8 - KA)) < NS ? ((k_) - (8 - KA)) : 0); } \
        o[od_] = ATT_MFMA(ATT_PAF(pk_), ATT_VFR(vi_), o[od_]); ATT_EX4(X_, i_, k_); ATT_PIN(X_); ATT_SBAR(); } while (0)
#define ATT_STEP2(C0_, C1_, P0_, P1_, tt_, BAND_) do { const int t = (tt_); ATT_SBAR(); \
        const LAS unsigned char* vp_ = vp0 + ((t - 1 - t0) & 3) * 8192; const LAS float* bps_ = bp0 + ((t - t0) & 3) * 64; \
        float sacc = P0_[0] + P0_[1]; \
        ATT_GAPA(C0_, C1_, 0, 0, P0_[2], P0_[3], P0_[4], P0_[5],     pw0[0] = ATT_PKW(P0_, 0),  pw0[1] = ATT_PKW(P0_, 2),  pw0); \
        ATT_GAPA(C0_, C1_, 1, 4, P0_[6], P0_[7], P0_[8], P0_[9],     pw0[2] = ATT_PKW(P0_, 4),  pw0[3] = ATT_PKW(P0_, 6),  pw0); \
        ATT_GAPA(C0_, C1_, 2, 1, P0_[10], P0_[11], P0_[12], P0_[13], pw1[0] = ATT_PKW(P0_, 8),  pw1[1] = ATT_PKW(P0_, 10), pw1); \
        ATT_GAPA(C0_, C1_, 3, 5, P0_[14], P0_[15], P1_[0], P1_[1],   pw1[2] = ATT_PKW(P0_, 12), pw1[3] = ATT_PKW(P0_, 14), pw1); \
        ATT_GAPA(C0_, C1_, 4, 2, P1_[2], P1_[3], P1_[4], P1_[5],     pw2[0] = ATT_PKW(P1_, 0),  pw2[1] = ATT_PKW(P1_, 2),  pw2); \
        ATT_GAPA(C0_, C1_, 5, 6, P1_[6], P1_[7], P1_[8], P1_[9],     pw2[2] = ATT_PKW(P1_, 4),  pw2[3] = ATT_PKW(P1_, 6),  pw2); \
        ATT_GAPA(C0_, C1_, 6, 3, P1_[10], P1_[11], P1_[12], P1_[13], pw3[0] = ATT_PKW(P1_, 8),  pw3[1] = ATT_PKW(P1_, 10), pw3); \
        ATT_GAPA(C0_, C1_, 7, 7, P1_[14], P1_[15], 0.f, 0.f,         pw3[2] = ATT_PKW(P1_, 12), pw3[3] = ATT_PKW(P1_, 14), pw3); \
        if (NS > 4) { ATT_GAPX(C0_, C1_, (NS > 4 ? 8 : 0)); ATT_GAPX(C0_, C1_, (NS > 4 ? 9 : 1)); } \
        if (NS > 5) { ATT_GAPX(C0_, C1_, (NS > 5 ? 10 : 0)); ATT_GAPX(C0_, C1_, (NS > 5 ? 11 : 1)); } \
        l_reg += sacc; \
        if (BAND_) { if (t + 2 < NT) ATT_DMAV(t + 2, (t + 2 - t0) & 3); if (t + 3 < NT) ATT_DMAK(t + 3, (t + 3 - t0) & 3); } \
        else { ATT_DMAV(t + 2, (t + 2 - t0) & 3); ATT_DMAK(t + 3, (t + 3 - t0) & 3); } \
        if (BAND_) { const int jb = t - (NT - 4); if (jb >= 0) ATT_MASK(C0_, C1_, jb); } \
        const bool kl_ = !(BAND_) || (t + 1 < NT);     \
        if (!HOLD && MODE == 1) { bq[0] = *(const LAS f32x4*)(bps_); bq[1] = *(const LAS f32x4*)(bps_ + 8); } \
        ATT_SBAR(); \
        ATT_GAPB(0, 0, 0, 0, -1, 1, C0_, 0);  ATT_GAPB(1, 1, 0, 4, 0, 5, C0_, 4);  ATT_GAPB(2, 0, 1, 1, 1, 2, C0_, 8);  ATT_GAPB(3, 1, 1, 5, 2, 6, C0_, 12); \
        ATT_GAPB(4, 0, 2, 2, 3, 3, C1_, 0);   ATT_GAPB(5, 1, 2, 6, -1, 7, C1_, 4); ATT_GAPB(6, 0, 3, 3, -1, -1, C1_, 8); ATT_GAPB(7, 1, 3, 7, -1, -1, C1_, 12); \
    } while (0)
#define ATT_DRAIN(P0_, P1_) do { float sacc = P0_[0] + P0_[1]; \
        _Pragma("unroll") for (int r = 2; r < 16; ++r) sacc += P0_[r]; \
        _Pragma("unroll") for (int r = 0; r < 16; ++r) sacc += P1_[r]; \
        l_reg += sacc; \
        pw0 = (u32x4){ATT_PKW(P0_, 0), ATT_PKW(P0_, 2), ATT_PKW(P0_, 4), ATT_PKW(P0_, 6)}; pw1 = (u32x4){ATT_PKW(P0_, 8), ATT_PKW(P0_, 10), ATT_PKW(P0_, 12), ATT_PKW(P0_, 14)}; \
        pw2 = (u32x4){ATT_PKW(P1_, 0), ATT_PKW(P1_, 2), ATT_PKW(P1_, 4), ATT_PKW(P1_, 6)}; pw3 = (u32x4){ATT_PKW(P1_, 8), ATT_PKW(P1_, 10), ATT_PKW(P1_, 12), ATT_PKW(P1_, 14)}; \
        const LAS unsigned char* vp_ = vp0 + ((NT - 1 - t0) & 3) * 8192; \
        ATT_VRD(0); ATT_VRD(1); ATT_VRD(2); ATT_VRD(3); ATT_VRD(4); ATT_VRD(5); ATT_VRD(6); ATT_VRD(7); \
        o[0] = ATT_MFMA(ATT_PAF(0), ATT_VFR(0), o[0]); o[1] = ATT_MFMA(ATT_PAF(0), ATT_VFR(4), o[1]); o[0] = ATT_MFMA(ATT_PAF(1), ATT_VFR(1), o[0]); o[1] = ATT_MFMA(ATT_PAF(1), ATT_VFR(5), o[1]); \
        o[0] = ATT_MFMA(ATT_PAF(2), ATT_VFR(2), o[0]); o[1] = ATT_MFMA(ATT_PAF(2), ATT_VFR(6), o[1]); o[0] = ATT_MFMA(ATT_PAF(3), ATT_VFR(3), o[0]); o[1] = ATT_MFMA(ATT_PAF(3), ATT_VFR(7), o[1]); } while (0)
    ATT_WB3(3, 5, 5);
    { _Pragma("unroll") for (int d0 = 0; d0 < NS; ++d0) ATT_KLOAD2(t0, d0);
      _Pragma("unroll") for (int m = 0; m < 2 * NS; ++m) { if (m & 1) pA1 = ATT_MFMA(kf[m], qr[m >> 1], (m >> 1) == 0 ? cinit : pA1); else pA0 = ATT_MFMA(kf[m], qr[m >> 1], (m >> 1) == 0 ? cinit : pA0); }
      if (NT - 4 == t0) ATT_MASK(pA0, pA1, 0);
      if (MODE == 1) {
#pragma unroll
          for (int g = 0; g < 4; ++g) { const f32x4 b0 = *(const LAS f32x4*)(bp0 + 8 * g), b1 = *(const LAS f32x4*)(bp0 + 32 + 8 * g);
#pragma unroll
              for (int j = 0; j < 4; ++j) { pA0[4 * g + j] -= b0[j]; pA1[4 * g + j] -= b1[j]; } } }
#pragma unroll
      for (int r = 0; r < 16; ++r) { pA0[r] = __builtin_amdgcn_exp2f(pA0[r]); pA1[r] = __builtin_amdgcn_exp2f(pA1[r]); } }
    ATT_WB(0);
    ATT_DMAV(t0 + 2, 2); ATT_DMAK(t0 + 3, 3);
    { _Pragma("unroll") for (int d0 = 0; d0 < (HOLD ? NS : KA); ++d0) ATT_KLOAD2(t0 + 1, d0); }
    int tc = t0 + 1;
    for (; tc + 5 < NT; tc += 2) {
        ATT_STEP2(pB0, pB1, pA0, pA1, tc, 0);     ATT_WB3(2, 3, 4);
        ATT_STEP2(pA0, pA1, pB0, pB1, tc + 1, 0); ATT_WB3(2, 3, 4);
    }
    for (; tc + 1 < NT; tc += 2) {
        ATT_STEP2(pB0, pB1, pA0, pA1, tc, 1);     ATT_WB(0);
        ATT_STEP2(pA0, pA1, pB0, pB1, tc + 1, 1); ATT_WB(0);
    }
    if (tc < NT) { ATT_STEP2(pB0, pB1, pA0, pA1, tc, 1); ATT_WB(0); ATT_DRAIN(pB0, pB1); }
    else { ATT_DRAIN(pA0, pA1); }
    unsigned nxu = 0u;
    if (tid == 0) nxu = __hip_atomic_fetch_add((GAS_ unsigned*)A.ctr, 1u, __ATOMIC_RELAXED, __HIP_MEMORY_SCOPE_AGENT);
    { auto rr = __builtin_amdgcn_permlane32_swap(__float_as_uint(l_reg), __float_as_uint(l_reg), false, false); l_reg = __uint_as_float(rr[0]) + __uint_as_float(rr[1]); }
    if (hi == 0) wsf[32 + r32] = l_reg;
    asm volatile("s_waitcnt lgkmcnt(0)" ::: "memory");
    float rli[16];
#pragma unroll
    for (int r = 0; r < 16; ++r) rli[r] = __builtin_amdgcn_rcpf(wsf[32 + crow(r, hi)]);
    bf16_t* Ow = A.O + (rowbase + q0 + wid * 32) * A.ldo + h * 64;
    { LAS bf16_t* stg = (LAS bf16_t*)(L + LDS_OST) + wid * 2048;
#pragma unroll
      for (int r = 0; r < 16; ++r) { const int orow = crow(r, hi);
#pragma unroll
          for (int d0 = 0; d0 < 2; ++d0) stg[orow * 64 + d0 * 32 + r32] = f2bf(o[d0][r] * rli[r]); }
      asm volatile("s_waitcnt lgkmcnt(0)" ::: "memory");
#pragma unroll
      for (int i = 0; i < 4; ++i) { const int row = i * 8 + (lane >> 3), ch = lane & 7; const u32x4 v = *(const LAS u32x4*)(stg + row * 64 + ch * 8); *(u32x4*)(Ow + (size_t)row * A.ldo + ch * 8) = v;
          const unsigned vw[4] = {v.x, v.y, v.z, v.w}; float ss = 0.f;
#pragma unroll
          for (int q = 0; q < 4; ++q) { const float lo = bf2f(vw[q] & 0xffff), hi_ = bf2f(vw[q] >> 16); ss += lo * lo + hi_ * hi_; }
          ss += shx(ss, 1, lane); ss += shx(ss, 2, lane); ss += shx(ss, 4, lane);
          if (ch == 0) A.ssq[(rowbase + q0 + wid * 32 + row) * 16 + h] = ss; } }
    if (tid == 0) *(LAS unsigned*)(L + LDS_U) = nxu;
    asm volatile("s_waitcnt vmcnt(0) lgkmcnt(0)" ::: "memory");
    __builtin_amdgcn_s_barrier();
#undef ATT_DMAV
#undef ATT_DMAK
#undef ATT_STEP2
}
struct NoSide { __device__ __forceinline__ void step() {} };
template <int NS, int MODE, int SH, class Side>
__device__ __forceinline__ void phase(const Args& A, unsigned char* lds, const int tid, Side& side) {
    LAS unsigned* uw = (LAS unsigned*)((LAS unsigned char*)lds + LDS_U);
    if (tid == 0) *uw = __hip_atomic_fetch_add(A.ctr, 1u, __ATOMIC_RELAXED, __HIP_MEMORY_SCOPE_AGENT);
    __syncthreads();
    for (;;) {
        const int u = __builtin_amdgcn_readfirstlane((int)*uw);
        __syncthreads();
        if (u >= NB * 6 * 16) break;
        const int qb = 15 - u / 48, bh = u % 48;
        unit<NS, MODE, SH>(bh / 6, bh % 6, qb, A, lds, tid);
        side.step();
    }
}
#undef ATT_WAITV
#undef ATT_GLDS16
#undef ATT_GLDS4
}

__device__ __forceinline__ void ph_attn_mla(unsigned char* lds, Params P, int layer) {
    const int TIDX = hidden_tid(P.wid); P.ws = launder_ptr(P.ws);
    const int lane = TIDX & 63, lr = (layer >= 4) ? layer - 4 : layer;
    const float gqm = wmax(fmaxf(fabsf(P.mla_gq[lr * 96 + lane]), fabsf(P.mla_gq[lr * 96 + 64 + (lane & 31)])), lane), gkm = wmax(fmaxf(fabsf(P.mla_gk[lr * 96 + lane]), fabsf(P.mla_gk[lr * 96 + 64 + (lane & 31)])), lane);
    const float bm = __uint_as_float(__builtin_amdgcn_readfirstlane(__float_as_uint(96.f * C2_MLA * gqm * gkm * 1.02f)));
    att::Args A{(const bf16_t*)(P.ws + WS_QRAW), 768, (const bf16_t*)(P.ws + WS_KMLA), 576, (const bf16_t*)(P.ws + WS_KVRAW) + 64, 768, 128, (bf16_t*)(P.ws + WS_HBUF) + 256, D, (float*)(P.ws + WS_SSQ2) + 4, nullptr,
                 (unsigned*)(P.ws + WS_CTL) + CW_ATTN + layer * 2, 0.f, P.mla_gq + lr * 96, (const float*)(P.ws + WS_COS), (const float*)(P.ws + WS_SIN), bm};
    att::NoSide ns;
    if (__all(bm <= 60.f)) att::phase<6, 0, 0>(A, lds, TIDX, ns);
    else att::phase<6, 0, 1>(A, lds, TIDX, ns);
}
__device__ __forceinline__ void ph_attn_fox(unsigned char* lds, Params P, int layer) {
    const int TIDX = hidden_tid(P.wid); P.ws = launder_ptr(P.ws);
    const int lane = TIDX & 63, lr = (layer >= 4) ? layer - 4 : layer;
    const float gqm = wmax(fabsf(P.fox_gq[lr * 64 + lane]), lane), gkm = wmax(fabsf(P.fox_gk[lr * 64 + lane]), lane);
    const float bf_ = __uint_as_float(__builtin_amdgcn_readfirstlane(__float_as_uint(64.f * C2_FOX * gqm * gkm * 1.02f))), th = 2.f * bf_ + 40.f;
    att::Args A{(const bf16_t*)(P.ws + WS_PROJ) + PC_FQ, PJ, (const bf16_t*)(P.ws + WS_PROJ) + PC_FK, PJ, (const bf16_t*)(P.ws + WS_PROJ) + PC_FV, PJ, 64, (bf16_t*)(P.ws + WS_HBUF) + 640, D, (float*)(P.ws + WS_SSQ2) + 10, (const float*)(P.ws + WS_CB2),
                 (unsigned*)(P.ws + WS_CTL) + CW_ATTN + layer * 2 + 1, th, nullptr, nullptr, nullptr, bf_};
    att::NoSide ns; att::phase<4, 1, 1>(A, lds, TIDX, ns);
}
__device__ __forceinline__ void ph_attn_all(unsigned char* lds, Params P, int layer) { ph_attn_mla(lds, P, layer); ph_attn_fox(lds, P, layer); }


__device__ __forceinline__ void ssm_tables1(const Params& P, int layer, unsigned char* lds, int tid, int bid, int gdim) {
    float* lamp = (float*)lds;
    float* bbar = lamp + 64 * 33 * 2;
    float* cc = bbar + 64 * 16 * 2;
    float* qq = cc + 16 * 64 * 2;
    float* KM = (float*)(P.ws + WS_KM + (size_t)(layer & 1) * (512u << 10)); float* LAMP = (float*)(P.ws + WS_LAMP + (size_t)(layer & 1) * (512u << 10)); float* BBAR = (float*)(P.ws + WS_BBAR + (size_t)(layer & 1) * (512u << 10));
    for (int item = bid; item < 128; item += gdim) {
        const int g = item >> 3, dq = item & 7;
        __syncthreads();
        const float dt = expf(P.log_dt[layer * 16 + g]);
        for (int e = tid; e < 64 * 33; e += 512) { const int p = e / 33, d = e % 33; const size_t gp = ((size_t)layer * 16 + g) * 64 + p;
            const float a_ = P.lam_re[gp] * dt, b_ = P.lam_im[gp] * dt; float s_, c_; sincosf((float)d * b_, &s_, &c_); const float e_ = expf((float)d * a_);
            lamp[e * 2] = e_ * c_; lamp[e * 2 + 1] = e_ * s_;
            if (dq == 0) { LAMP[((size_t)g * 64 * 33 + e) * 2] = e_ * c_; LAMP[((size_t)g * 64 * 33 + e) * 2 + 1] = e_ * s_; } }
        if (tid < 64) { const int p = tid; const size_t gp = ((size_t)layer * 16 + g) * 64 + p;
            const float lre = P.lam_re[gp], lim = P.lam_im[gp], a_ = lre * dt, b_ = lim * dt; float sb_, cb_; sincosf(b_, &sb_, &cb_); const float sh_ = sinf(0.5f * b_);
            const float nr = expm1f(a_) * cb_ - 2.f * sh_ * sh_, ni = expf(a_) * sb_;
            const float dd = lre * lre + lim * lim; qq[p * 2] = (nr * lre + ni * lim) / dd; qq[p * 2 + 1] = (ni * lre - nr * lim) / dd; }
        for (int e = tid; e < 1024; e += 512) { const int c = e >> 6, p = e & 63; const size_t ix = (((size_t)layer * 16 + g) * 16 + c) * 64 + p; cc[e * 2] = P.c_re[ix]; cc[e * 2 + 1] = P.c_im[ix]; }
        __syncthreads();
        for (int e = tid; e < 1024; e += 512) { const int p = e >> 4, c = e & 15; const size_t ix = (((size_t)layer * 16 + g) * 64 + p) * 16 + c;
            const float bre = P.b_re[ix], bim = P.b_im[ix], qr = qq[p * 2], qi = qq[p * 2 + 1];
            const float br = qr * bre - qi * bim, bi = qr * bim + qi * bre; bbar[e * 2] = br; bbar[e * 2 + 1] = bi;
            if (dq == 0) { BBAR[((size_t)g * 1024 + e) * 2] = br; BBAR[((size_t)g * 1024 + e) * 2 + 1] = bi; } }
        __syncthreads();
        for (int e = tid; e < 4 * 256; e += 512) { const int d = dq * 4 + (e >> 8), c = (e >> 4) & 15, c2 = e & 15; float acc = 0.f;
            for (int p = 0; p < 64; ++p) { const float cr = cc[(c * 64 + p) * 2], ci = cc[(c * 64 + p) * 2 + 1], lr = lamp[(p * 33 + d) * 2], li = lamp[(p * 33 + d) * 2 + 1];
                const float clr = cr * lr - ci * li, cli = cr * li + ci * lr; acc += clr * bbar[(p * 16 + c2) * 2] - cli * bbar[(p * 16 + c2) * 2 + 1]; }
            KM[(size_t)g * 8192 + d * 256 + (e & 255)] = acc; }
    }
    __syncthreads();
}
__device__ __forceinline__ void ssm_tables2(const Params& P, int layer, int tid, int bid, int gdim) {
    const float* KM = (const float*)(P.ws + WS_KM + (size_t)(layer & 1) * (512u << 10)); const float* LAMP = (const float*)(P.ws + WS_LAMP + (size_t)(layer & 1) * (512u << 10)); const float* BBAR = (const float*)(P.ws + WS_BBAR + (size_t)(layer & 1) * (512u << 10));
    bf16_t* B1t = (bf16_t*)(P.ws + W_B1T); bf16_t* T2t = (bf16_t*)(P.ws + W_T2T);
    const int gt = bid * 512 + tid, nt = gdim * 512;
    for (int v0 = gt; v0 < 16 * 256 * 64; v0 += 2 * nt) {
        f32x4 bb[2][4]; float lr[2], li[2];
#pragma unroll
        for (int u = 0; u < 2; ++u) { const int v = v0 + u * nt, k0 = (v & 63) * 8, n = (v >> 6) & 255, g = v >> 14;
            if (v < 16 * 256 * 64 && n < 128) { const int p = n >> 1, i = k0 >> 4, c0 = k0 & 15;
                const float* lp = LAMP + (((size_t)g * 64 + p) * 33 + (31 - i)) * 2; lr[u] = lp[0]; li[u] = lp[1];
                const float* bp = BBAR + (((size_t)g * 64 + p) * 16 + c0) * 2;
#pragma unroll
                for (int q = 0; q < 4; ++q) bb[u][q] = *(const f32x4*)(bp + 4 * q); } }
#pragma unroll
        for (int u = 0; u < 2; ++u) { const int v = v0 + u * nt, k0 = (v & 63) * 8, n = (v >> 6) & 255, g = v >> 14;
            if (v < 16 * 256 * 64) { u32x4 o = {0u, 0u, 0u, 0u};
                if (n < 128) { const int ri = n & 1; float w[8];
#pragma unroll
                    for (int q = 0; q < 4; ++q) { const f32x4 t = bb[u][q]; w[2 * q] = ri == 0 ? (lr[u] * t[0] - li[u] * t[1]) : (lr[u] * t[1] + li[u] * t[0]); w[2 * q + 1] = ri == 0 ? (lr[u] * t[2] - li[u] * t[3]) : (lr[u] * t[3] + li[u] * t[2]); }
                    o.x = pk2(w[0], w[1]); o.y = pk2(w[2], w[3]); o.z = pk2(w[4], w[5]); o.w = pk2(w[6], w[7]); }
                *(u32x4*)(B1t + ((size_t)(g * 256 + n)) * 512 + k0) = o; } }
    }
    for (int v0 = gt; v0 < 16 * 512 * 64; v0 += 4 * nt) {
        f32x4 ka[4], kb[4];
#pragma unroll
        for (int u = 0; u < 4; ++u) { const int v = v0 + u * nt, k0 = (v & 63) * 8, n = (v >> 6) & 511, g = v >> 15, j = n >> 4, c = n & 15, i = k0 >> 4, c0 = k0 & 15;
            ka[u] = (f32x4){0.f, 0.f, 0.f, 0.f}; kb[u] = ka[u];
            if (v < 16 * 512 * 64 && j >= i) { const float* kp = KM + (size_t)g * 8192 + (j - i) * 256 + c * 16 + c0; ka[u] = *(const f32x4*)kp; kb[u] = *(const f32x4*)(kp + 4); } }
#pragma unroll
        for (int u = 0; u < 4; ++u) { const int v = v0 + u * nt, k0 = (v & 63) * 8, n = (v >> 6) & 511, g = v >> 15;
            if (v < 16 * 512 * 64) { u32x4 o; o.x = pk2(ka[u][0], ka[u][1]); o.y = pk2(ka[u][2], ka[u][3]); o.z = pk2(kb[u][0], kb[u][1]); o.w = pk2(kb[u][2], kb[u][3]);
                *(u32x4*)(T2t + ((size_t)(g * 512 + n)) * 640 + k0) = o; } }
    }
    for (int v = gt; v < 16 * 512 * 16; v += nt) {
        const int p0 = (v & 15) * 4, n = (v >> 4) & 511, g = v >> 13, j = n >> 4, c = n & 15;
        const size_t ix = (((size_t)layer * 16 + g) * 16 + c) * 64 + p0; const f32x4 cr = *(const f32x4*)(P.c_re + ix), ci = *(const f32x4*)(P.c_im + ix);
        float lr[4], li[4];
#pragma unroll
        for (int q = 0; q < 4; ++q) { const float* lp = LAMP + (((size_t)g * 64 + p0 + q) * 33 + (j + 1)) * 2; lr[q] = lp[0]; li[q] = lp[1]; }
        float w[8];
#pragma unroll
        for (int q = 0; q < 4; ++q) { w[2 * q] = cr[q] * lr[q] - ci[q] * li[q]; w[2 * q + 1] = -(cr[q] * li[q] + ci[q] * lr[q]); }
        u32x4 o; o.x = pk2(w[0], w[1]); o.y = pk2(w[2], w[3]); o.z = pk2(w[4], w[5]); o.w = pk2(w[6], w[7]);
        *(u32x4*)(T2t + ((size_t)(g * 512 + n)) * 640 + 512 + 2 * p0) = o;
    }
}
__device__ __forceinline__ void ssm_carry(const Params& P, int layer, int item, int lane) {
    const int b = item >> 4, g = item & 15;
    const float* LAMP = (const float*)(P.ws + WS_LAMP + (size_t)(layer & 1) * (512u << 10)); const float* lp = LAMP + (((size_t)g * 64 + lane) * 33 + 32) * 2; const float lr = lp[0], li = lp[1];
    const float* sl = (const float*)(P.ws + WS_SLOC) + ((size_t)g * 1024 + b * 128) * 128 + lane * 2;
    bf16_t* ug = (bf16_t*)(P.ws + WS_UG) + ((size_t)g * 1024 + b * 128) * 640 + 512 + lane * 2;
    float sr = 0.f, si = 0.f;
    for (int n0 = 0; n0 < 128; n0 += 16) {
        float xr[16], xi[16];
#pragma unroll
        for (int k = 0; k < 16; ++k) { const float* q = sl + (size_t)(n0 + k) * 128; xr[k] = q[0]; xi[k] = q[1]; }
#pragma unroll
        for (int k = 0; k < 16; ++k) { *(unsigned*)(ug + (size_t)(n0 + k) * 640) = pk2(sr, si);
            const float nr = lr * sr - li * si + xr[k], ni = lr * si + li * sr + xi[k]; sr = nr; si = ni; }
    }
}
struct EpiSloc {
    static constexpr bool PERM = true, AFTER_DRAIN = false;
    float* S;
    __device__ __forceinline__ void operator()(const f32x4 (&acc)[2][2][4][2], const Unit& u, int wr, int wc, int fr, int fq) const {
        const int row0 = u.pm * 256 + wr * 64 + fr, col0 = wc * 32 + 8 * fq;
#pragma unroll
        for (int ai = 0; ai < 2; ++ai)
#pragma unroll
            for (int m = 0; m < 4; ++m) { float* rp = S + (size_t)(row0 + ai * 128 + m * 16) * 128 + col0; *(f32x4*)rp = acc[ai][0][m][0]; *(f32x4*)(rp + 4) = acc[ai][0][m][1]; }
    }
};
struct EpiSsmY {
    static constexpr bool PERM = true, AFTER_DRAIN = false;
    const bf16_t* proj; bf16_t* yg; const float* dsk;
    __device__ __forceinline__ void operator()(const f32x4 (&acc)[2][2][4][2], const Unit& u, int wr, int wc, int fr, int fq) const {
        const int ct = u.pn & 1, g = u.pm >> 2;
        f32x4 dv[2][2]; int jj[2], cc[2]; const float* dsk = launder_ptr(this->dsk);
#pragma unroll
        for (int bj = 0; bj < 2; ++bj) { const int nc = 256 * ct + 128 * bj + 32 * wc + 8 * fq; jj[bj] = nc >> 4; cc[bj] = nc & 15; dv[bj][0] = *(const f32x4*)(dsk + g * 16 + cc[bj]); dv[bj][1] = *(const f32x4*)(dsk + g * 16 + cc[bj] + 4); }
#pragma unroll
        for (int ai = 0; ai < 2; ++ai) {
            u32x4 uv[4][2];
#pragma unroll
            for (int m = 0; m < 4; ++m) { const int R = u.pm * 256 + ai * 128 + wr * 64 + m * 16 + fr, rl = R & 1023, b = rl >> 7, ch = rl & 127;
#pragma unroll
                for (int bj = 0; bj < 2; ++bj) uv[m][bj] = *(const GAS_ u32x4*)(proj + (size_t)R * 640 + jj[bj] * 16 + cc[bj]); (void)b; (void)ch; }
#pragma unroll
            for (int m = 0; m < 4; ++m) { const int R = u.pm * 256 + ai * 128 + wr * 64 + m * 16 + fr, rl = R & 1023, b = rl >> 7, ch = rl & 127;
#pragma unroll
                for (int bj = 0; bj < 2; ++bj) { const size_t tok = (size_t)b * SEQ + ch * 32 + jj[bj];
                    const unsigned uw[4] = {uv[m][bj].x, uv[m][bj].y, uv[m][bj].z, uv[m][bj].w}; f32x4 o0, o1;
#pragma unroll
                    for (int q = 0; q < 4; ++q) { const float ua = q & 1 ? bf2f(uw[q >> 1] >> 16) : bf2f(uw[q >> 1] & 0xffff), ub = q & 1 ? bf2f(uw[2 + (q >> 1)] >> 16) : bf2f(uw[2 + (q >> 1)] & 0xffff);
                        o0[q] = gelu_tanh(acc[ai][bj][m][0][q] + dv[bj][0][q] * ua); o1[q] = gelu_tanh(acc[ai][bj][m][1][q] + dv[bj][1][q] * ub); }
                    *(GAS_ u32x4*)((GAS_ bf16_t*)yg + tok * 256 + g * 16 + cc[bj]) = pg8::pack8(o0, o1); } } }
    }
};
struct SsmDec1 { __device__ __forceinline__ void operator()(int L, Unit& u) const { u.pm = L; u.pn = L >> 2; } };
struct SsmDec2 { __device__ __forceinline__ void operator()(int L, Unit& u) const { u.pm = L >> 1; u.pn = ((L >> 3) << 1) | (L & 1); } };
__device__ __forceinline__ void ph_ssm_tab1(unsigned char* lds, Params P, int layer, int rot = 0) {
    const int TIDX = hidden_tid(P.wid), BIDX = launder_i((int)blockIdx.x), GDIM = launder_i((int)gridDim.x); P.ws = launder_ptr(P.ws);
    ssm_tables1(P, layer, lds, TIDX, GDIM >= 256 ? (BIDX + GDIM - rot) % GDIM : BIDX, GDIM);
}
__device__ __forceinline__ void ph_ssm_tab2(unsigned char* lds, Params P, int layer) {
    const int TIDX = hidden_tid(P.wid), BIDX = launder_i((int)blockIdx.x), GDIM = launder_i((int)gridDim.x); P.ws = launder_ptr(P.ws);
    ssm_tables2(P, layer, TIDX, BIDX, GDIM);
}
__device__ __forceinline__ void ph_ssm_gemm1(unsigned char* lds, Params P, int layer) {
    const int TIDX = hidden_tid(P.wid), BIDX = launder_i((int)blockIdx.x), GDIM = launder_i((int)gridDim.x); P.ws = launder_ptr(P.ws); (void)TIDX;
    pg8::Gemm g{(const bf16_t*)(P.ws + WS_UG), (const bf16_t*)(P.ws + W_B1T), 640, 512, 512, P.wid};
    pg8::ListOrder<SsmDec1> S{64, GDIM, GDIM >= 128 ? (BIDX + GDIM - 64) % GDIM : BIDX, SsmDec1{}};
    EpiSloc E{(float*)(P.ws + WS_SLOC)};
    pg8::gemm_phase<EpiSloc, pg8::ListOrder<SsmDec1>, true, true>(GEMM_LDS, g, S, E);
}
__device__ __forceinline__ void ph_ssm_carry(unsigned char* lds, Params P, int layer) {
    const int TIDX = hidden_tid(P.wid), BIDX = launder_i((int)blockIdx.x), GDIM = launder_i((int)gridDim.x); P.ws = launder_ptr(P.ws);
    if ((TIDX >> 6) == 0) for (int item = BIDX; item < 128; item += GDIM) ssm_carry(P, layer, item, TIDX & 63);
    __syncthreads();
}
struct SsmOrder2 {
    static constexpr bool GATHER = false;
    int c;
    __device__ __forceinline__ bool next(int i, Unit& u) const { if (c >= 64 || i >= 2) return false; u.pm = c; u.pn = ((c >> 2) << 1) | i; return true; }
    __device__ __forceinline__ void a_ready(const Unit&) const {}
    __device__ __forceinline__ void done(const Unit&) const {}
};
__device__ __forceinline__ void ph_ssm_gemm2(unsigned char* lds, Params P, int layer) {
    const int TIDX = hidden_tid(P.wid), BIDX = launder_i((int)blockIdx.x), GDIM = launder_i((int)gridDim.x); P.ws = launder_ptr(P.ws);
    {
        pg8::Gemm g1{(const bf16_t*)(P.ws + WS_UG), (const bf16_t*)(P.ws + W_B1T), 640, 512, 512, P.wid};
        pg8::ListOrder<SsmDec1> S1{64, GDIM, BIDX, SsmDec1{}};
        EpiSloc E1{(float*)(P.ws + WS_SLOC)};
        pg8::gemm_phase<EpiSloc, pg8::ListOrder<SsmDec1>, true, true>(GEMM_LDS, g1, S1, E1);
        asm volatile("s_waitcnt vmcnt(0)" ::: "memory");
        __syncthreads();
    }
    if (BIDX < 64) { const int wv = TIDX >> 6; if (wv < 2) ssm_carry(P, layer, (2 * (BIDX & 3) + wv) * 16 + (BIDX >> 2), TIDX & 63); }
    asm volatile("s_waitcnt vmcnt(0)" ::: "memory");
    __syncthreads();
    pg8::Gemm g{(const bf16_t*)(P.ws + WS_UG), (const bf16_t*)(P.ws + W_T2T), 640, 640, 640, P.wid};
    SsmOrder2 S{BIDX};
    EpiSsmY E{(const bf16_t*)(P.ws + WS_UG), (bf16_t*)(P.ws + WS_YG), P.ssm_d + layer * 256};
    pg8::gemm_phase<EpiSsmY, SsmOrder2, true, true>(GEMM_LDS, g, S, E);
}

__device__ __forceinline__ void unpack8(const u32x4 w, float (&f)[8]) {
    f[0] = bf2f(w.x & 0xffff); f[1] = bf2f(w.x >> 16); f[2] = bf2f(w.y & 0xffff); f[3] = bf2f(w.y >> 16);
    f[4] = bf2f(w.z & 0xffff); f[5] = bf2f(w.z >> 16); f[6] = bf2f(w.w & 0xffff); f[7] = bf2f(w.w >> 16); }
__device__ __forceinline__ u32x4 pack8f(const float (&f)[8]) { u32x4 o; o.x = pg8::cvt_pk_bf16(f[0], f[1]); o.y = pg8::cvt_pk_bf16(f[2], f[3]); o.z = pg8::cvt_pk_bf16(f[4], f[5]); o.w = pg8::cvt_pk_bf16(f[6], f[7]); return o; }
__device__ __forceinline__ float ssq8(const float (&f)[8]) { float s = 0.f;
#pragma unroll
    for (int j = 0; j < 8; ++j) s = fmaf(f[j], f[j], s);
    return s; }
__device__ __forceinline__ unsigned shxu(unsigned v, int o, int lane) { return (unsigned)__builtin_amdgcn_ds_bpermute((lane ^ o) << 2, (int)v); }

__device__ __forceinline__ void ph_passC2(unsigned char* lds, Params P, int layer) {
    const int TIDX = hidden_tid(P.wid), BIDX = launder_i((int)blockIdx.x), GDIM = launder_i((int)gridDim.x); P.ws = launder_ptr(P.ws);
    float (*lfs)[8] = (float (*)[8])lds;
    const int wid = TIDX >> 6, lane = TIDX & 63;
    bf16_t* proj = (bf16_t*)(P.ws + WS_PROJ); const float* fg = (const float*)(P.ws + WS_FG);
    float* rq = (float*)(P.ws + WS_RSTDQ); float* rkv = (float*)(P.ws + WS_RSTDKV);
    float* cloc = (float*)(P.ws + WS_CLOC); float* ctot = (float*)(P.ws + WS_CTOT); bf16_t* ug = (bf16_t*)(P.ws + WS_UG);
    float gq8[8], gk8[8];
#pragma unroll
    for (int j = 0; j < 8; ++j) { gq8[j] = P.fox_gq[layer * 64 + (lane & 7) * 8 + j] * C2_FOX; gk8[j] = P.fox_gk[layer * 64 + (lane & 7) * 8 + j]; }
    const int off1 = lane < 32 ? PC_CQ + lane * 8 : PC_CKV + (lane - 32) * 8;
    const int lf = lane < 48 ? lane : 0;
    for (int chunk = BIDX; chunk < T / 128; chunk += GDIM) {
        for (int i = 0; i < 16; i += 2) {
            u32x4 w1[2], wu[2], wq[2], wk[2];
#pragma unroll
            for (int k = 0; k < 2; ++k) { const bf16_t* pr = proj + (size_t)(chunk * 128 + wid * 16 + i + k) * PJ;
                w1[k] = *(const u32x4*)(pr + off1); wu[k] = *(const u32x4*)(pr + PC_U + (lane & 31) * 8);
                wq[k] = *(const u32x4*)(pr + PC_FQ + lf * 8); wk[k] = *(const u32x4*)(pr + PC_FK + lf * 8); }
#pragma unroll
            for (int k = 0; k < 2; ++k) {
                const int tl = wid * 16 + i + k, row = chunk * 128 + tl; bf16_t* pr = proj + (size_t)row * PJ;
                float v[8]; unpack8(w1[k], v); float s1 = lane < 48 ? ssq8(v) : 0.f;
                s1 += shx(s1, 1, lane); s1 += shx(s1, 2, lane); s1 += shx(s1, 4, lane); s1 += shx(s1, 8, lane);
                const float s1b = s1 + shx(s1, 16, lane);
                if (lane == 0) rq[row] = rsqrtf(s1b * (1.f / 256.f) + EPS);
                if (lane == 32) rkv[row] = rsqrtf(s1 * (1.f / 128.f) + EPS);
                if (lane < 32) { const int b_ = row / SEQ, t_ = row % SEQ;
                    *(u32x4*)(ug + (size_t)((lane >> 1) * 1024 + b_ * 128 + (t_ >> 5)) * 640 + (t_ & 31) * 16 + (lane & 1) * 8) = wu[k]; }
                float a[8], b[8]; unpack8(wq[k], a); unpack8(wk[k], b);
                float sa = ssq8(a), sb = ssq8(b);
                sa += shx(sa, 1, lane); sb += shx(sb, 1, lane); sa += shx(sa, 2, lane); sb += shx(sb, 2, lane); sa += shx(sa, 4, lane); sb += shx(sb, 4, lane);
                const float ra = rsqrtf(sa * (1.f / 64.f) + EPS), rb = rsqrtf(sb * (1.f / 64.f) + EPS);
#pragma unroll
                for (int j = 0; j < 8; ++j) { a[j] *= ra * gq8[j]; b[j] *= rb * gk8[j]; }
                if (lane < 48) { *(u32x4*)(pr + PC_FQ + lane * 8) = pack8f(a); *(u32x4*)(pr + PC_FK + lane * 8) = pack8f(b); }
                if (lane < 6) { const float z = fg[(size_t)row * 8 + lane] + P.fox_bf[layer * 6 + lane];
                    const float e = __expf(-fabsf(z)); lfs[tl][lane] = fminf(z, 0.f) - __logf(1.f + e); }
            }
        }
        __syncthreads();
        if (TIDX < 6) {
            const int h = TIDX, b = (chunk * 128) / SEQ, t0 = (chunk * 128) % SEQ; float run = 0.f;
            for (int j = 0; j < 128; ++j) { run += lfs[j][h]; cloc[((size_t)b * 6 + h) * SEQ + t0 + j] = run; }
            ctot[chunk * 8 + h] = run;
        }
        __syncthreads();
    }
}

__device__ __forceinline__ void ph_passE2(unsigned char* lds, Params P, int layer) {
    const int TIDX = hidden_tid(P.wid), BIDX = launder_i((int)blockIdx.x), GDIM = launder_i((int)gridDim.x); P.ws = launder_ptr(P.ws);
    const int wid = TIDX >> 6, lane = TIDX & 63, grp = lane >> 4, c = lane & 15; const bool act = c < 12, rop = act && c >= 8;
    const bf16_t* proj = (const bf16_t*)(P.ws + WS_PROJ); const bf16_t* qraw = (const bf16_t*)(P.ws + WS_QRAW); const bf16_t* kvraw = (const bf16_t*)(P.ws + WS_KVRAW);
    bf16_t* qm = (bf16_t*)(P.ws + WS_QMLA); bf16_t* km = (bf16_t*)(P.ws + WS_KMLA);
    const float* cs = (const float*)(P.ws + WS_COS); const float* sn = (const float*)(P.ws + WS_SIN);
    const int cc = act ? c : 0, cp = cc ^ 2;
    float gq8[8], gk8[8], gqp[8], gkp[8];
#pragma unroll
    for (int j = 0; j < 8; ++j) { gq8[j] = P.mla_gq[layer * 96 + cc * 8 + j] * C2_MLA; gk8[j] = P.mla_gk[layer * 96 + cc * 8 + j];
        gqp[j] = rop ? P.mla_gq[layer * 96 + cp * 8 + j] * C2_MLA : 0.f; gkp[j] = rop ? P.mla_gk[layer * 96 + cp * 8 + j] : 0.f; }
    const int hC = 4 + (grp & 1); const bool kC = grp >= 2;
    const int qoffA = grp * 96 + cc * 8, qoffC = hC * 96 + cc * 8;
    const int koffA = cc < 8 ? grp * 128 + cc * 8 : -1, koffC = cc < 8 ? hC * 128 + cc * 8 : -1;
    const int kroff = PC_KR + (cc & 3) * 8, j0 = (cc & 1) * 8;
    for (int chunk = BIDX; chunk < T / 128; chunk += GDIM) {
        for (int i = 0; i < 16; ++i) {
            const size_t row = (size_t)chunk * 128 + wid * 16 + i;
            u32x4 w[3];
            w[0] = *(const u32x4*)(qraw + row * 768 + qoffA);
            w[1] = koffA >= 0 ? *(const u32x4*)(kvraw + row * 768 + koffA) : *(const u32x4*)(proj + row * PJ + kroff);
            w[2] = !kC ? *(const u32x4*)(qraw + row * 768 + qoffC) : (koffC >= 0 ? *(const u32x4*)(kvraw + row * 768 + koffC) : *(const u32x4*)(proj + row * PJ + kroff));
            f32x4 c0 = {0.f, 0.f, 0.f, 0.f}, c1 = c0, s0 = c0, s1 = c0;
            if (rop) { c0 = *(const f32x4*)(cs + row * 16 + j0); c1 = *(const f32x4*)(cs + row * 16 + j0 + 4); s0 = *(const f32x4*)(sn + row * 16 + j0); s1 = *(const f32x4*)(sn + row * 16 + j0 + 4); }
            const float cv[8] = {c0[0], c0[1], c0[2], c0[3], c1[0], c1[1], c1[2], c1[3]}, sv[8] = {s0[0], s0[1], s0[2], s0[3], s1[0], s1[1], s1[2], s1[3]};
#pragma unroll
            for (int ps = 0; ps < 3; ++ps) {
                const bool isk = (ps == 1) || (ps == 2 && kC);
                float v[8]; unpack8(w[ps], v);
                float ss = act ? ssq8(v) : 0.f;
                ss += shx(ss, 1, lane); ss += shx(ss, 2, lane); ss += shx(ss, 4, lane); ss += shx(ss, 8, lane);
                const float r = rsqrtf(ss * (1.f / 96.f) + EPS);
                u32x4 pw; pw.x = shxu(w[ps].x, 2, lane); pw.y = shxu(w[ps].y, 2, lane); pw.z = shxu(w[ps].z, 2, lane); pw.w = shxu(w[ps].w, 2, lane);
                float pv[8]; unpack8(pw, pv);
                float o[8];
#pragma unroll
                for (int j = 0; j < 8; ++j) { const float n = v[j] * r * (isk ? gk8[j] : gq8[j]), pn = pv[j] * r * (isk ? gkp[j] : gqp[j]);
                    o[j] = !rop ? n : (c < 10 ? n * cv[j] - pn * sv[j] : pn * sv[j] + n * cv[j]); }
                if (act) { bf16_t* dst = ps == 0 ? qm + row * 576 + qoffA : (ps == 1 ? km + row * 576 + qoffA : (kC ? km : qm) + row * 576 + qoffC);
                    *(u32x4*)dst = pack8f(o); }
            }
        }
    }
    __syncthreads();
}

__device__ __forceinline__ void ph_fox_cumsum(unsigned char* lds, Params P, int layer) {
    const int TIDX = hidden_tid(P.wid), BIDX = launder_i((int)blockIdx.x), GDIM = launder_i((int)gridDim.x); P.ws = launder_ptr(P.ws);
    const int wid = TIDX >> 6, lane = TIDX & 63;
    const float* lf = (const float*)(P.ws + WS_FG); float* cb2 = (float*)(P.ws + WS_CB2); float* wtot = (float*)lds;
    const int first = GDIM >= 256 ? (BIDX + GDIM - 192) % GDIM : BIDX;
    for (int item = first; item < NB * 6; item += GDIM) {
        const int b = item / 6, h = item % 6;
        float v[8];
#pragma unroll
        for (int j = 0; j < 8; ++j) v[j] = lf[((size_t)b * SEQ + TIDX * 8 + j) * 8 + h];
        float run = 0.f;
#pragma unroll
        for (int j = 0; j < 8; ++j) { run += v[j]; v[j] = run; }
        float incl = run;
#pragma unroll
        for (int o = 1; o < 64; o <<= 1) { const float t = __int_as_float(__builtin_amdgcn_ds_bpermute(((lane - o) & 63) << 2, __float_as_int(incl))); if (lane >= o) incl += t; }
        __syncthreads();
        if (lane == 63) wtot[wid] = incl;
        __syncthreads();
        float base = incl - run;
#pragma unroll
        for (int w = 0; w < 8; ++w) if (w < wid) base += wtot[w];
        float* dst = cb2 + ((size_t)b * 6 + h) * SEQ + TIDX * 8;
        *(f32x4*)dst = (f32x4){(base + v[0]) * LOG2E, (base + v[1]) * LOG2E, (base + v[2]) * LOG2E, (base + v[3]) * LOG2E};
        *(f32x4*)(dst + 4) = (f32x4){(base + v[4]) * LOG2E, (base + v[5]) * LOG2E, (base + v[6]) * LOG2E, (base + v[7]) * LOG2E};
    }
    __syncthreads();
}

#define XB_TMO      128
#define XB_XCNT(j)  (256  + 64 * (j))
#define XB_XSUB(j)  (1280 + 64 * (j))
#define XB_XGEN(j)  (2304 + 64 * (j))
#define XB_TOP      3328
#define XB_TOPGEN   3392
#define XCD_BAR_WORDS 3456
#define XB_SPIN_CAP (1u << 18)
#define LAS __attribute__((address_space(3)))

__device__ __forceinline__ unsigned xb_ld(unsigned* p)              { return __hip_atomic_load(p, __ATOMIC_RELAXED, __HIP_MEMORY_SCOPE_AGENT); }
__device__ __forceinline__ unsigned xb_add(unsigned* p, unsigned v) { return __hip_atomic_fetch_add(p, v, __ATOMIC_RELAXED, __HIP_MEMORY_SCOPE_AGENT); }
__device__ __forceinline__ unsigned xb_xcc_id() { return (unsigned)__builtin_amdgcn_s_getreg((3 << 11) | 20) & 0xFu; }
#define XB_SPIN(cond, bar) do { unsigned _sp = 0; while (cond) { __builtin_amdgcn_s_sleep(1); \
    if ((++_sp & 255u) == 0u) { if (xb_ld(&(bar)[XB_TMO])) break; if (_sp > XB_SPIN_CAP) { atomicAdd(&(bar)[XB_TMO], 1u); break; } } } } while (0)

struct XcdBarrier {
    unsigned* bar; unsigned x;
    volatile LAS unsigned* st;
};

__device__ __forceinline__ XcdBarrier xcd_barrier_post(unsigned* bar, volatile LAS unsigned* st) {
    XcdBarrier b; b.bar = bar; b.x = xb_xcc_id(); b.st = st;
    if (threadIdx.x == 0) (void)xb_add(&bar[XB_XCNT(b.x)], 1u);
    return b;
}
__device__ __forceinline__ void xcd_barrier_complete(unsigned* bar, unsigned x, unsigned& nloc, unsigned& nx) {
    const unsigned G = gridDim.x * gridDim.y * gridDim.z;
    unsigned sum, cnt, mine, sp = 0u;
    for (;;) {
        sum = 0u; cnt = 0u; mine = 0u;
#pragma unroll
        for (unsigned j = 0; j < 16; ++j) { const unsigned c = xb_ld(&bar[XB_XCNT(j)]); sum += c; cnt += (c > 0u) ? 1u : 0u; mine = (j == x) ? c : mine; }
        if (sum == G) break;
        __builtin_amdgcn_s_sleep(1);
        if ((++sp & 255u) == 0u) { if (xb_ld(&bar[XB_TMO])) break; if (sp > XB_SPIN_CAP) { atomicAdd(&bar[XB_TMO], 1u); break; } }
    }
    nloc = mine > 0u ? mine : 1u; nx = cnt > 0u ? cnt : 1u;
}

__device__ __forceinline__ void xcd_barrier(const XcdBarrier& b) {
    asm volatile("s_waitcnt vmcnt(0)" ::: "memory");
    __syncthreads();
    if (threadIdx.x == 0) {
        unsigned* bar = b.bar;
        __builtin_amdgcn_s_waitcnt(0);
        unsigned nloc = b.st[0], nx = b.st[1];
        if (nloc == 0u) { xcd_barrier_complete(bar, b.x, nloc, nx); b.st[0] = nloc; b.st[1] = nx; }
        const unsigned old = xb_add(&bar[XB_XSUB(b.x)], 1u);
        const unsigned gen = old / nloc;
        if (old + 1u == (gen + 1u) * nloc) {
            __builtin_amdgcn_fence(__ATOMIC_RELEASE, "agent");
            asm volatile("s_waitcnt vmcnt(0)" ::: "memory");
            const unsigned og = xb_add(&bar[XB_TOP], 1u);
            const unsigned tg = og / nx;
            if (og + 1u == (tg + 1u) * nx) xb_add(&bar[XB_TOPGEN], 1u);
            else XB_SPIN(xb_ld(&bar[XB_TOPGEN]) == tg, bar);
            __builtin_amdgcn_fence(__ATOMIC_ACQUIRE, "agent");
            xb_add(&bar[XB_XGEN(b.x)], 1u);
            asm volatile("s_waitcnt vmcnt(0)" ::: "memory");
        } else {
            XB_SPIN(xb_ld(&bar[XB_XGEN(b.x)]) == gen, bar);
            __builtin_amdgcn_fence(__ATOMIC_ACQUIRE, "agent");
            asm volatile("s_waitcnt vmcnt(0)" ::: "memory");
        }
    }
    __syncthreads();
}

extern __shared__ __attribute__((aligned(16))) unsigned char dlds[];
constexpr int LDS_BYTES = 147456, LDS_MISC = 131072;
constexpr int CW_BAR = 4096;

#define ATTN_MLA_ARGS(P) (const bf16_t*)((P).ws + WS_QMLA), 576, (const bf16_t*)((P).ws + WS_KMLA), 576, (const bf16_t*)((P).ws + WS_KVRAW) + 64, 768, 128, (bf16_t*)((P).ws + WS_OBUF), 768, (const float*)nullptr
#define ATTN_FOX_ARGS(P) (const bf16_t*)((P).ws + WS_PROJ) + PC_FQ, PJ, (const bf16_t*)((P).ws + WS_PROJ) + PC_FK, PJ, (const bf16_t*)((P).ws + WS_PROJ) + PC_FV, PJ, 64, (bf16_t*)((P).ws + WS_OBUF) + 384, 768, (const float*)((P).ws + WS_CB2)

typedef const __attribute__((address_space(4))) Params* KParams;
template <class T> __device__ __forceinline__ T launder_s(T p) { asm volatile("" : "+s"(p)); return p; }
__device__ __forceinline__ Params load_params(KParams kp, int wid) { Params r; r.x = kp->x; r.c = kp->c; r.pos = kp->pos; r.norm_mix = kp->norm_mix; r.norm_ffn = kp->norm_ffn; r.w_ada = kp->w_ada; r.b_ada = kp->b_ada; r.w_in = kp->w_in; r.lam_re = kp->lam_re; r.lam_im = kp->lam_im; r.log_dt = kp->log_dt; r.b_re = kp->b_re; r.b_im = kp->b_im; r.c_re = kp->c_re; r.c_im = kp->c_im; r.ssm_d = kp->ssm_d; r.w_glu = kp->w_glu; r.b_glu = kp->b_glu; r.q_norm = kp->q_norm; r.kv_norm = kp->kv_norm; r.w_uq = kp->w_uq; r.w_ukv = kp->w_ukv; r.mla_gq = kp->mla_gq; r.mla_gk = kp->mla_gk; r.fox_bf = kp->fox_bf; r.fox_gq = kp->fox_gq; r.fox_gk = kp->fox_gk; r.out_norm = kp->out_norm; r.w_out = kp->w_out; r.ffn_wg = kp->ffn_wg; r.ffn_wu = kp->ffn_wu; r.ffn_wd = kp->ffn_wd; r.moe_wr = kp->moe_wr; r.moe_br = kp->moe_br; r.moe_wg = kp->moe_wg; r.moe_wu = kp->moe_wu; r.moe_wd = kp->moe_wd; r.out = kp->out; r.ws = kp->ws; r.wid = wid; r.pad = 0; return r; }
__device__ __forceinline__ void sub64_barrier(unsigned* word) {
    asm volatile("s_waitcnt vmcnt(0)" ::: "memory");
    __syncthreads();
    if (threadIdx.x == 0) {
        __builtin_amdgcn_s_waitcnt(0);
        __builtin_amdgcn_fence(__ATOMIC_RELEASE, "agent");
        asm volatile("s_waitcnt vmcnt(0)" ::: "memory");
        (void)xb_add(word, 1u);
        unsigned sp = 0; while (xb_ld(word) < 64u) { __builtin_amdgcn_s_sleep(1); if (++sp > XB_SPIN_CAP) break; }
        __builtin_amdgcn_fence(__ATOMIC_ACQUIRE, "agent");
        asm volatile("s_waitcnt vmcnt(0)" ::: "memory");
    }
    __syncthreads();
}
__device__ __forceinline__ void ph_glu_sub(unsigned char* lds, Params P, int layer) {
    const int BIDX = launder_i((int)blockIdx.x), GDIM = launder_i((int)gridDim.x);
    if (GDIM < 64) return;
    if (BIDX < 64) { sub64_barrier((unsigned*)(launder_ptr(P.ws) + WS_CTL) + CW_SUB + (layer & 7) * 32); ph_glu_opt(lds, P, layer, 1); }
}
__global__ void __launch_bounds__(512, 2) k_mega(Params P_karg) {
    const KParams kp = (KParams)__builtin_amdgcn_kernarg_segment_ptr();
const int wid_s = __builtin_amdgcn_readfirstlane((int)(threadIdx.x >> 6));
#define P load_params(launder_s(kp), wid_s)
    unsigned char* lds = dlds;
    volatile LAS unsigned* xbw = (volatile LAS unsigned*)(dlds + LDS_MISC);
    if (threadIdx.x < 4) xbw[threadIdx.x] = 0u;
    __syncthreads();
    (void)xcd_barrier_post((unsigned*)(launder_s(kp)->ws + WS_CTL) + CW_BAR, xbw);
#define GBAR() do { XcdBarrier b_; b_.bar = (unsigned*)(launder_s(kp)->ws + WS_CTL) + CW_BAR; b_.x = xb_xcc_id(); b_.st = (volatile LAS unsigned*)(dlds + LDS_MISC); xcd_barrier(b_); if (DUP & 65536) xcd_barrier(b_); } while (0)
    ph_prologue(lds, P);
    if (DUP & (1 << 10)) { GBAR(); ph_prologue(lds, P); }
    ph_convert(lds, P, 0); ph_ssm_tab1(lds, P, 0);
    GBAR();
    for (int layer = 0; layer < DEPTH; ++layer) {
#define DUPIF(bit, ...) if (DUP & (1 << (bit))) { GBAR(); __VA_ARGS__ }
        { const Params Pl = P; if (layer == 0) ph_norm<0, 1>(lds, Pl, layer, Pl.x, -1); else if (layer == 2) ph_norm<0, 2>(lds, Pl, layer, nullptr, 1); else ph_norm<0, 0>(lds, Pl, layer, nullptr, -1); }
        if (layer != 0) { ph_convert(lds, P, layer); ph_ssm_tab1(lds, P, layer); }
        if (layer != 2) { DUPIF(19, { const Params Pl = P; if (layer == 0) ph_norm<0, 1>(lds, Pl, layer, Pl.x, -1); else ph_norm<0, 0>(lds, Pl, layer, nullptr, -1); }) }
        DUPIF(13, ph_convert(lds, P, layer);)
        DUPIF(14, ph_ssm_tab1(lds, P, layer);)
        GBAR();
        ph_inproj_opt(lds, P, layer);
        GBAR();
        ph_ssm_tab2(lds, P, layer);
        DUPIF(12, ph_ssm_tab2(lds, P, layer);)
        ph_fox_cumsum(lds, P, layer);
        ph_qup_opt(lds, P, layer); ph_kvup_opt(lds, P, layer);
        DUPIF(1, ph_qup_opt(lds, P, layer); ph_kvup_opt(lds, P, layer); ph_ssm_gemm1(lds, P, layer);)
        GBAR();
        ph_ssm_gemm2(lds, P, layer);
        ph_glu_sub(lds, P, layer);
        ph_attn_all(lds, P, layer);
        DUPIF(2, ph_ssm_gemm2(lds, P, layer); ph_attn_mla(lds, P, layer + 4); ph_attn_fox(lds, P, layer + 4);)
        GBAR();
        if (launder_i((int)gridDim.x) < 64) { ph_glu_opt(lds, P, layer); GBAR(); }
        DUPIF(17, ph_outproj_opt(lds, P, layer, 1);)
        ph_outproj_opt(lds, P, layer);
        GBAR();
        if ((layer & 1) == 0) {
            { const Params Pl = P; ph_norm<1, 0>(lds, Pl, layer, nullptr, -1); }
            DUPIF(8, { const Params Pl = P; ph_norm<1, 0>(lds, Pl, layer, nullptr, -1); })
            GBAR();
            ph_ffn1_opt(lds, P, layer);
            DUPIF(4, ph_ffn1_opt(lds, P, layer);)
            GBAR();
            DUPIF(18, ph_ffn2_opt(lds, P, layer, 1);)
            ph_ffn2_opt(lds, P, layer);
            GBAR();
        } else {
            { const Params Pl = P; ph_norm<2, 0>(lds, Pl, layer, nullptr, -1); }
            GBAR();
            ph_moe1_opt(lds, P, layer);
            DUPIF(4, ph_moe1_opt(lds, P, layer);)
            GBAR();
            ph_moe2_opt(lds, P, layer);
            DUPIF(4, ph_moe2_opt(lds, P, layer);)
            GBAR();
            if (layer == DEPTH - 1) ph_moe_combine(lds, P, layer);
        }
    }
}
#undef P

#if CHECK || !MEGA
#define KWRAP(NAME, DECL, CALL) __global__ void __launch_bounds__(512, 2) k_##NAME DECL { P.wid = __builtin_amdgcn_readfirstlane((int)(threadIdx.x >> 6)); ph_##NAME CALL; }
#define KWRAPT(NAME, TDECL, TARGS, DECL, CALL) template <TDECL> __global__ void __launch_bounds__(512, 2) k_##NAME DECL { P.wid = __builtin_amdgcn_readfirstlane((int)(threadIdx.x >> 6)); ph_##NAME<TARGS> CALL; }
KWRAP(prologue, (Params P), (dlds, P))
KWRAPT(norm, int MODE, MODE, (Params P, int layer, const float* src, int copy, int comb), (dlds, P, layer, src, copy, comb))
KWRAP(convert, (Params P, int layer), (dlds, P, layer))
KWRAP(inproj_opt, (Params P, int layer), (dlds, P, layer))
KWRAP(inproj_naive, (Params P, int layer, int chk), (dlds, P, layer, chk))
KWRAP(fox_cumsum, (Params P, int layer), (dlds, P, layer))
KWRAP(qup_opt, (Params P, int layer), (dlds, P, layer))
KWRAP(kvup_opt, (Params P, int layer), (dlds, P, layer))
KWRAP(qup_naive, (Params P, int layer, int chk), (dlds, P, layer, chk))
KWRAP(kvup_naive, (Params P, int layer, int chk), (dlds, P, layer, chk))
KWRAP(passE2, (Params P, int layer), (dlds, P, layer))
template <int DQK, int MODE> __global__ void __launch_bounds__(512, 2) k_attn_naive(Params P, const bf16_t* Q, int ldq, const bf16_t* K, int ldk, const bf16_t* V, int ldv, int vhs, bf16_t* O, int ldo, const float* cb2, int chk) {
    P.wid = __builtin_amdgcn_readfirstlane((int)(threadIdx.x >> 6)); ph_attn_naive<DQK, MODE>(dlds, P, Q, ldq, K, ldk, V, ldv, vhs, O, ldo, cb2, chk); }
KWRAP(attn_mla, (Params P, int layer), (dlds, P, layer))
KWRAP(attn_fox, (Params P, int layer), (dlds, P, layer))
KWRAP(ssm_tab1, (Params P, int layer), (dlds, P, layer))
KWRAP(ssm_tab2, (Params P, int layer), (dlds, P, layer))
KWRAP(ssm_gemm1, (Params P, int layer), (dlds, P, layer))
KWRAP(ssm_carry, (Params P, int layer), (dlds, P, layer))
KWRAP(ssm_gemm2, (Params P, int layer), (dlds, P, layer))
KWRAP(ssm_naive, (Params P, int layer, int chk), (dlds, P, layer, chk))
KWRAP(glu_opt, (Params P, int layer), (dlds, P, layer))
KWRAP(glu_naive, (Params P, int layer, int chk), (dlds, P, layer, chk))
KWRAP(merge, (Params P), (dlds, P))
KWRAP(outproj_opt, (Params P, int layer), (dlds, P, layer))
KWRAP(outproj_naive, (Params P, int layer, float* dst, int chk), (dlds, P, layer, dst, chk))
KWRAP(cmp_x, (Params P, const float* xe, int stage), (dlds, P, xe, stage))
KWRAP(ffn1_opt, (Params P, int layer), (dlds, P, layer))
KWRAP(ffn2_opt, (Params P, int layer), (dlds, P, layer))
KWRAP(ffn1_naive, (Params P, int layer, int chk), (dlds, P, layer, chk))
KWRAP(ffn2_naive, (Params P, int layer, float* dst, int chk), (dlds, P, layer, dst, chk))
KWRAP(moe_gather, (Params P, int layer), (dlds, P, layer))
KWRAP(moe1_opt, (Params P, int layer), (dlds, P, layer))
KWRAP(moe2_opt, (Params P, int layer), (dlds, P, layer))
KWRAP(moe1_naive, (Params P, int layer, int chk), (dlds, P, layer, chk))
KWRAP(moe2_naive, (Params P, int layer, int chk), (dlds, P, layer, chk))
KWRAP(moe_combine, (Params P, int layer), (dlds, P, layer))
KWRAP(check_final, (Params P), (dlds, P))
#endif

template <class... KA, class... A> static void launch(void (*k)(KA...), int grid, hipStream_t stream, A... a) {
    (void)hipFuncSetAttribute((const void*)k, hipFuncAttributeMaxDynamicSharedMemorySize, LDS_BYTES);
    hipLaunchKernelGGL(k, dim3(grid), dim3(512), LDS_BYTES, stream, a...);
}
extern "C" void kernel_launch(void* const* d_in, const int* in_sizes, int n_in, void* d_out, int out_size, void* d_ws, size_t ws_size, hipStream_t stream) {
    if (ws_size < WS_END || n_in < 37) return;
    Params P{};
    P.x = (const float*)d_in[0]; P.c = (const float*)d_in[1]; P.pos = (const int*)d_in[2]; P.norm_mix = (const float*)d_in[3]; P.norm_ffn = (const float*)d_in[4];
    P.w_ada = (const float*)d_in[5]; P.b_ada = (const float*)d_in[6]; P.w_in = (const float*)d_in[7];
    P.lam_re = (const float*)d_in[8]; P.lam_im = (const float*)d_in[9]; P.log_dt = (const float*)d_in[10]; P.b_re = (const float*)d_in[11]; P.b_im = (const float*)d_in[12];
    P.c_re = (const float*)d_in[13]; P.c_im = (const float*)d_in[14]; P.ssm_d = (const float*)d_in[15]; P.w_glu = (const float*)d_in[16]; P.b_glu = (const float*)d_in[17];
    P.q_norm = (const float*)d_in[18]; P.kv_norm = (const float*)d_in[19]; P.w_uq = (const float*)d_in[20]; P.w_ukv = (const float*)d_in[21]; P.mla_gq = (const float*)d_in[22]; P.mla_gk = (const float*)d_in[23];
    P.fox_bf = (const float*)d_in[24]; P.fox_gq = (const float*)d_in[25]; P.fox_gk = (const float*)d_in[26]; P.out_norm = (const float*)d_in[27]; P.w_out = (const float*)d_in[28];
    P.ffn_wg = (const float*)d_in[29]; P.ffn_wu = (const float*)d_in[30]; P.ffn_wd = (const float*)d_in[31];
    P.moe_wr = (const float*)d_in[32]; P.moe_br = (const float*)d_in[33]; P.moe_wg = (const float*)d_in[34]; P.moe_wu = (const float*)d_in[35]; P.moe_wd = (const float*)d_in[36];
    P.out = (float*)d_out; P.ws = (unsigned char*)d_ws;
    (void)hipMemsetAsync(d_ws, 0, CTL_BYTES, stream);
#if MEGA && !CHECK
    static int grid = 0;
    if (!grid) { int dev = 0, cus = 0; (void)hipGetDevice(&dev); (void)hipDeviceGetAttribute(&cus, hipDeviceAttributeMultiprocessorCount, dev); grid = cus > 0 ? cus : 256; }
    launch(k_mega, grid, stream, P);
#else
    float* xe = (float*)(P.ws + WS_XE);
    const int G = 256;
    launch(k_prologue, G, stream, P);
    for (int layer = 0; layer < DEPTH; ++layer) {
        launch(k_norm<0>, G * 4, stream, P, layer, layer == 0 ? P.x : (const float*)P.out, (layer == 0 || layer == 2) ? 1 : 0, layer == 2 ? 1 : -1);
        launch(k_convert, G, stream, P, layer);
        launch(k_ssm_tab1, G, stream, P, layer);
        launch(k_inproj_opt, G, stream, P, layer);
        launch(k_fox_cumsum, G, stream, P, layer);
        launch(k_ssm_tab2, G, stream, P, layer);
        launch(k_qup_opt, G, stream, P, layer); launch(k_kvup_opt, G, stream, P, layer);
        if (CHECK) { launch(k_qup_naive, G * 4, stream, P, layer, 2); launch(k_kvup_naive, G * 4, stream, P, layer, 3); }
        launch(k_ssm_gemm1, G, stream, P, layer);
        launch(k_ssm_gemm2, G, stream, P, layer);
        launch(k_attn_mla, G, stream, P, layer); launch(k_attn_fox, G, stream, P, layer);
        if (CHECK) { launch(k_attn_naive<96, 0>, 384, stream, P, ATTN_MLA_ARGS(P), 10); launch(k_attn_naive<64, 1>, 384, stream, P, ATTN_FOX_ARGS(P), 11); }
        if (CHECK) launch(k_ssm_naive, 16, stream, P, layer, 12);
        launch(k_glu_opt, G, stream, P, layer);
        if (CHECK) launch(k_glu_naive, G * 2, stream, P, layer, 4);
        launch(k_merge, G * 4, stream, P);
        if (CHECK) launch(k_outproj_naive, G * 4, stream, P, layer, xe, 5);
        launch(k_outproj_opt, G, stream, P, layer);
        if (CHECK) launch(k_cmp_x, G * 4, stream, P, (const float*)xe, 5);
        if ((layer & 1) == 0) {
            launch(k_norm<1>, G * 4, stream, P, layer, (const float*)P.out, 0, -1);
            launch(k_ffn1_opt, G, stream, P, layer);
            if (CHECK) { launch(k_ffn1_naive, G * 8, stream, P, layer, 6); launch(k_ffn2_naive, G * 4, stream, P, layer, xe, 7); }
            launch(k_ffn2_opt, G, stream, P, layer);
            if (CHECK) launch(k_cmp_x, G * 4, stream, P, (const float*)xe, 7);
        } else {
            launch(k_norm<2>, G * 4, stream, P, layer, (const float*)P.out, 0, -1);
            launch(k_moe1_opt, G, stream, P, layer);
            if (CHECK) launch(k_moe1_naive, G * 8, stream, P, layer, 8);
            launch(k_moe2_opt, G, stream, P, layer);
            if (CHECK) launch(k_moe2_naive, G * 4, stream, P, layer, 9);
            if (layer == DEPTH - 1) launch(k_moe_combine, G * 4, stream, P, layer);
        }
    }
    if (CHECK) launch(k_check_final, G * 4, stream, P);
#endif
}
```

```cpp
#include <hip/hip_runtime.h>
#include <stdint.h>
#include <math.h>

typedef unsigned short bf16_t;
typedef float f32x4 __attribute__((ext_vector_type(4)));
typedef unsigned u32x2 __attribute__((ext_vector_type(2)));
typedef unsigned u32x4 __attribute__((ext_vector_type(4)));

#ifndef DUP
#define DUP 0
#endif
#ifndef CHECK
#define CHECK 0
#endif
#ifndef MEGA
#define MEGA 1
#endif
#define LATE_CONVERT 0

constexpr int NB = 8, SEQ = 4096, T = NB * SEQ, D = 1024, DEPTH = 4;
constexpr int INC = 1830, PJ = 2048;
constexpr int PC_U = 0, PC_CQ = 256, PC_CKV = 512, PC_KR = 640, PC_FQ = 768, PC_FK = 1152, PC_FV = 1536, PC_FG = 1920;
constexpr int DFF = 2816, NEXP = 8, DFE = 1408;
constexpr float EPS = 1e-6f;
constexpr float LOG2E = 1.4426950408889634f;
constexpr float C2_MLA = 0.10206207261596577f * LOG2E;
constexpr float C2_FOX = 0.125f * LOG2E;
constexpr int NSLOT = 2 * T + NEXP * 256;

constexpr size_t MiB = 1u << 20;
constexpr size_t WS_CTL = 0, CTL_BYTES = 1 * MiB;
constexpr size_t WS_ADA = 1 * MiB;
constexpr size_t WS_COS = 2 * MiB, WS_SIN = 4 * MiB;
constexpr size_t WS_RSTDQ = 6 * MiB, WS_RSTDKV = 6 * MiB + 128 * 1024;
constexpr size_t WS_FG = 7 * MiB;
constexpr size_t WS_CLOC = 8 * MiB;
constexpr size_t WS_CTOT = 8 * MiB + 896 * 1024;
constexpr size_t WS_CB2 = 9 * MiB;
constexpr size_t WS_TOKINFO = 10 * MiB;
constexpr size_t WS_PROB = 10 * MiB + 512 * 1024;
constexpr size_t WS_SLOTOF = 10 * MiB + 768 * 1024;
constexpr size_t WS_P2E = 11 * MiB;
constexpr size_t WS_YG = 20 * MiB;
constexpr size_t WS_OSSM = 36 * MiB;
constexpr size_t WS_W = 72 * MiB;
constexpr size_t W_IN = WS_W, W_UQ = WS_W + 4 * MiB, W_UKV = WS_W + 4 * MiB + 512 * 1024, W_GLU = WS_W + 5 * MiB, W_OUT = WS_W + 6 * MiB;
constexpr size_t W_F1 = WS_W + 8 * MiB, W_F2 = WS_W + 52 * MiB, W_B1T = WS_W + 76 * MiB, W_T2T = WS_W + 80 * MiB;
constexpr size_t WS_UG = 52 * MiB;
constexpr size_t WS_SLOC = 12 * MiB;
constexpr size_t WS_KM = WS_W + 90 * MiB;
constexpr size_t WS_LAMP = WS_W + 91 * MiB;
constexpr size_t WS_BBAR = WS_W + 92 * MiB;
constexpr size_t WS_SSQ = WS_W + 93 * MiB;
constexpr size_t WS_HBUF = 168 * MiB;
constexpr size_t WS_BIG = 232 * MiB;
constexpr size_t WS_PROJ = WS_BIG;
constexpr size_t WS_QRAW = WS_BIG + 128 * MiB;
constexpr size_t WS_KVRAW = WS_BIG + 176 * MiB;
constexpr size_t WS_QMLA = WS_BIG + 224 * MiB;
constexpr size_t WS_KMLA = WS_BIG + 260 * MiB;
constexpr size_t WS_OBUF = WS_BIG + 296 * MiB;
constexpr size_t WS_ACT = WS_BIG;
constexpr size_t WS_HG = WS_BIG;
constexpr size_t WS_ACTM = WS_BIG + 132 * MiB;
constexpr size_t WS_LIST = WS_BIG + 320 * MiB;
constexpr size_t WS_XE = WS_BIG + 192 * MiB;
constexpr size_t WS_END = WS_BIG + 344 * MiB;
constexpr size_t WS_SSQ2 = 36 * MiB;
constexpr size_t WS_XB2 = WS_BIG + 68 * MiB;

constexpr int CW_CNT = 1024;
constexpr int CW_ATTN = 1536;
constexpr int CW_SUB = 12288;
constexpr int CW_ATTQ = 8192;
constexpr int CW_CHKE = 2048, CW_CHKR = 2112;

struct Params {
    const float* x; const float* c; const int* pos; const float* norm_mix; const float* norm_ffn; const float* w_ada; const float* b_ada; const float* w_in;
    const float* lam_re; const float* lam_im; const float* log_dt; const float* b_re; const float* b_im; const float* c_re; const float* c_im;
    const float* ssm_d; const float* w_glu; const float* b_glu;
    const float* q_norm; const float* kv_norm; const float* w_uq; const float* w_ukv; const float* mla_gq; const float* mla_gk;
    const float* fox_bf; const float* fox_gq; const float* fox_gk; const float* out_norm; const float* w_out;
    const float* ffn_wg; const float* ffn_wu; const float* ffn_wd;
    const float* moe_wr; const float* moe_br; const float* moe_wg; const float* moe_wu; const float* moe_wd;
    float* out; unsigned char* ws;
    int wid, pad;
};

__device__ __forceinline__ float bf2f(bf16_t h) { return __uint_as_float(((unsigned)h) << 16); }
__device__ __forceinline__ bf16_t f2bf(float f) { unsigned u = __float_as_uint(f); return (bf16_t)((u + 0x7fffu + ((u >> 16) & 1u)) >> 16); }
__device__ __forceinline__ unsigned pk2(float lo, float hi) { return (unsigned)f2bf(lo) | ((unsigned)f2bf(hi) << 16); }
__device__ __forceinline__ int hidden_tid(int wid) { int t; asm volatile("v_mbcnt_lo_u32_b32 %0, -1, 0\n\tv_mbcnt_hi_u32_b32 %0, -1, %0\n\tv_lshl_add_u32 %0, %1, 6, %0" : "=&v"(t) : "s"(wid)); return t; }
__device__ __forceinline__ int launder_i(int v) { asm volatile("" : "+s"(v)); return v; }
template <class T> __device__ __forceinline__ T* launder_ptr(T* p) { asm volatile("" : "+s"(p)); return p; }
__device__ __forceinline__ float shx(float v, int o, int lane) { return __int_as_float(__builtin_amdgcn_ds_bpermute((lane ^ o) << 2, __float_as_int(v))); }
__device__ __forceinline__ float wsum(float v, int lane) {
#pragma unroll
    for (int o = 32; o > 0; o >>= 1) v += shx(v, o, lane);
    return v;
}
__device__ __forceinline__ float wmax(float v, int lane) {
#pragma unroll
    for (int o = 32; o > 0; o >>= 1) v = fmaxf(v, shx(v, o, lane));
    return v;
}
__device__ __forceinline__ float silu_f(float v) { return v / (1.f + __expf(-v)); }
__device__ __forceinline__ float sigmoid_f(float v) { return 1.f / (1.f + __expf(-v)); }
__device__ __forceinline__ float gelu_tanh(float x) { return 0.5f * x * (1.f + tanhf(0.7978845608028654f * (x + 0.044715f * x * x * x))); }
__device__ __forceinline__ bf16_t* xstream(const Params& P, int idx) { return idx >= DEPTH ? (bf16_t*)(P.ws + WS_XB2) : (bf16_t*)(P.out + (size_t)T * D / 2); }
__device__ __forceinline__ size_t ymoe_off(int layer) { return layer == DEPTH - 1 ? WS_HBUF : WS_HG; }
__device__ __forceinline__ float* adap(const Params& P, int layer, int b, int which) { return (float*)(P.ws + WS_ADA) + ((size_t)(layer * NB + b) * 6 + which) * D; }

struct Chk { float e, r; };
__device__ __forceinline__ void chk_upd(Chk& c, float naive, float stored) { const float d = fabsf(naive - stored); c.e = (d != d) ? INFINITY : fmaxf(c.e, d); c.r = fmaxf(c.r, fabsf(naive)); }
__device__ __forceinline__ void chk_commit(const Params& P, int stage, Chk c) {
    const int lane_ = (int)(threadIdx.x & 63); const float e = wmax(c.e, lane_), r = wmax(c.r, lane_);
    if (lane_ == 0) { unsigned* ctl = (unsigned*)(P.ws + WS_CTL); atomicMax(ctl + CW_CHKE + stage, __float_as_uint(e)); atomicMax(ctl + CW_CHKR + stage, __float_as_uint(r)); }
}
__device__ __forceinline__ void st4(bf16_t* p, const float (&v)[4], int chk, Chk& c) {
    if (!chk) { u32x2 o; o.x = pk2(v[0], v[1]); o.y = pk2(v[2], v[3]); *(u32x2*)p = o; }
    else { const u32x2 o = *(const u32x2*)p; chk_upd(c, v[0], bf2f(o.x & 0xffff)); chk_upd(c, v[1], bf2f(o.x >> 16)); chk_upd(c, v[2], bf2f(o.y & 0xffff)); chk_upd(c, v[3], bf2f(o.y >> 16)); }
}
__device__ __forceinline__ void st2(bf16_t* p, float a, float b, int chk, Chk& c) {
    if (!chk) *(unsigned*)p = pk2(a, b);
    else { const unsigned o = *(const unsigned*)p; chk_upd(c, a, bf2f(o & 0xffff)); chk_upd(c, b, bf2f(o >> 16)); }
}

template <class FA, class FT, class FB, class FS>
__device__ __forceinline__ void naive_gemm(int M, int N, int K, FA fa, FT ft, FB fb, FS fs, float* sm) {
    const int tid = threadIdx.x, ty = tid >> 5, tx = tid & 31;
    float (*As)[132] = (float (*)[132])sm;
    float (*Bs)[132] = (float (*)[132])(sm + 16 * 132);
    const int tm = (M + 127) / 128, tn = (N + 127) / 128;
    for (int tile = blockIdx.x; tile < tm * tn; tile += gridDim.x) {
        const int bm = (tile / tn) * 128, bn = (tile % tn) * 128;
        const int ctx = ft(bm);
        float acc[8][4];
#pragma unroll
        for (int i = 0; i < 8; ++i)
#pragma unroll
            for (int j = 0; j < 4; ++j) acc[i][j] = 0.f;
        for (int k0 = 0; k0 < K; k0 += 16) {
#pragma unroll
            for (int j = 0; j < 4; ++j) {
                const int e = tid + 512 * j, r = e >> 4, kk = e & 15;
                As[kk][r] = (bm + r < M) ? fa(bm + r, k0 + kk) : 0.f;
                const int k2 = e >> 7, cc = e & 127;
                Bs[k2][cc] = (bn + cc < N) ? fb(k0 + k2, bn + cc, ctx) : 0.f;
            }
            __syncthreads();
#pragma unroll
            for (int kk = 0; kk < 16; ++kk) {
                const f32x4 a0 = *(const f32x4*)&As[kk][ty * 8], a1 = *(const f32x4*)&As[kk][ty * 8 + 4], b = *(const f32x4*)&Bs[kk][tx * 4];
                const float a[8] = {a0[0], a0[1], a0[2], a0[3], a1[0], a1[1], a1[2], a1[3]};
#pragma unroll
                for (int i = 0; i < 8; ++i)
#pragma unroll
                    for (int j = 0; j < 4; ++j) acc[i][j] = fmaf(a[i], b[j], acc[i][j]);
            }
            __syncthreads();
        }
#pragma unroll
        for (int i = 0; i < 8; ++i) { const int row = bm + ty * 8 + i; if (row < M) fs(row, bn + tx * 4, acc[i]); }
    }
}

__device__ __forceinline__ void ph_prologue(unsigned char* lds, Params P) {
    const int TIDX = hidden_tid(P.wid), BIDX = launder_i((int)blockIdx.x), GDIM = launder_i((int)gridDim.x); P.ws = launder_ptr(P.ws); P.out = launder_ptr(P.out);
    float* cact = (float*)lds;
    float* red = cact + NB * D;
    { f32x4 cv[4];
#pragma unroll
      for (int i = 0; i < 4; ++i) cv[i] = *(const f32x4*)(P.c + (size_t)(i * 512 + TIDX) * 4);
#pragma unroll
      for (int i = 0; i < 4; ++i) *(f32x4*)(cact + (size_t)(i * 512 + TIDX) * 4) = (f32x4){silu_f(cv[i][0]), silu_f(cv[i][1]), silu_f(cv[i][2]), silu_f(cv[i][3])}; }
    __syncthreads();
    float* ada = (float*)(P.ws + WS_ADA);
    const int j4 = (TIDX & 7) * 4, ks = TIDX >> 3;
    f32x4 wv[16], wn[16];
    auto load_item = [&](int item, f32x4 (&w_)[16]) { const int layer = item / 192, c0 = (item % 192) * 32;
        const float* w = P.w_ada + (size_t)layer * D * 6 * D + (size_t)(ks * 16) * 6 * D + c0 + j4;
#pragma unroll
        for (int u = 0; u < 16; ++u) w_[u] = *(const f32x4*)(w + (size_t)u * 6 * D); };
    if (BIDX < DEPTH * 192) load_item(BIDX, wv);
    for (int item = BIDX; item < DEPTH * 192; item += GDIM) {
        const int layer = item / 192, c0 = (item % 192) * 32;
        if (item + GDIM < DEPTH * 192) load_item(item + GDIM, wn);
        f32x4 acc[NB];
#pragma unroll
        for (int b = 0; b < NB; ++b) acc[b] = (f32x4){0.f, 0.f, 0.f, 0.f};
#pragma unroll
        for (int u = 0; u < 16; ++u)
#pragma unroll
            for (int b = 0; b < NB; ++b) acc[b] += cact[b * D + ks * 16 + u] * wv[u];
#pragma unroll
        for (int b = 0; b < NB; ++b) *(f32x4*)(red + (ks * NB + b) * 32 + j4) = acc[b];
        __syncthreads();
        if (TIDX < 256) { const int b = TIDX >> 5, jj = TIDX & 31; float s = 0.f;
            for (int k2 = 0; k2 < 64; ++k2) s += red[(k2 * NB + b) * 32 + jj];
            ada[(size_t)(layer * NB + b) * 6 * D + c0 + jj] = s + P.b_ada[layer * 6 * D + c0 + jj]; }
        __syncthreads();
#pragma unroll
        for (int u = 0; u < 16; ++u) wv[u] = wn[u];
    }
    float* cs = (float*)(P.ws + WS_COS); float* sn = (float*)(P.ws + WS_SIN);
    const int gt = BIDX * 512 + TIDX, nt = GDIM * 512;
    for (int idx0 = gt; idx0 < T * 16; idx0 += 4 * nt) {
        int pp[4];
#pragma unroll
        for (int u = 0; u < 4; ++u) { const int idx = idx0 + u * nt; pp[u] = idx < T * 16 ? P.pos[idx >> 4] : 0; }
#pragma unroll
        for (int u = 0; u < 4; ++u) { const int idx = idx0 + u * nt;
            if (idx < T * 16) { const int jx = idx & 15; const float ang = (float)pp[u] * exp2f(-(float)jx * (13.287712379549449f / 16.f));
                float sv_, cv_; sincosf(ang, &sv_, &cv_); cs[idx] = cv_; sn[idx] = sv_; } }
    }
}

__device__ __forceinline__ void moe_offsets(const Params& P, int layer, int (&off)[NEXP + 1]) {
    const unsigned* cnt = (const unsigned*)(P.ws + WS_CTL) + CW_CNT + 16 * (layer / 2);
    int o = 0;
#pragma unroll
    for (int e = 0; e < NEXP; ++e) { off[e] = o; o += (int)((cnt[e] + 255u) >> 8) << 8; }
    off[NEXP] = o;
}
__device__ __forceinline__ int moe_sel(const int (&off)[NEXP + 1], int e) { int r = 0;
#pragma unroll
    for (int j = 0; j < NEXP; ++j) if (e == j) r = off[j];
    return r; }
template <int MODE, int VAR>
__device__ __forceinline__ void ph_norm(unsigned char* lds, Params P, int layer, const float* src, int comb) {
    const int TIDX = hidden_tid(P.wid), BIDX = launder_i((int)blockIdx.x), GDIM = launder_i((int)gridDim.x); P.ws = launder_ptr(P.ws); P.out = launder_ptr(P.out);
    const int wid = TIDX >> 6, lane = TIDX & 63;
    const float* gain = (MODE == 0 ? P.norm_mix : P.norm_ffn) + layer * D;
    bf16_t* hb = (bf16_t*)(P.ws + WS_HBUF); bf16_t* xs = xstream(P, (MODE == 2 && layer == DEPTH - 1) ? DEPTH : layer);
    float* wrl = (float*)(lds + 4096);
    if (MODE == 2) { if (TIDX < 16) ((unsigned*)lds)[TIDX] = 0u;
        const f32x4* src4 = (const f32x4*)(P.moe_wr + (size_t)(layer / 2) * D * NEXP); for (int i = TIDX; i < D * NEXP / 4; i += 512) ((f32x4*)wrl)[i] = src4[i];
        __syncthreads(); }
    constexpr int NR = 4;
    const int RPW = (T + GDIM * 8 - 1) / (GDIM * 8), rbeg = (BIDX * 8 + wid) * RPW;
    int off_[NEXP + 1];
    if (VAR == 2) moe_offsets(P, comb, off_);
    const bf16_t* ym = (const bf16_t*)(P.ws + WS_HG); const int* tinfo = (const int*)(P.ws + WS_TOKINFO); const float* prob = (const float*)(P.ws + WS_PROB);
    int bcur = -1; f32x4 av[4], bv[4], gq[4];
    for (int j0 = 0; j0 < RPW; j0 += NR) {
        f32x4 vf[VAR == 1 ? NR : 1][4]; u32x2 w[VAR == 1 ? 1 : NR][4], ya[VAR == 2 ? NR : 1][4], yb[VAR == 2 ? NR : 1][4]; float p0[NR], p1[NR];
        if (VAR == 1) {
#pragma unroll
            for (int k = 0; k < NR; ++k) { const int row = rbeg + j0 + k;
                if (j0 + k < RPW && row < T) {
#pragma unroll
                    for (int q = 0; q < 4; ++q) vf[VAR == 1 ? k : 0][q] = *(const f32x4*)(src + (size_t)row * D + q * 256 + lane * 4); } }
        } else {
#pragma unroll
            for (int k = 0; k < NR; ++k) { const int row = rbeg + j0 + k;
                if (j0 + k < RPW && row < T) {
#pragma unroll
                    for (int q = 0; q < 4; ++q) w[VAR == 1 ? 0 : k][q] = *(const u32x2*)(xs + (size_t)row * D + q * 256 + lane * 4); } }
            if (VAR == 2) {
                int s0[NR], s1[NR];
#pragma unroll
                for (int k = 0; k < NR; ++k) { const int row = rbeg + j0 + k;
                    if (j0 + k < RPW && row < T) { const int* ti_ = tinfo + (size_t)row * 4; s0[k] = moe_sel(off_, ti_[0]) + ti_[1]; s1[k] = moe_sel(off_, ti_[2]) + ti_[3]; p0[k] = prob[(size_t)row * 2]; p1[k] = prob[(size_t)row * 2 + 1]; } }
#pragma unroll
                for (int k = 0; k < NR; ++k) { const int row = rbeg + j0 + k;
                    if (j0 + k < RPW && row < T) {
#pragma unroll
                        for (int q = 0; q < 4; ++q) { ya[VAR == 2 ? k : 0][q] = *(const u32x2*)(ym + (size_t)s0[k] * D + q * 256 + lane * 4); yb[VAR == 2 ? k : 0][q] = *(const u32x2*)(ym + (size_t)s1[k] * D + q * 256 + lane * 4); } } }
            }
        }
#pragma unroll
        for (int k = 0; k < NR; ++k) { const int row = rbeg + j0 + k;
            if (j0 + k < RPW && row < T) {
                const int b = row / SEQ;
                f32x4 v[4];
#pragma unroll
                for (int q = 0; q < 4; ++q) { if (VAR == 1) v[q] = vf[VAR == 1 ? k : 0][q]; else { const u32x2 ww = w[VAR == 1 ? 0 : k][q]; v[q] = (f32x4){bf2f(ww.x & 0xffff), bf2f(ww.x >> 16), bf2f(ww.y & 0xffff), bf2f(ww.y >> 16)}; } }
                if (b != bcur) {
                    bcur = b; const float* sh = adap(P, layer, b, MODE == 0 ? 0 : 3); const float* sc = adap(P, layer, b, MODE == 0 ? 1 : 4);
#pragma unroll
                    for (int q = 0; q < 4; ++q) { const int col = q * 256 + lane * 4; const f32x4 g = *(const f32x4*)(gain + col), s1_ = *(const f32x4*)(sc + col); bv[q] = *(const f32x4*)(sh + col); av[q] = g * (1.f + s1_);
                        if (VAR == 2) gq[q] = *(const f32x4*)(adap(P, comb, b, 5) + col); } }
                if (VAR == 2) {
#pragma unroll
                    for (int q = 0; q < 4; ++q) { const u32x2 a = ya[VAR == 2 ? k : 0][q], b2 = yb[VAR == 2 ? k : 0][q]; const f32x4 g = gq[q];
                        v[q][0] += g[0] * (p0[k] * bf2f(a.x & 0xffff) + p1[k] * bf2f(b2.x & 0xffff)); v[q][1] += g[1] * (p0[k] * bf2f(a.x >> 16) + p1[k] * bf2f(b2.x >> 16));
                        v[q][2] += g[2] * (p0[k] * bf2f(a.y & 0xffff) + p1[k] * bf2f(b2.y & 0xffff)); v[q][3] += g[3] * (p0[k] * bf2f(a.y >> 16) + p1[k] * bf2f(b2.y >> 16)); } }
                float ss = 0.f;
#pragma unroll
                for (int q = 0; q < 4; ++q) ss += v[q][0] * v[q][0] + v[q][1] * v[q][1] + v[q][2] * v[q][2] + v[q][3] * v[q][3];
                if (VAR != 0) {
#pragma unroll
                    for (int q = 0; q < 4; ++q) { u32x2 o; o.x = pk2(v[q][0], v[q][1]); o.y = pk2(v[q][2], v[q][3]); *(u32x2*)(xs + (size_t)row * D + q * 256 + lane * 4) = o; }
                }
                ss = wsum(ss, lane);
                const float rstd = rsqrtf(ss * (1.f / D) + EPS);
                float lg[NEXP];
#pragma unroll
                for (int e = 0; e < NEXP; ++e) lg[e] = 0.f;
#pragma unroll
                for (int q = 0; q < 4; ++q) {
                    const int col = q * 256 + lane * 4;
                    float h[4];
#pragma unroll
                    for (int j = 0; j < 4; ++j) h[j] = v[q][j] * rstd * av[q][j] + bv[q][j];
                    u32x2 o; o.x = pk2(h[0], h[1]); o.y = pk2(h[2], h[3]);
                    *(u32x2*)(hb + (size_t)row * D + col) = o;
                    if (MODE == 2) {
                        const float* wr = wrl + col * NEXP;
#pragma unroll
                        for (int j = 0; j < 4; ++j) { const f32x4 w0 = *(const f32x4*)(wr + j * 8), w1 = *(const f32x4*)(wr + j * 8 + 4);
                            lg[0] += h[j] * w0[0]; lg[1] += h[j] * w0[1]; lg[2] += h[j] * w0[2]; lg[3] += h[j] * w0[3];
                            lg[4] += h[j] * w1[0]; lg[5] += h[j] * w1[1]; lg[6] += h[j] * w1[2]; lg[7] += h[j] * w1[3]; }
                    }
                }
                if (MODE == 2) {
#pragma unroll
                    for (int e = 0; e < NEXP; ++e) lg[e] = wsum(lg[e], lane) + P.moe_br[(layer / 2) * NEXP + e];
                    if (lane == 0) {
                        int i0 = 0; float v0 = lg[0];
#pragma unroll
                        for (int e = 1; e < NEXP; ++e) if (lg[e] > v0) { v0 = lg[e]; i0 = e; }
                        int i1 = -1; float v1 = -INFINITY;
#pragma unroll
                        for (int e = 0; e < NEXP; ++e) if (e != i0 && lg[e] > v1) { v1 = lg[e]; i1 = e; }
                        const float pa = 1.f / (1.f + expf(v1 - v0)), pb = 1.f - pa;
                        unsigned* lcnt = (unsigned*)lds; int* lti = (int*)(lds + 64) + (wid * 16 + j0 + k) * 4;
                        const int pos0 = (int)atomicAdd(lcnt + i0, 1u), pos1 = (int)atomicAdd(lcnt + i1, 1u);
                        lti[0] = i0; lti[1] = pos0; lti[2] = i1; lti[3] = pos1;
                        float* pr = (float*)(P.ws + WS_PROB) + (size_t)row * 2; pr[0] = pa; pr[1] = pb;
                    }
                }
            }
        }
    }
    if (MODE == 2) {
        __syncthreads();
        unsigned* lcnt = (unsigned*)lds; int* lti = (int*)(lds + 64);
        if (TIDX < NEXP) { unsigned* cnt = (unsigned*)(P.ws + WS_CTL) + CW_CNT + 16 * (layer / 2); lcnt[8 + TIDX] = atomicAdd(cnt + TIDX, lcnt[TIDX]); }
        __syncthreads();
        if (TIDX < 128) { const int w_ = TIDX >> 4, j_ = TIDX & 15, row = (BIDX * 8 + w_) * RPW + j_;
            if (j_ < RPW && row < T) { const int e0 = lti[TIDX * 4], e1 = lti[TIDX * 4 + 2]; int* ti = (int*)(P.ws + WS_TOKINFO) + (size_t)row * 4;
                const int q0_ = lti[TIDX * 4 + 1] + (int)lcnt[8 + e0], q1_ = lti[TIDX * 4 + 3] + (int)lcnt[8 + e1]; int* list = (int*)(P.ws + WS_LIST);
                ti[0] = e0; ti[1] = q0_; ti[2] = e1; ti[3] = q1_; list[(size_t)e0 * T + q0_] = row; list[(size_t)e1 * T + q1_] = row; } }
        __syncthreads();
    }
}

__device__ __forceinline__ int proj_orig_col(int col) { return col < 672 ? col : (col < 768 ? -1 : (col < 1926 ? col - 96 : -1)); }
__device__ __forceinline__ void ph_inproj_naive(unsigned char* lds, Params P, int layer, int chk) {
    const int TIDX = hidden_tid(P.wid), BIDX = launder_i((int)blockIdx.x), GDIM = launder_i((int)gridDim.x); P.ws = launder_ptr(P.ws); P.out = launder_ptr(P.out);
    float* sm = (float*)lds;
    const bf16_t* hb = (const bf16_t*)(P.ws + WS_HBUF); const float* w = P.w_in + (size_t)layer * D * INC;
    bf16_t* proj = (bf16_t*)(P.ws + WS_PROJ); float* fg = (float*)(P.ws + WS_FG);
    Chk ck{0.f, 0.f};
    naive_gemm(T, PJ, D,
        [&](int r, int k) { return bf2f(hb[(size_t)r * D + k]); },
        [&](int) { return 0; },
        [&](int k, int col, int) { const int oc = proj_orig_col(col); return oc < 0 ? 0.f : w[(size_t)k * INC + oc]; },
        [&](int r, int c0, const float (&v)[4]) {
            st4(proj + (size_t)r * PJ + c0, v, chk, ck);
            if (c0 >= PC_FG && c0 < PC_FG + 8) { float* fp = fg + (size_t)r * 8 + (c0 - PC_FG);
                if (!chk) *(f32x4*)fp = (f32x4){v[0], v[1], v[2], v[3]};
                else { chk_upd(ck, v[0], fp[0]); chk_upd(ck, v[1], fp[1]); chk_upd(ck, v[2], fp[2]); chk_upd(ck, v[3], fp[3]); } }
        }, sm);
    if (chk) chk_commit(P, chk, ck);
}

__device__ __forceinline__ void ph_passC(unsigned char* lds, Params P, int layer) {
    const int TIDX = hidden_tid(P.wid), BIDX = launder_i((int)blockIdx.x), GDIM = launder_i((int)gridDim.x); P.ws = launder_ptr(P.ws); P.out = launder_ptr(P.out);
    float (*lfs)[8] = (float (*)[8])lds;
    const int wid = TIDX >> 6, lane = TIDX & 63;
    bf16_t* proj = (bf16_t*)(P.ws + WS_PROJ); const float* fg = (const float*)(P.ws + WS_FG);
    float* rq = (float*)(P.ws + WS_RSTDQ); float* rkv = (float*)(P.ws + WS_RSTDKV);
    float* cloc = (float*)(P.ws + WS_CLOC); float* ctot = (float*)(P.ws + WS_CTOT);
    const float gq = P.fox_gq[layer * 64 + lane] * C2_FOX, gk = P.fox_gk[layer * 64 + lane];
    for (int chunk = BIDX; chunk < T / 128; chunk += GDIM) {
        for (int i = 0; i < 16; ++i) {
            const int tl = wid * 16 + i, row = chunk * 128 + tl;
            bf16_t* pr = proj + (size_t)row * PJ;
            { const u32x2 w = *(const u32x2*)(pr + PC_CQ + lane * 4); const float a = bf2f(w.x & 0xffff), b = bf2f(w.x >> 16), c = bf2f(w.y & 0xffff), d = bf2f(w.y >> 16);
              const float ss = wsum(a * a + b * b + c * c + d * d, lane); if (lane == 0) rq[row] = rsqrtf(ss * (1.f / 256.f) + EPS); }
            { const u32x2 w = *(const u32x2*)(pr + PC_U + lane * 4); const int g_ = lane >> 2, c_ = (lane & 3) * 4, b_ = row / SEQ, t_ = row % SEQ;
              *(u32x2*)((bf16_t*)(P.ws + WS_UG) + (size_t)(g_ * 1024 + b_ * 128 + (t_ >> 5)) * 640 + (t_ & 31) * 16 + c_) = w; }
            { const unsigned w = *(const unsigned*)(pr + PC_CKV + lane * 2); const float a = bf2f(w & 0xffff), b = bf2f(w >> 16);
              const float ss = wsum(a * a + b * b, lane); if (lane == 0) rkv[row] = rsqrtf(ss * (1.f / 128.f) + EPS); }
#pragma unroll
            for (int h = 0; h < 6; ++h) {
                const float a = bf2f(pr[PC_FQ + h * 64 + lane]); const float ra = rsqrtf(wsum(a * a, lane) * (1.f / 64.f) + EPS); pr[PC_FQ + h * 64 + lane] = f2bf(a * ra * gq);
                const float b = bf2f(pr[PC_FK + h * 64 + lane]); const float rb = rsqrtf(wsum(b * b, lane) * (1.f / 64.f) + EPS); pr[PC_FK + h * 64 + lane] = f2bf(b * rb * gk);
            }
            if (lane < 6) { const float z = fg[(size_t)row * 8 + lane] + P.fox_bf[layer * 6 + lane];
                lfs[tl][lane] = z >= 0.f ? -log1pf(expf(-z)) : z - log1pf(expf(z)); }
        }
        __syncthreads();
        if (TIDX < 6) {
            const int h = TIDX, b = (chunk * 128) / SEQ, t0 = (chunk * 128) % SEQ; float run = 0.f;
            for (int j = 0; j < 128; ++j) { run += lfs[j][h]; cloc[((size_t)b * 6 + h) * SEQ + t0 + j] = run; }
            ctot[chunk * 8 + h] = run;
        }
        __syncthreads();
    }
}

__device__ __forceinline__ void ph_qup_naive(unsigned char* lds, Params P, int layer, int chk) {
    const int TIDX = hidden_tid(P.wid), BIDX = launder_i((int)blockIdx.x), GDIM = launder_i((int)gridDim.x); P.ws = launder_ptr(P.ws); P.out = launder_ptr(P.out);
    float* sm = (float*)lds;
    const bf16_t* proj = (const bf16_t*)(P.ws + WS_PROJ); const float* rq = (const float*)(P.ws + WS_RSTDQ);
    const float* w = P.w_uq + (size_t)layer * 256 * 576; const float* g = P.q_norm + layer * 256; bf16_t* qraw = (bf16_t*)(P.ws + WS_QRAW);
    Chk ck{0.f, 0.f};
    naive_gemm(T, 576, 256,
        [&](int r, int k) { return bf2f(proj[(size_t)r * PJ + PC_CQ + k]); },
        [&](int) { return 0; },
        [&](int k, int col, int) { return g[k] * w[(size_t)k * 576 + col]; },
        [&](int r, int c0, const float (&v)[4]) { const float s = rq[r]; const float o[4] = {v[0] * s, v[1] * s, v[2] * s, v[3] * s}; st4(qraw + (size_t)r * 768 + c0, o, chk, ck); }, sm);
    if (chk) chk_commit(P, chk, ck);
}
__device__ __forceinline__ void ph_kvup_naive(unsigned char* lds, Params P, int layer, int chk) {
    const int TIDX = hidden_tid(P.wid), BIDX = launder_i((int)blockIdx.x), GDIM = launder_i((int)gridDim.x); P.ws = launder_ptr(P.ws); P.out = launder_ptr(P.out);
    float* sm = (float*)lds;
    const bf16_t* proj = (const bf16_t*)(P.ws + WS_PROJ); const float* rk = (const float*)(P.ws + WS_RSTDKV);
    const float* w = P.w_ukv + (size_t)layer * 128 * 768; const float* g = P.kv_norm + layer * 128; bf16_t* kvraw = (bf16_t*)(P.ws + WS_KVRAW);
    Chk ck{0.f, 0.f};
    naive_gemm(T, 768, 128,
        [&](int r, int k) { return bf2f(proj[(size_t)r * PJ + PC_CKV + k]); },
        [&](int) { return 0; },
        [&](int k, int col, int) { return g[k] * w[(size_t)k * 768 + col]; },
        [&](int r, int c0, const float (&v)[4]) { const float s = rk[r]; const float o[4] = {v[0] * s, v[1] * s, v[2] * s, v[3] * s}; st4(kvraw + (size_t)r * 768 + c0, o, chk, ck); }, sm);
    if (chk) chk_commit(P, chk, ck);
}

__device__ __forceinline__ void ph_passE(unsigned char* lds, Params P, int layer) {
    const int TIDX = hidden_tid(P.wid), BIDX = launder_i((int)blockIdx.x), GDIM = launder_i((int)gridDim.x); P.ws = launder_ptr(P.ws); P.out = launder_ptr(P.out);
    float* pref = (float*)lds;
    const int wid = TIDX >> 6, lane = TIDX & 63;
    const bf16_t* proj = (const bf16_t*)(P.ws + WS_PROJ); const bf16_t* qraw = (const bf16_t*)(P.ws + WS_QRAW); const bf16_t* kvraw = (const bf16_t*)(P.ws + WS_KVRAW);
    bf16_t* qm = (bf16_t*)(P.ws + WS_QMLA); bf16_t* km = (bf16_t*)(P.ws + WS_KMLA);
    const float* cs = (const float*)(P.ws + WS_COS); const float* sn = (const float*)(P.ws + WS_SIN);
    const float* cloc = (const float*)(P.ws + WS_CLOC); const float* ctot = (const float*)(P.ws + WS_CTOT); float* cb2 = (float*)(P.ws + WS_CB2);
    const float gqa = P.mla_gq[layer * 96 + lane], gqb = lane < 32 ? P.mla_gq[layer * 96 + 64 + lane] : 0.f;
    const float gka = P.mla_gk[layer * 96 + lane], gkb = lane < 32 ? P.mla_gk[layer * 96 + 64 + lane] : 0.f;
    for (int chunk = BIDX; chunk < T / 128; chunk += GDIM) {
        const int b = (chunk * 128) / SEQ, t0 = (chunk * 128) % SEQ, ci = chunk % 32;
        if (TIDX < 6) { float s = 0.f; for (int c = 0; c < ci; ++c) s += ctot[(b * 32 + c) * 8 + TIDX]; pref[TIDX] = s; }
        __syncthreads();
        for (int e = TIDX; e < 6 * 128; e += 512) { const int h = e / 128, j = e % 128; const size_t ix = ((size_t)b * 6 + h) * SEQ + t0 + j; cb2[ix] = (cloc[ix] + pref[h]) * LOG2E; }
        for (int i = 0; i < 16; ++i) {
            const int row = chunk * 128 + wid * 16 + i;
            const float cv = cs[(size_t)row * 16 + (lane & 15)], sv = sn[(size_t)row * 16 + (lane & 15)];
#pragma unroll
            for (int h = 0; h < 6; ++h) {
                {
                    const float a = bf2f(qraw[(size_t)row * 768 + h * 96 + lane]); const float bq = lane < 32 ? bf2f(qraw[(size_t)row * 768 + h * 96 + 64 + lane]) : 0.f;
                    const float r = rsqrtf(wsum(a * a + bq * bq, lane) * (1.f / 96.f) + EPS);
                    const float an = a * r * gqa, bn = bq * r * gqb; const float pn = shx(bn, 16, lane);
                    const float ro = lane < 16 ? bn * cv - pn * sv : pn * sv + bn * cv;
                    qm[(size_t)row * 576 + h * 96 + lane] = f2bf(an * C2_MLA); if (lane < 32) qm[(size_t)row * 576 + h * 96 + 64 + lane] = f2bf(ro * C2_MLA);
                }
                {
                    const float a = bf2f(kvraw[(size_t)row * 768 + h * 128 + lane]); const float bk = lane < 32 ? bf2f(proj[(size_t)row * PJ + PC_KR + lane]) : 0.f;
                    const float r = rsqrtf(wsum(a * a + bk * bk, lane) * (1.f / 96.f) + EPS);
                    const float an = a * r * gka, bn = bk * r * gkb; const float pn = shx(bn, 16, lane);
                    const float ro = lane < 16 ? bn * cv - pn * sv : pn * sv + bn * cv;
                    km[(size_t)row * 576 + h * 96 + lane] = f2bf(an); if (lane < 32) km[(size_t)row * 576 + h * 96 + 64 + lane] = f2bf(ro);
                }
            }
        }
        __syncthreads();
    }
}

template <int DQK, int MODE>
__device__ __forceinline__ void ph_attn_naive(unsigned char* lds, Params P, const bf16_t* Q, int ldq, const bf16_t* K, int ldk, const bf16_t* V, int ldv, int vhs, bf16_t* O, int ldo, const float* cb2, int chk) {
    const int TIDX = hidden_tid(P.wid), BIDX = launder_i((int)blockIdx.x), GDIM = launder_i((int)gridDim.x); P.ws = launder_ptr(P.ws); P.out = launder_ptr(P.out);
    float (*Ks)[DQK] = (float (*)[DQK])lds; float (*Vs)[64] = (float (*)[64])(lds + 64 * DQK * 4); float* cbs = (float*)(lds + 64 * DQK * 4 + 64 * 64 * 4);
    const int tid = TIDX;
    Chk ck{0.f, 0.f};
    for (int item = BIDX; item < NB * 6 * 8; item += GDIM) {
        const int qb = 7 - (item / 48), bh = item % 48, b = bh / 6, h = bh % 6;
        const int q = qb * 512 + tid; const size_t rowq = (size_t)b * SEQ + q;
        float qv[DQK], o[64];
#pragma unroll
        for (int d = 0; d < DQK; ++d) qv[d] = bf2f(Q[rowq * ldq + h * DQK + d]);
#pragma unroll
        for (int d = 0; d < 64; ++d) o[d] = 0.f;
        float m = -INFINITY, l = 0.f;
        const float* cbp = MODE == 1 ? cb2 + ((size_t)b * 6 + h) * SEQ : nullptr;
        const int kend = qb * 512 + 512;
        for (int k0 = 0; k0 < kend; k0 += 64) {
            __syncthreads();
            for (int e = tid; e < 64 * DQK; e += 512) { const int j = e / DQK, d = e % DQK; Ks[j][d] = bf2f(K[((size_t)b * SEQ + k0 + j) * ldk + h * DQK + d]); }
            for (int e = tid; e < 64 * 64; e += 512) { const int j = e >> 6, d = e & 63; Vs[j][d] = bf2f(V[((size_t)b * SEQ + k0 + j) * ldv + h * vhs + d]); }
            if (MODE == 1 && tid < 64) cbs[tid] = cbp[k0 + tid];
            __syncthreads();
            for (int j = 0; j < 64; ++j) {
                const int key = k0 + j;
                const bool ok = MODE == 0 ? ((key >> 6) <= (q >> 6)) : (key <= q);
                if (ok) {
                    float s = 0.f;
#pragma unroll
                    for (int d = 0; d < DQK; d += 4) { const f32x4 kk = *(const f32x4*)&Ks[j][d]; s += qv[d] * kk[0] + qv[d + 1] * kk[1] + qv[d + 2] * kk[2] + qv[d + 3] * kk[3]; }
                    if (MODE == 1) s -= cbs[j];
                    if (s > m) { const float f = exp2f(m - s); l *= f;
#pragma unroll
                        for (int d = 0; d < 64; ++d) o[d] *= f;
                        m = s; }
                    const float p = exp2f(s - m); l += p;
#pragma unroll
                    for (int d = 0; d < 64; d += 4) { const f32x4 vv = *(const f32x4*)&Vs[j][d]; o[d] += p * vv[0]; o[d + 1] += p * vv[1]; o[d + 2] += p * vv[2]; o[d + 3] += p * vv[3]; }
                }
            }
        }
        const float il = 1.f / l;
#pragma unroll
        for (int d = 0; d < 64; d += 2) st2(O + rowq * ldo + h * 64 + d, o[d] * il, o[d + 1] * il, chk, ck);
    }
    if (chk) chk_commit(P, chk, ck);
}

__device__ __forceinline__ void ph_ssm_naive(unsigned char* lds, Params P, int layer, int chk) {
    const int TIDX = hidden_tid(P.wid), BIDX = launder_i((int)blockIdx.x), GDIM = launder_i((int)gridDim.x); P.ws = launder_ptr(P.ws); P.out = launder_ptr(P.out);
    float (*smy)[16 * 64] = (float (*)[16 * 64])lds;
    const int wid = TIDX >> 6, lane = TIDX & 63;
    float* sm = smy[wid];
    const bf16_t* proj = (const bf16_t*)(P.ws + WS_PROJ); bf16_t* yg = (bf16_t*)(P.ws + WS_YG);
    Chk ck{0.f, 0.f};
    for (int item = BIDX * 8 + wid; item < NB * 16; item += GDIM * 8) {
        const int b = item / 16, g = item % 16, p = lane;
        const size_t gp = ((size_t)layer * 16 + g) * 64 + p;
        const float lre = P.lam_re[gp], lim = P.lam_im[gp], dt = expf(P.log_dt[layer * 16 + g]);
        const float a_ = lre * dt, b_ = lim * dt; float sb_, cb_; sincosf(b_, &sb_, &cb_); const float sh_ = sinf(0.5f * b_);
        const float er = expf(a_), lbr = er * cb_, lbi = er * sb_;
        const float nr = expm1f(a_) * cb_ - 2.f * sh_ * sh_, ni = lbi;
        const float dd = lre * lre + lim * lim, qr = (nr * lre + ni * lim) / dd, qi = (ni * lre - nr * lim) / dd;
        float bbr[16], bbi[16], cr[16], ci[16];
#pragma unroll
        for (int c = 0; c < 16; ++c) {
            const float bre = P.b_re[gp * 16 + c], bim = P.b_im[gp * 16 + c];
            bbr[c] = qr * bre - qi * bim; bbi[c] = qr * bim + qi * bre;
            cr[c] = P.c_re[(((size_t)layer * 16 + g) * 16 + c) * 64 + p]; ci[c] = P.c_im[(((size_t)layer * 16 + g) * 16 + c) * 64 + p];
        }
        const float lr = lbr, li = lbi;
        const float dsk = P.ssm_d[layer * 256 + g * 16 + (lane & 15)];
        float sr = 0.f, si = 0.f;
        for (int t = 0; t < SEQ; ++t) {
            const size_t row = (size_t)b * SEQ + t;
            const bf16_t* up = proj + row * PJ + g * 16;
            const u32x4 w0 = *(const u32x4*)up, w1 = *(const u32x4*)(up + 8);
            const unsigned ww[8] = {w0.x, w0.y, w0.z, w0.w, w1.x, w1.y, w1.z, w1.w};
            float bur = 0.f, bui = 0.f;
#pragma unroll
            for (int c = 0; c < 16; ++c) { const float u = (c & 1) ? bf2f(ww[c >> 1] >> 16) : bf2f(ww[c >> 1] & 0xffff); bur = fmaf(bbr[c], u, bur); bui = fmaf(bbi[c], u, bui); }
            const float nsr = lr * sr - li * si + bur, nsi = lr * si + li * sr + bui; sr = nsr; si = nsi;
#pragma unroll
            for (int c = 0; c < 16; ++c) sm[c * 64 + lane] = cr[c] * sr - ci[c] * si;
            asm volatile("s_waitcnt lgkmcnt(0)" ::: "memory");
            const int cc = lane & 15, qd = lane >> 4; float part = 0.f;
#pragma unroll
            for (int j = 0; j < 16; ++j) part += sm[cc * 64 + qd * 16 + j];
            part += shx(part, 16, lane); part += shx(part, 32, lane);
            asm volatile("s_waitcnt lgkmcnt(0)" ::: "memory");
            if (lane < 16) { const float uv = bf2f(up[lane]); const float yv = gelu_tanh(part + dsk * uv); bf16_t* dst = yg + row * 256 + g * 16 + lane;
                if (!chk) *dst = f2bf(yv); else chk_upd(ck, yv, bf2f(*dst)); }
        }
    }
    if (chk) chk_commit(P, chk, ck);
}

__device__ __forceinline__ void ph_glu_naive(unsigned char* lds, Params P, int layer, int chk) {
    const int TIDX = hidden_tid(P.wid), BIDX = launder_i((int)blockIdx.x), GDIM = launder_i((int)gridDim.x); P.ws = launder_ptr(P.ws); P.out = launder_ptr(P.out);
    float* sm = (float*)lds;
    const bf16_t* yg = (const bf16_t*)(P.ws + WS_YG); bf16_t* os = (bf16_t*)(P.ws + WS_OSSM);
    const float* w = P.w_glu + (size_t)layer * 256 * 256; const float* bg = P.b_glu + layer * 256;
    Chk ck{0.f, 0.f};
    naive_gemm(T, 256, 256,
        [&](int r, int k) { return bf2f(yg[(size_t)r * 256 + k]); },
        [&](int) { return 0; },
        [&](int k, int col, int) { return w[(size_t)k * 256 + col]; },
        [&](int r, int c0, const float (&v)[4]) {
            float o[4];
#pragma unroll
            for (int j = 0; j < 4; ++j) o[j] = bf2f(yg[(size_t)r * 256 + c0 + j]) * sigmoid_f(v[j] + bg[c0 + j]);
            st4(os + (size_t)r * 256 + c0, o, chk, ck); }, sm);
    if (chk) chk_commit(P, chk, ck);
}

__device__ __forceinline__ void ph_merge(unsigned char* lds, Params P) {
    const int TIDX = hidden_tid(P.wid), BIDX = launder_i((int)blockIdx.x), GDIM = launder_i((int)gridDim.x); P.ws = launder_ptr(P.ws); P.out = launder_ptr(P.out);
    const int wid = TIDX >> 6, lane = TIDX & 63;
    const bf16_t* os = (const bf16_t*)(P.ws + WS_OSSM); const bf16_t* ob = (const bf16_t*)(P.ws + WS_OBUF); bf16_t* hb = (bf16_t*)(P.ws + WS_HBUF);
    constexpr int NR = 8;
    const int RPW = (T + GDIM * 8 - 1) / (GDIM * 8), rbeg = (BIDX * 8 + wid) * RPW;
    for (int j0 = 0; j0 < RPW; j0 += NR) {
        u32x2 ws_[NR]; unsigned wo[NR][6];
#pragma unroll
        for (int k = 0; k < NR; ++k) { const int row = rbeg + j0 + k;
            if (j0 + k < RPW && row < T) { ws_[k] = *(const u32x2*)(os + (size_t)row * 256 + lane * 4);
#pragma unroll
                for (int part = 0; part < 2; ++part) { const bf16_t* src = ob + (size_t)row * 768 + part * 384 + lane * 6; wo[k][part * 3] = *(const unsigned*)src; wo[k][part * 3 + 1] = *(const unsigned*)(src + 2); wo[k][part * 3 + 2] = *(const unsigned*)(src + 4); } } }
#pragma unroll
        for (int k = 0; k < NR; ++k) { const int row = rbeg + j0 + k;
            if (j0 + k < RPW && row < T) {
                { const u32x2 w = ws_[k]; const float a = bf2f(w.x & 0xffff), b = bf2f(w.x >> 16), c = bf2f(w.y & 0xffff), d = bf2f(w.y >> 16);
                  const float r = rsqrtf(wsum(a * a + b * b + c * c + d * d, lane) * (1.f / 256.f) + EPS); u32x2 o; o.x = pk2(a * r, b * r); o.y = pk2(c * r, d * r); *(u32x2*)(hb + (size_t)row * D + lane * 4) = o; }
#pragma unroll
                for (int part = 0; part < 2; ++part) {
                    const unsigned w0 = wo[k][part * 3], w1 = wo[k][part * 3 + 1], w2 = wo[k][part * 3 + 2];
                    const float v[6] = {bf2f(w0 & 0xffff), bf2f(w0 >> 16), bf2f(w1 & 0xffff), bf2f(w1 >> 16), bf2f(w2 & 0xffff), bf2f(w2 >> 16)};
                    float ss = 0.f;
#pragma unroll
                    for (int j = 0; j < 6; ++j) ss += v[j] * v[j];
                    const float r = rsqrtf(wsum(ss, lane) * (1.f / 384.f) + EPS);
                    unsigned* dst = (unsigned*)(hb + (size_t)row * D + 256 + part * 384 + lane * 6);
                    dst[0] = pk2(v[0] * r, v[1] * r); dst[1] = pk2(v[2] * r, v[3] * r); dst[2] = pk2(v[4] * r, v[5] * r);
                }
            }
        }
    }
}

__device__ __forceinline__ void ph_outproj_naive(unsigned char* lds, Params P, int layer, float* dst, int chk) {
    const int TIDX = hidden_tid(P.wid), BIDX = launder_i((int)blockIdx.x), GDIM = launder_i((int)gridDim.x); P.ws = launder_ptr(P.ws); P.out = launder_ptr(P.out);
    float* sm = (float*)lds;
    const bf16_t* hb = (const bf16_t*)(P.ws + WS_HBUF); const float* w = P.w_out + (size_t)layer * D * D; const float* g = P.out_norm + layer * D;
    Chk ck{0.f, 0.f};
    naive_gemm(T, D, D,
        [&](int r, int k) { return bf2f(hb[(size_t)r * D + k]); },
        [&](int) { return 0; },
        [&](int k, int col, int) { return g[k] * w[(size_t)k * D + col]; },
        [&](int r, int c0, const float (&v)[4]) {
            const float* g1 = adap(P, layer, r / SEQ, 2) + c0; f32x4 xv = *(const f32x4*)(P.out + (size_t)r * D + c0);
#pragma unroll
            for (int j = 0; j < 4; ++j) { const float dl = g1[j] * v[j]; xv[j] += dl; ck.r = fmaxf(ck.r, fabsf(dl)); }
            *(f32x4*)(dst + (size_t)r * D + c0) = xv; }, sm);
    if (chk) chk_commit(P, chk, ck);
}

__device__ __forceinline__ void ph_ffn1_naive(unsigned char* lds, Params P, int layer, int chk) {
    const int TIDX = hidden_tid(P.wid), BIDX = launder_i((int)blockIdx.x), GDIM = launder_i((int)gridDim.x); P.ws = launder_ptr(P.ws); P.out = launder_ptr(P.out);
    float* sm = (float*)lds;
    const bf16_t* hb = (const bf16_t*)(P.ws + WS_HBUF); bf16_t* act = (bf16_t*)(P.ws + WS_ACT);
    const float* wg = P.ffn_wg + (size_t)(layer / 2) * D * DFF; const float* wu = P.ffn_wu + (size_t)(layer / 2) * D * DFF;
    Chk ck{0.f, 0.f};
    naive_gemm(T, 2 * DFF, D,
        [&](int r, int k) { return bf2f(hb[(size_t)r * D + k]); },
        [&](int) { return 0; },
        [&](int k, int col, int) { return (col & 1) ? wu[(size_t)k * DFF + (col >> 1)] : wg[(size_t)k * DFF + (col >> 1)]; },
        [&](int r, int c0, const float (&v)[4]) { st2(act + (size_t)r * DFF + (c0 >> 1), silu_f(v[0]) * v[1], silu_f(v[2]) * v[3], chk, ck); }, sm);
    if (chk) chk_commit(P, chk, ck);
}
__device__ __forceinline__ void ph_ffn2_naive(unsigned char* lds, Params P, int layer, float* dst, int chk) {
    const int TIDX = hidden_tid(P.wid), BIDX = launder_i((int)blockIdx.x), GDIM = launder_i((int)gridDim.x); P.ws = launder_ptr(P.ws); P.out = launder_ptr(P.out);
    float* sm = (float*)lds;
    const bf16_t* act = (const bf16_t*)(P.ws + WS_ACT); const float* w = P.ffn_wd + (size_t)(layer / 2) * DFF * D;
    Chk ck{0.f, 0.f};
    naive_gemm(T, D, DFF,
        [&](int r, int k) { return bf2f(act[(size_t)r * DFF + k]); },
        [&](int) { return 0; },
        [&](int k, int col, int) { return w[(size_t)k * D + col]; },
        [&](int r, int c0, const float (&v)[4]) {
            const float* g2 = adap(P, layer, r / SEQ, 5) + c0; f32x4 xv = *(const f32x4*)(P.out + (size_t)r * D + c0);
#pragma unroll
            for (int j = 0; j < 4; ++j) { const float dl = g2[j] * v[j]; xv[j] += dl; ck.r = fmaxf(ck.r, fabsf(dl)); }
            *(f32x4*)(dst + (size_t)r * D + c0) = xv; }, sm);
    if (chk) chk_commit(P, chk, ck);
}
__device__ __forceinline__ void ph_cmp_x(unsigned char* lds, Params P, const float* xe, int stage) {
    const int TIDX = hidden_tid(P.wid), BIDX = launder_i((int)blockIdx.x), GDIM = launder_i((int)gridDim.x); P.ws = launder_ptr(P.ws); P.out = launder_ptr(P.out);
    Chk ck{0.f, 0.f};
    for (size_t i = (size_t)BIDX * 512 + TIDX; i < (size_t)T * D / 4; i += (size_t)GDIM * 512) {
        const f32x4 a = ((const f32x4*)P.out)[i], b = ((const f32x4*)xe)[i];
#pragma unroll
        for (int j = 0; j < 4; ++j) { const float d = fabsf(a[j] - b[j]); ck.e = (d != d) ? INFINITY : fmaxf(ck.e, d); }
    }
    chk_commit(P, stage, ck);
}

__device__ __forceinline__ void ph_moe_gather(unsigned char* lds, Params P, int layer) {
    const int TIDX = hidden_tid(P.wid), BIDX = launder_i((int)blockIdx.x), GDIM = launder_i((int)gridDim.x); P.ws = launder_ptr(P.ws); P.out = launder_ptr(P.out);
    const int wid = TIDX >> 6, lane = TIDX & 63;
    int off[NEXP + 1]; moe_offsets(P, layer, off);
    int* p2e = (int*)(P.ws + WS_P2E);
    if (BIDX == 0) {
        for (int pnl = TIDX; pnl < 272; pnl += 512) { int e = 0;
#pragma unroll
            for (int j = 1; j < NEXP; ++j) if (pnl * 256 >= off[j]) e = j;
            p2e[pnl] = e; }
        if (TIDX == 0) p2e[300] = off[NEXP] >> 8;
    }
    const bf16_t* hb = (const bf16_t*)(P.ws + WS_HBUF); bf16_t* hg = (bf16_t*)(P.ws + WS_HG);
    const int* ti = (const int*)(P.ws + WS_TOKINFO); int* so = (int*)(P.ws + WS_SLOTOF);
    for (int row = BIDX * 8 + wid; row < T; row += GDIM * 8) {
        const u32x4 v0 = *(const u32x4*)(hb + (size_t)row * D + lane * 8), v1 = *(const u32x4*)(hb + (size_t)row * D + 512 + lane * 8);
#pragma unroll
        for (int k = 0; k < 2; ++k) {
            const int e = ti[(size_t)row * 4 + 2 * k], pos = ti[(size_t)row * 4 + 2 * k + 1];
            int base = 0;
#pragma unroll
            for (int j = 0; j < NEXP; ++j) if (e == j) base = off[j];
            const int slot = base + pos;
            *(u32x4*)(hg + (size_t)slot * D + lane * 8) = v0; *(u32x4*)(hg + (size_t)slot * D + 512 + lane * 8) = v1;
            if (lane == 0) so[(size_t)row * 2 + k] = slot;
        }
    }
}
__device__ __forceinline__ void ph_moe1_naive(unsigned char* lds, Params P, int layer, int chk) {
    const int TIDX = hidden_tid(P.wid), BIDX = launder_i((int)blockIdx.x), GDIM = launder_i((int)gridDim.x); P.ws = launder_ptr(P.ws); P.out = launder_ptr(P.out);
    float* sm = (float*)lds;
    const bf16_t* hg = (const bf16_t*)(P.ws + WS_HG); bf16_t* act = (bf16_t*)(P.ws + WS_ACTM); const int* p2e = (const int*)(P.ws + WS_P2E);
    const float* wg = P.moe_wg + (size_t)(layer / 2) * NEXP * D * DFE; const float* wu = P.moe_wu + (size_t)(layer / 2) * NEXP * D * DFE;
    const int M = p2e[300] * 256;
    Chk ck{0.f, 0.f};
    naive_gemm(M, 2 * DFE, D,
        [&](int r, int k) { return bf2f(hg[(size_t)r * D + k]); },
        [&](int bm) { return p2e[bm >> 8]; },
        [&](int k, int col, int e) { const size_t o = ((size_t)e * D + k) * DFE + (col >> 1); return (col & 1) ? wu[o] : wg[o]; },
        [&](int r, int c0, const float (&v)[4]) { st2(act + (size_t)r * DFE + (c0 >> 1), silu_f(v[0]) * v[1], silu_f(v[2]) * v[3], chk, ck); }, sm);
    if (chk) chk_commit(P, chk, ck);
}
__device__ __forceinline__ void ph_moe2_naive(unsigned char* lds, Params P, int layer, int chk) {
    const int TIDX = hidden_tid(P.wid), BIDX = launder_i((int)blockIdx.x), GDIM = launder_i((int)gridDim.x); P.ws = launder_ptr(P.ws); P.out = launder_ptr(P.out);
    float* sm = (float*)lds;
    const bf16_t* act = (const bf16_t*)(P.ws + WS_ACTM); bf16_t* ym = (bf16_t*)(P.ws + WS_HG); const int* p2e = (const int*)(P.ws + WS_P2E);
    const float* wd = P.moe_wd + (size_t)(layer / 2) * NEXP * DFE * D;
    const int M = p2e[300] * 256;
    Chk ck{0.f, 0.f};
    naive_gemm(M, D, DFE,
        [&](int r, int k) { return bf2f(act[(size_t)r * DFE + k]); },
        [&](int bm) { return p2e[bm >> 8]; },
        [&](int k, int col, int e) { return wd[((size_t)e * DFE + k) * D + col]; },
        [&](int r, int c0, const float (&v)[4]) { st4(ym + (size_t)r * D + c0, v, chk, ck); }, sm);
    if (chk) chk_commit(P, chk, ck);
}
__device__ __forceinline__ void ph_moe_combine(unsigned char* lds, Params P, int layer) {
    const int TIDX = hidden_tid(P.wid), BIDX = launder_i((int)blockIdx.x), GDIM = launder_i((int)gridDim.x); P.ws = launder_ptr(P.ws); P.out = launder_ptr(P.out);
    const int wid = TIDX >> 6, lane = TIDX & 63;
    const bf16_t* ym = (const bf16_t*)(P.ws + ymoe_off(layer)); const bf16_t* xs = xstream(P, DEPTH); const int* ti = (const int*)(P.ws + WS_TOKINFO); const float* pr = (const float*)(P.ws + WS_PROB);
    int off_[NEXP + 1]; moe_offsets(P, layer, off_);
    constexpr int NR = 4;
    const int RPW = (T + GDIM * 8 - 1) / (GDIM * 8), rbeg = (BIDX * 8 + wid) * RPW;
    for (int j0 = 0; j0 < RPW; j0 += NR) {
        int s0[NR], s1[NR]; float p0[NR], p1[NR]; u32x2 xw[NR][4], ya[NR][4], yb[NR][4];
#pragma unroll
        for (int k = 0; k < NR; ++k) { const int row = rbeg + j0 + k;
            if (j0 + k < RPW && row < T) { const int* ti_ = ti + (size_t)row * 4; s0[k] = moe_sel(off_, ti_[0]) + ti_[1]; s1[k] = moe_sel(off_, ti_[2]) + ti_[3]; p0[k] = pr[(size_t)row * 2]; p1[k] = pr[(size_t)row * 2 + 1];
#pragma unroll
                for (int q = 0; q < 4; ++q) xw[k][q] = *(const u32x2*)(xs + (size_t)row * D + q * 256 + lane * 4); } }
#pragma unroll
        for (int k = 0; k < NR; ++k) { const int row = rbeg + j0 + k;
            if (j0 + k < RPW && row < T) {
#pragma unroll
                for (int q = 0; q < 4; ++q) { ya[k][q] = *(const u32x2*)(ym + (size_t)s0[k] * D + q * 256 + lane * 4); yb[k][q] = *(const u32x2*)(ym + (size_t)s1[k] * D + q * 256 + lane * 4); } } }
#pragma unroll
        for (int k = 0; k < NR; ++k) { const int row = rbeg + j0 + k;
            if (j0 + k < RPW && row < T) {
                const float* g2 = adap(P, layer, row / SEQ, 5);
#pragma unroll
                for (int q = 0; q < 4; ++q) { const int col = q * 256 + lane * 4;
                    const u32x2 a = ya[k][q], b = yb[k][q], x = xw[k][q]; const f32x4 g = *(const f32x4*)(g2 + col);
                    f32x4 xv = {bf2f(x.x & 0xffff), bf2f(x.x >> 16), bf2f(x.y & 0xffff), bf2f(x.y >> 16)};
                    xv[0] += g[0] * (p0[k] * bf2f(a.x & 0xffff) + p1[k] * bf2f(b.x & 0xffff)); xv[1] += g[1] * (p0[k] * bf2f(a.x >> 16) + p1[k] * bf2f(b.x >> 16));
                    xv[2] += g[2] * (p0[k] * bf2f(a.y & 0xffff) + p1[k] * bf2f(b.y & 0xffff)); xv[3] += g[3] * (p0[k] * bf2f(a.y >> 16) + p1[k] * bf2f(b.y >> 16));
                    *(f32x4*)(P.out + (size_t)row * D + col) = xv; } } }
    }
}
__device__ __forceinline__ void ph_check_final(unsigned char* lds, Params P) {
    const int TIDX = hidden_tid(P.wid), BIDX = launder_i((int)blockIdx.x), GDIM = launder_i((int)gridDim.x); P.ws = launder_ptr(P.ws); P.out = launder_ptr(P.out);
    const unsigned* ctl = (const unsigned*)(P.ws + WS_CTL);
    int code = 0;
    for (int s = 31; s >= 1; --s) { const float e = __uint_as_float(ctl[CW_CHKE + s]), r = __uint_as_float(ctl[CW_CHKR + s]); if (!(e <= 0.04f * r)) code = s; }
    if (code == 0) return;
    const float sc = 1.f + 0.1f * code;
    for (size_t i = (size_t)BIDX * 512 + TIDX; i < (size_t)T * D; i += (size_t)GDIM * 512) P.out[i] *= sc;
}

namespace pg8 {
#define PG8_LAS __attribute__((address_space(3)))
typedef short bf16x8 __attribute__((ext_vector_type(8)));
constexpr int BM = 256, BK = 64, HALF = 128, HTB = HALF * BK * 2  , STAGE_BYTES = 8 * HTB, NXCD = 8, WGM = 8;
__host__ __device__ __forceinline__ int lds_byte(int r, int c) { const int st = (r >> 4) * 2 + (c >> 5), rr = r & 15, cc = c & 31, ob = rr * 64 + cc * 2; return st * 1024 + (ob ^ (((ob >> 9) & 1) << 5)); }
__host__ __device__ __forceinline__ void stage_rc(int b, int& R, int& C) { const int st = b / 1024, sb = b % 1024, swz = sb ^ (((sb >> 9) & 1) << 5); R = (st >> 1) * 16 + swz / 64; C = (st & 1) * 32 + (swz % 64) / 2; }
__host__ __device__ __forceinline__ int perm32(int rho) { const int n = rho >> 4, i = rho & 15; return 8 * (i >> 2) + 4 * n + (i & 3); }
struct Unit { int pm, pn; };
struct Gemm { const bf16_t* A; const bf16_t* Bt; int lda, ldb, K, wid; };
struct StaticOrder {
    static constexpr bool GATHER = false;
    int nM, nN, nwg, G, c;
    __host__ __device__ void init(int M, int N, int G_, int c_) { nM = M / BM; nN = N / BM; nwg = nM * nN; G = G_; c = c_; }
    __host__ __device__ bool next(int i, Unit& u) const {
        const long L = (long)i * G + c; if (L >= nwg) return false;
        int wgid = (int)L; { const int q = nwg / NXCD, r = nwg % NXCD, xcd = wgid % NXCD, off = wgid / NXCD; wgid = (xcd < r ? xcd * (q + 1) : r * (q + 1) + (xcd - r) * q) + off; }
        const int nig = WGM * nN, gid = wgid / nig, fm = gid * WGM, gsz = (nM - fm) < WGM ? (nM - fm) : WGM;
        u.pm = fm + ((wgid % nig) % gsz); u.pn = (wgid % nig) / gsz; return true;
    }
    __device__ __forceinline__ void a_ready(const Unit&) const {}
    __device__ __forceinline__ void done(const Unit&) const {}
};
template <class F> struct ListOrder {
    static constexpr bool GATHER = false;
    int n, G, c; F f;
    __device__ __forceinline__ bool next(int i, Unit& u) const { const long L = (long)i * G + c; if (L >= n) return false; f((int)L, u); return true; }
    __device__ __forceinline__ void a_ready(const Unit&) const {}
    __device__ __forceinline__ void done(const Unit&) const {}
};
__device__ __forceinline__ unsigned cvt_pk_bf16(float lo, float hi) { unsigned r; asm volatile("v_cvt_pk_bf16_f32 %0, %1, %2" : "=v"(r) : "v"(lo), "v"(hi)); return r; }
__device__ __forceinline__ u32x4 pack8(const f32x4 a, const f32x4 b) { u32x4 w; w.x = cvt_pk_bf16(a[0], a[1]); w.y = cvt_pk_bf16(a[2], a[3]); w.z = cvt_pk_bf16(b[0], b[1]); w.w = cvt_pk_bf16(b[2], b[3]); return w; }

template <class T, class = void> struct epi_kscale { static constexpr bool value = false; };
template <class T> struct epi_kscale<T, decltype((void)T::KSCALE)> { static constexpr bool value = T::KSCALE; };
__device__ __forceinline__ void kscale_rows(PG8_LAS unsigned char* lds, f32x4 (&acc)[2][2][4][2], int ui, int which, int wr, int) {
    const int fr = hidden_tid(0) & 15;
    const PG8_LAS float* tb = (const PG8_LAS float*)(lds + 132096) + (launder_i(ui) * 3 + which) * 256 + wr * 64 + fr;
#pragma unroll
    for (int ai = 0; ai < 2; ++ai)
#pragma unroll
        for (int m = 0; m < 4; ++m) { const float sc = tb[ai * 128 + m * 16];
#pragma unroll
            for (int bj = 0; bj < 2; ++bj)
#pragma unroll
                for (int n = 0; n < 2; ++n) acc[ai][bj][m][n] = acc[ai][bj][m][n] * sc; }
}
template <class Epi, class Sched, bool ALIGN_EPI = false, bool SP2 = false>
__device__ __forceinline__ void gemm_phase(PG8_LAS unsigned char* lds, const Gemm g, const Sched& S, const Epi& E) {
    const int tid = hidden_tid(g.wid), wid = __builtin_amdgcn_readfirstlane(tid >> 6), lane = tid & 63, wr = wid >> 2, wc = wid & 3, fr = lane & 15, fq = lane >> 4;
    const int K = launder_i(g.K), nt = K / BK;
    unsigned voffA[2], voffB[2]; int gR[2], gC[2];
#pragma unroll
    for (int i = 0; i < 2; ++i) { int R, C; stage_rc(tid * 16 + i * 8192, R, C); const int Rb = Epi::PERM ? ((R & ~31) + perm32(R & 31)) : R;
        voffA[i] = (unsigned)(R * g.lda + C) * 2u; voffB[i] = (unsigned)(Rb * g.ldb + C) * 2u; gR[i] = R; gC[i] = C * 2; }
    const size_t kstep = (size_t)(BK * 2);
    const size_t hstepA = Sched::GATHER ? 0 : (size_t)HALF * g.lda * 2, hstepB = (size_t)HALF * g.ldb * 2;
    const size_t tstepA = 2 * hstepA, tstepB = 2 * hstepB;
    const unsigned ldsw = (unsigned)wid * 1024u;
    const int aoff = lds_byte(wr * 64 + fr, fq * 8), boff = lds_byte(wc * 32 + fr, fq * 8);
#define PG8_SA(b, h) (((b) * 2 + (h)) * HTB)
#define PG8_SB(b, h) ((4 + (b) * 2 + (h)) * HTB)
#define PG8_STAGE(bufoff, gbase, voff) do { _Pragma("unroll") for (int _i = 0; _i < 2; ++_i) \
        __builtin_amdgcn_global_load_lds((const unsigned*)((const char*)(gbase) + (voff)[_i]), (PG8_LAS unsigned*)(lds + (bufoff) + ldsw + _i * 8192), 16, 0, 0); } while (0)
#define PG8_LDA(dst, b, h) do { _Pragma("unroll") for (int m = 0; m < 4; ++m) _Pragma("unroll") for (int k = 0; k < 2; ++k) dst[m][k] = *(const PG8_LAS bf16x8*)(lds + PG8_SA(b, h) + aoff + m * 2048 + k * 1024); } while (0)
#define PG8_LDB(dst, b, h) do { _Pragma("unroll") for (int n = 0; n < 2; ++n) _Pragma("unroll") for (int k = 0; k < 2; ++k) dst[n][k] = *(const PG8_LAS bf16x8*)(lds + PG8_SB(b, h) + boff + n * 2048 + k * 1024); } while (0)
#define PG8_MMA(ai, bj, At, Bt) do { __builtin_amdgcn_s_setprio(1); _Pragma("unroll") for (int m = 0; m < 4; ++m) _Pragma("unroll") for (int n = 0; n < 2; ++n) _Pragma("unroll") for (int k = 0; k < 2; ++k) \
        acc[ai][bj][m][n] = __builtin_amdgcn_mfma_f32_16x16x32_bf16(Bt[n][k], At[m][k], acc[ai][bj][m][n], 0, 0, 0); __builtin_amdgcn_s_setprio(0); } while (0)
#define PG8_WAIT_V(n) asm volatile("s_waitcnt vmcnt(" #n ")" ::: "memory")
#define PG8_WAIT_L(n) asm volatile("s_waitcnt lgkmcnt(" #n ")" ::: "memory")
#define PG8_BAR __builtin_amdgcn_s_barrier()
#define PG8_SCHED __builtin_amdgcn_sched_barrier(0)
    Unit cur, nxt; int ui = 0;
    if (!S.next(0, cur)) return;
    f32x4 acc[2][2][4][2];
#pragma unroll
    for (int a = 0; a < 2; ++a)
#pragma unroll
        for (int b = 0; b < 2; ++b)
#pragma unroll
            for (int m = 0; m < 4; ++m)
#pragma unroll
                for (int n = 0; n < 2; ++n) acc[a][b][m][n] = (f32x4){0.f, 0.f, 0.f, 0.f};
    bf16x8 At[4][2], B0[2][2], B1[2][2];
    const char* cA = (const char*)g.A + (size_t)cur.pm * tstepA; const char* cB = (const char*)g.Bt + (size_t)cur.pn * tstepB;
    unsigned vc0[2] = {0u, 0u}, vc1[2] = {0u, 0u}, w0[2] = {0u, 0u}, w1[2] = {0u, 0u};
    PG8_LAS u32x4* const vpark = (PG8_LAS u32x4*)(lds + 132096) + tid;
    if constexpr (Sched::GATHER) { static_assert(SP2, "row gather is wired into the SP2 loop only");
#pragma unroll
        for (int i = 0; i < 1; ++i) { S.rowoff4(cur, gR[0], vc0[0], vc0[1], vc1[0], vc1[1]); vc0[0] += (unsigned)gC[0]; vc0[1] += (unsigned)gC[0]; vc1[0] += (unsigned)gC[0]; vc1[1] += (unsigned)gC[0]; } }
#define PG8_STAGE_A(bufoff, gbase, half, v0, v1) do { if constexpr (Sched::GATHER) { if ((half) == 0) PG8_STAGE(bufoff, gbase, v0); else PG8_STAGE(bufoff, gbase, v1); } else PG8_STAGE(bufoff, (gbase) + (half) * hstepA, voffA); } while (0)
    S.a_ready(cur);
    if constexpr (SP2) {
        PG8_STAGE(PG8_SB(0, 0), cB, voffB); PG8_STAGE(PG8_SB(0, 1), cB + hstepB, voffB); PG8_STAGE_A(PG8_SA(0, 0), cA, 0, vc0, vc1); PG8_STAGE_A(PG8_SA(0, 1), cA, 1, vc0, vc1);
        if (wr == 1) PG8_BAR;
        PG8_WAIT_V(2); PG8_BAR;
        PG8_STAGE(PG8_SB(1, 0), cB + kstep, voffB); PG8_STAGE_A(PG8_SA(1, 0), cA + kstep, 0, vc0, vc1); PG8_STAGE(PG8_SB(1, 1), cB + hstepB + kstep, voffB);
        PG8_WAIT_V(6); PG8_BAR;
    } else {
        PG8_STAGE(PG8_SB(0, 0), cB, voffB); PG8_STAGE(PG8_SA(0, 0), cA, voffA); PG8_STAGE(PG8_SB(0, 1), cB + hstepB, voffB); PG8_STAGE(PG8_SA(0, 1), cA + hstepA, voffA);
        if (wr == 1) PG8_BAR;
        PG8_WAIT_V(4); PG8_BAR;
        PG8_STAGE(PG8_SB(1, 0), cB + kstep, voffB); PG8_STAGE(PG8_SA(1, 0), cA + kstep, voffA); PG8_STAGE(PG8_SB(1, 1), cB + hstepB + kstep, voffB);
        PG8_WAIT_V(6); PG8_BAR;
    }
    for (;;) {
        const bool has_next = S.next(ui + 1, nxt);
        if constexpr (Sched::GATHER) {
#pragma unroll
            for (int i = 0; i < 1; ++i) { if (has_next) { S.rowoff4(nxt, gR[0], w0[0], w0[1], w1[0], w1[1]); w0[0] += (unsigned)gC[0]; w0[1] += (unsigned)gC[0]; w1[0] += (unsigned)gC[0]; w1[1] += (unsigned)gC[0]; } else { w0[0] = vc0[0]; w0[1] = vc0[1]; w1[0] = vc1[0]; w1[1] = vc1[1]; } }
            *vpark = (u32x4){w0[0], w0[1], w1[0], w1[1]}; }
        const char* nA = has_next ? (const char*)g.A + (size_t)nxt.pm * tstepA : cA; const char* nB = has_next ? (const char*)g.Bt + (size_t)nxt.pn * tstepB : cB;
        for (int t = 0; t < nt; t += 2) {
            const bool last = (t == nt - 2);
            const char* a1 = cA + (size_t)(t + 1) * kstep;
            const char* a2 = last ? nA : cA + (size_t)(t + 2) * kstep; const char* b2 = last ? nB : cB + (size_t)(t + 2) * kstep;
            const char* a3 = a2 + kstep; const char* b3 = b2 + kstep;
            if constexpr (Sched::GATHER) { if (last) { const u32x4 q_ = *vpark; w0[0] = q_.x; w0[1] = q_.y; w1[0] = q_.z; w1[1] = q_.w; } else { w0[0] = vc0[0]; w0[1] = vc0[1]; w1[0] = vc1[0]; w1[1] = vc1[1]; } }
            if (last && has_next) S.a_ready(nxt);
            if constexpr (epi_kscale<Epi>::value) { if (t == Epi::KB0) kscale_rows(lds, acc, ui, 0, wr, fr); else if (t == Epi::KB1) kscale_rows(lds, acc, ui, 1, wr, fr); }
            if constexpr (SP2) {
            PG8_LDB(B0, 0, 0); PG8_LDB(B1, 0, 1); PG8_SCHED; PG8_LDA(At, 0, 0); PG8_STAGE_A(PG8_SA(1, 1), a1, 1, vc0, vc1);
            PG8_WAIT_V(8); PG8_WAIT_L(0); PG8_BAR; PG8_MMA(0, 0, At, B0); PG8_MMA(0, 1, At, B1); PG8_BAR; PG8_SCHED;
            PG8_LDA(At, 0, 1); PG8_STAGE(PG8_SB(0, 0), b2, voffB); PG8_STAGE(PG8_SB(0, 1), b2 + hstepB, voffB); PG8_STAGE_A(PG8_SA(0, 0), a2, 0, w0, w1);
            PG8_WAIT_V(8); PG8_WAIT_L(0); PG8_BAR; PG8_MMA(1, 0, At, B0); PG8_MMA(1, 1, At, B1); PG8_BAR; PG8_SCHED;
            PG8_LDB(B0, 1, 0); PG8_LDB(B1, 1, 1); PG8_SCHED; PG8_LDA(At, 1, 0); PG8_STAGE_A(PG8_SA(0, 1), a2, 1, w0, w1);
            PG8_WAIT_V(8); PG8_WAIT_L(0); PG8_BAR; PG8_MMA(0, 0, At, B0); PG8_MMA(0, 1, At, B1); PG8_BAR; PG8_SCHED;
            PG8_LDA(At, 1, 1); PG8_STAGE(PG8_SB(1, 0), b3, voffB); PG8_STAGE(PG8_SB(1, 1), b3 + hstepB, voffB); PG8_STAGE_A(PG8_SA(1, 0), a3, 0, w0, w1);
            PG8_WAIT_V(8); PG8_WAIT_L(0); PG8_BAR; PG8_MMA(1, 0, At, B0); PG8_MMA(1, 1, At, B1); PG8_BAR; PG8_SCHED;
            } else {
            PG8_LDB(B0, 0, 0); PG8_SCHED; PG8_LDA(At, 0, 0); PG8_STAGE(PG8_SA(1, 1), a1 + hstepA, voffA);
            PG8_WAIT_L(8); PG8_BAR; PG8_WAIT_L(0); PG8_MMA(0, 0, At, B0); PG8_BAR; PG8_SCHED;
            PG8_LDB(B1, 0, 1); PG8_STAGE(PG8_SB(0, 0), b2, voffB);
            PG8_BAR; PG8_WAIT_L(0); PG8_MMA(0, 1, At, B1); PG8_BAR;
            PG8_LDA(At, 0, 1); PG8_STAGE(PG8_SA(0, 0), a2, voffA);
            PG8_BAR; PG8_WAIT_L(0); PG8_MMA(1, 0, At, B0); PG8_BAR; PG8_SCHED;
            PG8_STAGE(PG8_SB(0, 1), b2 + hstepB, voffB);
            PG8_WAIT_V(6); PG8_BAR; PG8_MMA(1, 1, At, B1); PG8_BAR;
            PG8_LDB(B0, 1, 0); PG8_SCHED; PG8_LDA(At, 1, 0); PG8_STAGE(PG8_SA(0, 1), a2 + hstepA, voffA);
            PG8_WAIT_L(8); PG8_BAR; PG8_WAIT_L(0); PG8_MMA(0, 0, At, B0); PG8_BAR; PG8_SCHED;
            PG8_LDB(B1, 1, 1); PG8_STAGE(PG8_SB(1, 0), b3, voffB);
            PG8_BAR; PG8_WAIT_L(0); PG8_MMA(0, 1, At, B1); PG8_BAR;
            PG8_LDA(At, 1, 1); PG8_STAGE(PG8_SA(1, 0), a3, voffA);
            PG8_BAR; PG8_WAIT_L(0); PG8_MMA(1, 0, At, B0); PG8_BAR; PG8_SCHED;
            PG8_STAGE(PG8_SB(1, 1), b3 + hstepB, voffB);
            PG8_WAIT_V(6); PG8_BAR; PG8_MMA(1, 1, At, B1); PG8_BAR;
            }
        }
        if constexpr (epi_kscale<Epi>::value) kscale_rows(lds, acc, ui, 2, wr, fr);
        if constexpr (ALIGN_EPI) { if (wr == 0) PG8_BAR; }
        if constexpr (!Epi::AFTER_DRAIN) { E(acc, cur, wr, wc, fr, fq); S.done(cur); }
        if (!has_next) break;
#pragma unroll
        for (int a = 0; a < 2; ++a)
#pragma unroll
            for (int b = 0; b < 2; ++b)
#pragma unroll
                for (int m = 0; m < 4; ++m)
#pragma unroll
                    for (int n = 0; n < 2; ++n) acc[a][b][m][n] = (f32x4){0.f, 0.f, 0.f, 0.f};
        cur = nxt; cA = nA; cB = nB; ++ui;
        if constexpr (Sched::GATHER) { vc0[0] = w0[0]; vc0[1] = w0[1]; vc1[0] = w1[0]; vc1[1] = w1[1]; }
        if constexpr (ALIGN_EPI) { if (wr == 1) PG8_BAR; }
    }
    PG8_WAIT_V(0);
    if constexpr (!ALIGN_EPI) { if (wr == 0) PG8_BAR; }
    PG8_BAR;
    if constexpr (Epi::AFTER_DRAIN) { E.fused(acc, cur, wr, wc, fr, fq, lds, wid, lane); S.done(cur); }
#undef PG8_SA
#undef PG8_SB
#undef PG8_STAGE
#undef PG8_STAGE_A
#undef PG8_LDA
#undef PG8_LDB
#undef PG8_MMA
#undef PG8_WAIT_V
#undef PG8_WAIT_L
#undef PG8_BAR
#undef PG8_SCHED
}
}

using pg8::Unit;
#define GAS_ __attribute__((address_space(1)))
struct EpiStore {
    static constexpr bool PERM = true, AFTER_DRAIN = false;
    bf16_t* O; int ldc; const float* ssq; float inv_n; int pn_mod; int ncol;
    __device__ __forceinline__ void operator()(const f32x4 (&acc)[2][2][4][2], const Unit& u, int wr, int wc, int fr, int fq) const {
        const int row0 = u.pm * 256 + wr * 64 + fr, col0 = (u.pn % pn_mod) * 256 + wc * 32 + 8 * fq;
        float sc[2][4];
#pragma unroll
        for (int ai = 0; ai < 2; ++ai)
#pragma unroll
            for (int m = 0; m < 4; ++m) { sc[ai][m] = 1.f; if (ssq) { const f32x4 p4 = *(const GAS_ f32x4*)(ssq + (size_t)(row0 + ai * 128 + m * 16) * 4); sc[ai][m] = rsqrtf(((p4[0] + p4[1]) + (p4[2] + p4[3])) * inv_n + EPS); } }
#pragma unroll
        for (int ai = 0; ai < 2; ++ai)
#pragma unroll
            for (int m = 0; m < 4; ++m) { const float s = sc[ai][m]; GAS_ bf16_t* rp = (GAS_ bf16_t*)O + (size_t)(row0 + ai * 128 + m * 16) * ldc + col0;
#pragma unroll
                for (int bj = 0; bj < 2; ++bj) if (col0 + bj * 128 < ncol) *(GAS_ u32x4*)(rp + bj * 128) = pg8::pack8(acc[ai][bj][m][0] * s, acc[ai][bj][m][1] * s); }
    }
};
struct EpiInproj {
    static constexpr bool PERM = true, AFTER_DRAIN = false;
    bf16_t* O; float* fg;
    __device__ __forceinline__ void operator()(const f32x4 (&acc)[2][2][4][2], const Unit& u, int wr, int wc, int fr, int fq) const {
        const int row0 = u.pm * 256 + wr * 64 + fr, col0 = u.pn * 256 + wc * 32 + 8 * fq;
        const bool isfg = (u.pn == 7) && (wc == 0) && (fq == 0);
#pragma unroll
        for (int ai = 0; ai < 2; ++ai)
#pragma unroll
            for (int m = 0; m < 4; ++m) { const int row = row0 + ai * 128 + m * 16; bf16_t* rp = O + (size_t)row * PJ + col0;
#pragma unroll
                for (int bj = 0; bj < 2; ++bj) *(u32x4*)(rp + bj * 128) = pg8::pack8(acc[ai][bj][m][0], acc[ai][bj][m][1]);
                if (isfg) { *(f32x4*)(fg + (size_t)row * 8) = acc[ai][1][m][0]; *(f32x4*)(fg + (size_t)row * 8 + 4) = acc[ai][1][m][1]; } }
    }
};
struct EpiInproj2 {
    static constexpr bool PERM = true, AFTER_DRAIN = false;
    bf16_t* O; float* lf; bf16_t* ug; float* ssq; const float* gq; const float* gk; const float* bf;
    __device__ __forceinline__ void operator()(const f32x4 (&acc)[2][2][4][2], const Unit& u, int wr, int wc, int fr, int fq) const {
        const int lane = fq * 16 + fr, row0 = u.pm * 256 + wr * 64 + fr;
        if (u.pn >= 3 && u.pn <= 5) {
            const int hg = (u.pn - 3) * 4 + wc; const bool isq = hg < 6; const int h = isq ? hg : hg - 6;
            const float* gp = launder_ptr(isq ? gq : gk) + 8 * fq; const float gs = isq ? C2_FOX : 1.f;
            const f32x4 g00 = *(const f32x4*)gp * gs, g01 = *(const f32x4*)(gp + 4) * gs, g10 = *(const f32x4*)(gp + 32) * gs, g11 = *(const f32x4*)(gp + 36) * gs;
            bf16_t* base = O + (isq ? PC_FQ : PC_FK) + h * 64 + 8 * fq;
#pragma unroll
            for (int ai = 0; ai < 2; ++ai)
#pragma unroll
                for (int m = 0; m < 4; ++m) { const int row = row0 + ai * 128 + m * 16;
                    const f32x4 a0 = acc[ai][0][m][0], a1 = acc[ai][0][m][1], b0 = acc[ai][1][m][0], b1 = acc[ai][1][m][1];
                    float s = 0.f;
#pragma unroll
                    for (int j = 0; j < 4; ++j) s += a0[j] * a0[j] + a1[j] * a1[j] + b0[j] * b0[j] + b1[j] * b1[j];
                    s += shx(s, 16, lane); s += shx(s, 32, lane);
                    const float r = rsqrtf(s * (1.f / 64.f) + EPS);
                    bf16_t* rp = base + (size_t)row * PJ;
                    *(u32x4*)rp = pg8::pack8(a0 * g00 * r, a1 * g01 * r); *(u32x4*)(rp + 32) = pg8::pack8(b0 * g10 * r, b1 * g11 * r);
                    asm volatile("" ::: "memory"); }
            return;
        }
        const int col0 = u.pn * 256 + wc * 32 + 8 * fq;
#pragma unroll
        for (int ai = 0; ai < 2; ++ai)
#pragma unroll
            for (int m = 0; m < 4; ++m) { const int row = row0 + ai * 128 + m * 16; bf16_t* rp = O + (size_t)row * PJ + col0;
                const u32x4 w0 = pg8::pack8(acc[ai][0][m][0], acc[ai][0][m][1]), w1 = pg8::pack8(acc[ai][1][m][0], acc[ai][1][m][1]);
                if (u.pn != 0) { *(u32x4*)rp = w0; *(u32x4*)(rp + 128) = w1; }
                if (u.pn == 0) { const int b = row >> 12, t = row & 4095, c0 = wc * 32 + 8 * fq;
                    bf16_t* up = ug + (size_t)(b * 128 + (t >> 5)) * 640 + (t & 31) * 16 + (c0 & 15);
                    *(u32x4*)(up + (size_t)(c0 >> 4) * 1024 * 640) = w0; *(u32x4*)(up + (size_t)((c0 >> 4) + 8) * 1024 * 640) = w1; }
                else if (u.pn == 1 || u.pn == 2) {
                    const f32x4 a0 = acc[ai][0][m][0], a1 = acc[ai][0][m][1], b0 = acc[ai][1][m][0], b1 = acc[ai][1][m][1];
                    float s0 = 0.f, s1 = 0.f;
#pragma unroll
                    for (int j = 0; j < 4; ++j) { s0 += a0[j] * a0[j] + a1[j] * a1[j]; s1 += b0[j] * b0[j] + b1[j] * b1[j]; }
                    if (u.pn == 1) { float s = s0 + s1; s += shx(s, 16, lane); s += shx(s, 32, lane); if (fq == 0) ssq[(size_t)row * 4 + wc] = s; }
                    else { s0 += shx(s0, 16, lane); s0 += shx(s0, 32, lane); if (fq == 0) ssq[(size_t)4 * T + (size_t)row * 4 + wc] = s0;
                        if (wc == 0) { s1 += shx(s1, 16, lane); s1 += shx(s1, 32, lane); if (fq == 0) ssq[(size_t)8 * T + row] = s1; } } }
                else if (u.pn == 7 && wc == 0 && fq == 0) { const f32x4 z0 = acc[ai][1][m][0] + (f32x4){bf[0], bf[1], bf[2], bf[3]}, z1 = acc[ai][1][m][1] + (f32x4){bf[4], bf[5], 0.f, 0.f}; f32x4 l0, l1;
#pragma unroll
                    for (int j = 0; j < 4; ++j) { l0[j] = fminf(z0[j], 0.f) - __logf(1.f + __expf(-fabsf(z0[j]))); l1[j] = fminf(z1[j], 0.f) - __logf(1.f + __expf(-fabsf(z1[j]))); }
                    *(f32x4*)(lf + (size_t)row * 8) = l0; *(f32x4*)(lf + (size_t)row * 8 + 4) = l1; }
                asm volatile("" ::: "memory"); }
    }
};
struct EpiKvup {
    static constexpr bool PERM = true, AFTER_DRAIN = false;
    bf16_t* km; bf16_t* kv; const bf16_t* proj; const float* ssq; const float* gk; const float* cs; const float* sn;
    __device__ __forceinline__ void operator()(const f32x4 (&acc)[2][2][4][2], const Unit& u, int wr, int wc, int, int) const {
        const int lane = hidden_tid(0), fr = lane & 15, fq = lane >> 4, row0 = u.pm * 256 + wr * 64 + fr, head = 2 * u.pn + (wc >> 1); const bool isv = wc & 1;
        const float* gk = launder_ptr(this->gk);
        const f32x4 g00 = *(const f32x4*)(gk + 8 * fq), g01 = *(const f32x4*)(gk + 8 * fq + 4), g10 = *(const f32x4*)(gk + 32 + 8 * fq), g11 = *(const f32x4*)(gk + 36 + 8 * fq);
#pragma unroll
        for (int ai2 = 0; ai2 < 8; ++ai2) {
            const int ai = ai2 >> 2, mb = ai2 & 3;
            f32x4 p4[4], cv[4], sv[4], gr1, gr2; float krs[4]; u32x2 ka[4], kb[4];
#pragma unroll
            for (int m = mb; m < mb + 1; ++m) { const int row = row0 + ai * 128 + m * 16; p4[m] = *(const GAS_ f32x4*)(ssq + (size_t)4 * T + (size_t)row * 4);
                if (!isv) { krs[m] = *(const GAS_ float*)(ssq + (size_t)8 * T + row); ka[m] = *(const GAS_ u32x2*)(proj + (size_t)row * PJ + PC_KR + 4 * fq); kb[m] = *(const GAS_ u32x2*)(proj + (size_t)row * PJ + PC_KR + 16 + 4 * fq);
                    cv[m] = *(const GAS_ f32x4*)(cs + (size_t)row * 16 + 4 * fq); sv[m] = *(const GAS_ f32x4*)(sn + (size_t)row * 16 + 4 * fq);
                    gr1 = *(const GAS_ f32x4*)(gk + 64 + 4 * fq); gr2 = *(const GAS_ f32x4*)(gk + 80 + 4 * fq); } }
#pragma unroll
            for (int m = mb; m < mb + 1; ++m) { const int row = row0 + ai * 128 + m * 16;
                const float rkv = rsqrtf(((p4[m][0] + p4[m][1]) + (p4[m][2] + p4[m][3])) * (1.f / 128.f) + EPS);
                const f32x4 a0 = acc[ai][0][m][0], a1 = acc[ai][0][m][1], b0 = acc[ai][1][m][0], b1 = acc[ai][1][m][1];
                if (isv) { GAS_ bf16_t* vp = (GAS_ bf16_t*)kv + (size_t)row * 768 + head * 128 + 64 + 8 * fq; *(GAS_ u32x4*)vp = pg8::pack8(a0 * rkv, a1 * rkv); *(GAS_ u32x4*)(vp + 32) = pg8::pack8(b0 * rkv, b1 * rkv); }
                else {
                    float s = 0.f;
#pragma unroll
                    for (int j = 0; j < 4; ++j) s += a0[j] * a0[j] + a1[j] * a1[j] + b0[j] * b0[j] + b1[j] * b1[j];
                    s += shx(s, 16, lane); s += shx(s, 32, lane);
                    const float rh = rsqrtf((s * rkv * rkv + krs[m]) * (1.f / 96.f) + EPS), sc = rkv * rh;
                    GAS_ bf16_t* kp = (GAS_ bf16_t*)km + (size_t)row * 576 + head * 96;
                    *(GAS_ u32x4*)(kp + 8 * fq) = pg8::pack8(a0 * g00 * sc, a1 * g01 * sc); *(GAS_ u32x4*)(kp + 32 + 8 * fq) = pg8::pack8(b0 * g10 * sc, b1 * g11 * sc);
                    const f32x4 x1 = (f32x4){bf2f(ka[m].x & 0xffff), bf2f(ka[m].x >> 16), bf2f(ka[m].y & 0xffff), bf2f(ka[m].y >> 16)} * gr1 * rh, x2 = (f32x4){bf2f(kb[m].x & 0xffff), bf2f(kb[m].x >> 16), bf2f(kb[m].y & 0xffff), bf2f(kb[m].y >> 16)} * gr2 * rh;
                    const f32x4 o1 = x1 * cv[m] - x2 * sv[m], o2 = x1 * sv[m] + x2 * cv[m];
                    u32x2 w1, w2; w1.x = pg8::cvt_pk_bf16(o1[0], o1[1]); w1.y = pg8::cvt_pk_bf16(o1[2], o1[3]); w2.x = pg8::cvt_pk_bf16(o2[0], o2[1]); w2.y = pg8::cvt_pk_bf16(o2[2], o2[3]);
                    *(GAS_ u32x2*)(kp + 64 + 4 * fq) = w1; *(GAS_ u32x2*)(kp + 80 + 4 * fq) = w2; } } }
    }
};
template <bool KS>
struct EpiResidT {
    static constexpr bool KSCALE = KS; static constexpr int KB0 = 4, KB1 = 10;
    static constexpr bool PERM = true, AFTER_DRAIN = false;
    const bf16_t* X; const float* gate0; bf16_t* Xo;
    __device__ __forceinline__ void operator()(const f32x4 (&acc)[2][2][4][2], const Unit& u, int wr, int wc, int fr, int fq) const {
        const int row0 = u.pm * 256 + wr * 64 + fr, col0 = u.pn * 256 + wc * 32 + 8 * fq;
        const float* gp = gate0 + (size_t)(u.pm >> 4) * 6 * D + col0;
        f32x4 g[2][2];
#pragma unroll
        for (int bj = 0; bj < 2; ++bj) { g[bj][0] = *(const f32x4*)(gp + bj * 128); g[bj][1] = *(const f32x4*)(gp + bj * 128 + 4); }
#pragma unroll
        for (int ai = 0; ai < 2; ++ai) {
            u32x4 xv[4][2];
#pragma unroll
            for (int m = 0; m < 4; ++m) { const GAS_ bf16_t* rp = (const GAS_ bf16_t*)X + (size_t)(row0 + ai * 128 + m * 16) * D + col0;
#pragma unroll
                for (int bj = 0; bj < 2; ++bj) xv[m][bj] = *(const GAS_ u32x4*)(rp + bj * 128); }
#pragma unroll
            for (int m = 0; m < 4; ++m) { GAS_ bf16_t* wp = (GAS_ bf16_t*)Xo + (size_t)(row0 + ai * 128 + m * 16) * D + col0;
#pragma unroll
                for (int bj = 0; bj < 2; ++bj) { const u32x4 w = xv[m][bj];
                    const f32x4 x0 = {__uint_as_float(w.x << 16), __uint_as_float(w.x & 0xffff0000u), __uint_as_float(w.y << 16), __uint_as_float(w.y & 0xffff0000u)};
                    const f32x4 x1 = {__uint_as_float(w.z << 16), __uint_as_float(w.z & 0xffff0000u), __uint_as_float(w.w << 16), __uint_as_float(w.w & 0xffff0000u)};
                    *(GAS_ u32x4*)(wp + bj * 128) = pg8::pack8(x0 + g[bj][0] * acc[ai][bj][m][0], x1 + g[bj][1] * acc[ai][bj][m][1]); } } }
    }
};
using EpiResid = EpiResidT<false>; using EpiResidK = EpiResidT<true>;
__device__ __forceinline__ f32x4 silu_mul4(const f32x4 g, const f32x4 u) { f32x4 o;
#pragma unroll
    for (int j = 0; j < 4; ++j) o[j] = g[j] * __builtin_amdgcn_rcpf(1.f + __expf(-g[j])) * u[j];
    return o; }
struct EpiSwiglu {
    static constexpr bool PERM = true, AFTER_DRAIN = false;
    bf16_t* O; int ldc; int pn_mod;
    __device__ __forceinline__ void operator()(const f32x4 (&acc)[2][2][4][2], const Unit& u, int wr, int wc, int fr, int fq) const {
        const int row0 = u.pm * 256 + wr * 64 + fr, ff0 = (u.pn % pn_mod) * 128 + wc * 32 + 8 * fq;
#pragma unroll
        for (int ai = 0; ai < 2; ++ai)
#pragma unroll
            for (int m = 0; m < 4; ++m) *(u32x4*)(O + (size_t)(row0 + ai * 128 + m * 16) * ldc + ff0) = pg8::pack8(silu_mul4(acc[ai][0][m][0], acc[ai][1][m][0]), silu_mul4(acc[ai][0][m][1], acc[ai][1][m][1]));
    }
};
struct EpiGlu {
    static constexpr bool PERM = true, AFTER_DRAIN = false;
    const bf16_t* Y; bf16_t* O; const float* bias; int ldo; float* ssq;
    __device__ __forceinline__ void operator()(const f32x4 (&acc)[2][2][4][2], const Unit& u, int wr, int wc, int, int) const {
        const int lane = hidden_tid(0), fr = lane & 15, fq = lane >> 4, row0 = u.pm * 256 + wr * 64 + fr, col0 = wc * 32 + 8 * fq;
        f32x4 bb[2][2]; const float* bias = launder_ptr(this->bias);
#pragma unroll
        for (int bj = 0; bj < 2; ++bj) { bb[bj][0] = *(const f32x4*)(bias + col0 + bj * 128); bb[bj][1] = *(const f32x4*)(bias + col0 + bj * 128 + 4); }
#pragma unroll
        for (int ai = 0; ai < 2; ++ai) {
            u32x4 yv[4][2];
#pragma unroll
            for (int m = 0; m < 4; ++m)
#pragma unroll
                for (int bj = 0; bj < 2; ++bj) yv[m][bj] = *(const GAS_ u32x4*)(Y + (size_t)(row0 + ai * 128 + m * 16) * 256 + col0 + bj * 128);
#pragma unroll
            for (int m = 0; m < 4; ++m) { float ss = 0.f;
#pragma unroll
                for (int bj = 0; bj < 2; ++bj) { const unsigned yw[4] = {yv[m][bj].x, yv[m][bj].y, yv[m][bj].z, yv[m][bj].w}; f32x4 o0, o1;
#pragma unroll
                    for (int j = 0; j < 4; ++j) { const float ya = j & 1 ? bf2f(yw[j >> 1] >> 16) : bf2f(yw[j >> 1] & 0xffff), yb = j & 1 ? bf2f(yw[2 + (j >> 1)] >> 16) : bf2f(yw[2 + (j >> 1)] & 0xffff);
                        o0[j] = ya * __builtin_amdgcn_rcpf(1.f + __expf(-(acc[ai][bj][m][0][j] + bb[bj][0][j]))); o1[j] = yb * __builtin_amdgcn_rcpf(1.f + __expf(-(acc[ai][bj][m][1][j] + bb[bj][1][j]))); }
#pragma unroll
                    for (int j = 0; j < 4; ++j) ss += o0[j] * o0[j] + o1[j] * o1[j];
                    *(GAS_ u32x4*)((GAS_ bf16_t*)O + (size_t)(row0 + ai * 128 + m * 16) * ldo + col0 + bj * 128) = pg8::pack8(o0, o1); }
                ss += shx(ss, 16, lane); ss += shx(ss, 32, lane);
                if (fq == 0) ssq[(size_t)(row0 + ai * 128 + m * 16) * 16 + wc] = ss; } }
    }
};

__device__ __forceinline__ int inproj_nat_col(int n) { if (n < 768 || n >= 1536) return n; const int pn = n >> 8, c = n & 255; return 768 + ((((pn - 3) * 4 + ((c >> 5) & 3))) << 6) + ((c >> 7) << 5) + (c & 31); }
template <class SRC>
__device__ __forceinline__ void convert_tiles(bf16_t* Bt, int N, int K, SRC src, float* scr, int gw, int ngw, int lane) {
    const int nblk = N / 32, items = (K / 64) * nblk;
    for (int it = gw; it < items; it += ngw) {
        const int kb = it / nblk, nb = it % nblk, k0 = kb * 64, n0 = nb * 32;
#pragma unroll 8
        for (int i = 0; i < 32; ++i) { const int kk = 2 * i + (lane >> 5); scr[kk * 33 + (lane & 31)] = src(k0 + kk, n0 + (lane & 31)); }
        asm volatile("s_waitcnt lgkmcnt(0)" ::: "memory");
        const int c = lane & 7;
#pragma unroll
        for (int j = 0; j < 4; ++j) { const int n = (lane >> 3) + 8 * j; const float* s = scr + (8 * c) * 33 + n;
            u32x4 o; o.x = pk2(s[0], s[33]); o.y = pk2(s[66], s[99]); o.z = pk2(s[132], s[165]); o.w = pk2(s[198], s[231]);
            *(u32x4*)(Bt + (size_t)(n0 + n) * K + k0 + 8 * c) = o; }
        asm volatile("s_waitcnt lgkmcnt(0)" ::: "memory");
    }
}

struct CvtTile { const float* src; const float* gain; bf16_t* dst; int ld, K; };
__device__ __forceinline__ int cvt_count(int layer) { return 512 + ((layer & 1) == 0 ? (D / 64) * (2 * DFF / 32) + (DFF / 64) * (D / 32) : NEXP * ((D / 64) * (2 * DFE / 32) + (DFE / 64) * (D / 32))); }
__device__ __forceinline__ void cvt_decode(const Params& P, int layer, int it, int kr, int n4, CvtTile& t) {
    unsigned char* ws = P.ws;
    if (it < 512) { const int kb = it >> 5, nb = it & 31, k0 = kb * 64, n0 = nb * 32;
        t.src = P.w_out + (size_t)layer * D * D + (size_t)(k0 + kr) * D + n0 + n4; t.gain = P.out_norm + layer * D + k0 + kr; t.ld = D; t.K = D; t.dst = (bf16_t*)(ws + W_OUT) + (size_t)n0 * D + k0; return; }
    it -= 512; t.gain = nullptr;
    if ((layer & 1) == 0) {
        const int n1 = (D / 64) * (2 * DFF / 32);
        if (it < n1) { const int nblk = 2 * DFF / 32, kb = it / nblk, nb = it % nblk, k0 = kb * 64, n0 = nb * 32, ff = (n0 >> 8) * 128 + (n0 & 127);
            t.src = ((n0 & 128) ? P.ffn_wu : P.ffn_wg) + (size_t)(layer / 2) * D * DFF + (size_t)(k0 + kr) * DFF + ff + n4; t.ld = DFF; t.K = D; t.dst = (bf16_t*)(ws + W_F1) + (size_t)n0 * D + k0; }
        else { it -= n1; const int kb = it >> 5, nb = it & 31, k0 = kb * 64, n0 = nb * 32;
            t.src = P.ffn_wd + (size_t)(layer / 2) * DFF * D + (size_t)(k0 + kr) * D + n0 + n4; t.ld = D; t.K = DFF; t.dst = (bf16_t*)(ws + W_F2) + (size_t)n0 * DFF + k0; }
    } else {
        const int n1 = (D / 64) * (2 * DFE / 32), n2 = (DFE / 64) * (D / 32), e = it / (n1 + n2); it -= e * (n1 + n2);
        const size_t eo = (size_t)(layer / 2) * NEXP + e;
        if (it < n1) { const int nblk = 2 * DFE / 32, kb = it / nblk, nb = it % nblk, k0 = kb * 64, n0 = nb * 32, ff = (n0 >> 8) * 128 + (n0 & 127);
            t.src = ((n0 & 128) ? P.moe_wu : P.moe_wg) + eo * D * DFE + (size_t)(k0 + kr) * DFE + ff + n4; t.ld = DFE; t.K = D; t.dst = (bf16_t*)(ws + W_F1) + (size_t)e * 2 * DFE * D + (size_t)n0 * D + k0; }
        else { it -= n1; const int kb = it >> 5, nb = it & 31, k0 = kb * 64, n0 = nb * 32;
            t.src = P.moe_wd + eo * DFE * D + (size_t)(k0 + kr) * D + n0 + n4; t.ld = D; t.K = DFE; t.dst = (bf16_t*)(ws + W_F2) + (size_t)e * D * DFE + (size_t)n0 * DFE + k0; }
    }
}
__device__ __forceinline__ void cvt_load(const CvtTile& t, f32x4 (&v)[8], float (&g)[8]) {
#pragma unroll
    for (int i = 0; i < 8; ++i) v[i] = *(const f32x4*)(t.src + (size_t)(i * 8) * t.ld);
    if (t.gain) {
#pragma unroll
        for (int i = 0; i < 8; ++i) g[i] = t.gain[i * 8]; }
}
__device__ __forceinline__ void convert_stream(const Params& P, int layer, float* scr, int first, int items, int ngw, int lane) {
    const int kr = lane >> 3, n4 = (lane & 7) * 4, c = lane & 7;
    CvtTile t, tn; f32x4 v[8], vn[8]; float g[8], gn[8];
    if (first < items) { cvt_decode(P, layer, first, kr, n4, t); cvt_load(t, v, g); }
    for (int it = first; it < items; it += ngw) {
        const int nit = it + ngw;
        if (nit < items) { cvt_decode(P, layer, nit, kr, n4, tn); cvt_load(tn, vn, gn); }
        if (t.gain) {
#pragma unroll
            for (int i = 0; i < 8; ++i) v[i] = v[i] * g[i]; }
#pragma unroll
        for (int i = 0; i < 8; ++i)
#pragma unroll
            for (int j = 0; j < 4; ++j) scr[(n4 + j) * 68 + i * 8 + kr] = v[i][j];
        asm volatile("s_waitcnt lgkmcnt(0)" ::: "memory");
#pragma unroll
        for (int j = 0; j < 4; ++j) { const int n = (lane >> 3) + 8 * j; const float* s = scr + n * 68 + 8 * c; const f32x4 a = *(const f32x4*)s, b = *(const f32x4*)(s + 4);
            u32x4 o_; o_.x = pk2(a[0], a[1]); o_.y = pk2(a[2], a[3]); o_.z = pk2(b[0], b[1]); o_.w = pk2(b[2], b[3]);
            *(u32x4*)(t.dst + (size_t)n * t.K + 8 * c) = o_; }
        asm volatile("s_waitcnt lgkmcnt(0)" ::: "memory");
#pragma unroll
        for (int i = 0; i < 8; ++i) { v[i] = vn[i]; g[i] = gn[i]; }
        t = tn;
    }
}
__device__ __forceinline__ float cvt0_src(const Params& P, int layer, int which, int k, int n) {
    if (which == 0) { const int oc = proj_orig_col(inproj_nat_col(n)); return oc < 0 ? 0.f : P.w_in[(size_t)layer * D * INC + (size_t)k * INC + oc]; }
    if (which == 1) return n < 576 ? P.q_norm[layer * 256 + k] * P.w_uq[(size_t)layer * 256 * 576 + (size_t)k * 576 + n] : 0.f;
    if (which == 2) { const int c = n & 255, wc_ = (c >> 5) & 3, nat = (2 * (n >> 8) + (wc_ >> 1)) * 128 + (wc_ & 1) * 64 + ((c >> 7) << 5) + (c & 31); return k < 128 ? P.kv_norm[layer * 128 + k] * P.w_ukv[(size_t)layer * 128 * 768 + (size_t)k * 768 + nat] : 0.f; }
    return P.w_glu[(size_t)layer * 256 * 256 + (size_t)k * 256 + n];
}
__device__ __forceinline__ void convert_small(const Params& P, int layer, float* scr, int gw, int ngw, int lane) {
    unsigned char* ws = P.ws;
    for (int it = gw; it < 1024 + 96 + 96 + 32; it += ngw) {
        int which, r, nblk, K; bf16_t* Bt;
        if (it < 1024) { which = 0; r = it; nblk = PJ / 32; K = D; Bt = (bf16_t*)(ws + W_IN); }
        else if (it < 1120) { which = 1; r = it - 1024; nblk = 24; K = 256; Bt = (bf16_t*)(ws + W_UQ); }
        else if (it < 1216) { which = 2; r = it - 1120; nblk = 24; K = 256; Bt = (bf16_t*)(ws + W_UKV); }
        else { which = 3; r = it - 1216; nblk = 8; K = 256; Bt = (bf16_t*)(ws + W_GLU); }
        const int kb = r / nblk, nb = r % nblk, k0 = kb * 64, n0 = nb * 32;
        float v[32];
#pragma unroll
        for (int i = 0; i < 32; ++i) v[i] = cvt0_src(P, layer, which, k0 + 2 * i + (lane >> 5), n0 + (lane & 31));
#pragma unroll
        for (int i = 0; i < 32; ++i) scr[(2 * i + (lane >> 5)) * 33 + (lane & 31)] = v[i];
        asm volatile("s_waitcnt lgkmcnt(0)" ::: "memory");
        const int c = lane & 7;
#pragma unroll
        for (int j = 0; j < 4; ++j) { const int n = (lane >> 3) + 8 * j; const float* s = scr + (8 * c) * 33 + n;
            u32x4 o; o.x = pk2(s[0], s[33]); o.y = pk2(s[66], s[99]); o.z = pk2(s[132], s[165]); o.w = pk2(s[198], s[231]);
            *(u32x4*)(Bt + (size_t)(n0 + n) * K + k0 + 8 * c) = o; }
        asm volatile("s_waitcnt lgkmcnt(0)" ::: "memory");
    }
}
__device__ __forceinline__ void ph_convert(unsigned char* lds, Params P, int layer) {
    const int TIDX = hidden_tid(P.wid), BIDX = launder_i((int)blockIdx.x), GDIM = launder_i((int)gridDim.x); P.ws = launder_ptr(P.ws); P.out = launder_ptr(P.out);
    const int wid = TIDX >> 6, lane = TIDX & 63;
    convert_small(P, layer, (float*)lds + wid * 2176, BIDX * 8 + wid, GDIM * 8, lane);
    { const int ngw = GDIM * 8; int first = BIDX * 8 + wid - 1248 % ngw; if (first < 0) first += ngw;
      convert_stream(P, layer, (float*)lds + wid * 2176, first, cvt_count(layer), ngw, lane); }
}
#define GEMM_LDS ((PG8_LAS unsigned char*)lds)
__device__ __forceinline__ void ph_inproj_opt(unsigned char* lds, Params P, int layer) {
    const int TIDX = hidden_tid(P.wid), BIDX = launder_i((int)blockIdx.x), GDIM = launder_i((int)gridDim.x); P.ws = launder_ptr(P.ws); P.out = launder_ptr(P.out);
    pg8::Gemm g{(const bf16_t*)(P.ws + WS_HBUF), (const bf16_t*)(P.ws + W_IN), D, D, D, P.wid}; pg8::StaticOrder S; S.init(T, PJ, GDIM, BIDX);
    EpiInproj2 E{(bf16_t*)(P.ws + WS_PROJ), (float*)(P.ws + WS_FG), (bf16_t*)(P.ws + WS_UG), (float*)(P.ws + WS_SSQ), P.fox_gq + layer * 64, P.fox_gk + layer * 64, P.fox_bf + layer * 6};
    pg8::gemm_phase<EpiInproj2, pg8::StaticOrder, true, true>(GEMM_LDS, g, S, E);
}
__device__ __forceinline__ void ph_qup_opt(unsigned char* lds, Params P, int layer) {
    const int TIDX = hidden_tid(P.wid), BIDX = launder_i((int)blockIdx.x), GDIM = launder_i((int)gridDim.x); P.ws = launder_ptr(P.ws); P.out = launder_ptr(P.out);
    pg8::Gemm g{(const bf16_t*)(P.ws + WS_PROJ) + PC_CQ, (const bf16_t*)(P.ws + W_UQ), PJ, 256, 256, P.wid}; pg8::StaticOrder S; S.init(T, 768, GDIM, BIDX);
    EpiStore E{(bf16_t*)(P.ws + WS_QRAW), 768, (const float*)(P.ws + WS_SSQ), 1.f / 256.f, 1 << 20, 576};
    pg8::gemm_phase<EpiStore, pg8::StaticOrder, true, true>(GEMM_LDS, g, S, E);
}
__device__ __forceinline__ void ph_kvup_opt(unsigned char* lds, Params P, int layer) {
    const int TIDX = hidden_tid(P.wid), BIDX = launder_i((int)blockIdx.x), GDIM = launder_i((int)gridDim.x); P.ws = launder_ptr(P.ws); P.out = launder_ptr(P.out);
    pg8::Gemm g{(const bf16_t*)(P.ws + WS_PROJ) + PC_CKV, (const bf16_t*)(P.ws + W_UKV), PJ, 256, 128, P.wid};     pg8::StaticOrder S; S.init(T, 768, GDIM, (BIDX + (GDIM >> 1)) % GDIM);
    EpiKvup E{(bf16_t*)(P.ws + WS_KMLA), (bf16_t*)(P.ws + WS_KVRAW), (const bf16_t*)(P.ws + WS_PROJ), (const float*)(P.ws + WS_SSQ), P.mla_gk + layer * 96, (const float*)(P.ws + WS_COS), (const float*)(P.ws + WS_SIN)};
    pg8::gemm_phase<EpiKvup, pg8::StaticOrder, true, true>(GEMM_LDS, g, S, E);
}
__device__ __forceinline__ void ph_glu_opt(unsigned char* lds, Params P, int layer, int sub = 0) {
    const int TIDX = hidden_tid(P.wid), BIDX = launder_i((int)blockIdx.x), GDIM = launder_i((int)gridDim.x); P.ws = launder_ptr(P.ws); P.out = launder_ptr(P.out);
    pg8::Gemm g{(const bf16_t*)(P.ws + WS_YG), (const bf16_t*)(P.ws + W_GLU), 256, 256, 256, P.wid}; pg8::StaticOrder S; S.init(T, 256, sub ? 64 : GDIM, sub ? (BIDX < 64 ? BIDX : (1 << 20)) : BIDX);
    EpiGlu E{(const bf16_t*)(P.ws + WS_YG), (bf16_t*)(P.ws + WS_HBUF), P.b_glu + layer * 256, D, (float*)(P.ws + WS_SSQ2)};
    pg8::gemm_phase<EpiGlu, pg8::StaticOrder, true, true>(GEMM_LDS, g, S, E);
}
__device__ __forceinline__ void ph_outproj_opt(unsigned char* lds, Params P, int layer, int probe = 0) {
    const int TIDX = hidden_tid(P.wid), BIDX = launder_i((int)blockIdx.x), GDIM = launder_i((int)gridDim.x); P.ws = launder_ptr(P.ws); P.out = launder_ptr(P.out);
    pg8::Gemm g{(const bf16_t*)(P.ws + WS_HBUF), (const bf16_t*)(P.ws + W_OUT), D, D, D, P.wid}; pg8::StaticOrder S; S.init(T, D, GDIM, BIDX);
    {
        PG8_LAS float* tab = (PG8_LAS float*)(GEMM_LDS + 132096); const float* sq = (const float*)(P.ws + WS_SSQ2);
        for (int e = TIDX; e < 4 * 256; e += 512) { const int j = e >> 8, r = e & 255; pg8::Unit uu;
            if (S.next(j, uu)) { const float* p = sq + (size_t)(uu.pm * 256 + r) * 16; const f32x4 a = *(const f32x4*)p, b = *(const f32x4*)(p + 4), c = *(const f32x4*)(p + 8), d = *(const f32x4*)(p + 12);
                const float s1 = (a[0] + a[1]) + (a[2] + a[3]), s2 = ((b[0] + b[1]) + (b[2] + b[3])) + (c[0] + c[1]), s3 = ((c[2] + c[3]) + (d[0] + d[1])) + (d[2] + d[3]);
                const float r1 = rsqrtf(s1 * (1.f / 256.f) + EPS), r2 = rsqrtf(s2 * (1.f / 384.f) + EPS), r3 = rsqrtf(s3 * (1.f / 384.f) + EPS);
                tab[(j * 3 + 0) * 256 + r] = r1 / r2; tab[(j * 3 + 1) * 256 + r] = r2 / r3; tab[(j * 3 + 2) * 256 + r] = r3; } }
        __syncthreads(); }
    EpiResidK E{xstream(P, layer), adap(P, layer, 0, 2), probe ? (bf16_t*)(P.ws + WS_XE) : xstream(P, layer + (layer == DEPTH - 1))};
    pg8::gemm_phase<EpiResidK, pg8::StaticOrder, true, true>(GEMM_LDS, g, S, E);
}
__device__ __forceinline__ void ph_ffn1_opt(unsigned char* lds, Params P, int layer) {
    const int TIDX = hidden_tid(P.wid), BIDX = launder_i((int)blockIdx.x), GDIM = launder_i((int)gridDim.x); P.ws = launder_ptr(P.ws); P.out = launder_ptr(P.out);
    pg8::Gemm g{(const bf16_t*)(P.ws + WS_HBUF), (const bf16_t*)(P.ws + W_F1), D, D, D, P.wid}; pg8::StaticOrder S; S.init(T, 2 * DFF, GDIM, BIDX);
    EpiSwiglu E{(bf16_t*)(P.ws + WS_ACT), DFF, 1 << 20};
    pg8::gemm_phase<EpiSwiglu, pg8::StaticOrder, true, true>(GEMM_LDS, g, S, E);
}
__device__ __forceinline__ void ph_ffn2_opt(unsigned char* lds, Params P, int layer, int probe = 0) {
    const int TIDX = hidden_tid(P.wid), BIDX = launder_i((int)blockIdx.x), GDIM = launder_i((int)gridDim.x); P.ws = launder_ptr(P.ws); P.out = launder_ptr(P.out);
    pg8::Gemm g{(const bf16_t*)(P.ws + WS_ACT), (const bf16_t*)(P.ws + W_F2), DFF, DFF, DFF, P.wid}; pg8::StaticOrder S; S.init(T, D, GDIM, BIDX);
    EpiResid E{xstream(P, layer), adap(P, layer, 0, 5), probe ? (bf16_t*)(P.ws + WS_XE) : xstream(P, layer)};
    pg8::gemm_phase<EpiResid, pg8::StaticOrder, true, true>(GEMM_LDS, g, S, E);
}
struct MoeSlots {
    int off[NEXP + 1], cnt[NEXP];
    __device__ __forceinline__ void init(const unsigned* c) { int o_ = 0;
#pragma unroll
        for (int e = 0; e < NEXP; ++e) { cnt[e] = __builtin_amdgcn_readfirstlane((int)c[e]); off[e] = o_; o_ += ((cnt[e] + 255) >> 8) << 8; }
        off[NEXP] = o_; }
    __device__ __forceinline__ int expert_of(int pnl) const { int e = 0;
#pragma unroll
        for (int j = 1; j < NEXP; ++j) if (pnl * 256 >= off[j]) e = j;
        return e; }
    __device__ __forceinline__ int off_of(int e) const { int r = 0;
#pragma unroll
        for (int j = 0; j < NEXP; ++j) if (e == j) r = off[j];
        return r; }
    __device__ __forceinline__ int cnt_of(int e) const { int r = 0;
#pragma unroll
        for (int j = 0; j < NEXP; ++j) if (e == j) r = cnt[j];
        return r; }
};
struct MoeOrder1 {
    static constexpr bool GATHER = true;
    int n, G, c; MoeSlots sl; const int* list;
    __device__ __forceinline__ bool next(int i, Unit& u) const { const long L = (long)i * G + c; if (L >= n) return false;
        int Lx = (int)L; { const int q = n / pg8::NXCD, r = n % pg8::NXCD, xcd = Lx % pg8::NXCD, off = Lx / pg8::NXCD; Lx = (xcd < r ? xcd * (q + 1) : r * (q + 1) + (xcd - r) * q) + off; }
        const int pnl = Lx / 11, t = Lx % 11; u.pm = pnl; u.pn = sl.expert_of(pnl) * 11 + t; return true; }
    __device__ __forceinline__ void rowoff4(const Unit& u, int R, unsigned& o0, unsigned& o1, unsigned& o2, unsigned& o3) const {
        const int e = sl.expert_of(u.pm), r = u.pm * 256 - sl.off_of(e) + R, c = sl.cnt_of(e); const int* lp = list + (size_t)e * T + r;
        const int t0 = r < c ? lp[0] : 0, t1 = r + 64 < c ? lp[64] : 0, t2 = r + 128 < c ? lp[128] : 0, t3 = r + 192 < c ? lp[192] : 0;
        o0 = (unsigned)t0 * (unsigned)(D * 2); o1 = (unsigned)t1 * (unsigned)(D * 2); o2 = (unsigned)t2 * (unsigned)(D * 2); o3 = (unsigned)t3 * (unsigned)(D * 2); }
    __device__ __forceinline__ void a_ready(const Unit&) const {}
    __device__ __forceinline__ void done(const Unit&) const {}
};
struct MoeDec2 { MoeSlots sl; __device__ __forceinline__ void operator()(int L, Unit& u) const { const int pnl = L >> 2, t = L & 3; u.pm = pnl; u.pn = sl.expert_of(pnl) * 4 + t; } };
__device__ __forceinline__ void ph_moe1_opt(unsigned char* lds, Params P, int layer) {
    const int TIDX = hidden_tid(P.wid), BIDX = launder_i((int)blockIdx.x), GDIM = launder_i((int)gridDim.x); P.ws = launder_ptr(P.ws); P.out = launder_ptr(P.out); (void)TIDX;
    MoeSlots sl; sl.init((const unsigned*)(P.ws + WS_CTL) + CW_CNT + 16 * (layer / 2));
    pg8::Gemm g{(const bf16_t*)(P.ws + WS_HBUF), (const bf16_t*)(P.ws + W_F1), D, D, D, P.wid};
    MoeOrder1 S{(sl.off[NEXP] >> 8) * 11, (int)GDIM, (int)BIDX, sl, (const int*)(P.ws + WS_LIST)};
    EpiSwiglu E{(bf16_t*)(P.ws + WS_ACTM), DFE, 11};
    pg8::gemm_phase<EpiSwiglu, MoeOrder1, true, true>(GEMM_LDS, g, S, E);
}
__device__ __forceinline__ void ph_moe2_opt(unsigned char* lds, Params P, int layer) {
    const int TIDX = hidden_tid(P.wid), BIDX = launder_i((int)blockIdx.x), GDIM = launder_i((int)gridDim.x); P.ws = launder_ptr(P.ws); P.out = launder_ptr(P.out); (void)TIDX;
    MoeSlots sl; sl.init((const unsigned*)(P.ws + WS_CTL) + CW_CNT + 16 * (layer / 2));
    pg8::Gemm g{(const bf16_t*)(P.ws + WS_ACTM), (const bf16_t*)(P.ws + W_F2), DFE, DFE, DFE, P.wid};
    pg8::ListOrder<MoeDec2> S{(sl.off[NEXP] >> 8) * 4, (int)GDIM, (int)BIDX, MoeDec2{sl}};
    EpiStore E{(bf16_t*)(P.ws + ymoe_off(layer)), D, nullptr, 0.f, 4, 1 << 20};
    pg8::gemm_phase<EpiStore, pg8::ListOrder<MoeDec2>, true, true>(GEMM_LDS, g, S, E);
}


#ifndef LAS
#define LAS __attribute__((address_space(3)))
#endif
namespace att {
typedef short bf16x8 __attribute__((ext_vector_type(8)));
typedef short s16x4 __attribute__((ext_vector_type(4)));
typedef float f32x16 __attribute__((ext_vector_type(16)));
constexpr int LDS_K = 0, LDS_V = 49152, LDS_B = 81920, LDS_WS = 82944, LDS_OST = 84992, LDS_U = 117760;
struct Args { const bf16_t* Q; int ldq; const bf16_t* K; int ldk; const bf16_t* V; int ldv; int vhs; bf16_t* O; int ldo; float* ssq; const float* cb; unsigned* ctr; float th; const float* gq; const float* cs; const float* sn; float bsh; };
__device__ __forceinline__ int crow(int r, int hi) { return (r & 3) + 8 * (r >> 2) + 4 * hi; }
#define ATT_WAITV(N) asm volatile("s_waitcnt vmcnt(" #N ")" ::: "memory")
#define ATT_GLDS16(g, l) __builtin_amdgcn_global_load_lds((const unsigned*)(g), (LAS unsigned*)(l), 16, 0, 0)
#define ATT_GLDS4(g, l) __builtin_amdgcn_global_load_lds((const unsigned*)(g), (LAS unsigned*)(l), 4, 0, 0)
__device__ __forceinline__ unsigned cvtpk(float lo, float hi) { unsigned r; asm volatile("v_cvt_pk_bf16_f32 %0, %1, %2" : "=v"(r) : "v"(lo), "v"(hi)); return r; }
__device__ __forceinline__ void pv(f32x16* o, int vb, bf16x8 pa0, bf16x8 pa1, bf16x8 pa2, bf16x8 pa3) {
#pragma unroll
    for (int d0 = 0; d0 < 2; ++d0) { s16x4 lo[4], hi[4];
#pragma unroll
        for (int ks = 0; ks < 4; ++ks) {
            asm volatile("ds_read_b64_tr_b16 %0,%1 offset:%c2" : "=&v"(lo[ks]) : "v"(vb), "i"(d0 * 4096 + ks * 1024) : "memory");
            asm volatile("ds_read_b64_tr_b16 %0,%1 offset:%c2" : "=&v"(hi[ks]) : "v"(vb), "i"(d0 * 4096 + ks * 1024 + 512) : "memory"); }
        asm volatile("s_waitcnt lgkmcnt(0)" ::: "memory"); __builtin_amdgcn_sched_barrier(0);
#define ATT_PK(k) (bf16x8){lo[k][0], lo[k][1], lo[k][2], lo[k][3], hi[k][0], hi[k][1], hi[k][2], hi[k][3]}
        o[d0] = __builtin_amdgcn_mfma_f32_32x32x16_bf16(pa0, ATT_PK(0), o[d0], 0, 0, 0);
        o[d0] = __builtin_amdgcn_mfma_f32_32x32x16_bf16(pa1, ATT_PK(1), o[d0], 0, 0, 0);
        o[d0] = __builtin_amdgcn_mfma_f32_32x32x16_bf16(pa2, ATT_PK(2), o[d0], 0, 0, 0);
        o[d0] = __builtin_amdgcn_mfma_f32_32x32x16_bf16(pa3, ATT_PK(3), o[d0], 0, 0, 0);
#undef ATT_PK
    }
}
template <int NS, int MODE, int SH>
__device__ __forceinline__ void unit(const int b, const int h, const int qb, const Args& A, unsigned char* lds, const int tid_) {
    constexpr int DQK = 16 * NS, KSLOT = NS * 2048;
    const int wid = __builtin_amdgcn_readfirstlane(tid_ >> 6), tid = hidden_tid(wid);
    const int lane = tid & 63, r32 = lane & 31, hi = lane >> 5;
    const size_t rowbase = (size_t)b * SEQ; const int q0 = qb * 256;
    const bf16_t* Qw = A.Q + (rowbase + q0 + wid * 32) * A.ldq + h * DQK;
    const bf16_t* Kh = A.K + rowbase * A.ldk + h * DQK; const bf16_t* Vh = A.V + rowbase * A.ldv + h * A.vhs;
    LAS unsigned char* L = (LAS unsigned char*)lds;
    const unsigned lds0 = (unsigned)(uintptr_t)lds;
    const bf16_t* ksrc = Kh + (size_t)lane * A.ldk + wid * 8;
    const bf16_t* vsrc = Vh + (size_t)(16 * (wid & 3) + (lane >> 2)) * A.ldv + (wid >> 2) * 32 + (lane & 3) * 8;
    const float* bsrc = MODE == 1 ? A.cb + ((size_t)b * 6 + h) * SEQ + lane : nullptr;
    const bool k2 = (NS > 4) && (wid < 2 * NS - 8), bw = (MODE == 1) && (wid == 7), n3 = k2 || bw;
    const int NT = (q0 + 256) / 64;
    int t0 = 0;
    if (MODE == 1) {
        const float* cbh = A.cb + ((size_t)b * 6 + h) * SEQ; const float cq0 = cbh[q0];
        bool sk = false; if (lane < NT - 4) sk = (cq0 - cbh[64 * lane + 63]) < -A.th;
        const unsigned long long m = __ballot(sk);
        t0 = __builtin_amdgcn_readfirstlane((int)__builtin_ctzll(~m));
    }
#define ATT_DMAV(t, s) ATT_GLDS16(vsrc + (size_t)(t) * 64 * A.ldv, L + LDS_V + (s) * 8192 + wid * 1024)
#define ATT_DMAK(t, s) do { ATT_GLDS16(ksrc + (size_t)(t) * 64 * A.ldk, L + LDS_K + (s) * KSLOT + wid * 1024); \
        if (k2) ATT_GLDS16(ksrc + (size_t)(t) * 64 * A.ldk + 64, L + LDS_K + (s) * KSLOT + (wid + 8) * 1024); \
        if (bw) ATT_GLDS4(bsrc + (t) * 64, L + LDS_B + (s) * 256); } while (0)
#define ATT_WB(N) asm volatile("s_waitcnt vmcnt(" #N ") lgkmcnt(0)\n\ts_barrier" ::: "memory")
#define ATT_WB3(a_, b_, c_) do { if (k2) ATT_WB(b_); else if (bw) ATT_WB(c_); else ATT_WB(a_); } while (0)
    bf16x8 qr[NS];
#pragma unroll
    for (int d0 = 0; d0 < NS; ++d0) qr[d0] = *(const bf16x8*)(Qw + (size_t)r32 * A.ldq + d0 * 16 + hi * 8);
    ATT_DMAV(t0, 0); ATT_DMAK(t0, 0); ATT_DMAV(t0 + 1, 1); ATT_DMAK(t0 + 1, 1); ATT_DMAK(t0 + 2, 2);
    if (MODE == 0 && A.gq) {
        float qf[NS][8]; float ss = 0.f;
#pragma unroll
        for (int d0 = 0; d0 < NS; ++d0) { const u32x4 w = __builtin_bit_cast(u32x4, qr[d0]);
            qf[d0][0] = bf2f(w.x & 0xffff); qf[d0][1] = bf2f(w.x >> 16); qf[d0][2] = bf2f(w.y & 0xffff); qf[d0][3] = bf2f(w.y >> 16);
            qf[d0][4] = bf2f(w.z & 0xffff); qf[d0][5] = bf2f(w.z >> 16); qf[d0][6] = bf2f(w.w & 0xffff); qf[d0][7] = bf2f(w.w >> 16);
#pragma unroll
            for (int j = 0; j < 8; ++j) ss = fmaf(qf[d0][j], qf[d0][j], ss); }
        { auto rr = __builtin_amdgcn_permlane32_swap(__float_as_uint(ss), __float_as_uint(ss), false, false); ss = __uint_as_float(rr[0]) + __uint_as_float(rr[1]); }
        const float rq = rsqrtf(ss * (1.f / 96.f) + EPS) * C2_MLA;
#pragma unroll
        for (int d0 = 0; d0 < NS; ++d0) { const f32x4 g0 = *(const f32x4*)(A.gq + d0 * 16 + hi * 8), g1 = *(const f32x4*)(A.gq + d0 * 16 + hi * 8 + 4);
#pragma unroll
            for (int j = 0; j < 4; ++j) { qf[d0][j] *= rq * g0[j]; qf[d0][4 + j] *= rq * g1[j]; } }
        { const size_t row = rowbase + q0 + wid * 32 + r32; const float* cp = A.cs + row * 16 + hi * 8; const float* sp = A.sn + row * 16 + hi * 8;
          const f32x4 c0 = *(const f32x4*)cp, c1 = *(const f32x4*)(cp + 4), s0 = *(const f32x4*)sp, s1 = *(const f32x4*)(sp + 4);
#pragma unroll
          for (int j = 0; j < 8; ++j) { const float cv = j < 4 ? c0[j & 3] : c1[j & 3], sv = j < 4 ? s0[j & 3] : s1[j & 3]; const float x1 = qf[4][j], x2 = qf[5][j];
              qf[4][j] = x1 * cv - x2 * sv; qf[5][j] = x1 * sv + x2 * cv; } }
#pragma unroll
        for (int d0 = 0; d0 < NS; ++d0) { u32x4 w; w.x = cvtpk(qf[d0][0], qf[d0][1]); w.y = cvtpk(qf[d0][2], qf[d0][3]); w.z = cvtpk(qf[d0][4], qf[d0][5]); w.w = cvtpk(qf[d0][6], qf[d0][7]); qr[d0] = __builtin_bit_cast(bf16x8, w); }
    }
    float l_reg = 0.f; f32x16 o[2], cinit;
    { const float nm = SH ? ((MODE == 1 ? A.cb[((size_t)b * 6 + h) * SEQ + q0 + wid * 32 + r32] : 0.f) - A.bsh) : 0.f;
#pragma unroll
      for (int r = 0; r < 16; ++r) { o[0][r] = 0.f; o[1][r] = 0.f; cinit[r] = nm; } }
#define ATT_PIN(x) asm volatile("" : "+v"(x))
#define ATT_SBAR() __builtin_amdgcn_sched_barrier(0)
#define ATT_MFMA(a_, b_, c_) __builtin_amdgcn_mfma_f32_32x32x16_bf16(a_, b_, c_, 0, 0, 0)
    ATT_PIN(cinit);
    LAS float* wsf = (LAS float*)(L + LDS_WS) + wid * 64;
    const int qrel = wid * 32 + r32;
    const LAS unsigned char* const kp0 = L + LDS_K + hi * 1024 + r32 * 16;
    const LAS unsigned char* const vp0 = L + LDS_V + ((lane >> 4) & 1) * 32 + (lane & 3) * 8 + (4 * hi + ((lane & 15) >> 2)) * 64;
    const LAS float* const bp0 = (const LAS float*)(L + LDS_B) + 4 * hi;
    f32x16 pA0, pA1, pB0, pB1; bf16x8 kf[2 * NS]; s16x4 vlo[8], vhi[8]; u32x4 pw0, pw1, pw2, pw3; f32x4 bq[8];
    typedef short v4i16_t __attribute__((ext_vector_type(4)));
#define ATT_KLOAD2(t_, d0_) do { const LAS unsigned char* kb_ = kp0 + (((t_) - t0) & 3) * KSLOT; kf[2 * (d0_)] = *(const LAS bf16x8*)(kb_ + (d0_) * 2048); kf[2 * (d0_) + 1] = *(const LAS bf16x8*)(kb_ + (d0_) * 2048 + 512); } while (0)
#define ATT_VTR(p_) __builtin_bit_cast(s16x4, __builtin_amdgcn_ds_read_tr16_b64_v4i16((LAS v4i16_t*)(p_)))
#define ATT_VRD(i_) do { vlo[i_] = ATT_VTR(vp_ + (((i_) >> 2) * 4096 + ((i_) & 3) * 1024)); vhi[i_] = ATT_VTR(vp_ + (((i_) >> 2) * 4096 + ((i_) & 3) * 1024 + 512)); } while (0)
#define ATT_VFR(i_) (bf16x8){vlo[i_][0], vlo[i_][1], vlo[i_][2], vlo[i_][3], vhi[i_][0], vhi[i_][1], vhi[i_][2], vhi[i_][3]}
#define ATT_PKW(P_, i_) cvtpk(P_[i_], P_[(i_) + 1])
#define ATT_PAF(k_) __builtin_bit_cast(bf16x8, pw##k_)
#define ATT_QKM(C0_, C1_, m_) do { if ((m_) & 1) C1_ = ATT_MFMA(kf[m_], qr[(m_) >> 1], ((m_) >> 1) == 0 ? cinit : C1_); else C0_ = ATT_MFMA(kf[m_], qr[(m_) >> 1], ((m_) >> 1) == 0 ? cinit : C0_); } while (0)
#define ATT_MASK(C0_, C1_, jb_) do { if (MODE == 0) { if ((jb_) > (wid >> 1)) { _Pragma("unroll") for (int r = 0; r < 16; ++r) { C0_[r] = -INFINITY; C1_[r] = -INFINITY; } } } \
        else { const int kb = 64 * (jb_) + 4 * hi; _Pragma("unroll") for (int r = 0; r < 16; ++r) { const int kv = kb + (r & 3) + 8 * (r >> 2); if (kv > qrel) C0_[r] = -INFINITY; if (kv + 32 > qrel) C1_[r] = -INFINITY; } } } while (0)
    constexpr int KA = 3;
    constexpr bool HOLD = NS <= 4;
#define ATT_PREA(m_, vi_) do { if (HOLD) { if ((vi_) >= 0) ATT_VRD((vi_) < 0 ? 0 : (vi_)); if (MODE == 1 && (m_) < 8) bq[(m_) & 7] = *(const LAS f32x4*)(bps_ + 8 * ((m_) & 7)); ATT_SBAR(); } \
        else { if (((m_) & 1) == 0 && ((m_) >> 1) + KA < NS) ATT_KLOAD2(t, ((m_) >> 1) + KA); if ((m_) >= 2 * NS - 8) ATT_VRD(((m_) - (2 * NS - 8)) & 1 ? 4 + (((m_) - (2 * NS - 8)) >> 1) : (((m_) - (2 * NS - 8)) >> 1)); ATT_SBAR(); } } while (0)
#define ATT_GAPA(C0_, C1_, m_, vi_, a0_, a1_, a2_, a3_, W0_, W1_, PW_) do { ATT_PREA(m_, vi_); \
        ATT_QKM(C0_, C1_, m_); sacc += a0_; sacc += a1_; sacc += a2_; sacc += a3_; W0_; W1_; ATT_PIN(PW_); ATT_PIN(sacc); ATT_SBAR(); } while (0)
#define ATT_GAPX(C0_, C1_, m_) do { ATT_PREA(m_, -1); ATT_QKM(C0_, C1_, m_); ATT_SBAR(); } while (0)
#define ATT_EX4(X_, i_, k_) do { if (MODE == 1) { X_[i_] = __builtin_amdgcn_exp2f(X_[i_] - bq[k_][0]); X_[(i_) + 1] = __builtin_amdgcn_exp2f(X_[(i_) + 1] - bq[k_][1]); X_[(i_) + 2] = __builtin_amdgcn_exp2f(X_[(i_) + 2] - bq[k_][2]); X_[(i_) + 3] = __builtin_amdgcn_exp2f(X_[(i_) + 3] - bq[k_][3]); } \
        else { X_[i_] = __builtin_amdgcn_exp2f(X_[i_]); X_[(i_) + 1] = __builtin_amdgcn_exp2f(X_[(i_) + 1]); X_[(i_) + 2] = __builtin_amdgcn_exp2f(X_[(i_) + 2]); X_[(i_) + 3] = __builtin_amdgcn_exp2f(X_[(i_) + 3]); } } while (0)
#define ATT_GAPB(k_, od_, pk_, vi_, kd_, vnext_, X_, i_) do { \
        if (HOLD) { if ((kd_) >= 0 && (kd_) < NS && kl_) { ATT_KLOAD2(t + 1, ((kd_) >= 0 && (kd_) < NS) ? (kd_) : 0); ATT_SBAR(); } } \
        else { if (MODE == 1 && (k_) + 2 < 8) bq[((k_) + 2) & 7] = *(const LAS f32x4*)(bps_ + 8 * (((k_) + 2) & 7)); \
               if ((k_) >= 8 - KA && kl_) ATT_KLOAD2(t + 1, ((k_) - (8 - KA)) < NS ? ((k_) - (8 - KA)) : 0); } \
        o[od_] = ATT_MFMA(ATT_PAF(pk_), ATT_VFR(vi_), o[od_]); ATT_EX4(X_, i_, k_); ATT_PIN(X_); ATT_SBAR(); } while (0)
#define ATT_STEP2(C0_, C1_, P0_, P1_, tt_, BAND_) do { const int t = (tt_); ATT_SBAR(); \
        const LAS unsigned char* vp_ = vp0 + ((t - 1 - t0) & 3) * 8192; const LAS float* bps_ = bp0 + ((t - t0) & 3) * 64; \
        float sacc = P0_[0] + P0_[1]; \
        ATT_GAPA(C0_, C1_, 0, 0, P0_[2], P0_[3], P0_[4], P0_[5],     pw0[0] = ATT_PKW(P0_, 0),  pw0[1] = ATT_PKW(P0_, 2),  pw0); \
        ATT_GAPA(C0_, C1_, 1, 4, P0_[6], P0_[7], P0_[8], P0_[9],     pw0[2] = ATT_PKW(P0_, 4),  pw0[3] = ATT_PKW(P0_, 6),  pw0); \
        ATT_GAPA(C0_, C1_, 2, 1, P0_[10], P0_[11], P0_[12], P0_[13], pw1[0] = ATT_PKW(P0_, 8),  pw1[1] = ATT_PKW(P0_, 10), pw1); \
        ATT_GAPA(C0_, C1_, 3, 5, P0_[14], P0_[15], P1_[0], P1_[1],   pw1[2] = ATT_PKW(P0_, 12), pw1[3] = ATT_PKW(P0_, 14), pw1); \
        ATT_GAPA(C0_, C1_, 4, 2, P1_[2], P1_[3], P1_[4], P1_[5],     pw2[0] = ATT_PKW(P1_, 0),  pw2[1] = ATT_PKW(P1_, 2),  pw2); \
        ATT_GAPA(C0_, C1_, 5, 6, P1_[6], P1_[7], P1_[8], P1_[9],     pw2[2] = ATT_PKW(P1_, 4),  pw2[3] = ATT_PKW(P1_, 6),  pw2); \
        ATT_GAPA(C0_, C1_, 6, 3, P1_[10], P1_[11], P1_[12], P1_[13], pw3[0] = ATT_PKW(P1_, 8),  pw3[1] = ATT_PKW(P1_, 10), pw3); \
        ATT_GAPA(C0_, C1_, 7, 7, P1_[14], P1_[15], 0.f, 0.f,         pw3[2] = ATT_PKW(P1_, 12), pw3[3] = ATT_PKW(P1_, 14), pw3); \
        if (NS > 4) { ATT_GAPX(C0_, C1_, (NS > 4 ? 8 : 0)); ATT_GAPX(C0_, C1_, (NS > 4 ? 9 : 1)); } \
        if (NS > 5) { ATT_GAPX(C0_, C1_, (NS > 5 ? 10 : 0)); ATT_GAPX(C0_, C1_, (NS > 5 ? 11 : 1)); } \
        l_reg += sacc; \
        if (BAND_) { if (t + 2 < NT) ATT_DMAV(t + 2, (t + 2 - t0) & 3); if (t + 3 < NT) ATT_DMAK(t + 3, (t + 3 - t0) & 3); } \
        else { ATT_DMAV(t + 2, (t + 2 - t0) & 3); ATT_DMAK(t + 3, (t + 3 - t0) & 3); } \
        if (BAND_) { const int jb = t - (NT - 4); if (jb >= 0) ATT_MASK(C0_, C1_, jb); } \
        const bool kl_ = !(BAND_) || (t + 1 < NT);     \
        if (!HOLD && MODE == 1) { bq[0] = *(const LAS f32x4*)(bps_); bq[1] = *(const LAS f32x4*)(bps_ + 8); } \
        ATT_SBAR(); \
        ATT_GAPB(0, 0, 0, 0, -1, 1, C0_, 0);  ATT_GAPB(1, 1, 0, 4, 0, 5, C0_, 4);  ATT_GAPB(2, 0, 1, 1, 1, 2, C0_, 8);  ATT_GAPB(3, 1, 1, 5, 2, 6, C0_, 12); \
        ATT_GAPB(4, 0, 2, 2, 3, 3, C1_, 0);   ATT_GAPB(5, 1, 2, 6, -1, 7, C1_, 4); ATT_GAPB(6, 0, 3, 3, -1, -1, C1_, 8); ATT_GAPB(7, 1, 3, 7, -1, -1, C1_, 12); \
    } while (0)
#define ATT_DRAIN(P0_, P1_) do { float sacc = P0_[0] + P0_[1]; \
        _Pragma("unroll") for (int r = 2; r < 16; ++r) sacc += P0_[r]; \
        _Pragma("unroll") for (int r = 0; r < 16; ++r) sacc += P1_[r]; \
        l_reg += sacc; \
        pw0 = (u32x4){ATT_PKW(P0_, 0), ATT_PKW(P0_, 2), ATT_PKW(P0_, 4), ATT_PKW(P0_, 6)}; pw1 = (u32x4){ATT_PKW(P0_, 8), ATT_PKW(P0_, 10), ATT_PKW(P0_, 12), ATT_PKW(P0_, 14)}; \
        pw2 = (u32x4){ATT_PKW(P1_, 0), ATT_PKW(P1_, 2), ATT_PKW(P1_, 4), ATT_PKW(P1_, 6)}; pw3 = (u32x4){ATT_PKW(P1_, 8), ATT_PKW(P1_, 10), ATT_PKW(P1_, 12), ATT_PKW(P1_, 14)}; \
        const LAS unsigned char* vp_ = vp0 + ((NT - 1 - t0) & 3) * 8192; \
        ATT_VRD(0); ATT_VRD(1); ATT_VRD(2); ATT_VRD(3); ATT_VRD(4); ATT_VRD(5); ATT_VRD(6); ATT_VRD(7); \
        o[0] = ATT_MFMA(ATT_PAF(0), ATT_VFR(0), o[0]); o[1] = ATT_MFMA(ATT_PAF(0), ATT_VFR(4), o[1]); o[0] = ATT_MFMA(ATT_PAF(1), ATT_VFR(1), o[0]); o[1] = ATT_MFMA(ATT_PAF(1), ATT_VFR(5), o[1]); \
        o[0] = ATT_MFMA(ATT_PAF(2), ATT_VFR(2), o[0]); o[1] = ATT_MFMA(ATT_PAF(2), ATT_VFR(6), o[1]); o[0] = ATT_MFMA(ATT_PAF(3), ATT_VFR(3), o[0]); o[1] = ATT_MFMA(ATT_PAF(3), ATT_VFR(7), o[1]); } while (0)
    ATT_WB3(3, 5, 5);
    { _Pragma("unroll") for (int d0 = 0; d0 < NS; ++d0) ATT_KLOAD2(t0, d0);
      _Pragma("unroll") for (int m = 0; m < 2 * NS; ++m) { if (m & 1) pA1 = ATT_MFMA(kf[m], qr[m >> 1], (m >> 1) == 0 ? cinit : pA1); else pA0 = ATT_MFMA(kf[m], qr[m >> 1], (m >> 1) == 0 ? cinit : pA0); }
      if (NT - 4 == t0) ATT_MASK(pA0, pA1, 0);
      if (MODE == 1) {
#pragma unroll
          for (int g = 0; g < 4; ++g) { const f32x4 b0 = *(const LAS f32x4*)(bp0 + 8 * g), b1 = *(const LAS f32x4*)(bp0 + 32 + 8 * g);
#pragma unroll
              for (int j = 0; j < 4; ++j) { pA0[4 * g + j] -= b0[j]; pA1[4 * g + j] -= b1[j]; } } }
#pragma unroll
      for (int r = 0; r < 16; ++r) { pA0[r] = __builtin_amdgcn_exp2f(pA0[r]); pA1[r] = __builtin_amdgcn_exp2f(pA1[r]); } }
    ATT_WB(0);
    ATT_DMAV(t0 + 2, 2); ATT_DMAK(t0 + 3, 3);
    { _Pragma("unroll") for (int d0 = 0; d0 < (HOLD ? NS : KA); ++d0) ATT_KLOAD2(t0 + 1, d0); }
    int tc = t0 + 1;
    for (; tc + 5 < NT; tc += 2) {
        ATT_STEP2(pB0, pB1, pA0, pA1, tc, 0);     ATT_WB3(2, 3, 4);
        ATT_STEP2(pA0, pA1, pB0, pB1, tc + 1, 0); ATT_WB3(2, 3, 4);
    }
    for (; tc + 1 < NT; tc += 2) {
        ATT_STEP2(pB0, pB1, pA0, pA1, tc, 1);     ATT_WB(0);
        ATT_STEP2(pA0, pA1, pB0, pB1, tc + 1, 1); ATT_WB(0);
    }
    if (tc < NT) { ATT_STEP2(pB0, pB1, pA0, pA1, tc, 1); ATT_WB(0); ATT_DRAIN(pB0, pB1); }
    else { ATT_DRAIN(pA0, pA1); }
    unsigned nxu = 0u;
    if (tid == 0) nxu = __hip_atomic_fetch_add((GAS_ unsigned*)A.ctr, 1u, __ATOMIC_RELAXED, __HIP_MEMORY_SCOPE_AGENT);
    { auto rr = __builtin_amdgcn_permlane32_swap(__float_as_uint(l_reg), __float_as_uint(l_reg), false, false); l_reg = __uint_as_float(rr[0]) + __uint_as_float(rr[1]); }
    if (hi == 0) wsf[32 + r32] = l_reg;
    asm volatile("s_waitcnt lgkmcnt(0)" ::: "memory");
    float rli[16];
#pragma unroll
    for (int r = 0; r < 16; ++r) rli[r] = __builtin_amdgcn_rcpf(wsf[32 + crow(r, hi)]);
    bf16_t* Ow = A.O + (rowbase + q0 + wid * 32) * A.ldo + h * 64;
    { LAS bf16_t* stg = (LAS bf16_t*)(L + LDS_OST) + wid * 2048;
#pragma unroll
      for (int r = 0; r < 16; ++r) { const int orow = crow(r, hi);
#pragma unroll
          for (int d0 = 0; d0 < 2; ++d0) stg[orow * 64 + d0 * 32 + r32] = f2bf(o[d0][r] * rli[r]); }
      asm volatile("s_waitcnt lgkmcnt(0)" ::: "memory");
#pragma unroll
      for (int i = 0; i < 4; ++i) { const int row = i * 8 + (lane >> 3), ch = lane & 7; const u32x4 v = *(const LAS u32x4*)(stg + row * 64 + ch * 8); *(u32x4*)(Ow + (size_t)row * A.ldo + ch * 8) = v;
          const unsigned vw[4] = {v.x, v.y, v.z, v.w}; float ss = 0.f;
#pragma unroll
          for (int q = 0; q < 4; ++q) { const float lo = bf2f(vw[q] & 0xffff), hi_ = bf2f(vw[q] >> 16); ss += lo * lo + hi_ * hi_; }
          ss += shx(ss, 1, lane); ss += shx(ss, 2, lane); ss += shx(ss, 4, lane);
          if (ch == 0) A.ssq[(rowbase + q0 + wid * 32 + row) * 16 + h] = ss; } }
    if (tid == 0) *(LAS unsigned*)(L + LDS_U) = nxu;
    asm volatile("s_waitcnt vmcnt(0) lgkmcnt(0)" ::: "memory");
    __builtin_amdgcn_s_barrier();
#undef ATT_DMAV
#undef ATT_DMAK
#undef ATT_STEP2
}
struct NoSide { __device__ __forceinline__ void step() {} };
template <int NS, int MODE, int SH, class Side>
__device__ __forceinline__ void phase(const Args& A, unsigned char* lds, const int tid, Side& side) {
    LAS unsigned* uw = (LAS unsigned*)((LAS unsigned char*)lds + LDS_U);
    if (tid == 0) *uw = __hip_atomic_fetch_add(A.ctr, 1u, __ATOMIC_RELAXED, __HIP_MEMORY_SCOPE_AGENT);
    __syncthreads();
    for (;;) {
        const int u = __builtin_amdgcn_readfirstlane((int)*uw);
        __syncthreads();
        if (u >= NB * 6 * 16) break;
        const int qb = 15 - u / 48, bh = u % 48;
        unit<NS, MODE, SH>(bh / 6, bh % 6, qb, A, lds, tid);
        side.step();
    }
}
#undef ATT_WAITV
#undef ATT_GLDS16
#undef ATT_GLDS4
}

__device__ __forceinline__ void ph_attn_mla(unsigned char* lds, Params P, int layer) {
    const int TIDX = hidden_tid(P.wid); P.ws = launder_ptr(P.ws);
    const int lane = TIDX & 63, lr = (layer >= 4) ? layer - 4 : layer;
    const float gqm = wmax(fmaxf(fabsf(P.mla_gq[lr * 96 + lane]), fabsf(P.mla_gq[lr * 96 + 64 + (lane & 31)])), lane), gkm = wmax(fmaxf(fabsf(P.mla_gk[lr * 96 + lane]), fabsf(P.mla_gk[lr * 96 + 64 + (lane & 31)])), lane);
    const float bm = __uint_as_float(__builtin_amdgcn_readfirstlane(__float_as_uint(96.f * C2_MLA * gqm * gkm * 1.02f)));
    att::Args A{(const bf16_t*)(P.ws + WS_QRAW), 768, (const bf16_t*)(P.ws + WS_KMLA), 576, (const bf16_t*)(P.ws + WS_KVRAW) + 64, 768, 128, (bf16_t*)(P.ws + WS_HBUF) + 256, D, (float*)(P.ws + WS_SSQ2) + 4, nullptr,
                 (unsigned*)(P.ws + WS_CTL) + CW_ATTN + layer * 2, 0.f, P.mla_gq + lr * 96, (const float*)(P.ws + WS_COS), (const float*)(P.ws + WS_SIN), bm};
    att::NoSide ns;
    if (__all(bm <= 60.f)) att::phase<6, 0, 0>(A, lds, TIDX, ns);
    else att::phase<6, 0, 1>(A, lds, TIDX, ns);
}
__device__ __forceinline__ void ph_attn_fox(unsigned char* lds, Params P, int layer) {
    const int TIDX = hidden_tid(P.wid); P.ws = launder_ptr(P.ws);
    const int lane = TIDX & 63, lr = (layer >= 4) ? layer - 4 : layer;
    const float gqm = wmax(fabsf(P.fox_gq[lr * 64 + lane]), lane), gkm = wmax(fabsf(P.fox_gk[lr * 64 + lane]), lane);
    const float bf_ = __uint_as_float(__builtin_amdgcn_readfirstlane(__float_as_uint(64.f * C2_FOX * gqm * gkm * 1.02f))), th = 2.f * bf_ + 40.f;
    att::Args A{(const bf16_t*)(P.ws + WS_PROJ) + PC_FQ, PJ, (const bf16_t*)(P.ws + WS_PROJ) + PC_FK, PJ, (const bf16_t*)(P.ws + WS_PROJ) + PC_FV, PJ, 64, (bf16_t*)(P.ws + WS_HBUF) + 640, D, (float*)(P.ws + WS_SSQ2) + 10, (const float*)(P.ws + WS_CB2),
                 (unsigned*)(P.ws + WS_CTL) + CW_ATTN + layer * 2 + 1, th, nullptr, nullptr, nullptr, bf_};
    att::NoSide ns; att::phase<4, 1, 1>(A, lds, TIDX, ns);
}
__device__ __forceinline__ void ph_attn_all(unsigned char* lds, Params P, int layer) { ph_attn_mla(lds, P, layer); ph_attn_fox(lds, P, layer); }


__device__ __forceinline__ void ssm_tables1(const Params& P, int layer, unsigned char* lds, int tid, int bid, int gdim) {
    float* lamp = (float*)lds;
    float* bbar = lamp + 64 * 33 * 2;
    float* cc = bbar + 64 * 16 * 2;
    float* qq = cc + 16 * 64 * 2;
    float* KM = (float*)(P.ws + WS_KM + (size_t)(layer & 1) * (512u << 10)); float* LAMP = (float*)(P.ws + WS_LAMP + (size_t)(layer & 1) * (512u << 10)); float* BBAR = (float*)(P.ws + WS_BBAR + (size_t)(layer & 1) * (512u << 10));
    for (int item = bid; item < 128; item += gdim) {
        const int g = item >> 3, dq = item & 7;
        __syncthreads();
        const float dt = expf(P.log_dt[layer * 16 + g]);
        for (int e = tid; e < 64 * 33; e += 512) { const int p = e / 33, d = e % 33; const size_t gp = ((size_t)layer * 16 + g) * 64 + p;
            const float a_ = P.lam_re[gp] * dt, b_ = P.lam_im[gp] * dt; float s_, c_; sincosf((float)d * b_, &s_, &c_); const float e_ = expf((float)d * a_);
            lamp[e * 2] = e_ * c_; lamp[e * 2 + 1] = e_ * s_;
            if (dq == 0) { LAMP[((size_t)g * 64 * 33 + e) * 2] = e_ * c_; LAMP[((size_t)g * 64 * 33 + e) * 2 + 1] = e_ * s_; } }
        if (tid < 64) { const int p = tid; const size_t gp = ((size_t)layer * 16 + g) * 64 + p;
            const float lre = P.lam_re[gp], lim = P.lam_im[gp], a_ = lre * dt, b_ = lim * dt; float sb_, cb_; sincosf(b_, &sb_, &cb_); const float sh_ = sinf(0.5f * b_);
            const float nr = expm1f(a_) * cb_ - 2.f * sh_ * sh_, ni = expf(a_) * sb_;
            const float dd = lre * lre + lim * lim; qq[p * 2] = (nr * lre + ni * lim) / dd; qq[p * 2 + 1] = (ni * lre - nr * lim) / dd; }
        for (int e = tid; e < 1024; e += 512) { const int c = e >> 6, p = e & 63; const size_t ix = (((size_t)layer * 16 + g) * 16 + c) * 64 + p; cc[e * 2] = P.c_re[ix]; cc[e * 2 + 1] = P.c_im[ix]; }
        __syncthreads();
        for (int e = tid; e < 1024; e += 512) { const int p = e >> 4, c = e & 15; const size_t ix = (((size_t)layer * 16 + g) * 64 + p) * 16 + c;
            const float bre = P.b_re[ix], bim = P.b_im[ix], qr = qq[p * 2], qi = qq[p * 2 + 1];
            const float br = qr * bre - qi * bim, bi = qr * bim + qi * bre; bbar[e * 2] = br; bbar[e * 2 + 1] = bi;
            if (dq == 0) { BBAR[((size_t)g * 1024 + e) * 2] = br; BBAR[((size_t)g * 1024 + e) * 2 + 1] = bi; } }
        __syncthreads();
        for (int e = tid; e < 4 * 256; e += 512) { const int d = dq * 4 + (e >> 8), c = (e >> 4) & 15, c2 = e & 15; float acc = 0.f;
            for (int p = 0; p < 64; ++p) { const float cr = cc[(c * 64 + p) * 2], ci = cc[(c * 64 + p) * 2 + 1], lr = lamp[(p * 33 + d) * 2], li = lamp[(p * 33 + d) * 2 + 1];
                const float clr = cr * lr - ci * li, cli = cr * li + ci * lr; acc += clr * bbar[(p * 16 + c2) * 2] - cli * bbar[(p * 16 + c2) * 2 + 1]; }
            KM[(size_t)g * 8192 + d * 256 + (e & 255)] = acc; }
    }
    __syncthreads();
}
__device__ __forceinline__ void ssm_tables2(const Params& P, int layer, int tid, int bid, int gdim) {
    const float* KM = (const float*)(P.ws + WS_KM + (size_t)(layer & 1) * (512u << 10)); const float* LAMP = (const float*)(P.ws + WS_LAMP + (size_t)(layer & 1) * (512u << 10)); const float* BBAR = (const float*)(P.ws + WS_BBAR + (size_t)(layer & 1) * (512u << 10));
    bf16_t* B1t = (bf16_t*)(P.ws + W_B1T); bf16_t* T2t = (bf16_t*)(P.ws + W_T2T);
    const int gt = bid * 512 + tid, nt = gdim * 512;
    for (int v0 = gt; v0 < 16 * 256 * 64; v0 += 2 * nt) {
        f32x4 bb[2][4]; float lr[2], li[2];
#pragma unroll
        for (int u = 0; u < 2; ++u) { const int v = v0 + u * nt, k0 = (v & 63) * 8, n = (v >> 6) & 255, g = v >> 14;
            if (v < 16 * 256 * 64 && n < 128) { const int p = n >> 1, i = k0 >> 4, c0 = k0 & 15;
                const float* lp = LAMP + (((size_t)g * 64 + p) * 33 + (31 - i)) * 2; lr[u] = lp[0]; li[u] = lp[1];
                const float* bp = BBAR + (((size_t)g * 64 + p) * 16 + c0) * 2;
#pragma unroll
                for (int q = 0; q < 4; ++q) bb[u][q] = *(const f32x4*)(bp + 4 * q); } }
#pragma unroll
        for (int u = 0; u < 2; ++u) { const int v = v0 + u * nt, k0 = (v & 63) * 8, n = (v >> 6) & 255, g = v >> 14;
            if (v < 16 * 256 * 64) { u32x4 o = {0u, 0u, 0u, 0u};
                if (n < 128) { const int ri = n & 1; float w[8];
#pragma unroll
                    for (int q = 0; q < 4; ++q) { const f32x4 t = bb[u][q]; w[2 * q] = ri == 0 ? (lr[u] * t[0] - li[u] * t[1]) : (lr[u] * t[1] + li[u] * t[0]); w[2 * q + 1] = ri == 0 ? (lr[u] * t[2] - li[u] * t[3]) : (lr[u] * t[3] + li[u] * t[2]); }
                    o.x = pk2(w[0], w[1]); o.y = pk2(w[2], w[3]); o.z = pk2(w[4], w[5]); o.w = pk2(w[6], w[7]); }
                *(u32x4*)(B1t + ((size_t)(g * 256 + n)) * 512 + k0) = o; } }
    }
    for (int v0 = gt; v0 < 16 * 512 * 64; v0 += 4 * nt) {
        f32x4 ka[4], kb[4];
#pragma unroll
        for (int u = 0; u < 4; ++u) { const int v = v0 + u * nt, k0 = (v & 63) * 8, n = (v >> 6) & 511, g = v >> 15, j = n >> 4, c = n & 15, i = k0 >> 4, c0 = k0 & 15;
            ka[u] = (f32x4){0.f, 0.f, 0.f, 0.f}; kb[u] = ka[u];
            if (v < 16 * 512 * 64 && j >= i) { const float* kp = KM + (size_t)g * 8192 + (j - i) * 256 + c * 16 + c0; ka[u] = *(const f32x4*)kp; kb[u] = *(const f32x4*)(kp + 4); } }
#pragma unroll
        for (int u = 0; u < 4; ++u) { const int v = v0 + u * nt, k0 = (v & 63) * 8, n = (v >> 6) & 511, g = v >> 15;
            if (v < 16 * 512 * 64) { u32x4 o; o.x = pk2(ka[u][0], ka[u][1]); o.y = pk2(ka[u][2], ka[u][3]); o.z = pk2(kb[u][0], kb[u][1]); o.w = pk2(kb[u][2], kb[u][3]);
                *(u32x4*)(T2t + ((size_t)(g * 512 + n)) * 640 + k0) = o; } }
    }
    for (int v = gt; v < 16 * 512 * 16; v += nt) {
        const int p0 = (v & 15) * 4, n = (v >> 4) & 511, g = v >> 13, j = n >> 4, c = n & 15;
        const size_t ix = (((size_t)layer * 16 + g) * 16 + c) * 64 + p0; const f32x4 cr = *(const f32x4*)(P.c_re + ix), ci = *(const f32x4*)(P.c_im + ix);
        float lr[4], li[4];
#pragma unroll
        for (int q = 0; q < 4; ++q) { const float* lp = LAMP + (((size_t)g * 64 + p0 + q) * 33 + (j + 1)) * 2; lr[q] = lp[0]; li[q] = lp[1]; }
        float w[8];
#pragma unroll
        for (int q = 0; q < 4; ++q) { w[2 * q] = cr[q] * lr[q] - ci[q] * li[q]; w[2 * q + 1] = -(cr[q] * li[q] + ci[q] * lr[q]); }
        u32x4 o; o.x = pk2(w[0], w[1]); o.y = pk2(w[2], w[3]); o.z = pk2(w[4], w[5]); o.w = pk2(w[6], w[7]);
        *(u32x4*)(T2t + ((size_t)(g * 512 + n)) * 640 + 512 + 2 * p0) = o;
    }
}
__device__ __forceinline__ void ssm_carry(const Params& P, int layer, int item, int lane) {
    const int b = item >> 4, g = item & 15;
    const float* LAMP = (const float*)(P.ws + WS_LAMP + (size_t)(layer & 1) * (512u << 10)); const float* lp = LAMP + (((size_t)g * 64 + lane) * 33 + 32) * 2; const float lr = lp[0], li = lp[1];
    const float* sl = (const float*)(P.ws + WS_SLOC) + ((size_t)g * 1024 + b * 128) * 128 + lane * 2;
    bf16_t* ug = (bf16_t*)(P.ws + WS_UG) + ((size_t)g * 1024 + b * 128) * 640 + 512 + lane * 2;
    float sr = 0.f, si = 0.f;
    for (int n0 = 0; n0 < 128; n0 += 16) {
        float xr[16], xi[16];
#pragma unroll
        for (int k = 0; k < 16; ++k) { const float* q = sl + (size_t)(n0 + k) * 128; xr[k] = q[0]; xi[k] = q[1]; }
#pragma unroll
        for (int k = 0; k < 16; ++k) { *(unsigned*)(ug + (size_t)(n0 + k) * 640) = pk2(sr, si);
            const float nr = lr * sr - li * si + xr[k], ni = lr * si + li * sr + xi[k]; sr = nr; si = ni; }
    }
}
struct EpiSloc {
    static constexpr bool PERM = true, AFTER_DRAIN = false;
    float* S;
    __device__ __forceinline__ void operator()(const f32x4 (&acc)[2][2][4][2], const Unit& u, int wr, int wc, int fr, int fq) const {
        const int row0 = u.pm * 256 + wr * 64 + fr, col0 = wc * 32 + 8 * fq;
#pragma unroll
        for (int ai = 0; ai < 2; ++ai)
#pragma unroll
            for (int m = 0; m < 4; ++m) { float* rp = S + (size_t)(row0 + ai * 128 + m * 16) * 128 + col0; *(f32x4*)rp = acc[ai][0][m][0]; *(f32x4*)(rp + 4) = acc[ai][0][m][1]; }
    }
};
struct EpiSsmY {
    static constexpr bool PERM = true, AFTER_DRAIN = false;
    const bf16_t* proj; bf16_t* yg; const float* dsk;
    __device__ __forceinline__ void operator()(const f32x4 (&acc)[2][2][4][2], const Unit& u, int wr, int wc, int fr, int fq) const {
        const int ct = u.pn & 1, g = u.pm >> 2;
        f32x4 dv[2][2]; int jj[2], cc[2]; const float* dsk = launder_ptr(this->dsk);
#pragma unroll
        for (int bj = 0; bj < 2; ++bj) { const int nc = 256 * ct + 128 * bj + 32 * wc + 8 * fq; jj[bj] = nc >> 4; cc[bj] = nc & 15; dv[bj][0] = *(const f32x4*)(dsk + g * 16 + cc[bj]); dv[bj][1] = *(const f32x4*)(dsk + g * 16 + cc[bj] + 4); }
#pragma unroll
        for (int ai = 0; ai < 2; ++ai) {
            u32x4 uv[4][2];
#pragma unroll
            for (int m = 0; m < 4; ++m) { const int R = u.pm * 256 + ai * 128 + wr * 64 + m * 16 + fr, rl = R & 1023, b = rl >> 7, ch = rl & 127;
#pragma unroll
                for (int bj = 0; bj < 2; ++bj) uv[m][bj] = *(const GAS_ u32x4*)(proj + (size_t)R * 640 + jj[bj] * 16 + cc[bj]); (void)b; (void)ch; }
#pragma unroll
            for (int m = 0; m < 4; ++m) { const int R = u.pm * 256 + ai * 128 + wr * 64 + m * 16 + fr, rl = R & 1023, b = rl >> 7, ch = rl & 127;
#pragma unroll
                for (int bj = 0; bj < 2; ++bj) { const size_t tok = (size_t)b * SEQ + ch * 32 + jj[bj];
                    const unsigned uw[4] = {uv[m][bj].x, uv[m][bj].y, uv[m][bj].z, uv[m][bj].w}; f32x4 o0, o1;
#pragma unroll
                    for (int q = 0; q < 4; ++q) { const float ua = q & 1 ? bf2f(uw[q >> 1] >> 16) : bf2f(uw[q >> 1] & 0xffff), ub = q & 1 ? bf2f(uw[2 + (q >> 1)] >> 16) : bf2f(uw[2 + (q >> 1)] & 0xffff);
                        o0[q] = gelu_tanh(acc[ai][bj][m][0][q] + dv[bj][0][q] * ua); o1[q] = gelu_tanh(acc[ai][bj][m][1][q] + dv[bj][1][q] * ub); }
                    *(GAS_ u32x4*)((GAS_ bf16_t*)yg + tok * 256 + g * 16 + cc[bj]) = pg8::pack8(o0, o1); } } }
    }
};
struct SsmDec1 { __device__ __forceinline__ void operator()(int L, Unit& u) const { u.pm = L; u.pn = L >> 2; } };
struct SsmDec2 { __device__ __forceinline__ void operator()(int L, Unit& u) const { u.pm = L >> 1; u.pn = ((L >> 3) << 1) | (L & 1); } };
__device__ __forceinline__ void ph_ssm_tab1(unsigned char* lds, Params P, int layer, int rot = 0) {
    const int TIDX = hidden_tid(P.wid), BIDX = launder_i((int)blockIdx.x), GDIM = launder_i((int)gridDim.x); P.ws = launder_ptr(P.ws);
    ssm_tables1(P, layer, lds, TIDX, GDIM >= 256 ? (BIDX + GDIM - rot) % GDIM : BIDX, GDIM);
}
__device__ __forceinline__ void ph_ssm_tab2(unsigned char* lds, Params P, int layer) {
    const int TIDX = hidden_tid(P.wid), BIDX = launder_i((int)blockIdx.x), GDIM = launder_i((int)gridDim.x); P.ws = launder_ptr(P.ws);
    ssm_tables2(P, layer, TIDX, BIDX, GDIM);
}
__device__ __forceinline__ void ph_ssm_gemm1(unsigned char* lds, Params P, int layer) {
    const int TIDX = hidden_tid(P.wid), BIDX = launder_i((int)blockIdx.x), GDIM = launder_i((int)gridDim.x); P.ws = launder_ptr(P.ws); (void)TIDX;
    pg8::Gemm g{(const bf16_t*)(P.ws + WS_UG), (const bf16_t*)(P.ws + W_B1T), 640, 512, 512, P.wid};
    pg8::ListOrder<SsmDec1> S{64, GDIM, GDIM >= 128 ? (BIDX + GDIM - 64) % GDIM : BIDX, SsmDec1{}};
    EpiSloc E{(float*)(P.ws + WS_SLOC)};
    pg8::gemm_phase<EpiSloc, pg8::ListOrder<SsmDec1>, true, true>(GEMM_LDS, g, S, E);
}
__device__ __forceinline__ void ph_ssm_carry(unsigned char* lds, Params P, int layer) {
    const int TIDX = hidden_tid(P.wid), BIDX = launder_i((int)blockIdx.x), GDIM = launder_i((int)gridDim.x); P.ws = launder_ptr(P.ws);
    if ((TIDX >> 6) == 0) for (int item = BIDX; item < 128; item += GDIM) ssm_carry(P, layer, item, TIDX & 63);
    __syncthreads();
}
struct SsmOrder2 {
    static constexpr bool GATHER = false;
    int c;
    __device__ __forceinline__ bool next(int i, Unit& u) const { if (c >= 64 || i >= 2) return false; u.pm = c; u.pn = ((c >> 2) << 1) | i; return true; }
    __device__ __forceinline__ void a_ready(const Unit&) const {}
    __device__ __forceinline__ void done(const Unit&) const {}
};
__device__ __forceinline__ void ph_ssm_gemm2(unsigned char* lds, Params P, int layer) {
    const int TIDX = hidden_tid(P.wid), BIDX = launder_i((int)blockIdx.x), GDIM = launder_i((int)gridDim.x); P.ws = launder_ptr(P.ws);
    {
        pg8::Gemm g1{(const bf16_t*)(P.ws + WS_UG), (const bf16_t*)(P.ws + W_B1T), 640, 512, 512, P.wid};
        pg8::ListOrder<SsmDec1> S1{64, GDIM, BIDX, SsmDec1{}};
        EpiSloc E1{(float*)(P.ws + WS_SLOC)};
        pg8::gemm_phase<EpiSloc, pg8::ListOrder<SsmDec1>, true, true>(GEMM_LDS, g1, S1, E1);
        asm volatile("s_waitcnt vmcnt(0)" ::: "memory");
        __syncthreads();
    }
    if (BIDX < 64) { const int wv = TIDX >> 6; if (wv < 2) ssm_carry(P, layer, (2 * (BIDX & 3) + wv) * 16 + (BIDX >> 2), TIDX & 63); }
    asm volatile("s_waitcnt vmcnt(0)" ::: "memory");
    __syncthreads();
    pg8::Gemm g{(const bf16_t*)(P.ws + WS_UG), (const bf16_t*)(P.ws + W_T2T), 640, 640, 640, P.wid};
    SsmOrder2 S{BIDX};
    EpiSsmY E{(const bf16_t*)(P.ws + WS_UG), (bf16_t*)(P.ws + WS_YG), P.ssm_d + layer * 256};
    pg8::gemm_phase<EpiSsmY, SsmOrder2, true, true>(GEMM_LDS, g, S, E);
}

__device__ __forceinline__ void unpack8(const u32x4 w, float (&f)[8]) {
    f[0] = bf2f(w.x & 0xffff); f[1] = bf2f(w.x >> 16); f[2] = bf2f(w.y & 0xffff); f[3] = bf2f(w.y >> 16);
    f[4] = bf2f(w.z & 0xffff); f[5] = bf2f(w.z >> 16); f[6] = bf2f(w.w & 0xffff); f[7] = bf2f(w.w >> 16); }
__device__ __forceinline__ u32x4 pack8f(const float (&f)[8]) { u32x4 o; o.x = pg8::cvt_pk_bf16(f[0], f[1]); o.y = pg8::cvt_pk_bf16(f[2], f[3]); o.z = pg8::cvt_pk_bf16(f[4], f[5]); o.w = pg8::cvt_pk_bf16(f[6], f[7]); return o; }
__device__ __forceinline__ float ssq8(const float (&f)[8]) { float s = 0.f;
#pragma unroll
    for (int j = 0; j < 8; ++j) s = fmaf(f[j], f[j], s);
    return s; }
__device__ __forceinline__ unsigned shxu(unsigned v, int o, int lane) { return (unsigned)__builtin_amdgcn_ds_bpermute((lane ^ o) << 2, (int)v); }

__device__ __forceinline__ void ph_passC2(unsigned char* lds, Params P, int layer) {
    const int TIDX = hidden_tid(P.wid), BIDX = launder_i((int)blockIdx.x), GDIM = launder_i((int)gridDim.x); P.ws = launder_ptr(P.ws);
    float (*lfs)[8] = (float (*)[8])lds;
    const int wid = TIDX >> 6, lane = TIDX & 63;
    bf16_t* proj = (bf16_t*)(P.ws + WS_PROJ); const float* fg = (const float*)(P.ws + WS_FG);
    float* rq = (float*)(P.ws + WS_RSTDQ); float* rkv = (float*)(P.ws + WS_RSTDKV);
    float* cloc = (float*)(P.ws + WS_CLOC); float* ctot = (float*)(P.ws + WS_CTOT); bf16_t* ug = (bf16_t*)(P.ws + WS_UG);
    float gq8[8], gk8[8];
#pragma unroll
    for (int j = 0; j < 8; ++j) { gq8[j] = P.fox_gq[layer * 64 + (lane & 7) * 8 + j] * C2_FOX; gk8[j] = P.fox_gk[layer * 64 + (lane & 7) * 8 + j]; }
    const int off1 = lane < 32 ? PC_CQ + lane * 8 : PC_CKV + (lane - 32) * 8;
    const int lf = lane < 48 ? lane : 0;
    for (int chunk = BIDX; chunk < T / 128; chunk += GDIM) {
        for (int i = 0; i < 16; i += 2) {
            u32x4 w1[2], wu[2], wq[2], wk[2];
#pragma unroll
            for (int k = 0; k < 2; ++k) { const bf16_t* pr = proj + (size_t)(chunk * 128 + wid * 16 + i + k) * PJ;
                w1[k] = *(const u32x4*)(pr + off1); wu[k] = *(const u32x4*)(pr + PC_U + (lane & 31) * 8);
                wq[k] = *(const u32x4*)(pr + PC_FQ + lf * 8); wk[k] = *(const u32x4*)(pr + PC_FK + lf * 8); }
#pragma unroll
            for (int k = 0; k < 2; ++k) {
                const int tl = wid * 16 + i + k, row = chunk * 128 + tl; bf16_t* pr = proj + (size_t)row * PJ;
                float v[8]; unpack8(w1[k], v); float s1 = lane < 48 ? ssq8(v) : 0.f;
                s1 += shx(s1, 1, lane); s1 += shx(s1, 2, lane); s1 += shx(s1, 4, lane); s1 += shx(s1, 8, lane);
                const float s1b = s1 + shx(s1, 16, lane);
                if (lane == 0) rq[row] = rsqrtf(s1b * (1.f / 256.f) + EPS);
                if (lane == 32) rkv[row] = rsqrtf(s1 * (1.f / 128.f) + EPS);
                if (lane < 32) { const int b_ = row / SEQ, t_ = row % SEQ;
                    *(u32x4*)(ug + (size_t)((lane >> 1) * 1024 + b_ * 128 + (t_ >> 5)) * 640 + (t_ & 31) * 16 + (lane & 1) * 8) = wu[k]; }
                float a[8], b[8]; unpack8(wq[k], a); unpack8(wk[k], b);
                float sa = ssq8(a), sb = ssq8(b);
                sa += shx(sa, 1, lane); sb += shx(sb, 1, lane); sa += shx(sa, 2, lane); sb += shx(sb, 2, lane); sa += shx(sa, 4, lane); sb += shx(sb, 4, lane);
                const float ra = rsqrtf(sa * (1.f / 64.f) + EPS), rb = rsqrtf(sb * (1.f / 64.f) + EPS);
#pragma unroll
                for (int j = 0; j < 8; ++j) { a[j] *= ra * gq8[j]; b[j] *= rb * gk8[j]; }
                if (lane < 48) { *(u32x4*)(pr + PC_FQ + lane * 8) = pack8f(a); *(u32x4*)(pr + PC_FK + lane * 8) = pack8f(b); }
                if (lane < 6) { const float z = fg[(size_t)row * 8 + lane] + P.fox_bf[layer * 6 + lane];
                    const float e = __expf(-fabsf(z)); lfs[tl][lane] = fminf(z, 0.f) - __logf(1.f + e); }
            }
        }
        __syncthreads();
        if (TIDX < 6) {
            const int h = TIDX, b = (chunk * 128) / SEQ, t0 = (chunk * 128) % SEQ; float run = 0.f;
            for (int j = 0; j < 128; ++j) { run += lfs[j][h]; cloc[((size_t)b * 6 + h) * SEQ + t0 + j] = run; }
            ctot[chunk * 8 + h] = run;
        }
        __syncthreads();
    }
}

__device__ __forceinline__ void ph_passE2(unsigned char* lds, Params P, int layer) {
    const int TIDX = hidden_tid(P.wid), BIDX = launder_i((int)blockIdx.x), GDIM = launder_i((int)gridDim.x); P.ws = launder_ptr(P.ws);
    const int wid = TIDX >> 6, lane = TIDX & 63, grp = lane >> 4, c = lane & 15; const bool act = c < 12, rop = act && c >= 8;
    const bf16_t* proj = (const bf16_t*)(P.ws + WS_PROJ); const bf16_t* qraw = (const bf16_t*)(P.ws + WS_QRAW); const bf16_t* kvraw = (const bf16_t*)(P.ws + WS_KVRAW);
    bf16_t* qm = (bf16_t*)(P.ws + WS_QMLA); bf16_t* km = (bf16_t*)(P.ws + WS_KMLA);
    const float* cs = (const float*)(P.ws + WS_COS); const float* sn = (const float*)(P.ws + WS_SIN);
    const int cc = act ? c : 0, cp = cc ^ 2;
    float gq8[8], gk8[8], gqp[8], gkp[8];
#pragma unroll
    for (int j = 0; j < 8; ++j) { gq8[j] = P.mla_gq[layer * 96 + cc * 8 + j] * C2_MLA; gk8[j] = P.mla_gk[layer * 96 + cc * 8 + j];
        gqp[j] = rop ? P.mla_gq[layer * 96 + cp * 8 + j] * C2_MLA : 0.f; gkp[j] = rop ? P.mla_gk[layer * 96 + cp * 8 + j] : 0.f; }
    const int hC = 4 + (grp & 1); const bool kC = grp >= 2;
    const int qoffA = grp * 96 + cc * 8, qoffC = hC * 96 + cc * 8;
    const int koffA = cc < 8 ? grp * 128 + cc * 8 : -1, koffC = cc < 8 ? hC * 128 + cc * 8 : -1;
    const int kroff = PC_KR + (cc & 3) * 8, j0 = (cc & 1) * 8;
    for (int chunk = BIDX; chunk < T / 128; chunk += GDIM) {
        for (int i = 0; i < 16; ++i) {
            const size_t row = (size_t)chunk * 128 + wid * 16 + i;
            u32x4 w[3];
            w[0] = *(const u32x4*)(qraw + row * 768 + qoffA);
            w[1] = koffA >= 0 ? *(const u32x4*)(kvraw + row * 768 + koffA) : *(const u32x4*)(proj + row * PJ + kroff);
            w[2] = !kC ? *(const u32x4*)(qraw + row * 768 + qoffC) : (koffC >= 0 ? *(const u32x4*)(kvraw + row * 768 + koffC) : *(const u32x4*)(proj + row * PJ + kroff));
            f32x4 c0 = {0.f, 0.f, 0.f, 0.f}, c1 = c0, s0 = c0, s1 = c0;
            if (rop) { c0 = *(const f32x4*)(cs + row * 16 + j0); c1 = *(const f32x4*)(cs + row * 16 + j0 + 4); s0 = *(const f32x4*)(sn + row * 16 + j0); s1 = *(const f32x4*)(sn + row * 16 + j0 + 4); }
            const float cv[8] = {c0[0], c0[1], c0[2], c0[3], c1[0], c1[1], c1[2], c1[3]}, sv[8] = {s0[0], s0[1], s0[2], s0[3], s1[0], s1[1], s1[2], s1[3]};
#pragma unroll
            for (int ps = 0; ps < 3; ++ps) {
                const bool isk = (ps == 1) || (ps == 2 && kC);
                float v[8]; unpack8(w[ps], v);
                float ss = act ? ssq8(v) : 0.f;
                ss += shx(ss, 1, lane); ss += shx(ss, 2, lane); ss += shx(ss, 4, lane); ss += shx(ss, 8, lane);
                const float r = rsqrtf(ss * (1.f / 96.f) + EPS);
                u32x4 pw; pw.x = shxu(w[ps].x, 2, lane); pw.y = shxu(w[ps].y, 2, lane); pw.z = shxu(w[ps].z, 2, lane); pw.w = shxu(w[ps].w, 2, lane);
                float pv[8]; unpack8(pw, pv);
                float o[8];
#pragma unroll
                for (int j = 0; j < 8; ++j) { const float n = v[j] * r * (isk ? gk8[j] : gq8[j]), pn = pv[j] * r * (isk ? gkp[j] : gqp[j]);
                    o[j] = !rop ? n : (c < 10 ? n * cv[j] - pn * sv[j] : pn * sv[j] + n * cv[j]); }
                if (act) { bf16_t* dst = ps == 0 ? qm + row * 576 + qoffA : (ps == 1 ? km + row * 576 + qoffA : (kC ? km : qm) + row * 576 + qoffC);
                    *(u32x4*)dst = pack8f(o); }
            }
        }
    }
    __syncthreads();
}

__device__ __forceinline__ void ph_fox_cumsum(unsigned char* lds, Params P, int layer) {
    const int TIDX = hidden_tid(P.wid), BIDX = launder_i((int)blockIdx.x), GDIM = launder_i((int)gridDim.x); P.ws = launder_ptr(P.ws);
    const int wid = TIDX >> 6, lane = TIDX & 63;
    const float* lf = (const float*)(P.ws + WS_FG); float* cb2 = (float*)(P.ws + WS_CB2); float* wtot = (float*)lds;
    const int first = GDIM >= 256 ? (BIDX + GDIM - 192) % GDIM : BIDX;
    for (int item = first; item < NB * 6; item += GDIM) {
        const int b = item / 6, h = item % 6;
        float v[8];
#pragma unroll
        for (int j = 0; j < 8; ++j) v[j] = lf[((size_t)b * SEQ + TIDX * 8 + j) * 8 + h];
        float run = 0.f;
#pragma unroll
        for (int j = 0; j < 8; ++j) { run += v[j]; v[j] = run; }
        float incl = run;
#pragma unroll
        for (int o = 1; o < 64; o <<= 1) { const float t = __int_as_float(__builtin_amdgcn_ds_bpermute(((lane - o) & 63) << 2, __float_as_int(incl))); if (lane >= o) incl += t; }
        __syncthreads();
        if (lane == 63) wtot[wid] = incl;
        __syncthreads();
        float base = incl - run;
#pragma unroll
        for (int w = 0; w < 8; ++w) if (w < wid) base += wtot[w];
        float* dst = cb2 + ((size_t)b * 6 + h) * SEQ + TIDX * 8;
        *(f32x4*)dst = (f32x4){(base + v[0]) * LOG2E, (base + v[1]) * LOG2E, (base + v[2]) * LOG2E, (base + v[3]) * LOG2E};
        *(f32x4*)(dst + 4) = (f32x4){(base + v[4]) * LOG2E, (base + v[5]) * LOG2E, (base + v[6]) * LOG2E, (base + v[7]) * LOG2E};
    }
    __syncthreads();
}

#define XB_TMO      128
#define XB_XCNT(j)  (256  + 64 * (j))
#define XB_XSUB(j)  (1280 + 64 * (j))
#define XB_XGEN(j)  (2304 + 64 * (j))
#define XB_TOP      3328
#define XB_TOPGEN   3392
#define XCD_BAR_WORDS 3456
#define XB_SPIN_CAP (1u << 18)
#define LAS __attribute__((address_space(3)))

__device__ __forceinline__ unsigned xb_ld(unsigned* p)              { return __hip_atomic_load(p, __ATOMIC_RELAXED, __HIP_MEMORY_SCOPE_AGENT); }
__device__ __forceinline__ unsigned xb_add(unsigned* p, unsigned v) { return __hip_atomic_fetch_add(p, v, __ATOMIC_RELAXED, __HIP_MEMORY_SCOPE_AGENT); }
__device__ __forceinline__ unsigned xb_xcc_id() { return (unsigned)__builtin_amdgcn_s_getreg((3 << 11) | 20) & 0xFu; }
#define XB_SPIN(cond, bar) do { unsigned _sp = 0; while (cond) { __builtin_amdgcn_s_sleep(1); \
    if ((++_sp & 255u) == 0u) { if (xb_ld(&(bar)[XB_TMO])) break; if (_sp > XB_SPIN_CAP) { atomicAdd(&(bar)[XB_TMO], 1u); break; } } } } while (0)

struct XcdBarrier {
    unsigned* bar; unsigned x;
    volatile LAS unsigned* st;
};

__device__ __forceinline__ XcdBarrier xcd_barrier_post(unsigned* bar, volatile LAS unsigned* st) {
    XcdBarrier b; b.bar = bar; b.x = xb_xcc_id(); b.st = st;
    if (threadIdx.x == 0) (void)xb_add(&bar[XB_XCNT(b.x)], 1u);
    return b;
}
__device__ __forceinline__ void xcd_barrier_complete(unsigned* bar, unsigned x, unsigned& nloc, unsigned& nx) {
    const unsigned G = gridDim.x * gridDim.y * gridDim.z;
    unsigned sum, cnt, mine, sp = 0u;
    for (;;) {
        sum = 0u; cnt = 0u; mine = 0u;
#pragma unroll
        for (unsigned j = 0; j < 16; ++j) { const unsigned c = xb_ld(&bar[XB_XCNT(j)]); sum += c; cnt += (c > 0u) ? 1u : 0u; mine = (j == x) ? c : mine; }
        if (sum == G) break;
        __builtin_amdgcn_s_sleep(1);
        if ((++sp & 255u) == 0u) { if (xb_ld(&bar[XB_TMO])) break; if (sp > XB_SPIN_CAP) { atomicAdd(&bar[XB_TMO], 1u); break; } }
    }
    nloc = mine > 0u ? mine : 1u; nx = cnt > 0u ? cnt : 1u;
}

__device__ __forceinline__ void xcd_barrier(const XcdBarrier& b) {
    asm volatile("s_waitcnt vmcnt(0)" ::: "memory");
    __syncthreads();
    if (threadIdx.x == 0) {
        unsigned* bar = b.bar;
        __builtin_amdgcn_s_waitcnt(0);
        unsigned nloc = b.st[0], nx = b.st[1];
        if (nloc == 0u) { xcd_barrier_complete(bar, b.x, nloc, nx); b.st[0] = nloc; b.st[1] = nx; }
        const unsigned old = xb_add(&bar[XB_XSUB(b.x)], 1u);
        const unsigned gen = old / nloc;
        if (old + 1u == (gen + 1u) * nloc) {
            __builtin_amdgcn_fence(__ATOMIC_RELEASE, "agent");
            asm volatile("s_waitcnt vmcnt(0)" ::: "memory");
            const unsigned og = xb_add(&bar[XB_TOP], 1u);
            const unsigned tg = og / nx;
            if (og + 1u == (tg + 1u) * nx) xb_add(&bar[XB_TOPGEN], 1u);
            else XB_SPIN(xb_ld(&bar[XB_TOPGEN]) == tg, bar);
            __builtin_amdgcn_fence(__ATOMIC_ACQUIRE, "agent");
            xb_add(&bar[XB_XGEN(b.x)], 1u);
            asm volatile("s_waitcnt vmcnt(0)" ::: "memory");
        } else {
            XB_SPIN(xb_ld(&bar[XB_XGEN(b.x)]) == gen, bar);
            __builtin_amdgcn_fence(__ATOMIC_ACQUIRE, "agent");
            asm volatile("s_waitcnt vmcnt(0)" ::: "memory");
        }
    }
    __syncthreads();
}

extern __shared__ __attribute__((aligned(16))) unsigned char dlds[];
constexpr int LDS_BYTES = 147456, LDS_MISC = 131072;
constexpr int CW_BAR = 4096;

#define ATTN_MLA_ARGS(P) (const bf16_t*)((P).ws + WS_QMLA), 576, (const bf16_t*)((P).ws + WS_KMLA), 576, (const bf16_t*)((P).ws + WS_KVRAW) + 64, 768, 128, (bf16_t*)((P).ws + WS_OBUF), 768, (const float*)nullptr
#define ATTN_FOX_ARGS(P) (const bf16_t*)((P).ws + WS_PROJ) + PC_FQ, PJ, (const bf16_t*)((P).ws + WS_PROJ) + PC_FK, PJ, (const bf16_t*)((P).ws + WS_PROJ) + PC_FV, PJ, 64, (bf16_t*)((P).ws + WS_OBUF) + 384, 768, (const float*)((P).ws + WS_CB2)

typedef const __attribute__((address_space(4))) Params* KParams;
template <class T> __device__ __forceinline__ T launder_s(T p) { asm volatile("" : "+s"(p)); return p; }
__device__ __forceinline__ Params load_params(KParams kp, int wid) { Params r; r.x = kp->x; r.c = kp->c; r.pos = kp->pos; r.norm_mix = kp->norm_mix; r.norm_ffn = kp->norm_ffn; r.w_ada = kp->w_ada; r.b_ada = kp->b_ada; r.w_in = kp->w_in; r.lam_re = kp->lam_re; r.lam_im = kp->lam_im; r.log_dt = kp->log_dt; r.b_re = kp->b_re; r.b_im = kp->b_im; r.c_re = kp->c_re; r.c_im = kp->c_im; r.ssm_d = kp->ssm_d; r.w_glu = kp->w_glu; r.b_glu = kp->b_glu; r.q_norm = kp->q_norm; r.kv_norm = kp->kv_norm; r.w_uq = kp->w_uq; r.w_ukv = kp->w_ukv; r.mla_gq = kp->mla_gq; r.mla_gk = kp->mla_gk; r.fox_bf = kp->fox_bf; r.fox_gq = kp->fox_gq; r.fox_gk = kp->fox_gk; r.out_norm = kp->out_norm; r.w_out = kp->w_out; r.ffn_wg = kp->ffn_wg; r.ffn_wu = kp->ffn_wu; r.ffn_wd = kp->ffn_wd; r.moe_wr = kp->moe_wr; r.moe_br = kp->moe_br; r.moe_wg = kp->moe_wg; r.moe_wu = kp->moe_wu; r.moe_wd = kp->moe_wd; r.out = kp->out; r.ws = kp->ws; r.wid = wid; r.pad = 0; return r; }
__device__ __forceinline__ void sub64_barrier(unsigned* word) {
    asm volatile("s_waitcnt vmcnt(0)" ::: "memory");
    __syncthreads();
    if (threadIdx.x == 0) {
        __builtin_amdgcn_s_waitcnt(0);
        __builtin_amdgcn_fence(__ATOMIC_RELEASE, "agent");
        asm volatile("s_waitcnt vmcnt(0)" ::: "memory");
        (void)xb_add(word, 1u);
        unsigned sp = 0; while (xb_ld(word) < 64u) { __builtin_amdgcn_s_sleep(1); if (++sp > XB_SPIN_CAP) break; }
        __builtin_amdgcn_fence(__ATOMIC_ACQUIRE, "agent");
        asm volatile("s_waitcnt vmcnt(0)" ::: "memory");
    }
    __syncthreads();
}
__device__ __forceinline__ void ph_glu_sub(unsigned char* lds, Params P, int layer) {
    const int BIDX = launder_i((int)blockIdx.x), GDIM = launder_i((int)gridDim.x);
    if (GDIM < 64) return;
    if (BIDX < 64) { sub64_barrier((unsigned*)(launder_ptr(P.ws) + WS_CTL) + CW_SUB + (layer & 7) * 32); ph_glu_opt(lds, P, layer, 1); }
}
__global__ void __launch_bounds__(512, 2) k_mega(Params P_karg) {
    const KParams kp = (KParams)__builtin_amdgcn_kernarg_segment_ptr();
const int wid_s = __builtin_amdgcn_readfirstlane((int)(threadIdx.x >> 6));
#define P load_params(launder_s(kp), wid_s)
    unsigned char* lds = dlds;
    volatile LAS unsigned* xbw = (volatile LAS unsigned*)(dlds + LDS_MISC);
    if (threadIdx.x < 4) xbw[threadIdx.x] = 0u;
    __syncthreads();
    (void)xcd_barrier_post((unsigned*)(launder_s(kp)->ws + WS_CTL) + CW_BAR, xbw);
#define GBAR() do { XcdBarrier b_; b_.bar = (unsigned*)(launder_s(kp)->ws + WS_CTL) + CW_BAR; b_.x = xb_xcc_id(); b_.st = (volatile LAS unsigned*)(dlds + LDS_MISC); xcd_barrier(b_); if (DUP & 65536) xcd_barrier(b_); } while (0)
    ph_prologue(lds, P);
    if (DUP & (1 << 10)) { GBAR(); ph_prologue(lds, P); }
    ph_convert(lds, P, 0); ph_ssm_tab1(lds, P, 0);
    GBAR();
    for (int layer = 0; layer < DEPTH; ++layer) {
#define DUPIF(bit, ...) if (DUP & (1 << (bit))) { GBAR(); __VA_ARGS__ }
        { const Params Pl = P; if (layer == 0) ph_norm<0, 1>(lds, Pl, layer, Pl.x, -1); else if (layer == 2) ph_norm<0, 2>(lds, Pl, layer, nullptr, 1); else ph_norm<0, 0>(lds, Pl, layer, nullptr, -1); }
        if (layer != 0) ph_convert(lds, P, layer);
        if (layer != 2) { DUPIF(19, { const Params Pl = P; if (layer == 0) ph_norm<0, 1>(lds, Pl, layer, Pl.x, -1); else ph_norm<0, 0>(lds, Pl, layer, nullptr, -1); }) }
        DUPIF(13, ph_convert(lds, P, layer);)
        DUPIF(14, ph_ssm_tab1(lds, P, layer);)
        GBAR();
        ph_inproj_opt(lds, P, layer);
        GBAR();
        ph_ssm_tab2(lds, P, layer);
        DUPIF(12, ph_ssm_tab2(lds, P, layer);)
        ph_fox_cumsum(lds, P, layer);
        ph_qup_opt(lds, P, layer); ph_kvup_opt(lds, P, layer);
        DUPIF(1, ph_qup_opt(lds, P, layer); ph_kvup_opt(lds, P, layer); ph_ssm_gemm1(lds, P, layer);)
        GBAR();
        if (layer + 1 < DEPTH) ph_ssm_tab1(lds, P, layer + 1, 128);
        ph_ssm_gemm2(lds, P, layer);
        ph_glu_sub(lds, P, layer);
        ph_attn_all(lds, P, layer);
        DUPIF(2, ph_ssm_gemm2(lds, P, layer); ph_attn_mla(lds, P, layer + 4); ph_attn_fox(lds, P, layer + 4);)
        GBAR();
        if (launder_i((int)gridDim.x) < 64) { ph_glu_opt(lds, P, layer); GBAR(); }
        DUPIF(17, ph_outproj_opt(lds, P, layer, 1);)
        ph_outproj_opt(lds, P, layer);
        GBAR();
        if ((layer & 1) == 0) {
            { const Params Pl = P; ph_norm<1, 0>(lds, Pl, layer, nullptr, -1); }
            DUPIF(8, { const Params Pl = P; ph_norm<1, 0>(lds, Pl, layer, nullptr, -1); })
            GBAR();
            ph_ffn1_opt(lds, P, layer);
            DUPIF(4, ph_ffn1_opt(lds, P, layer);)
            GBAR();
            DUPIF(18, ph_ffn2_opt(lds, P, layer, 1);)
            ph_ffn2_opt(lds, P, layer);
            GBAR();
        } else {
            { const Params Pl = P; ph_norm<2, 0>(lds, Pl, layer, nullptr, -1); }
            GBAR();
            ph_moe1_opt(lds, P, layer);
            DUPIF(4, ph_moe1_opt(lds, P, layer);)
            GBAR();
            ph_moe2_opt(lds, P, layer);
            DUPIF(4, ph_moe2_opt(lds, P, layer);)
            GBAR();
            if (layer == DEPTH - 1) ph_moe_combine(lds, P, layer);
        }
    }
}
#undef P

#if CHECK || !MEGA
#define KWRAP(NAME, DECL, CALL) __global__ void __launch_bounds__(512, 2) k_##NAME DECL { P.wid = __builtin_amdgcn_readfirstlane((int)(threadIdx.x >> 6)); ph_##NAME CALL; }
#define KWRAPT(NAME, TDECL, TARGS, DECL, CALL) template <TDECL> __global__ void __launch_bounds__(512, 2) k_##NAME DECL { P.wid = __builtin_amdgcn_readfirstlane((int)(threadIdx.x >> 6)); ph_##NAME<TARGS> CALL; }
KWRAP(prologue, (Params P), (dlds, P))
KWRAPT(norm, int MODE, MODE, (Params P, int layer, const float* src, int copy, int comb), (dlds, P, layer, src, copy, comb))
KWRAP(convert, (Params P, int layer), (dlds, P, layer))
KWRAP(inproj_opt, (Params P, int layer), (dlds, P, layer))
KWRAP(inproj_naive, (Params P, int layer, int chk), (dlds, P, layer, chk))
KWRAP(fox_cumsum, (Params P, int layer), (dlds, P, layer))
KWRAP(qup_opt, (Params P, int layer), (dlds, P, layer))
KWRAP(kvup_opt, (Params P, int layer), (dlds, P, layer))
KWRAP(qup_naive, (Params P, int layer, int chk), (dlds, P, layer, chk))
KWRAP(kvup_naive, (Params P, int layer, int chk), (dlds, P, layer, chk))
KWRAP(passE2, (Params P, int layer), (dlds, P, layer))
template <int DQK, int MODE> __global__ void __launch_bounds__(512, 2) k_attn_naive(Params P, const bf16_t* Q, int ldq, const bf16_t* K, int ldk, const bf16_t* V, int ldv, int vhs, bf16_t* O, int ldo, const float* cb2, int chk) {
    P.wid = __builtin_amdgcn_readfirstlane((int)(threadIdx.x >> 6)); ph_attn_naive<DQK, MODE>(dlds, P, Q, ldq, K, ldk, V, ldv, vhs, O, ldo, cb2, chk); }
KWRAP(attn_mla, (Params P, int layer), (dlds, P, layer))
KWRAP(attn_fox, (Params P, int layer), (dlds, P, layer))
KWRAP(ssm_tab1, (Params P, int layer), (dlds, P, layer))
KWRAP(ssm_tab2, (Params P, int layer), (dlds, P, layer))
KWRAP(ssm_gemm1, (Params P, int layer), (dlds, P, layer))
KWRAP(ssm_carry, (Params P, int layer), (dlds, P, layer))
KWRAP(ssm_gemm2, (Params P, int layer), (dlds, P, layer))
KWRAP(ssm_naive, (Params P, int layer, int chk), (dlds, P, layer, chk))
KWRAP(glu_opt, (Params P, int layer), (dlds, P, layer))
KWRAP(glu_naive, (Params P, int layer, int chk), (dlds, P, layer, chk))
KWRAP(merge, (Params P), (dlds, P))
KWRAP(outproj_opt, (Params P, int layer), (dlds, P, layer))
KWRAP(outproj_naive, (Params P, int layer, float* dst, int chk), (dlds, P, layer, dst, chk))
KWRAP(cmp_x, (Params P, const float* xe, int stage), (dlds, P, xe, stage))
KWRAP(ffn1_opt, (Params P, int layer), (dlds, P, layer))
KWRAP(ffn2_opt, (Params P, int layer), (dlds, P, layer))
KWRAP(ffn1_naive, (Params P, int layer, int chk), (dlds, P, layer, chk))
KWRAP(ffn2_naive, (Params P, int layer, float* dst, int chk), (dlds, P, layer, dst, chk))
KWRAP(moe_gather, (Params P, int layer), (dlds, P, layer))
KWRAP(moe1_opt, (Params P, int layer), (dlds, P, layer))
KWRAP(moe2_opt, (Params P, int layer), (dlds, P, layer))
KWRAP(moe1_naive, (Params P, int layer, int chk), (dlds, P, layer, chk))
KWRAP(moe2_naive, (Params P, int layer, int chk), (dlds, P, layer, chk))
KWRAP(moe_combine, (Params P, int layer), (dlds, P, layer))
KWRAP(check_final, (Params P), (dlds, P))
#endif

template <class... KA, class... A> static void launch(void (*k)(KA...), int grid, hipStream_t stream, A... a) {
    (void)hipFuncSetAttribute((const void*)k, hipFuncAttributeMaxDynamicSharedMemorySize, LDS_BYTES);
    hipLaunchKernelGGL(k, dim3(grid), dim3(512), LDS_BYTES, stream, a...);
}
extern "C" void kernel_launch(void* const* d_in, const int* in_sizes, int n_in, void* d_out, int out_size, void* d_ws, size_t ws_size, hipStream_t stream) {
    if (ws_size < WS_END || n_in < 37) return;
    Params P{};
    P.x = (const float*)d_in[0]; P.c = (const float*)d_in[1]; P.pos = (const int*)d_in[2]; P.norm_mix = (const float*)d_in[3]; P.norm_ffn = (const float*)d_in[4];
    P.w_ada = (const float*)d_in[5]; P.b_ada = (const float*)d_in[6]; P.w_in = (const float*)d_in[7];
    P.lam_re = (const float*)d_in[8]; P.lam_im = (const float*)d_in[9]; P.log_dt = (const float*)d_in[10]; P.b_re = (const float*)d_in[11]; P.b_im = (const float*)d_in[12];
    P.c_re = (const float*)d_in[13]; P.c_im = (const float*)d_in[14]; P.ssm_d = (const float*)d_in[15]; P.w_glu = (const float*)d_in[16]; P.b_glu = (const float*)d_in[17];
    P.q_norm = (const float*)d_in[18]; P.kv_norm = (const float*)d_in[19]; P.w_uq = (const float*)d_in[20]; P.w_ukv = (const float*)d_in[21]; P.mla_gq = (const float*)d_in[22]; P.mla_gk = (const float*)d_in[23];
    P.fox_bf = (const float*)d_in[24]; P.fox_gq = (const float*)d_in[25]; P.fox_gk = (const float*)d_in[26]; P.out_norm = (const float*)d_in[27]; P.w_out = (const float*)d_in[28];
    P.ffn_wg = (const float*)d_in[29]; P.ffn_wu = (const float*)d_in[30]; P.ffn_wd = (const float*)d_in[31];
    P.moe_wr = (const float*)d_in[32]; P.moe_br = (const float*)d_in[33]; P.moe_wg = (const float*)d_in[34]; P.moe_wu = (const float*)d_in[35]; P.moe_wd = (const float*)d_in[36];
    P.out = (float*)d_out; P.ws = (unsigned char*)d_ws;
    (void)hipMemsetAsync(d_ws, 0, CTL_BYTES, stream);
#if MEGA && !CHECK
    static int grid = 0;
    if (!grid) { int dev = 0, cus = 0; (void)hipGetDevice(&dev); (void)hipDeviceGetAttribute(&cus, hipDeviceAttributeMultiprocessorCount, dev); grid = cus > 0 ? cus : 256; }
    launch(k_mega, grid, stream, P);
#else
    float* xe = (float*)(P.ws + WS_XE);
    const int G = 256;
    launch(k_prologue, G, stream, P);
    for (int layer = 0; layer < DEPTH; ++layer) {
        launch(k_norm<0>, G * 4, stream, P, layer, layer == 0 ? P.x : (const float*)P.out, (layer == 0 || layer == 2) ? 1 : 0, layer == 2 ? 1 : -1);
        launch(k_convert, G, stream, P, layer);
        launch(k_ssm_tab1, G, stream, P, layer);
        launch(k_inproj_opt, G, stream, P, layer);
        launch(k_fox_cumsum, G, stream, P, layer);
        launch(k_ssm_tab2, G, stream, P, layer);
        launch(k_qup_opt, G, stream, P, layer); launch(k_kvup_opt, G, stream, P, layer);
        if (CHECK) { launch(k_qup_naive, G * 4, stream, P, layer, 2); launch(k_kvup_naive, G * 4, stream, P, layer, 3); }
        launch(k_ssm_gemm1, G, stream, P, layer);
        launch(k_ssm_gemm2, G, stream, P, layer);
        launch(k_attn_mla, G, stream, P, layer); launch(k_attn_fox, G, stream, P, layer);
        if (CHECK) { launch(k_attn_naive<96, 0>, 384, stream, P, ATTN_MLA_ARGS(P), 10); launch(k_attn_naive<64, 1>, 384, stream, P, ATTN_FOX_ARGS(P), 11); }
        if (CHECK) launch(k_ssm_naive, 16, stream, P, layer, 12);
        launch(k_glu_opt, G, stream, P, layer);
        if (CHECK) launch(k_glu_naive, G * 2, stream, P, layer, 4);
        launch(k_merge, G * 4, stream, P);
        if (CHECK) launch(k_outproj_naive, G * 4, stream, P, layer, xe, 5);
        launch(k_outproj_opt, G, stream, P, layer);
        if (CHECK) launch(k_cmp_x, G * 4, stream, P, (const float*)xe, 5);
        if ((layer & 1) == 0) {
            launch(k_norm<1>, G * 4, stream, P, layer, (const float*)P.out, 0, -1);
            launch(k_ffn1_opt, G, stream, P, layer);
            if (CHECK) { launch(k_ffn1_naive, G * 8, stream, P, layer, 6); launch(k_ffn2_naive, G * 4, stream, P, layer, xe, 7); }
            launch(k_ffn2_opt, G, stream, P, layer);
            if (CHECK) launch(k_cmp_x, G * 4, stream, P, (const float*)xe, 7);
        } else {
            launch(k_norm<2>, G * 4, stream, P, layer, (const float*)P.out, 0, -1);
            launch(k_moe1_opt, G, stream, P, layer);
            if (CHECK) launch(k_moe1_naive, G * 8, stream, P, layer, 8);
            launch(k_moe2_opt, G, stream, P, layer);
            if (CHECK) launch(k_moe2_naive, G * 4, stream, P, layer, 9);
            if (layer == DEPTH - 1) launch(k_moe_combine, G * 4, stream, P, layer);
        }
    }
    if (CHECK) launch(k_check_final, G * 4, stream, P);
#endif
}
```
